# Optimizing an MI355X kernel written in HIP

```python
import jax, jax.numpy as jnp
from jax import lax
import numpy as np

D_MODEL = 1024
BATCH = 2
SEQ = 8192
DEPTH = 2

CHUNK = 64
D_POOL = D_MODEL // 4
POOL_WINDOWS = (2, 4, 8, 16)
N_POOL_GROUPS = len(POOL_WINDOWS)
POOL_GROUP = D_POOL // N_POOL_GROUPS
D_GMLP = 3 * D_MODEL // 8
GMLP_HEADS = 4
GMLP_HEAD_DIM = D_GMLP // GMLP_HEADS
GMLP_BLOCK = 128
D_CONV = D_MODEL - D_POOL - D_GMLP
CONV_WIDTH = 31
D_MIX = D_POOL + D_GMLP + D_CONV
D_IN = D_POOL + 2 * D_GMLP + 2 * D_CONV
D_FF = 2816
N_EXPERTS = 8
TOP_K = 2
D_FF_EXPERT = 3584
N_DENSE = (DEPTH + 1) // 2
N_MOE = DEPTH // 2
EPS = 1e-6

kernel_name = "hybrid_pool_gmlp_conv_moe_trunk"


def rms_norm(x, g):
    xf = x.astype(jnp.float32)
    y = xf * lax.rsqrt(jnp.mean(xf * xf, axis=-1, keepdims=True) + EPS)
    return (y * g.astype(jnp.float32)).astype(x.dtype)


def layer_norm(x, g, b):
    xf = x.astype(jnp.float32)
    mu = jnp.mean(xf, axis=-1, keepdims=True)
    var = jnp.mean(jnp.square(xf - mu), axis=-1, keepdims=True)
    y = (xf - mu) * lax.rsqrt(var + EPS)
    return (y * g.astype(jnp.float32) + b.astype(jnp.float32)).astype(x.dtype)


def pool_mixer(a, w, scale):
    B, S, _ = a.shape
    af = a.astype(jnp.float32)
    csum = jnp.cumsum(af, axis=1)
    t = jnp.arange(1, S + 1, dtype=jnp.float32)
    outs = []
    for gi, win in enumerate(POOL_WINDOWS):
        sl = slice(gi * POOL_GROUP, (gi + 1) * POOL_GROUP)
        c = csum[..., sl]
        c_prev = jnp.pad(c[:, :-win], ((0, 0), (win, 0), (0, 0)))
        mean = (c - c_prev) / jnp.minimum(t, float(win))[None, :, None]
        outs.append(mean - af[..., sl])
    y = jnp.stack(outs, axis=2).astype(a.dtype)
    y = jnp.einsum('bsgc,gcd->bsgd', y, w).reshape(B, S, D_POOL)
    return y * scale


def gmlp_mixer(u, v, g, ws, b):
    B, S, _ = u.shape
    v = rms_norm(v, g)
    n_blk = S // GMLP_BLOCK
    vb = v.reshape(B, n_blk, GMLP_BLOCK, GMLP_HEADS, GMLP_HEAD_DIM)
    ci = jnp.arange(GMLP_BLOCK) // CHUNK
    mask = ci[:, None] >= ci[None, :]
    ws_m = jnp.where(mask[None], ws, jnp.zeros_like(ws))
    z = jnp.einsum('hij,bnjhc->bnihc', ws_m, vb) + b.T[None, None, :, :, None]
    return u * z.reshape(B, S, D_GMLP)


def conv_module(val, gate, w_dw, b_dw, ln_g, ln_b, w_pw, b_pw):
    h = val * jax.nn.sigmoid(gate)
    h = lax.conv_general_dilated(
        h, w_dw[:, None, :], window_strides=(1,),
        padding=((CONV_WIDTH - 1, 0),),
        dimension_numbers=('NWC', 'WIO', 'NWC'),
        feature_group_count=D_CONV) + b_dw
    h = jax.nn.silu(layer_norm(h, ln_g, ln_b))
    return h @ w_pw + b_pw


def swiglu(h, wg, wu, wd):
    return (jax.nn.silu(h @ wg) * (h @ wu)) @ wd


def moe_swiglu(h, router, wg, wu, wd):
    B, S, D = h.shape
    t = h.reshape(B * S, D)
    logits = t.astype(jnp.float32) @ router.astype(jnp.float32)
    top_v, top_i = lax.top_k(logits, TOP_K)
    top_w = jax.nn.softmax(top_v, axis=-1)
    gates = jnp.sum(jax.nn.one_hot(top_i, N_EXPERTS, dtype=jnp.float32)
                    * top_w[..., None], axis=1)
    out = jnp.zeros_like(t)
    for e in range(N_EXPERTS):
        out = out + gates[:, e:e + 1].astype(t.dtype) * swiglu(t, wg[e], wu[e], wd[e])
    return out.reshape(B, S, D)


def setup_inputs(seed: int = 0) -> dict:
    key = jax.random.key(seed)
    k = jax.random.split(key, 26)
    f32 = jnp.float32
    nrm = lambda kk, shape, s: jax.random.normal(kk, shape, f32) * s
    return {
        "x": nrm(k[0], (BATCH, SEQ, D_MODEL), 1.0),
        "norm1_g": 1.0 + nrm(k[1], (DEPTH, D_MODEL), 0.05),
        "w_in": nrm(k[2], (DEPTH, D_MODEL, D_IN), D_MODEL ** -0.5),
        "pool_w": nrm(k[3], (DEPTH, N_POOL_GROUPS, POOL_GROUP, POOL_GROUP), POOL_GROUP ** -0.5),
        "pool_scale": 1.0 + nrm(k[4], (DEPTH, D_POOL), 0.1),
        "gm_norm_g": 1.0 + nrm(k[5], (DEPTH, D_GMLP), 0.05),
        "gm_ws": nrm(k[6], (DEPTH, GMLP_HEADS, GMLP_BLOCK, GMLP_BLOCK), 0.5 * GMLP_BLOCK ** -0.5),
        "gm_b": 1.0 + nrm(k[7], (DEPTH, GMLP_HEADS, GMLP_BLOCK), 0.1),
        "conv_dw_w": nrm(k[8], (DEPTH, CONV_WIDTH, D_CONV), CONV_WIDTH ** -0.5),
        "conv_dw_b": nrm(k[9], (DEPTH, D_CONV), 0.02),
        "conv_ln_g": 1.0 + nrm(k[10], (DEPTH, D_CONV), 0.05),
        "conv_ln_b": nrm(k[11], (DEPTH, D_CONV), 0.02),
        "conv_pw_w": nrm(k[12], (DEPTH, D_CONV, D_CONV), D_CONV ** -0.5),
        "conv_pw_b": nrm(k[13], (DEPTH, D_CONV), 0.02),
        "w_out": nrm(k[14], (DEPTH, D_MIX, D_MODEL), D_MIX ** -0.5),
        "norm2_g": 1.0 + nrm(k[15], (DEPTH, D_MODEL), 0.05),
        "ffn_wg": nrm(k[16], (N_DENSE, D_MODEL, D_FF), D_MODEL ** -0.5),
        "ffn_wu": nrm(k[17], (N_DENSE, D_MODEL, D_FF), D_MODEL ** -0.5),
        "ffn_wd": nrm(k[18], (N_DENSE, D_FF, D_MODEL), D_FF ** -0.5),
        "moe_router": nrm(k[19], (N_MOE, D_MODEL, N_EXPERTS), D_MODEL ** -0.5),
        "moe_wg": nrm(k[20], (N_MOE, N_EXPERTS, D_MODEL, D_FF_EXPERT), D_MODEL ** -0.5),
        "moe_wu": nrm(k[21], (N_MOE, N_EXPERTS, D_MODEL, D_FF_EXPERT), D_MODEL ** -0.5),
        "moe_wd": nrm(k[22], (N_MOE, N_EXPERTS, D_FF_EXPERT, D_MODEL), D_FF_EXPERT ** -0.5),
        "final_g": 1.0 + nrm(k[23], (D_MODEL,), 0.05),
    }


def reference(x, norm1_g, w_in, pool_w, pool_scale, gm_norm_g, gm_ws, gm_b,
              conv_dw_w, conv_dw_b, conv_ln_g, conv_ln_b, conv_pw_w, conv_pw_b,
              w_out, norm2_g, ffn_wg, ffn_wu, ffn_wd,
              moe_router, moe_wg, moe_wu, moe_wd, final_g):
    splits = [D_POOL, D_POOL + D_GMLP, D_POOL + 2 * D_GMLP,
              D_POOL + 2 * D_GMLP + D_CONV]
    for l in range(DEPTH):
        h = rms_norm(x, norm1_g[l])
        p = h @ w_in[l]
        a, u, v, cv, cg = jnp.split(p, splits, axis=-1)
        ya = pool_mixer(a, pool_w[l], pool_scale[l])
        yb = gmlp_mixer(u, v, gm_norm_g[l], gm_ws[l], gm_b[l])
        yc = conv_module(cv, cg, conv_dw_w[l], conv_dw_b[l], conv_ln_g[l],
                         conv_ln_b[l], conv_pw_w[l], conv_pw_b[l])
        x = x + jnp.concatenate([ya, yb, yc], axis=-1) @ w_out[l]
        h = rms_norm(x, norm2_g[l])
        if l % 2 == 0:
            j = l // 2
            x = x + swiglu(h, ffn_wg[j], ffn_wu[j], ffn_wd[j])
        else:
            j = l // 2
            x = x + moe_swiglu(h, moe_router[j], moe_wg[j], moe_wu[j], moe_wd[j])
    return rms_norm(x, final_g)
```

```cpp
#define MK_PER_PHASE 0
#include <hip/hip_runtime.h>
#include <cstdio>
#include <cstdint>
constexpr int M = 16384, D = 1024, SEQ = 8192, DIN = 1792, DFF = 2816, DFE = 3584, NE = 8;
constexpr int DPOOL = 256, DGM = 384, DCV = 384;
constexpr int NGU = 2 * DFF, NGUE = 2 * DFE;
constexpr int ECAP = 16384;
constexpr int PMAX = 2 * M + NE * 256;
constexpr float EPS = 1e-6f;

#define LAS __attribute__((address_space(3)))
#define GAS __attribute__((address_space(1)))
typedef unsigned short bf16;
typedef short bf16x8 __attribute__((ext_vector_type(8)));
typedef short s16x4 __attribute__((ext_vector_type(4)));
typedef float f32x4 __attribute__((ext_vector_type(4)));
typedef float f32x2 __attribute__((ext_vector_type(2)));
typedef unsigned u32x4 __attribute__((ext_vector_type(4)));
typedef unsigned u32x2 __attribute__((ext_vector_type(2)));

__device__ __forceinline__ unsigned cvt_pk_bf16(float lo, float hi) { unsigned r; asm volatile("v_cvt_pk_bf16_f32 %0, %1, %2" : "=v"(r) : "v"(lo), "v"(hi)); return r; }
__device__ __forceinline__ float bf_lo(unsigned w) { return __uint_as_float(w << 16); }
__device__ __forceinline__ float bf_hi(unsigned w) { return __uint_as_float(w & 0xffff0000u); }
__device__ __forceinline__ float fast_sigmoid(float x) { return __builtin_amdgcn_rcpf(1.0f + __builtin_amdgcn_exp2f(-1.4426950408889634f * x)); }
__device__ __forceinline__ float wave_sum(float v) {
#pragma unroll
    for (int o = 1; o < 64; o <<= 1) v += __shfl_xor(v, o);
    return v;
}

namespace pg8 {
constexpr int BM = 256, BK = 64, HALF = 128, HTB = HALF * BK * 2, STAGE_BYTES = 8 * HTB, NXCD = 8, WGM = 8;
__host__ __device__ __forceinline__ int lds_byte(int r, int c) { const int st = (r >> 4) * 2 + (c >> 5), rr = r & 15, cc = c & 31, ob = rr * 64 + cc * 2; return st * 1024 + (ob ^ (((ob >> 9) & 1) << 5)); }
__host__ __device__ __forceinline__ void stage_rc(int b, int& R, int& C) { const int st = b / 1024, sb = b % 1024, swz = sb ^ (((sb >> 9) & 1) << 5); R = (st >> 1) * 16 + swz / 64; C = (st & 1) * 32 + (swz % 64) / 2; }
__host__ __device__ __forceinline__ int perm32(int rho) { const int n = rho >> 4, i = rho & 15; return 8 * (i >> 2) + 4 * n + (i & 3); }

struct Unit { int pm, pn, e, tab; };
struct Gemm { const bf16* A; const bf16* Bt; int K; size_t bstride_e; };

__device__ __forceinline__ void order_map(int wgid, int nM, int nN, int& pm, int& pn) {
    const int nwg = nM * nN; { const int q = nwg / NXCD, r = nwg % NXCD, xcd = wgid % NXCD, off = wgid / NXCD; wgid = (xcd < r ? xcd * (q + 1) : r * (q + 1) + (xcd - r) * q) + off; }
    const int nig = WGM * nN, gid = wgid / nig, fm = gid * WGM, gsz = (nM - fm) < WGM ? (nM - fm) : WGM;
    pm = fm + ((wgid % nig) % gsz); pn = (wgid % nig) / gsz;
}
struct StaticOrder {
    static constexpr bool GATHER = false;
    int nM, nN, nwg, G, c;
    __device__ void init(int Mrows, int N, int G_, int c_) { nM = Mrows / BM; nN = N / BM; nwg = nM * nN; G = G_; c = c_; }
    __device__ __forceinline__ bool next(int i, Unit& u) const { const long L = (long)i * G + c; if (L >= nwg) return false; order_map((int)L, nM, nN, u.pm, u.pn); u.e = 0; u.tab = 0; return true; }
    __device__ __forceinline__ const unsigned* a_table(const Unit&) const { return nullptr; }
};
struct MoeOrder {
    int pb[9]; int nN, nwg, G, c; const unsigned* rowoff;
    __device__ __forceinline__ bool next(int i, Unit& u) const {
        const long L = (long)i * G + c; if (L >= nwg) return false; order_map((int)L, pb[8], nN, u.pm, u.pn);
        int e = 0;
#pragma unroll
        for (int k = 1; k < 8; ++k) e += (u.pm >= pb[k]) ? 1 : 0;
        int pbe = pb[0];
#pragma unroll
        for (int k = 1; k < 8; ++k) pbe = (e == k) ? pb[k] : pbe;
        u.e = e; u.tab = e * ECAP + 256 * (u.pm - pbe); return true;
    }
    __device__ __forceinline__ const unsigned* a_table(const Unit& u) const { return rowoff + u.tab; }
};
struct MoeOrderGather : MoeOrder { static constexpr bool GATHER = true; };
struct MoeOrderDense : MoeOrder { static constexpr bool GATHER = false; };

__device__ __forceinline__ float rstd_of(const float* ssq, int row) { const float s = (ssq[row] + ssq[M + row]) + (ssq[2 * M + row] + ssq[3 * M + row]); return 1.0f / sqrtf(s * (1.0f / D) + EPS); }

struct EpiP {
    static constexpr bool PERM = true, AFTER_DRAIN = false;
    bf16* O; int ldc; const float* ssq;
    __device__ __forceinline__ void operator()(const f32x4 (&acc)[2][2][4][2], const Unit& u, int wr, int wc, int fr, int fq) const {
        const int row0 = u.pm * BM + wr * 64 + fr, col0 = u.pn * BM + wc * 32 + 8 * fq;
#pragma unroll
        for (int ai = 0; ai < 2; ++ai)
#pragma unroll
            for (int m = 0; m < 4; ++m) { const int row = row0 + ai * HALF + m * 16; const float rs = rstd_of(ssq, row); bf16* rowp = O + (size_t)row * ldc + col0;
#pragma unroll
                for (int bj = 0; bj < 2; ++bj) { const f32x4 v0 = acc[ai][bj][m][0] * rs, v1 = acc[ai][bj][m][1] * rs;
                    u32x4 w; w.x = cvt_pk_bf16(v0[0], v0[1]); w.y = cvt_pk_bf16(v0[2], v0[3]); w.z = cvt_pk_bf16(v1[0], v1[1]); w.w = cvt_pk_bf16(v1[2], v1[3]);
                    *(u32x4*)(rowp + bj * HALF) = w; } }
    }
};
template <bool MOE> struct EpiSwiglu {
    static constexpr bool PERM = true, AFTER_DRAIN = false;
    bf16* O; int ldc; const float* ssq; const float* rs_e; const float* gate_e;
    __device__ __forceinline__ void operator()(const f32x4 (&acc)[2][2][4][2], const Unit& u, int wr, int wc, int fr, int fq) const {
        const int lr0 = wr * 64 + fr, col0 = u.pn * HALF + wc * 32 + 8 * fq;
#pragma unroll
        for (int ai = 0; ai < 2; ++ai)
#pragma unroll
            for (int m = 0; m < 4; ++m) { const int lr = lr0 + ai * HALF + m * 16, row = u.pm * BM + lr; float rs, gw;
                if (MOE) { rs = rs_e[u.tab + lr]; gw = gate_e[u.tab + lr]; } else { rs = rstd_of(ssq, row); gw = 1.0f; }
                float o[8];
#pragma unroll
                for (int n = 0; n < 2; ++n)
#pragma unroll
                    for (int q = 0; q < 4; ++q) { const float g = acc[ai][0][m][n][q] * rs, up = acc[ai][1][m][n][q] * rs; o[n * 4 + q] = (g * fast_sigmoid(g)) * (up * gw); }
                u32x4 w; w.x = cvt_pk_bf16(o[0], o[1]); w.y = cvt_pk_bf16(o[2], o[3]); w.z = cvt_pk_bf16(o[4], o[5]); w.w = cvt_pk_bf16(o[6], o[7]);
                *(u32x4*)(O + (size_t)row * ldc + col0) = w; }
    }
};
struct EpiBf16 {
    static constexpr bool PERM = true, AFTER_DRAIN = false;
    bf16* O; int ldc;
    __device__ __forceinline__ void operator()(const f32x4 (&acc)[2][2][4][2], const Unit& u, int wr, int wc, int fr, int fq) const {
        const int row0 = u.pm * BM + wr * 64 + fr, col0 = u.pn * BM + wc * 32 + 8 * fq;
#pragma unroll
        for (int ai = 0; ai < 2; ++ai)
#pragma unroll
            for (int m = 0; m < 4; ++m) { bf16* rowp = O + (size_t)(row0 + ai * HALF + m * 16) * ldc + col0;
#pragma unroll
                for (int bj = 0; bj < 2; ++bj) { const f32x4 v0 = acc[ai][bj][m][0], v1 = acc[ai][bj][m][1];
                    u32x4 w; w.x = cvt_pk_bf16(v0[0], v0[1]); w.y = cvt_pk_bf16(v0[2], v0[3]); w.z = cvt_pk_bf16(v1[0], v1[1]); w.w = cvt_pk_bf16(v1[2], v1[3]);
                    *(u32x4*)(rowp + bj * HALF) = w; } }
    }
};
struct EpiResid {
    static constexpr bool PERM = false, AFTER_DRAIN = true;
    const float* xold; float* X; bf16* XB; float* ssq;
    __device__ __forceinline__ void fused(f32x4 (&acc)[2][2][4][2], const Unit& u, int wr, int wc, int fr, int fq, LAS unsigned char* lds, int wid, int lane) const {
        LAS float* Pt = (LAS float*)lds;
        const int col0 = u.pn * BM + wc * 32 + 4 * fq;
#pragma unroll
        for (int ai = 0; ai < 2; ++ai)
#pragma unroll
            for (int m = 0; m < 4; ++m) { const int r = ai * HALF + wr * 64 + m * 16 + fr; const size_t off = (size_t)(u.pm * BM + r) * D + col0; float s = 0.f;
#pragma unroll
                for (int bj = 0; bj < 2; ++bj)
#pragma unroll
                    for (int n = 0; n < 2; ++n) { const f32x4 bs = *(const f32x4*)(xold + off + bj * HALF + n * 16); const f32x4 o = bs + acc[ai][bj][m][n];
                        *(f32x4*)(X + off + bj * HALF + n * 16) = o; u32x2 w; w.x = cvt_pk_bf16(o[0], o[1]); w.y = cvt_pk_bf16(o[2], o[3]); *(u32x2*)(XB + off + bj * HALF + n * 16) = w;
                        s += (o[0] * o[0] + o[1] * o[1]) + (o[2] * o[2] + o[3] * o[3]); }
                s += __shfl_xor(s, 16); s += __shfl_xor(s, 32);
                if (fq == 0) Pt[r * 4 + wc] = s; }
        __syncthreads();
        const int t = wid * 64 + lane;
        if (t < 256) { const float s = (Pt[t * 4 + 0] + Pt[t * 4 + 1]) + (Pt[t * 4 + 2] + Pt[t * 4 + 3]); ssq[(size_t)u.pn * M + u.pm * BM + t] = s; }
        __syncthreads();
    }
};

template <class Epi, class Sched, bool ALIGN_EPI = false, bool SP2 = true>
__device__ __forceinline__ void gemm_phase(LAS unsigned char* lds, LAS unsigned* gtab, const Gemm g, const Sched& S, const Epi& E) {
    constexpr bool GATHER = Sched::GATHER;
    static_assert(!GATHER || SP2, "gather needs the SP2 loop (lgkmcnt(0) waits only)");
    int tid_ = threadIdx.x; asm volatile("" : "+v"(tid_));
    const int tid = tid_, wid = __builtin_amdgcn_readfirstlane(tid >> 6), lane = tid & 63, wr = wid >> 2, wc = wid & 3, fr = lane & 15, fq = lane >> 4;
    const int K = g.K, nt = K / BK;
    unsigned voffA[2], voffB[2];
#pragma unroll
    for (int i = 0; i < 2; ++i) { int R, C; stage_rc(tid * 16 + i * 8192, R, C); const int Rb = Epi::PERM ? ((R & ~31) + perm32(R & 31)) : R;
        voffA[i] = (unsigned)(R * K + C) * 2u; voffB[i] = (unsigned)(Rb * K + C) * 2u; }
    const size_t kstep = (size_t)(BK * 2);
    const size_t hstep = (size_t)HALF * K * 2;
    const size_t tstep = 2 * hstep;
    const unsigned ldsw = (unsigned)wid * 1024u;
    const int aoff = lds_byte(wr * 64 + fr, fq * 8), boff = lds_byte(wc * 32 + fr, fq * 8);
#define PG8_SA(b, h) (((b) * 2 + (h)) * HTB)
#define PG8_SB(b, h) ((4 + (b) * 2 + (h)) * HTB)
#define PG8_STAGE(bufoff, gbase, voff) do { _Pragma("unroll") for (int _i = 0; _i < 2; ++_i) \
        __builtin_amdgcn_global_load_lds((const unsigned*)((const char*)(gbase) + (voff)[_i]), (LAS unsigned*)(lds + (bufoff) + ldsw + _i * 8192), 16, 0, 0); } while (0)
#define PG8_STAGE_A(bufoff, ubase, kb, h) do { if constexpr (GATHER) { PG8_STAGE(bufoff, (const char*)g.A + (kb), ga[h]); } else { PG8_STAGE(bufoff, (ubase) + (size_t)(h) * hstep + (kb), voffA); } } while (0)
#define PG8_LDA(dst, b, h) do { _Pragma("unroll") for (int m = 0; m < 4; ++m) _Pragma("unroll") for (int k = 0; k < 2; ++k) dst[m][k] = *(const LAS bf16x8*)(lds + PG8_SA(b, h) + aoff + m * 2048 + k * 1024); } while (0)
#define PG8_LDB(dst, b, h) do { _Pragma("unroll") for (int n = 0; n < 2; ++n) _Pragma("unroll") for (int k = 0; k < 2; ++k) dst[n][k] = *(const LAS bf16x8*)(lds + PG8_SB(b, h) + boff + n * 2048 + k * 1024); } while (0)
#define PG8_MMA(ai, bj, At, Bt) do { __builtin_amdgcn_s_setprio(1); _Pragma("unroll") for (int m = 0; m < 4; ++m) _Pragma("unroll") for (int n = 0; n < 2; ++n) _Pragma("unroll") for (int k = 0; k < 2; ++k) \
        acc[ai][bj][m][n] = __builtin_amdgcn_mfma_f32_16x16x32_bf16(Bt[n][k], At[m][k], acc[ai][bj][m][n], 0, 0, 0); __builtin_amdgcn_s_setprio(0); } while (0)
#define PG8_WAIT_V(n) asm volatile("s_waitcnt vmcnt(" #n ")" ::: "memory")
#define PG8_WAIT_L(n) asm volatile("s_waitcnt lgkmcnt(" #n ")" ::: "memory")
#define PG8_BAR __builtin_amdgcn_s_barrier()
#define PG8_SCHED __builtin_amdgcn_sched_barrier(0)
#define PG8_GTAB_DMA(un, slot) do { if (wid < 4) __builtin_amdgcn_global_load_lds(S.a_table(un) + wid * 64 + lane, (LAS unsigned*)(gtab + (slot) * 256 + wid * 64), 4, 0, 0); } while (0)
#define PG8_GTAB_READ(dst, slot) do { _Pragma("unroll") for (int _i = 0; _i < 2; ++_i) { int _R, _C; stage_rc(tid * 16 + _i * 8192, _R, _C); _Pragma("unroll") for (int _h = 0; _h < 2; ++_h) dst[_h][_i] = gtab[(slot) * 256 + _h * HALF + _R] + (unsigned)_C * 2u; } } while (0)
    Unit cur, nxt; int ui = 0;
    if (!S.next(0, cur)) return;
    f32x4 acc[2][2][4][2];
#pragma unroll
    for (int a = 0; a < 2; ++a)
#pragma unroll
        for (int b = 0; b < 2; ++b)
#pragma unroll
            for (int m = 0; m < 4; ++m)
#pragma unroll
                for (int n = 0; n < 2; ++n) acc[a][b][m][n] = (f32x4){0.f, 0.f, 0.f, 0.f};
    bf16x8 At[4][2], B0[2][2], B1[2][2];
    unsigned ga[2][2];
    const char* cA = (const char*)g.A + (GATHER ? (size_t)0 : (size_t)cur.pm * tstep); const char* cB = (const char*)g.Bt + ((size_t)cur.e * g.bstride_e) * 2 + (size_t)cur.pn * tstep;
    if constexpr (GATHER) { PG8_GTAB_DMA(cur, 0); PG8_WAIT_V(0); PG8_BAR; PG8_GTAB_READ(ga, 0); }
    if constexpr (SP2) {
        PG8_STAGE(PG8_SB(0, 0), cB, voffB); PG8_STAGE(PG8_SB(0, 1), cB + hstep, voffB); PG8_STAGE_A(PG8_SA(0, 0), cA, 0, 0); PG8_STAGE_A(PG8_SA(0, 1), cA, 0, 1);
        if (wr == 1) PG8_BAR;
        PG8_WAIT_V(2); PG8_BAR;
        PG8_STAGE(PG8_SB(1, 0), cB + kstep, voffB); PG8_STAGE_A(PG8_SA(1, 0), cA, kstep, 0); PG8_STAGE(PG8_SB(1, 1), cB + hstep + kstep, voffB);
        PG8_WAIT_V(6); PG8_BAR;
    } else {
        PG8_STAGE(PG8_SB(0, 0), cB, voffB); PG8_STAGE_A(PG8_SA(0, 0), cA, 0, 0); PG8_STAGE(PG8_SB(0, 1), cB + hstep, voffB); PG8_STAGE_A(PG8_SA(0, 1), cA, 0, 1);
        if (wr == 1) PG8_BAR;
        PG8_WAIT_V(4); PG8_BAR;
        PG8_STAGE(PG8_SB(1, 0), cB + kstep, voffB); PG8_STAGE_A(PG8_SA(1, 0), cA, kstep, 0); PG8_STAGE(PG8_SB(1, 1), cB + hstep + kstep, voffB);
        PG8_WAIT_V(6); PG8_BAR;
    }
    for (;;) {
        const bool has_next = S.next(ui + 1, nxt);
        const char* nA = (has_next && !GATHER) ? (const char*)g.A + (size_t)nxt.pm * tstep : cA;
        const char* nB = has_next ? (const char*)g.Bt + ((size_t)nxt.e * g.bstride_e) * 2 + (size_t)nxt.pn * tstep : cB;
        for (int t = 0; t < nt; t += 2) {
            const bool last = (t == nt - 2);
            const size_t k1 = (size_t)(t + 1) * kstep;
            const char* a2 = last ? nA : cA; const size_t k2 = last ? 0 : (size_t)(t + 2) * kstep;
            const char* b2 = last ? nB : cB + (size_t)(t + 2) * kstep; const char* b3 = b2 + kstep;
            const size_t k3 = k2 + kstep;
            if constexpr (GATHER) {
                if (t == nt - 4 && has_next) PG8_GTAB_DMA(nxt, (ui + 1) & 1);
            }
            if constexpr (SP2) {
            PG8_LDB(B0, 0, 0); PG8_LDB(B1, 0, 1); PG8_SCHED; PG8_LDA(At, 0, 0); PG8_STAGE_A(PG8_SA(1, 1), cA, k1, 1);
            if constexpr (GATHER) { if (last && has_next) PG8_GTAB_READ(ga, (ui + 1) & 1); }
            PG8_WAIT_V(8); PG8_WAIT_L(0); PG8_BAR; PG8_MMA(0, 0, At, B0); PG8_MMA(0, 1, At, B1); PG8_BAR; PG8_SCHED;
            PG8_LDA(At, 0, 1); PG8_STAGE(PG8_SB(0, 0), b2, voffB); PG8_STAGE(PG8_SB(0, 1), b2 + hstep, voffB); PG8_STAGE_A(PG8_SA(0, 0), a2, k2, 0);
            PG8_WAIT_V(8); PG8_WAIT_L(0); PG8_BAR; PG8_MMA(1, 0, At, B0); PG8_MMA(1, 1, At, B1); PG8_BAR; PG8_SCHED;
            PG8_LDB(B0, 1, 0); PG8_LDB(B1, 1, 1); PG8_SCHED; PG8_LDA(At, 1, 0); PG8_STAGE_A(PG8_SA(0, 1), a2, k2, 1);
            PG8_WAIT_V(8); PG8_WAIT_L(0); PG8_BAR; PG8_MMA(0, 0, At, B0); PG8_MMA(0, 1, At, B1); PG8_BAR; PG8_SCHED;
            PG8_LDA(At, 1, 1); PG8_STAGE(PG8_SB(1, 0), b3, voffB); PG8_STAGE(PG8_SB(1, 1), b3 + hstep, voffB); PG8_STAGE_A(PG8_SA(1, 0), a2, k3, 0);
            PG8_WAIT_V(8); PG8_WAIT_L(0); PG8_BAR; PG8_MMA(1, 0, At, B0); PG8_MMA(1, 1, At, B1); PG8_BAR; PG8_SCHED;
            } else {
            PG8_LDB(B0, 0, 0); PG8_SCHED; PG8_LDA(At, 0, 0); PG8_STAGE_A(PG8_SA(1, 1), cA, k1, 1);
            PG8_WAIT_L(8); PG8_BAR; PG8_WAIT_L(0); PG8_MMA(0, 0, At, B0); PG8_BAR; PG8_SCHED;
            PG8_LDB(B1, 0, 1); PG8_STAGE(PG8_SB(0, 0), b2, voffB);
            PG8_BAR; PG8_WAIT_L(0); PG8_MMA(0, 1, At, B1); PG8_BAR;
            PG8_LDA(At, 0, 1); PG8_STAGE_A(PG8_SA(0, 0), a2, k2, 0);
            PG8_BAR; PG8_WAIT_L(0); PG8_MMA(1, 0, At, B0); PG8_BAR; PG8_SCHED;
            PG8_STAGE(PG8_SB(0, 1), b2 + hstep, voffB);
            PG8_WAIT_V(6); PG8_BAR; PG8_MMA(1, 1, At, B1); PG8_BAR;
            PG8_LDB(B0, 1, 0); PG8_SCHED; PG8_LDA(At, 1, 0); PG8_STAGE_A(PG8_SA(0, 1), a2, k2, 1);
            PG8_WAIT_L(8); PG8_BAR; PG8_WAIT_L(0); PG8_MMA(0, 0, At, B0); PG8_BAR; PG8_SCHED;
            PG8_LDB(B1, 1, 1); PG8_STAGE(PG8_SB(1, 0), b3, voffB);
            PG8_BAR; PG8_WAIT_L(0); PG8_MMA(0, 1, At, B1); PG8_BAR;
            PG8_LDA(At, 1, 1); PG8_STAGE_A(PG8_SA(1, 0), a2, k3, 0);
            PG8_BAR; PG8_WAIT_L(0); PG8_MMA(1, 0, At, B0); PG8_BAR; PG8_SCHED;
            PG8_STAGE(PG8_SB(1, 1), b3 + hstep, voffB);
            PG8_WAIT_V(6); PG8_BAR; PG8_MMA(1, 1, At, B1); PG8_BAR;
            }
        }
        if constexpr (ALIGN_EPI) { if (wr == 0) PG8_BAR; }
        if constexpr (!Epi::AFTER_DRAIN) { E(acc, cur, wr, wc, fr, fq); }
        if (!has_next) break;
#pragma unroll
        for (int a = 0; a < 2; ++a)
#pragma unroll
            for (int b = 0; b < 2; ++b)
#pragma unroll
                for (int m = 0; m < 4; ++m)
#pragma unroll
                    for (int n = 0; n < 2; ++n) acc[a][b][m][n] = (f32x4){0.f, 0.f, 0.f, 0.f};
        cur = nxt; cA = nA; cB = nB; ++ui;
        if constexpr (ALIGN_EPI) { if (wr == 1) PG8_BAR; }
    }
    PG8_WAIT_V(0);
    if constexpr (!ALIGN_EPI) { if (wr == 0) PG8_BAR; }
    PG8_BAR;
    if constexpr (Epi::AFTER_DRAIN) { E.fused(acc, cur, wr, wc, fr, fq, lds, wid, lane); }
#undef PG8_SA
#undef PG8_SB
#undef PG8_STAGE
#undef PG8_STAGE_A
#undef PG8_LDA
#undef PG8_LDB
#undef PG8_MMA
#undef PG8_WAIT_V
#undef PG8_WAIT_L
#undef PG8_BAR
#undef PG8_SCHED
#undef PG8_GTAB_DMA
#undef PG8_GTAB_READ
}
}
constexpr size_t MiB = 1u << 20;
constexpr size_t WS_CTL = 0, CTL_ZERO_BYTES = 1 * MiB;
constexpr size_t WS_ROWOFF = 1 * MiB;
constexpr size_t WS_RS = WS_ROWOFF + 512 * 1024;
constexpr size_t WS_GATE = WS_RS + 512 * 1024;
constexpr size_t WS_SEL = WS_GATE + 512 * 1024;
constexpr size_t WS_SSQ = WS_SEL + 256 * 1024;
constexpr size_t WS_SMALLW = 4 * MiB;
constexpr size_t WS_PWT = WS_SMALLW;
constexpr size_t WS_POOLWT = WS_PWT + 2 * 384 * 384 * 2;
constexpr size_t WS_GMWS = WS_POOLWT + 2 * 4 * 64 * 64 * 2;
constexpr size_t WS_XB = 6 * MiB;
constexpr size_t WS_MOE_WD = 38 * MiB;
constexpr size_t WS_MOE_WGU = 94 * MiB;
constexpr size_t WS_YP = 94 * MiB;
constexpr size_t WS_ACTM = 206 * MiB;
constexpr size_t WS_P = 206 * MiB;
constexpr size_t WS_Y = 262 * MiB;
constexpr size_t WS_ACT = 206 * MiB;
constexpr size_t WS_WIN = 294 * MiB;
constexpr size_t WS_WOUT = 301 * MiB;
constexpr size_t WS_WGU = 305 * MiB;
constexpr size_t WS_WD = 316 * MiB;
constexpr size_t WS_END = 444 * MiB;
static_assert(WS_SSQ + 4 * (size_t)M * 4 <= WS_SMALLW && WS_GMWS + 2 * 4 * 128 * 128 * 2 <= WS_XB && WS_XB + (size_t)M * D * 2 <= WS_MOE_WD, "ws map 1");
static_assert(WS_MOE_WD + (size_t)NE * D * DFE * 2 <= WS_MOE_WGU && WS_MOE_WGU + (size_t)NE * NGUE * D * 2 <= WS_ACTM && WS_YP + (size_t)PMAX * D * 2 <= WS_ACTM, "ws map 2");
static_assert(WS_ACTM + (size_t)PMAX * DFE * 2 <= WS_END && WS_P + (size_t)M * DIN * 2 <= WS_Y && WS_Y + (size_t)M * D * 2 <= WS_WIN && WS_ACT + (size_t)M * DFF * 2 <= WS_WIN, "ws map 3");
static_assert(WS_WIN + 2 * (size_t)DIN * D * 2 <= WS_WOUT && WS_WOUT + 2 * (size_t)D * D * 2 <= WS_WGU && WS_WGU + (size_t)NGU * D * 2 <= WS_WD && WS_WD + (size_t)D * DFF * 2 <= WS_END, "ws map 4");
constexpr int CW_BAR = 4096;
constexpr int CW_CNT = 131072;
constexpr int NPHASE = 13;
constexpr int RING_BYTES = 131072;
constexpr int GTAB_OFF = RING_BYTES;
constexpr int MISC_OFF = GTAB_OFF + 2048;
constexpr int LDS_BYTES = 147456;
static_assert(MISC_OFF + 256 <= LDS_BYTES, "LDS map");

typedef GAS unsigned gu32;
#define RLX_AGENT __ATOMIC_RELAXED, __HIP_MEMORY_SCOPE_AGENT
#define LDS_WAIT() asm volatile("s_waitcnt lgkmcnt(0)" ::: "memory")
#define VM_WAIT() asm volatile("s_waitcnt vmcnt(0)" ::: "memory")

#define XB_TMO      128
#define XB_XCNT(j)  (256  + 64 * (j))
#define XB_XSUB(j)  (1280 + 64 * (j))
#define XB_XGEN(j)  (2304 + 64 * (j))
#define XB_TOP      3328
#define XB_TOPGEN   3392
#define XCD_BAR_WORDS 3456
#define XB_SPIN_CAP (1u << 18)
__device__ __forceinline__ unsigned xb_ld(unsigned* p)              { return __hip_atomic_load(p, __ATOMIC_RELAXED, __HIP_MEMORY_SCOPE_AGENT); }
__device__ __forceinline__ unsigned xb_add(unsigned* p, unsigned v) { return __hip_atomic_fetch_add(p, v, __ATOMIC_RELAXED, __HIP_MEMORY_SCOPE_AGENT); }
__device__ __forceinline__ unsigned xb_xcc_id() { return (unsigned)__builtin_amdgcn_s_getreg((3 << 11) | 20) & 0xFu; }
#define XB_SPIN(cond, bar) do { unsigned _sp = 0; while (cond) { __builtin_amdgcn_s_sleep(1); \
    if ((++_sp & 255u) == 0u) { if (xb_ld(&(bar)[XB_TMO])) break; if (_sp > XB_SPIN_CAP) { atomicAdd(&(bar)[XB_TMO], 1u); break; } } } } while (0)
struct XcdBarrier { unsigned* bar; unsigned x; volatile LAS unsigned* st; };
__device__ __forceinline__ XcdBarrier xcd_barrier_post(unsigned* bar, volatile LAS unsigned* st) {
    XcdBarrier b; b.bar = bar; b.x = xb_xcc_id(); b.st = st;
    if (threadIdx.x == 0) (void)xb_add(&bar[XB_XCNT(b.x)], 1u);
    return b;
}
__device__ __forceinline__ void xcd_barrier_complete(unsigned* bar, unsigned x, unsigned& nloc, unsigned& nx) {
    const unsigned G = gridDim.x * gridDim.y * gridDim.z;
    unsigned sum, cnt, mine, sp = 0u;
    for (;;) {
        sum = 0u; cnt = 0u; mine = 0u;
#pragma unroll
        for (unsigned j = 0; j < 16; ++j) { const unsigned c = xb_ld(&bar[XB_XCNT(j)]); sum += c; cnt += (c > 0u) ? 1u : 0u; mine = (j == x) ? c : mine; }
        if (sum == G) break;
        __builtin_amdgcn_s_sleep(1);
        if ((++sp & 255u) == 0u) { if (xb_ld(&bar[XB_TMO])) break; if (sp > XB_SPIN_CAP) { atomicAdd(&bar[XB_TMO], 1u); break; } }
    }
    nloc = mine > 0u ? mine : 1u; nx = cnt > 0u ? cnt : 1u;
}
__device__ __forceinline__ void xcd_barrier(const XcdBarrier& b) {
    asm volatile("s_waitcnt vmcnt(0)" ::: "memory");
    __syncthreads();
    if (threadIdx.x == 0) {
        unsigned* bar = b.bar;
        __builtin_amdgcn_s_waitcnt(0);
        unsigned nloc = b.st[0], nx = b.st[1];
        if (nloc == 0u) { xcd_barrier_complete(bar, b.x, nloc, nx); b.st[0] = nloc; b.st[1] = nx; }
        const unsigned old = xb_add(&bar[XB_XSUB(b.x)], 1u);
        const unsigned gen = old / nloc;
        if (old + 1u == (gen + 1u) * nloc) {
            __builtin_amdgcn_fence(__ATOMIC_RELEASE, "agent");
            asm volatile("s_waitcnt vmcnt(0)" ::: "memory");
            const unsigned og = xb_add(&bar[XB_TOP], 1u);
            const unsigned tg = og / nx;
            if (og + 1u == (tg + 1u) * nx) xb_add(&bar[XB_TOPGEN], 1u);
            else XB_SPIN(xb_ld(&bar[XB_TOPGEN]) == tg, bar);
            __builtin_amdgcn_fence(__ATOMIC_ACQUIRE, "agent");
            xb_add(&bar[XB_XGEN(b.x)], 1u);
            asm volatile("s_waitcnt vmcnt(0)" ::: "memory");
        } else {
            XB_SPIN(xb_ld(&bar[XB_XGEN(b.x)]) == gen, bar);
            __builtin_amdgcn_fence(__ATOMIC_ACQUIRE, "agent");
            asm volatile("s_waitcnt vmcnt(0)" ::: "memory");
        }
    }
    __syncthreads();
}

struct Frame {
    LAS unsigned char* lds; volatile LAS unsigned* MISC; unsigned* ctl;
    int tid, lane, wave, vcu, G;
    const float* const* in; float* out; unsigned char* ws;
};

__device__ __forceinline__ const float* const* in_tab(Frame& F) { return F.in; }
__device__ __forceinline__ void tr_item(const float* W, int K, int N, bf16* WT, int dst_row0, const float* gk, LAS float* scr, int k0, int n0, int lane) {
#pragma unroll 8
    for (int i = 0; i < 32; ++i) { const int kk = 2 * i + (lane >> 5); float v = W[(size_t)(k0 + kk) * N + n0 + (lane & 31)]; if (gk) v *= gk[k0 + kk]; scr[kk * 33 + (lane & 31)] = v; }
    LDS_WAIT(); asm volatile("" ::: "memory");
    const int c = lane & 7;
#pragma unroll
    for (int j = 0; j < 4; ++j) { const int n = (lane >> 3) + 8 * j; const LAS float* s = scr + (8 * c) * 33 + n;
        u32x4 o; o.x = cvt_pk_bf16(s[0 * 33], s[1 * 33]); o.y = cvt_pk_bf16(s[2 * 33], s[3 * 33]); o.z = cvt_pk_bf16(s[4 * 33], s[5 * 33]); o.w = cvt_pk_bf16(s[6 * 33], s[7 * 33]);
        *(GAS u32x4*)(WT + (size_t)(dst_row0 + n) * K + k0 + 8 * c) = o; }
    LDS_WAIT(); asm volatile("" ::: "memory");
}
__device__ __forceinline__ void tr_mat(const float* W, int K, int N, bf16* WT, int mode, const float* gk, LAS float* scr, int r, int lane) {
    const int nblk = N / 32, kb = r / nblk, nb = r % nblk, n0 = 32 * nb;
    const int drow = mode == 0 ? n0 : ((n0 >> 7) * 256 + (n0 & 127) + (mode == 2 ? 128 : 0));
    tr_item(W, K, N, WT, drow, gk, scr, 64 * kb, n0, lane);
}
__device__ __forceinline__ void p0_prologue(Frame& F) {
    LAS float* scr = (LAS float*)(F.lds + F.wave * 16384);
    const int gw = F.vcu * 8 + F.wave, NGW = F.G * 8, lane = F.lane;
    const float* const* in = in_tab(F); unsigned char* ws = F.ws;
    constexpr int I_IN = (D / 64) * (DIN / 32), I_OUT = (D / 64) * (D / 32), I_G = (D / 64) * (DFF / 32), I_D = (DFF / 64) * (D / 32), I_MG = (D / 64) * (DFE / 32), I_MD = (DFE / 64) * (D / 32), I_PW = (DCV / 64) * (DCV / 32), I_PL = 2;
    constexpr int NITEMS = 2 * I_IN + 2 * I_OUT + 2 * I_G + I_D + 2 * NE * I_MG + NE * I_MD + 2 * I_PW + 8 * I_PL;
    for (int it = gw; it < NITEMS; it += NGW) {
        int r = it;
        if (r < 2 * I_IN) { const int l = r / I_IN; tr_mat(in[2] + (size_t)l * D * DIN, D, DIN, (bf16*)(ws + WS_WIN) + (size_t)l * DIN * D, 0, in[1] + l * D, scr, r % I_IN, lane); continue; } r -= 2 * I_IN;
        if (r < 2 * I_OUT) { const int l = r / I_OUT; tr_mat(in[14] + (size_t)l * D * D, D, D, (bf16*)(ws + WS_WOUT) + (size_t)l * D * D, 0, nullptr, scr, r % I_OUT, lane); continue; } r -= 2 * I_OUT;
        if (r < I_G) { tr_mat(in[16], D, DFF, (bf16*)(ws + WS_WGU), 1, in[15], scr, r, lane); continue; } r -= I_G;
        if (r < I_G) { tr_mat(in[17], D, DFF, (bf16*)(ws + WS_WGU), 2, in[15], scr, r, lane); continue; } r -= I_G;
        if (r < I_D) { tr_mat(in[18], DFF, D, (bf16*)(ws + WS_WD), 0, nullptr, scr, r, lane); continue; } r -= I_D;
        if (r < NE * I_MG) { const int e = r / I_MG; tr_mat(in[20] + (size_t)e * D * DFE, D, DFE, (bf16*)(ws + WS_MOE_WGU) + (size_t)e * NGUE * D, 1, in[15] + D, scr, r % I_MG, lane); continue; } r -= NE * I_MG;
        if (r < NE * I_MG) { const int e = r / I_MG; tr_mat(in[21] + (size_t)e * D * DFE, D, DFE, (bf16*)(ws + WS_MOE_WGU) + (size_t)e * NGUE * D, 2, in[15] + D, scr, r % I_MG, lane); continue; } r -= NE * I_MG;
        if (r < NE * I_MD) { const int e = r / I_MD; tr_mat(in[22] + (size_t)e * DFE * D, DFE, D, (bf16*)(ws + WS_MOE_WD) + (size_t)e * D * DFE, 0, nullptr, scr, r % I_MD, lane); continue; } r -= NE * I_MD;
        if (r < 2 * I_PW) { const int l = r / I_PW; tr_mat(in[12] + (size_t)l * DCV * DCV, DCV, DCV, (bf16*)(ws + WS_PWT) + (size_t)l * DCV * DCV, 0, nullptr, scr, r % I_PW, lane); continue; } r -= 2 * I_PW;
        { const int gi = r / I_PL; tr_mat(in[3] + (size_t)gi * 64 * 64, 64, 64, (bf16*)(ws + WS_POOLWT) + (size_t)gi * 64 * 64, 0, nullptr, scr, r % I_PL, lane); }
    }
    { const float* src = in[6]; bf16* dst = (bf16*)(ws + WS_GMWS);
      for (int i = gw * 64 + lane; i < 2 * 4 * 128 * 128 / 8; i += NGW * 64) { const f32x4 a = *(const f32x4*)(src + (size_t)i * 8), b = *(const f32x4*)(src + (size_t)i * 8 + 4);
          u32x4 o; o.x = cvt_pk_bf16(a[0], a[1]); o.y = cvt_pk_bf16(a[2], a[3]); o.z = cvt_pk_bf16(b[0], b[1]); o.w = cvt_pk_bf16(b[2], b[3]); *(u32x4*)(dst + (size_t)i * 8) = o; } }
    { u32x4* t = (u32x4*)(ws + WS_ROWOFF); for (int i = gw * 64 + lane; i < NE * ECAP / 4; i += NGW * 64) t[i] = (u32x4){0u, 0u, 0u, 0u}; }
    { const float* x = in[0]; bf16* XB = (bf16*)(ws + WS_XB); float* ssq = (float*)(ws + WS_SSQ);
      for (int m = gw; m < M; m += NGW) { const f32x4* xr = (const f32x4*)(x + (size_t)m * D) + lane; f32x4 v[4]; float s = 0.f;
#pragma unroll
          for (int j = 0; j < 4; ++j) { v[j] = xr[64 * j]; s += (v[j][0] * v[j][0] + v[j][1] * v[j][1]) + (v[j][2] * v[j][2] + v[j][3] * v[j][3]); }
          s = wave_sum(s);
          u32x2* o = (u32x2*)(XB + (size_t)m * D) + lane;
#pragma unroll
          for (int j = 0; j < 4; ++j) { u32x2 w; w.x = cvt_pk_bf16(v[j][0], v[j][1]); w.y = cvt_pk_bf16(v[j][2], v[j][3]); o[64 * j] = w; }
          if (lane < 4) ssq[(size_t)lane * M + m] = lane == 0 ? s : 0.f; } }
}

__device__ __forceinline__ void unpack8(const u32x4 w, float (&f)[8]) { f[0] = bf_lo(w.x); f[1] = bf_hi(w.x); f[2] = bf_lo(w.y); f[3] = bf_hi(w.y); f[4] = bf_lo(w.z); f[5] = bf_hi(w.z); f[6] = bf_lo(w.w); f[7] = bf_hi(w.w); }
__device__ __forceinline__ void mixer_unit(Frame& F, int u, int layer) {
    LAS unsigned char* lds = F.lds; int tid = F.tid; asm volatile("" : "+v"(tid)); int lane = tid & 63; const int w = F.wave;
    const float* const* in = in_tab(F); unsigned char* ws = F.ws;
    const bf16* P = (const bf16*)(ws + WS_P); bf16* Y = (bf16*)(ws + WS_Y);
    const int r0 = 64 * u, s0 = r0 & (SEQ - 1), half = u & 1, blk0 = r0 & ~127;
#ifndef MIX_MASK
#define MIX_MASK 7
#endif
    if (MIX_MASK & 1) { constexpr int AIN = 0, YPL = 40448, YST = 528;
      for (int idx = tid; idx < 79 * 32; idx += 512) { const int rr = idx >> 5, ch = idx & 31, pos = s0 - 15 + rr; u32x4 v = (u32x4){0u, 0u, 0u, 0u};
          if (pos >= 0) v = *(const u32x4*)(P + (size_t)(r0 - 15 + rr) * DIN + ch * 8);
          *(LAS u32x4*)(lds + AIN + rr * 512 + ch * 16) = v; }
      __syncthreads();
      { const int p = tid & 127, rq = tid >> 7, g = p >> 5, win = 2 << g; float S0 = 0.f, S1 = 0.f;
        for (int j = 1; j < win; ++j) { const unsigned a = *(const LAS unsigned*)(lds + AIN + (16 * rq + 15 - j) * 512 + p * 4); S0 += bf_lo(a); S1 += bf_hi(a); }
#pragma unroll 4
        for (int t = 0; t < 16; ++t) { const int lt = 16 * rq + t, rr = lt + 15; const unsigned a = *(const LAS unsigned*)(lds + AIN + rr * 512 + p * 4); const float a0 = bf_lo(a), a1 = bf_hi(a);
            S0 += a0; S1 += a1; const int pos1 = s0 + lt + 1; const float n = (float)(pos1 < win ? pos1 : win);
            *(LAS unsigned*)(lds + YPL + lt * YST + p * 4) = cvt_pk_bf16(S0 / n - a0, S1 / n - a1);
            const unsigned o = *(const LAS unsigned*)(lds + AIN + (rr - win + 1) * 512 + p * 4); S0 -= bf_lo(o); S1 -= bf_hi(o); } }
      __syncthreads();
      { const int g = w >> 1, th = w & 1, fr = lane & 15, fq = lane >> 4; const bf16* wt = (const bf16*)(ws + WS_POOLWT) + (size_t)(layer * 4 + g) * 64 * 64;
        f32x4 acc[2][4];
#pragma unroll
        for (int a = 0; a < 2; ++a)
#pragma unroll
            for (int b = 0; b < 4; ++b) acc[a][b] = (f32x4){0.f, 0.f, 0.f, 0.f};
#pragma unroll
        for (int ks = 0; ks < 2; ++ks) { bf16x8 A[2], B[4];
#pragma unroll
            for (int mt = 0; mt < 2; ++mt) A[mt] = *(const LAS bf16x8*)(lds + YPL + ((2 * th + mt) * 16 + fr) * YST + (g * 64 + ks * 32 + 8 * fq) * 2);
#pragma unroll
            for (int nt = 0; nt < 4; ++nt) B[nt] = *(const bf16x8*)(wt + (nt * 16 + fr) * 64 + ks * 32 + 8 * fq);
#pragma unroll
            for (int mt = 0; mt < 2; ++mt)
#pragma unroll
                for (int nt = 0; nt < 4; ++nt) acc[mt][nt] = __builtin_amdgcn_mfma_f32_16x16x32_bf16(B[nt], A[mt], acc[mt][nt], 0, 0, 0); }
        const float* sc = in[4] + layer * DPOOL + g * 64;
#pragma unroll
        for (int mt = 0; mt < 2; ++mt)
#pragma unroll
            for (int nt = 0; nt < 4; ++nt) { const int t = r0 + (2 * th + mt) * 16 + fr, d = nt * 16 + 4 * fq; const f32x4 s4 = *(const f32x4*)(sc + d); const f32x4 v = acc[mt][nt] * s4;
                u32x2 o; o.x = cvt_pk_bf16(v[0], v[1]); o.y = cvt_pk_bf16(v[2], v[3]); *(u32x2*)(Y + (size_t)t * D + g * 64 + d) = o; } }
      __syncthreads(); }
    asm volatile("" : "+v"(tid)); lane = tid & 63;
    if (MIX_MASK & 2) { constexpr int VN = 0, VST = 800; const int nj = half ? 128 : 64;
      { u32x4 raw[16]; const int nr = nj >> 3;
#pragma unroll
        for (int i = 0; i < 16; ++i) { raw[i] = (u32x4){0u, 0u, 0u, 0u}; if (i < nr && lane < 48) raw[i] = *(const u32x4*)(P + (size_t)(blk0 + i * 8 + w) * DIN + 640 + lane * 8); }
#pragma unroll
        for (int i = 0; i < 16; ++i) { if (i < nr) { float f[8]; unpack8(raw[i], f); float s = 0.f;
#pragma unroll
                for (int q = 0; q < 8; ++q) s += f[q] * f[q];
                s = wave_sum(s); const float rs = 1.0f / sqrtf(s * (1.0f / DGM) + EPS);
                u32x4 o; o.x = cvt_pk_bf16(f[0] * rs, f[1] * rs); o.y = cvt_pk_bf16(f[2] * rs, f[3] * rs); o.z = cvt_pk_bf16(f[4] * rs, f[5] * rs); o.w = cvt_pk_bf16(f[6] * rs, f[7] * rs);
                if (lane < 48) *(LAS u32x4*)(lds + VN + (i * 8 + w) * VST + lane * 16) = o; } } }
      __syncthreads();
      { const int h = w & 3, ih = w >> 2, fr = lane & 15, fq = lane >> 4, q4 = (lane & 15) >> 2, p4 = lane & 3;
        const bf16* wsb = (const bf16*)(ws + WS_GMWS) + (size_t)(layer * 4 + h) * 128 * 128;
        f32x4 acc[2][6];
#pragma unroll
        for (int a = 0; a < 2; ++a)
#pragma unroll
            for (int b = 0; b < 6; ++b) acc[a][b] = (f32x4){0.f, 0.f, 0.f, 0.f};
        const int nks = nj >> 5;
        for (int ks = 0; ks < nks; ++ks) { bf16x8 A[2];
#pragma unroll
            for (int mt = 0; mt < 2; ++mt) A[mt] = *(const bf16x8*)(wsb + (size_t)(half * 64 + (2 * ih + mt) * 16 + fr) * 128 + ks * 32 + 8 * fq);
#pragma unroll
            for (int ct = 0; ct < 6; ++ct) { const unsigned ad = VN + (32 * ks + 8 * fq + q4) * VST + (h * 96 + ct * 16 + 4 * p4) * 2;
                const s16x4 t0 = __builtin_amdgcn_ds_read_tr16_b64_v4i16((LAS s16x4*)(lds + ad)), t1 = __builtin_amdgcn_ds_read_tr16_b64_v4i16((LAS s16x4*)(lds + ad + 4 * VST));
                bf16x8 B; B[0] = t0[0]; B[1] = t0[1]; B[2] = t0[2]; B[3] = t0[3]; B[4] = t1[0]; B[5] = t1[1]; B[6] = t1[2]; B[7] = t1[3];
#pragma unroll
                for (int mt = 0; mt < 2; ++mt) acc[mt][ct] = __builtin_amdgcn_mfma_f32_16x16x32_bf16(B, A[mt], acc[mt][ct], 0, 0, 0); } }
        const float* gg = in[5] + layer * DGM; const float* bb = in[7] + (size_t)(layer * 4 + h) * 128;
#pragma unroll
        for (int mt = 0; mt < 2; ++mt) { const int il = (2 * ih + mt) * 16 + fr, t = r0 + il; const float bi = bb[half * 64 + il];
#pragma unroll
            for (int ct = 0; ct < 6; ++ct) { const int c4 = h * 96 + ct * 16 + 4 * fq; const f32x4 g4 = *(const f32x4*)(gg + c4); const u32x2 uu = *(const u32x2*)(P + (size_t)t * DIN + 256 + c4);
                const f32x4 z = acc[mt][ct] * g4 + bi;
                u32x2 o; o.x = cvt_pk_bf16(bf_lo(uu.x) * z[0], bf_hi(uu.x) * z[1]); o.y = cvt_pk_bf16(bf_lo(uu.y) * z[2], bf_hi(uu.y) * z[3]); *(u32x2*)(Y + (size_t)t * D + 256 + c4) = o; } } }
      __syncthreads(); }
    asm volatile("" : "+v"(tid)); lane = tid & 63;
    if (MIX_MASK & 4) { constexpr int HC = 0, TT = 72192, TST = 784;
      for (int idx = tid; idx < 94 * 48; idx += 512) { const int rr = idx / 48, ch = idx % 48, pos = s0 - 30 + rr; u32x4 o = (u32x4){0u, 0u, 0u, 0u};
          if (pos >= 0) { const bf16* pr = P + (size_t)(r0 - 30 + rr) * DIN; const u32x4 cv = *(const u32x4*)(pr + 1024 + ch * 8), cg = *(const u32x4*)(pr + 1408 + ch * 8); float a[8], b[8]; unpack8(cv, a); unpack8(cg, b);
#pragma unroll
              for (int q = 0; q < 8; ++q) a[q] *= fast_sigmoid(b[q]);
              o.x = cvt_pk_bf16(a[0], a[1]); o.y = cvt_pk_bf16(a[2], a[3]); o.z = cvt_pk_bf16(a[4], a[5]); o.w = cvt_pk_bf16(a[6], a[7]); }
          *(LAS u32x4*)(lds + HC + rr * 768 + ch * 16) = o; }
      __syncthreads();
      asm volatile("" : "+v"(tid)); lane = tid & 63;
      { const float* dww = in[8] + (size_t)layer * 31 * DCV; const float* dwb = in[9] + layer * DCV; const float* lg = in[10] + layer * DCV; const float* lb = in[11] + layer * DCV;
        float dd[8][6];
#pragma unroll
        for (int q = 0; q < 3; ++q) { const int c = 128 * q + 2 * lane; f32x2 wj[31];
#pragma unroll
            for (int j = 0; j < 31; ++j) wj[j] = *(const f32x2*)(dww + j * DCV + c);
            const f32x2 b2 = *(const f32x2*)(dwb + c); float a0[8], a1[8];
#pragma unroll
            for (int r = 0; r < 8; ++r) { a0[r] = b2[0]; a1[r] = b2[1]; }
#pragma unroll
            for (int s = 0; s < 38; ++s) { const unsigned hv = *(const LAS unsigned*)(lds + HC + (8 * w + s) * 768 + c * 2); const float h0 = bf_lo(hv), h1 = bf_hi(hv);
#pragma unroll
                for (int r = 0; r < 8; ++r) { const int j = s - r; if (j >= 0 && j <= 30) { a0[r] += h0 * wj[j][0]; a1[r] += h1 * wj[j][1]; } } }
#pragma unroll
            for (int r = 0; r < 8; ++r) { dd[r][2 * q] = a0[r]; dd[r][2 * q + 1] = a1[r]; asm volatile("" : "+v"(dd[r][2 * q]), "+v"(dd[r][2 * q + 1])); }
            asm volatile("" ::: "memory"); }
        f32x2 g2[3], bt2[3];
#pragma unroll
        for (int q = 0; q < 3; ++q) { g2[q] = *(const f32x2*)(lg + 128 * q + 2 * lane); bt2[q] = *(const f32x2*)(lb + 128 * q + 2 * lane); }
#pragma unroll
        for (int r = 0; r < 8; ++r) { float s = 0.f;
#pragma unroll
            for (int q = 0; q < 6; ++q) s += dd[r][q];
            const float mu = wave_sum(s) * (1.0f / DCV); float v = 0.f;
#pragma unroll
            for (int q = 0; q < 6; ++q) { dd[r][q] -= mu; v += dd[r][q] * dd[r][q]; }
            const float rs = 1.0f / sqrtf(wave_sum(v) * (1.0f / DCV) + EPS);
#pragma unroll
            for (int q = 0; q < 3; ++q) { float y0 = dd[r][2 * q] * rs * g2[q][0] + bt2[q][0], y1 = dd[r][2 * q + 1] * rs * g2[q][1] + bt2[q][1]; y0 *= fast_sigmoid(y0); y1 *= fast_sigmoid(y1);
                *(LAS unsigned*)(lds + TT + (8 * w + r) * TST + (128 * q + 2 * lane) * 2) = cvt_pk_bf16(y0, y1); } } }
      __syncthreads();
      asm volatile("" : "+v"(tid)); lane = tid & 63;
      { const int fr = lane & 15, fq = lane >> 4; const bf16* pw = (const bf16*)(ws + WS_PWT) + (size_t)layer * DCV * DCV;
        f32x4 acc[4][3];
#pragma unroll
        for (int a = 0; a < 4; ++a)
#pragma unroll
            for (int b = 0; b < 3; ++b) acc[a][b] = (f32x4){0.f, 0.f, 0.f, 0.f};
#pragma unroll 2
        for (int ks = 0; ks < 12; ++ks) { bf16x8 A[4], B[3];
#pragma unroll
            for (int mt = 0; mt < 4; ++mt) A[mt] = *(const LAS bf16x8*)(lds + TT + (mt * 16 + fr) * TST + (ks * 32 + 8 * fq) * 2);
#pragma unroll
            for (int nt = 0; nt < 3; ++nt) B[nt] = *(const bf16x8*)(pw + (size_t)((3 * w + nt) * 16 + fr) * DCV + ks * 32 + 8 * fq);
#pragma unroll
            for (int mt = 0; mt < 4; ++mt)
#pragma unroll
                for (int nt = 0; nt < 3; ++nt) acc[mt][nt] = __builtin_amdgcn_mfma_f32_16x16x32_bf16(B[nt], A[mt], acc[mt][nt], 0, 0, 0); }
        const float* pb = in[13] + layer * DCV;
#pragma unroll
        for (int mt = 0; mt < 4; ++mt)
#pragma unroll
            for (int nt = 0; nt < 3; ++nt) { const int t = r0 + mt * 16 + fr, n4 = (3 * w + nt) * 16 + 4 * fq; const f32x4 v = acc[mt][nt] + *(const f32x4*)(pb + n4);
                u32x2 o; o.x = cvt_pk_bf16(v[0], v[1]); o.y = cvt_pk_bf16(v[2], v[3]); *(u32x2*)(Y + (size_t)t * D + 640 + n4) = o; } }
      __syncthreads(); }
}

__device__ __forceinline__ void router_phase(Frame& F) {
    LAS unsigned char* lds = F.lds; const int lane = F.lane, w = F.wave; unsigned char* ws = F.ws;
    const float* const* in = in_tab(F); const float* X = F.out; const float* g2 = in[15] + D; const float* R = in[19];
    unsigned* rowoff = (unsigned*)(ws + WS_ROWOFF); float* rs_e = (float*)(ws + WS_RS); float* gate_e = (float*)(ws + WS_GATE); int* sel = (int*)(ws + WS_SEL);
    unsigned* cnt = F.ctl + CW_CNT;
    LAS int* se0 = (LAS int*)lds; LAS int* se1 = se0 + 64; LAS float* sw0 = (LAS float*)(se1 + 64); LAS float* sw1 = sw0 + 64; LAS float* srs = sw1 + 64;
    float Rg[4][4][8];
#pragma unroll
    for (int j = 0; j < 4; ++j)
#pragma unroll
        for (int q = 0; q < 4; ++q) { const int k = 4 * lane + 256 * j + q; const float gk = g2[k]; const f32x4 a = *(const f32x4*)(R + k * 8), b = *(const f32x4*)(R + k * 8 + 4);
            Rg[j][q][0] = a[0] * gk; Rg[j][q][1] = a[1] * gk; Rg[j][q][2] = a[2] * gk; Rg[j][q][3] = a[3] * gk; Rg[j][q][4] = b[0] * gk; Rg[j][q][5] = b[1] * gk; Rg[j][q][6] = b[2] * gk; Rg[j][q][7] = b[3] * gk; }
    for (int b = F.vcu; b < M / 64; b += F.G) {
        for (int i = 0; i < 8; ++i) { const int tl = 8 * w + i, t = 64 * b + tl; const f32x4* xr = (const f32x4*)(X + (size_t)t * D) + lane; float ss = 0.f, le[8];
#pragma unroll
            for (int e = 0; e < 8; ++e) le[e] = 0.f;
#pragma unroll
            for (int j = 0; j < 4; ++j) { const f32x4 v = xr[64 * j];
#pragma unroll
                for (int q = 0; q < 4; ++q) { ss += v[q] * v[q];
#pragma unroll
                    for (int e = 0; e < 8; ++e) le[e] += v[q] * Rg[j][q][e]; } }
            ss = wave_sum(ss);
#pragma unroll
            for (int e = 0; e < 8; ++e) le[e] = wave_sum(le[e]);
            const float rs = 1.0f / sqrtf(ss * (1.0f / D) + EPS);
            int i0 = 0; float l0 = le[0];
#pragma unroll
            for (int e = 1; e < 8; ++e) if (le[e] > l0) { l0 = le[e]; i0 = e; }
            int i1 = -1; float l1 = -3.0e38f;
#pragma unroll
            for (int e = 0; e < 8; ++e) if (e != i0 && le[e] > l1) { l1 = le[e]; i1 = e; }
            const float ex = expf((l1 - l0) * rs), w0 = 1.0f / (1.0f + ex), w1 = ex / (1.0f + ex);
            if (lane == 0) { se0[tl] = i0; se1[tl] = i1; sw0[tl] = w0; sw1[tl] = w1; srs[tl] = rs; } }
        __syncthreads();
        if (w == 0) { const int e0 = se0[lane], e1 = se1[lane]; int r0 = 0, r1 = 0; const unsigned long long lt = (1ull << lane) - 1ull;
#pragma unroll
            for (int e = 0; e < 8; ++e) { const unsigned long long m0 = __ballot(e0 == e), m1 = __ballot(e1 == e); const int n0 = __popcll(m0), n = n0 + __popcll(m1); unsigned base = 0u;
                if (lane == 0 && n > 0) base = __hip_atomic_fetch_add(cnt + 64 * e, (unsigned)n, RLX_AGENT);
                base = __shfl(base, 0);
                if (e0 == e) r0 = (int)base + __popcll(m0 & lt);
                if (e1 == e) r1 = (int)base + n0 + __popcll(m1 & lt); }
            const int t = 64 * b + lane; const float rs = srs[lane];
            rowoff[e0 * ECAP + r0] = (unsigned)t * (unsigned)(D * 2); rs_e[e0 * ECAP + r0] = rs; gate_e[e0 * ECAP + r0] = sw0[lane];
            rowoff[e1 * ECAP + r1] = (unsigned)t * (unsigned)(D * 2); rs_e[e1 * ECAP + r1] = rs; gate_e[e1 * ECAP + r1] = sw1[lane];
            *(int4*)(sel + 4 * t) = make_int4(e0, r0, e1, r1); }
        __syncthreads();
    }
}
__device__ __forceinline__ void moe_panels(Frame& F, int (&pb)[9]) {
    unsigned* cnt = F.ctl + CW_CNT; pb[0] = 0;
#pragma unroll
    for (int e = 0; e < 8; ++e) { const unsigned c = (unsigned)__builtin_amdgcn_readfirstlane(__hip_atomic_load(cnt + 64 * e, RLX_AGENT)); pb[e + 1] = pb[e] + (int)((c + 255u) >> 8); }
}
__device__ __forceinline__ void final_phase(Frame& F) {
    int pb[9]; moe_panels(F, pb);
    const int gw = F.vcu * 8 + F.wave, NGW = F.G * 8, lane = F.lane; unsigned char* ws = F.ws;
    const bf16* YP = (const bf16*)(ws + WS_YP); const int* sel = (const int*)(ws + WS_SEL); const float* fg = in_tab(F)[23]; float* X = F.out;
    f32x4 g4[4];
#pragma unroll
    for (int j = 0; j < 4; ++j) g4[j] = *((const f32x4*)fg + lane + 64 * j);
    for (int t = gw; t < M; t += NGW) { const int4 s = *(const int4*)(sel + 4 * t); int b0 = 0, b1 = 0;
#pragma unroll
        for (int e = 0; e < 8; ++e) { b0 = (s.x == e) ? pb[e] : b0; b1 = (s.z == e) ? pb[e] : b1; }
        const size_t p0 = (size_t)(256 * b0 + s.y), p1 = (size_t)(256 * b1 + s.w);
        const f32x4* xr = (const f32x4*)(X + (size_t)t * D) + lane; const u32x2* y0 = (const u32x2*)(YP + p0 * D) + lane; const u32x2* y1 = (const u32x2*)(YP + p1 * D) + lane;
        f32x4 v[4]; float ss = 0.f;
#pragma unroll
        for (int j = 0; j < 4; ++j) { const f32x4 xv = xr[64 * j]; const u32x2 a = y0[64 * j], b = y1[64 * j];
            v[j][0] = xv[0] + bf_lo(a.x) + bf_lo(b.x); v[j][1] = xv[1] + bf_hi(a.x) + bf_hi(b.x); v[j][2] = xv[2] + bf_lo(a.y) + bf_lo(b.y); v[j][3] = xv[3] + bf_hi(a.y) + bf_hi(b.y);
            ss += (v[j][0] * v[j][0] + v[j][1] * v[j][1]) + (v[j][2] * v[j][2] + v[j][3] * v[j][3]); }
        ss = wave_sum(ss); const float rs = 1.0f / sqrtf(ss * (1.0f / D) + EPS);
        f32x4* o = (f32x4*)(X + (size_t)t * D) + lane;
#pragma unroll
        for (int j = 0; j < 4; ++j) o[64 * j] = v[j] * rs * g4[j]; }
}

struct Args { const float* in[24]; float* out; unsigned char* ws; int ph_lo, ph_hi, li, pad; };
__global__ void __launch_bounds__(512, 2) fwd(Args args) {
    extern __shared__ __attribute__((aligned(16))) unsigned char lds_raw[];
    Frame F;
    F.lds = (LAS unsigned char*)lds_raw; F.MISC = (volatile LAS unsigned*)(F.lds + MISC_OFF);
    F.tid = threadIdx.x; F.lane = F.tid & 63; F.wave = __builtin_amdgcn_readfirstlane(F.tid >> 6);
    F.G = gridDim.x; { const int bx = blockIdx.x; F.vcu = (F.G % 8 == 0) ? (bx % 8) * (F.G / 8) + bx / 8 : bx; }
    F.in = args.in; F.out = args.out; F.ws = args.ws; F.ctl = (unsigned*)(args.ws + WS_CTL);
    for (int u = F.tid; u < (LDS_BYTES - MISC_OFF) / 4; u += 512) ((LAS unsigned*)(F.lds + MISC_OFF))[u] = 0u;
    __syncthreads();
    XcdBarrier bar = xcd_barrier_post(F.ctl + CW_BAR + args.li * XCD_BAR_WORDS, F.MISC + 8);
    const int lo = args.ph_lo, hi = args.ph_hi;
#ifndef PH_MASK
#define PH_MASK 0xFFFF
#endif
#define PH_ON(k) (((PH_MASK) >> (k)) & 1)
#define IN(k) (lo <= (k) && (k) < hi)
#define SEAM(k) do { if (IN(k) && IN((k) + 1)) xcd_barrier(bar); } while (0)
    unsigned char* ws = args.ws; LAS unsigned* gtab = (LAS unsigned*)(F.lds + GTAB_OFF);
    bf16* XB = (bf16*)(ws + WS_XB); float* ssq = (float*)(ws + WS_SSQ);
    if (F.G != 256) return;

    if (PH_ON(0) && IN(0)) p0_prologue(F);
    SEAM(0);
#pragma unroll 1
    for (int layer = 0; layer < 2; ++layer) {
        const int pbase = 1 + layer * 5;
        if (PH_ON(1) && IN(pbase)) { pg8::Gemm g{XB, (const bf16*)(ws + WS_WIN) + (size_t)layer * DIN * D, D, 0}; pg8::StaticOrder S; S.init(M, DIN, F.G, (int)blockIdx.x);
            pg8::EpiP E{(bf16*)(ws + WS_P), DIN, ssq}; pg8::gemm_phase<pg8::EpiP, pg8::StaticOrder, true, true>(F.lds, gtab, g, S, E); }
        SEAM(pbase);
        if (PH_ON(2) && IN(pbase + 1)) { for (int u = F.vcu; u < M / 64; u += F.G) mixer_unit(F, u, layer); }
        SEAM(pbase + 1);
        if (PH_ON(3) && IN(pbase + 2)) { pg8::Gemm g{(const bf16*)(ws + WS_Y), (const bf16*)(ws + WS_WOUT) + (size_t)layer * D * D, D, 0}; pg8::StaticOrder S; S.init(M, D, F.G, (int)blockIdx.x);
            pg8::EpiResid E{layer == 0 ? in_tab(F)[0] : (const float*)args.out, args.out, XB, ssq}; pg8::gemm_phase<pg8::EpiResid, pg8::StaticOrder, false, true>(F.lds, gtab, g, S, E); }
        SEAM(pbase + 2);
        if (layer == 0) {
            if (PH_ON(4) && IN(4)) { pg8::Gemm g{XB, (const bf16*)(ws + WS_WGU), D, 0}; pg8::StaticOrder S; S.init(M, NGU, F.G, (int)blockIdx.x);
                pg8::EpiSwiglu<false> E{(bf16*)(ws + WS_ACT), DFF, ssq, nullptr, nullptr}; pg8::gemm_phase<pg8::EpiSwiglu<false>, pg8::StaticOrder, true, true>(F.lds, gtab, g, S, E); }
            SEAM(4);
            if (PH_ON(5) && IN(5)) { pg8::Gemm g{(const bf16*)(ws + WS_ACT), (const bf16*)(ws + WS_WD), DFF, 0}; pg8::StaticOrder S; S.init(M, D, F.G, (int)blockIdx.x);
                pg8::EpiResid E{(const float*)args.out, args.out, XB, ssq}; pg8::gemm_phase<pg8::EpiResid, pg8::StaticOrder, false, true>(F.lds, gtab, g, S, E); }
            SEAM(5);
        }
    }
    if (PH_ON(9) && IN(9)) router_phase(F);
    SEAM(9);
    if (PH_ON(10) && IN(10)) { pg8::MoeOrderGather S; moe_panels(F, S.pb); S.nN = NGUE / 256; S.nwg = S.pb[8] * S.nN; S.G = F.G; S.c = (int)blockIdx.x; S.rowoff = (const unsigned*)(ws + WS_ROWOFF);
        pg8::Gemm g{XB, (const bf16*)(ws + WS_MOE_WGU), D, (size_t)NGUE * D};
        pg8::EpiSwiglu<true> E{(bf16*)(ws + WS_ACTM), DFE, nullptr, (const float*)(ws + WS_RS), (const float*)(ws + WS_GATE)};
        pg8::gemm_phase<pg8::EpiSwiglu<true>, pg8::MoeOrderGather, true, true>(F.lds, gtab, g, S, E); }
    SEAM(10);
    if (PH_ON(11) && IN(11)) { pg8::MoeOrderDense S; moe_panels(F, S.pb); S.nN = D / 256; S.nwg = S.pb[8] * S.nN; S.G = F.G; S.c = (int)blockIdx.x; S.rowoff = nullptr;
        pg8::Gemm g{(const bf16*)(ws + WS_ACTM), (const bf16*)(ws + WS_MOE_WD), DFE, (size_t)D * DFE};
        pg8::EpiBf16 E{(bf16*)(ws + WS_YP), D};
        pg8::gemm_phase<pg8::EpiBf16, pg8::MoeOrderDense, true, true>(F.lds, gtab, g, S, E); }
    SEAM(11);
    if (PH_ON(12) && IN(12)) final_phase(F);
#undef IN
#undef SEAM
}
#ifndef MK_PER_PHASE
#define MK_PER_PHASE 0
#endif
extern "C" void kernel_launch(void* const* d_in, const int* in_sizes, int n_in, void* d_out, int out_size, void* d_ws, size_t ws_size, hipStream_t stream) {
    static int grid = 0;
    if (grid == 0) {
        if (n_in != 24 || out_size != M * D || ws_size < WS_END) { fprintf(stderr, "kernel_launch: unexpected shapes (n_in %d out %d ws %zu)\n", n_in, out_size, ws_size); grid = -1; return; }
        int dev = 0, cus = 0;
        if (hipGetDevice(&dev) != hipSuccess || hipDeviceGetAttribute(&cus, hipDeviceAttributeMultiprocessorCount, dev) != hipSuccess) { grid = -1; return; }
        if (hipFuncSetAttribute((const void*)fwd, hipFuncAttributeMaxDynamicSharedMemorySize, LDS_BYTES) != hipSuccess) { fprintf(stderr, "kernel_launch: hipFuncSetAttribute failed\n"); grid = -1; return; }
        int per_cu = 0;
        if (hipOccupancyMaxActiveBlocksPerMultiprocessor(&per_cu, (const void*)fwd, 512, LDS_BYTES) != hipSuccess || per_cu < 1) fprintf(stderr, "kernel_launch: occupancy query says %d\n", per_cu);
        (void)hipGetLastError();
        grid = cus;
        if (grid != 256) { fprintf(stderr, "kernel_launch: built for 256 CUs, found %d\n", grid); grid = -1; return; }
    }
    if (grid < 0) return;
    (void)hipMemsetAsync((char*)d_ws + WS_CTL, 0, CTL_ZERO_BYTES, stream);
    Args a{};
    for (int i = 0; i < 24; ++i) a.in[i] = (const float*)d_in[i];
    a.out = (float*)d_out; a.ws = (unsigned char*)d_ws; a.pad = 0;
#if MK_PER_PHASE
    for (int p = 0; p < NPHASE; ++p) { a.ph_lo = p; a.ph_hi = p + 1; a.li = p; hipLaunchKernelGGL(fwd, dim3(grid), dim3(512), LDS_BYTES, stream, a); }
#else
    a.ph_lo = 0; a.ph_hi = NPHASE; a.li = 0; hipLaunchKernelGGL(fwd, dim3(grid), dim3(512), LDS_BYTES, stream, a);
#endif
}
```

```cpp
#define MK_PER_PHASE 0
#include <hip/hip_runtime.h>
#include <cstdio>
#include <cstdint>
constexpr int M = 16384, D = 1024, SEQ = 8192, DIN = 1792, DFF = 2816, DFE = 3584, NE = 8;
constexpr int DPOOL = 256, DGM = 384, DCV = 384;
constexpr int NGU = 2 * DFF, NGUE = 2 * DFE;
constexpr int ECAP = 16384;
constexpr int PMAX = 2 * M + NE * 256;
constexpr float EPS = 1e-6f;

#define LAS __attribute__((address_space(3)))
#define GAS __attribute__((address_space(1)))
typedef unsigned short bf16;
typedef short bf16x8 __attribute__((ext_vector_type(8)));
typedef short s16x4 __attribute__((ext_vector_type(4)));
typedef float f32x4 __attribute__((ext_vector_type(4)));
typedef float f32x2 __attribute__((ext_vector_type(2)));
typedef unsigned u32x4 __attribute__((ext_vector_type(4)));
typedef unsigned u32x2 __attribute__((ext_vector_type(2)));

__device__ __forceinline__ unsigned cvt_pk_bf16(float lo, float hi) { unsigned r; asm volatile("v_cvt_pk_bf16_f32 %0, %1, %2" : "=v"(r) : "v"(lo), "v"(hi)); return r; }
__device__ __forceinline__ float bf_lo(unsigned w) { return __uint_as_float(w << 16); }
__device__ __forceinline__ float bf_hi(unsigned w) { return __uint_as_float(w & 0xffff0000u); }
__device__ __forceinline__ float fast_sigmoid(float x) { return __builtin_amdgcn_rcpf(1.0f + __builtin_amdgcn_exp2f(-1.4426950408889634f * x)); }
__device__ __forceinline__ float wave_sum(float v) {
#pragma unroll
    for (int o = 1; o < 64; o <<= 1) v += __shfl_xor(v, o);
    return v;
}

namespace pg8 {
constexpr int BM = 256, BK = 64, HALF = 128, HTB = HALF * BK * 2, STAGE_BYTES = 8 * HTB, NXCD = 8, WGM = 8;
__host__ __device__ __forceinline__ int lds_byte(int r, int c) { const int st = (r >> 4) * 2 + (c >> 5), rr = r & 15, cc = c & 31, ob = rr * 64 + cc * 2; return st * 1024 + (ob ^ (((ob >> 9) & 1) << 5)); }
__host__ __device__ __forceinline__ void stage_rc(int b, int& R, int& C) { const int st = b / 1024, sb = b % 1024, swz = sb ^ (((sb >> 9) & 1) << 5); R = (st >> 1) * 16 + swz / 64; C = (st & 1) * 32 + (swz % 64) / 2; }
__host__ __device__ __forceinline__ int perm32(int rho) { const int n = rho >> 4, i = rho & 15; return 8 * (i >> 2) + 4 * n + (i & 3); }

struct Unit { int pm, pn, e, tab; };
struct Gemm { const bf16* A; const bf16* Bt; int K; size_t bstride_e; };

__device__ __forceinline__ void order_map(int wgid, int nM, int nN, int& pm, int& pn) {
    const int nwg = nM * nN; { const int q = nwg / NXCD, r = nwg % NXCD, xcd = wgid % NXCD, off = wgid / NXCD; wgid = (xcd < r ? xcd * (q + 1) : r * (q + 1) + (xcd - r) * q) + off; }
    const int nig = WGM * nN, gid = wgid / nig, fm = gid * WGM, gsz = (nM - fm) < WGM ? (nM - fm) : WGM;
    pm = fm + ((wgid % nig) % gsz); pn = (wgid % nig) / gsz;
}
struct StaticOrder {
    static constexpr bool GATHER = false;
    int nM, nN, nwg, G, c;
    __device__ void init(int Mrows, int N, int G_, int c_) { nM = Mrows / BM; nN = N / BM; nwg = nM * nN; G = G_; c = c_; }
    __device__ __forceinline__ bool next(int i, Unit& u) const { const long L = (long)i * G + c; if (L >= nwg) return false; order_map((int)L, nM, nN, u.pm, u.pn); u.e = 0; u.tab = 0; return true; }
    __device__ __forceinline__ const unsigned* a_table(const Unit&) const { return nullptr; }
};
struct MoeOrder {
    int pb[9]; int nN, nwg, G, c; const unsigned* rowoff;
    __device__ __forceinline__ bool next(int i, Unit& u) const {
        const long L = (long)i * G + c; if (L >= nwg) return false; order_map((int)L, pb[8], nN, u.pm, u.pn);
        int e = 0;
#pragma unroll
        for (int k = 1; k < 8; ++k) e += (u.pm >= pb[k]) ? 1 : 0;
        int pbe = pb[0];
#pragma unroll
        for (int k = 1; k < 8; ++k) pbe = (e == k) ? pb[k] : pbe;
        u.e = e; u.tab = e * ECAP + 256 * (u.pm - pbe); return true;
    }
    __device__ __forceinline__ const unsigned* a_table(const Unit& u) const { return rowoff + u.tab; }
};
struct MoeOrderGather : MoeOrder { static constexpr bool GATHER = true; };
struct MoeOrderDense : MoeOrder { static constexpr bool GATHER = false; };

__device__ __forceinline__ float rstd_of(const float* ssq, int row) { const float s = (ssq[row] + ssq[M + row]) + (ssq[2 * M + row] + ssq[3 * M + row]); return 1.0f / sqrtf(s * (1.0f / D) + EPS); }

struct EpiP {
    static constexpr bool PERM = true, AFTER_DRAIN = false;
    bf16* O; int ldc; const float* ssq;
    __device__ __forceinline__ void operator()(const f32x4 (&acc)[2][2][4][2], const Unit& u, int wr, int wc, int fr, int fq) const {
        const int row0 = u.pm * BM + wr * 64 + fr, col0 = u.pn * BM + wc * 32 + 8 * fq;
#pragma unroll
        for (int ai = 0; ai < 2; ++ai)
#pragma unroll
            for (int m = 0; m < 4; ++m) { const int row = row0 + ai * HALF + m * 16; const float rs = rstd_of(ssq, row); bf16* rowp = O + (size_t)row * ldc + col0;
#pragma unroll
                for (int bj = 0; bj < 2; ++bj) { const f32x4 v0 = acc[ai][bj][m][0] * rs, v1 = acc[ai][bj][m][1] * rs;
                    u32x4 w; w.x = cvt_pk_bf16(v0[0], v0[1]); w.y = cvt_pk_bf16(v0[2], v0[3]); w.z = cvt_pk_bf16(v1[0], v1[1]); w.w = cvt_pk_bf16(v1[2], v1[3]);
                    *(u32x4*)(rowp + bj * HALF) = w; } }
    }
};
template <bool MOE> struct EpiSwiglu {
    static constexpr bool PERM = true, AFTER_DRAIN = false;
    bf16* O; int ldc; const float* ssq; const float* rs_e; const float* gate_e; int mode;
    __device__ __forceinline__ void operator()(const f32x4 (&acc)[2][2][4][2], const Unit& u, int wr, int wc, int fr, int fq) const {
        if (mode == 2) { asm volatile("" :: "v"(acc[0][0][0][0][0]), "v"(acc[1][1][3][1][3])); return; }
        const int lr0 = wr * 64 + fr, col0 = u.pn * HALF + wc * 32 + 8 * fq;
#pragma unroll
        for (int ai = 0; ai < 2; ++ai)
#pragma unroll
            for (int m = 0; m < 4; ++m) { const int lr = lr0 + ai * HALF + m * 16, row = u.pm * BM + lr; float rs, gw;
                if (MOE) { rs = rs_e[u.tab + lr]; gw = gate_e[u.tab + lr]; } else { rs = rstd_of(ssq, row); gw = 1.0f; }
                float o[8]; const float c1 = rs * -1.4426950408889634f, c2 = rs * rs * gw;
#pragma unroll
                for (int n = 0; n < 2; ++n) { const f32x4 ga = acc[ai][0][m][n], gu = ga * acc[ai][1][m][n] * c2, ex = ga * c1;
#pragma unroll
                    for (int q = 0; q < 4; ++q) o[n * 4 + q] = gu[q] * __builtin_amdgcn_rcpf(1.0f + __builtin_amdgcn_exp2f(ex[q])); }
                u32x4 w; w.x = cvt_pk_bf16(o[0], o[1]); w.y = cvt_pk_bf16(o[2], o[3]); w.z = cvt_pk_bf16(o[4], o[5]); w.w = cvt_pk_bf16(o[6], o[7]);
                if (mode == 1) { asm volatile("" :: "v"(w.x), "v"(w.y), "v"(w.z), "v"(w.w)); } else *(u32x4*)(O + (size_t)row * ldc + col0) = w; }
    }
};
struct EpiBf16 {
    static constexpr bool PERM = true, AFTER_DRAIN = false;
    bf16* O; int ldc;
    __device__ __forceinline__ void operator()(const f32x4 (&acc)[2][2][4][2], const Unit& u, int wr, int wc, int fr, int fq) const {
        const int row0 = u.pm * BM + wr * 64 + fr, col0 = u.pn * BM + wc * 32 + 8 * fq;
#pragma unroll
        for (int ai = 0; ai < 2; ++ai)
#pragma unroll
            for (int m = 0; m < 4; ++m) { bf16* rowp = O + (size_t)(row0 + ai * HALF + m * 16) * ldc + col0;
#pragma unroll
                for (int bj = 0; bj < 2; ++bj) { const f32x4 v0 = acc[ai][bj][m][0], v1 = acc[ai][bj][m][1];
                    u32x4 w; w.x = cvt_pk_bf16(v0[0], v0[1]); w.y = cvt_pk_bf16(v0[2], v0[3]); w.z = cvt_pk_bf16(v1[0], v1[1]); w.w = cvt_pk_bf16(v1[2], v1[3]);
                    *(u32x4*)(rowp + bj * HALF) = w; } }
    }
};
struct EpiResid {
    static constexpr bool PERM = false, AFTER_DRAIN = true;
    const float* xold; float* X; bf16* XB; float* ssq;
    __device__ __forceinline__ void fused(f32x4 (&acc)[2][2][4][2], const Unit& u, int wr, int wc, int fr, int fq, LAS unsigned char* lds, int wid, int lane) const {
        LAS float* Pt = (LAS float*)lds;
        const int col0 = u.pn * BM + wc * 32 + 4 * fq;
#pragma unroll
        for (int ai = 0; ai < 2; ++ai)
#pragma unroll
            for (int m = 0; m < 4; ++m) { const int r = ai * HALF + wr * 64 + m * 16 + fr; const size_t off = (size_t)(u.pm * BM + r) * D + col0; float s = 0.f;
#pragma unroll
                for (int bj = 0; bj < 2; ++bj)
#pragma unroll
                    for (int n = 0; n < 2; ++n) { const f32x4 bs = *(const f32x4*)(xold + off + bj * HALF + n * 16); const f32x4 o = bs + acc[ai][bj][m][n];
                        *(f32x4*)(X + off + bj * HALF + n * 16) = o; u32x2 w; w.x = cvt_pk_bf16(o[0], o[1]); w.y = cvt_pk_bf16(o[2], o[3]); *(u32x2*)(XB + off + bj * HALF + n * 16) = w;
                        s += (o[0] * o[0] + o[1] * o[1]) + (o[2] * o[2] + o[3] * o[3]); }
                s += __shfl_xor(s, 16); s += __shfl_xor(s, 32);
                if (fq == 0) Pt[r * 4 + wc] = s; }
        __syncthreads();
        const int t = wid * 64 + lane;
        if (t < 256) { const float s = (Pt[t * 4 + 0] + Pt[t * 4 + 1]) + (Pt[t * 4 + 2] + Pt[t * 4 + 3]); ssq[(size_t)u.pn * M + u.pm * BM + t] = s; }
        __syncthreads();
    }
};

template <class Epi, class Sched, bool ALIGN_EPI = false, bool SP2 = true>
__device__ __forceinline__ void gemm_phase(LAS unsigned char* lds, LAS unsigned* gtab, const Gemm g, const Sched& S, const Epi& E) {
    constexpr bool GATHER = Sched::GATHER;
    static_assert(!GATHER || SP2, "gather needs the SP2 loop (lgkmcnt(0) waits only)");
    int tid_ = threadIdx.x; asm volatile("" : "+v"(tid_));
    const int tid = tid_, wid = __builtin_amdgcn_readfirstlane(tid >> 6), lane = tid & 63, wr = wid >> 2, wc = wid & 3, fr = lane & 15, fq = lane >> 4;
    const int K = g.K, nt = K / BK;
    unsigned voffA[2], voffB[2];
#pragma unroll
    for (int i = 0; i < 2; ++i) { int R, C; stage_rc(tid * 16 + i * 8192, R, C); const int Rb = Epi::PERM ? ((R & ~31) + perm32(R & 31)) : R;
        voffA[i] = (unsigned)(R * K + C) * 2u; voffB[i] = (unsigned)(Rb * K + C) * 2u; }
    const size_t kstep = (size_t)(BK * 2);
    const size_t hstep = (size_t)HALF * K * 2;
    const size_t tstep = 2 * hstep;
    const unsigned ldsw = (unsigned)wid * 1024u;
    const int aoff = lds_byte(wr * 64 + fr, fq * 8), boff = lds_byte(wc * 32 + fr, fq * 8);
#define PG8_SA(b, h) (((b) * 2 + (h)) * HTB)
#define PG8_SB(b, h) ((4 + (b) * 2 + (h)) * HTB)
#define PG8_STAGE(bufoff, gbase, voff) do { _Pragma("unroll") for (int _i = 0; _i < 2; ++_i) \
        __builtin_amdgcn_global_load_lds((const unsigned*)((const char*)(gbase) + (voff)[_i]), (LAS unsigned*)(lds + (bufoff) + ldsw + _i * 8192), 16, 0, 0); } while (0)
#define PG8_STAGE_A(bufoff, ubase, kb, h) do { if constexpr (GATHER) { PG8_STAGE(bufoff, (const char*)g.A + (kb), ga[h]); } else { PG8_STAGE(bufoff, (ubase) + (size_t)(h) * hstep + (kb), voffA); } } while (0)
#define PG8_LDA(dst, b, h) do { _Pragma("unroll") for (int m = 0; m < 4; ++m) _Pragma("unroll") for (int k = 0; k < 2; ++k) dst[m][k] = *(const LAS bf16x8*)(lds + PG8_SA(b, h) + aoff + m * 2048 + k * 1024); } while (0)
#define PG8_LDB(dst, b, h) do { _Pragma("unroll") for (int n = 0; n < 2; ++n) _Pragma("unroll") for (int k = 0; k < 2; ++k) dst[n][k] = *(const LAS bf16x8*)(lds + PG8_SB(b, h) + boff + n * 2048 + k * 1024); } while (0)
#define PG8_MMA(ai, bj, At, Bt) do { __builtin_amdgcn_s_setprio(1); _Pragma("unroll") for (int m = 0; m < 4; ++m) _Pragma("unroll") for (int n = 0; n < 2; ++n) _Pragma("unroll") for (int k = 0; k < 2; ++k) \
        acc[ai][bj][m][n] = __builtin_amdgcn_mfma_f32_16x16x32_bf16(Bt[n][k], At[m][k], acc[ai][bj][m][n], 0, 0, 0); __builtin_amdgcn_s_setprio(0); } while (0)
#define PG8_WAIT_V(n) asm volatile("s_waitcnt vmcnt(" #n ")" ::: "memory")
#define PG8_WAIT_L(n) asm volatile("s_waitcnt lgkmcnt(" #n ")" ::: "memory")
#define PG8_BAR __builtin_amdgcn_s_barrier()
#define PG8_SCHED __builtin_amdgcn_sched_barrier(0)
#define PG8_GTAB_DMA(un, slot) do { if (wid < 4) __builtin_amdgcn_global_load_lds(S.a_table(un) + wid * 64 + lane, (LAS unsigned*)(gtab + (slot) * 256 + wid * 64), 4, 0, 0); } while (0)
#define PG8_GTAB_READ(dst, slot) do { _Pragma("unroll") for (int _i = 0; _i < 2; ++_i) { int _R, _C; stage_rc(tid * 16 + _i * 8192, _R, _C); _Pragma("unroll") for (int _h = 0; _h < 2; ++_h) dst[_h][_i] = gtab[(slot) * 256 + _h * HALF + _R] + (unsigned)_C * 2u; } } while (0)
    Unit cur, nxt; int ui = 0;
    if (!S.next(0, cur)) return;
    f32x4 acc[2][2][4][2];
#pragma unroll
    for (int a = 0; a < 2; ++a)
#pragma unroll
        for (int b = 0; b < 2; ++b)
#pragma unroll
            for (int m = 0; m < 4; ++m)
#pragma unroll
                for (int n = 0; n < 2; ++n) acc[a][b][m][n] = (f32x4){0.f, 0.f, 0.f, 0.f};
    bf16x8 At[4][2], B0[2][2], B1[2][2];
    unsigned ga[2][2];
    const char* cA = (const char*)g.A + (GATHER ? (size_t)0 : (size_t)cur.pm * tstep); const char* cB = (const char*)g.Bt + ((size_t)cur.e * g.bstride_e) * 2 + (size_t)cur.pn * tstep;
    if constexpr (GATHER) { PG8_GTAB_DMA(cur, 0); PG8_WAIT_V(0); PG8_BAR; PG8_GTAB_READ(ga, 0); }
    if constexpr (SP2) {
        PG8_STAGE(PG8_SB(0, 0), cB, voffB); PG8_STAGE(PG8_SB(0, 1), cB + hstep, voffB); PG8_STAGE_A(PG8_SA(0, 0), cA, 0, 0); PG8_STAGE_A(PG8_SA(0, 1), cA, 0, 1);
        if (wr == 1) PG8_BAR;
        PG8_WAIT_V(2); PG8_BAR;
        PG8_STAGE(PG8_SB(1, 0), cB + kstep, voffB); PG8_STAGE_A(PG8_SA(1, 0), cA, kstep, 0); PG8_STAGE(PG8_SB(1, 1), cB + hstep + kstep, voffB);
        PG8_WAIT_V(6); PG8_BAR;
    } else {
        PG8_STAGE(PG8_SB(0, 0), cB, voffB); PG8_STAGE_A(PG8_SA(0, 0), cA, 0, 0); PG8_STAGE(PG8_SB(0, 1), cB + hstep, voffB); PG8_STAGE_A(PG8_SA(0, 1), cA, 0, 1);
        if (wr == 1) PG8_BAR;
        PG8_WAIT_V(4); PG8_BAR;
        PG8_STAGE(PG8_SB(1, 0), cB + kstep, voffB); PG8_STAGE_A(PG8_SA(1, 0), cA, kstep, 0); PG8_STAGE(PG8_SB(1, 1), cB + hstep + kstep, voffB);
        PG8_WAIT_V(6); PG8_BAR;
    }
    for (;;) {
        const bool has_next = S.next(ui + 1, nxt);
        const char* nA = (has_next && !GATHER) ? (const char*)g.A + (size_t)nxt.pm * tstep : cA;
        const char* nB = has_next ? (const char*)g.Bt + ((size_t)nxt.e * g.bstride_e) * 2 + (size_t)nxt.pn * tstep : cB;
        for (int t = 0; t < nt; t += 2) {
            const bool last = (t == nt - 2);
            const size_t k1 = (size_t)(t + 1) * kstep;
            const char* a2 = last ? nA : cA; const size_t k2 = last ? 0 : (size_t)(t + 2) * kstep;
            const char* b2 = last ? nB : cB + (size_t)(t + 2) * kstep; const char* b3 = b2 + kstep;
            const size_t k3 = k2 + kstep;
            if constexpr (GATHER) {
                if (t == nt - 4 && has_next) PG8_GTAB_DMA(nxt, (ui + 1) & 1);
            }
            if constexpr (SP2) {
            PG8_LDB(B0, 0, 0); PG8_LDB(B1, 0, 1); PG8_SCHED; PG8_LDA(At, 0, 0); PG8_STAGE_A(PG8_SA(1, 1), cA, k1, 1);
            if constexpr (GATHER) { if (last && has_next) PG8_GTAB_READ(ga, (ui + 1) & 1); }
            PG8_WAIT_V(8); PG8_WAIT_L(0); PG8_BAR; PG8_MMA(0, 0, At, B0); PG8_MMA(0, 1, At, B1); PG8_BAR; PG8_SCHED;
            PG8_LDA(At, 0, 1); PG8_STAGE(PG8_SB(0, 0), b2, voffB); PG8_STAGE(PG8_SB(0, 1), b2 + hstep, voffB); PG8_STAGE_A(PG8_SA(0, 0), a2, k2, 0);
            PG8_WAIT_V(8); PG8_WAIT_L(0); PG8_BAR; PG8_MMA(1, 0, At, B0); PG8_MMA(1, 1, At, B1); PG8_BAR; PG8_SCHED;
            PG8_LDB(B0, 1, 0); PG8_LDB(B1, 1, 1); PG8_SCHED; PG8_LDA(At, 1, 0); PG8_STAGE_A(PG8_SA(0, 1), a2, k2, 1);
            PG8_WAIT_V(8); PG8_WAIT_L(0); PG8_BAR; PG8_MMA(0, 0, At, B0); PG8_MMA(0, 1, At, B1); PG8_BAR; PG8_SCHED;
            PG8_LDA(At, 1, 1); PG8_STAGE(PG8_SB(1, 0), b3, voffB); PG8_STAGE(PG8_SB(1, 1), b3 + hstep, voffB); PG8_STAGE_A(PG8_SA(1, 0), a2, k3, 0);
            PG8_WAIT_V(8); PG8_WAIT_L(0); PG8_BAR; PG8_MMA(1, 0, At, B0); PG8_MMA(1, 1, At, B1); PG8_BAR; PG8_SCHED;
            } else {
            PG8_LDB(B0, 0, 0); PG8_SCHED; PG8_LDA(At, 0, 0); PG8_STAGE_A(PG8_SA(1, 1), cA, k1, 1);
            PG8_WAIT_L(8); PG8_BAR; PG8_WAIT_L(0); PG8_MMA(0, 0, At, B0); PG8_BAR; PG8_SCHED;
            PG8_LDB(B1, 0, 1); PG8_STAGE(PG8_SB(0, 0), b2, voffB);
            PG8_BAR; PG8_WAIT_L(0); PG8_MMA(0, 1, At, B1); PG8_BAR;
            PG8_LDA(At, 0, 1); PG8_STAGE_A(PG8_SA(0, 0), a2, k2, 0);
            PG8_BAR; PG8_WAIT_L(0); PG8_MMA(1, 0, At, B0); PG8_BAR; PG8_SCHED;
            PG8_STAGE(PG8_SB(0, 1), b2 + hstep, voffB);
            PG8_WAIT_V(6); PG8_BAR; PG8_MMA(1, 1, At, B1); PG8_BAR;
            PG8_LDB(B0, 1, 0); PG8_SCHED; PG8_LDA(At, 1, 0); PG8_STAGE_A(PG8_SA(0, 1), a2, k2, 1);
            PG8_WAIT_L(8); PG8_BAR; PG8_WAIT_L(0); PG8_MMA(0, 0, At, B0); PG8_BAR; PG8_SCHED;
            PG8_LDB(B1, 1, 1); PG8_STAGE(PG8_SB(1, 0), b3, voffB);
            PG8_BAR; PG8_WAIT_L(0); PG8_MMA(0, 1, At, B1); PG8_BAR;
            PG8_LDA(At, 1, 1); PG8_STAGE_A(PG8_SA(1, 0), a2, k3, 0);
            PG8_BAR; PG8_WAIT_L(0); PG8_MMA(1, 0, At, B0); PG8_BAR; PG8_SCHED;
            PG8_STAGE(PG8_SB(1, 1), b3 + hstep, voffB);
            PG8_WAIT_V(6); PG8_BAR; PG8_MMA(1, 1, At, B1); PG8_BAR;
            }
        }
        if constexpr (ALIGN_EPI) { if (wr == 0) PG8_BAR; }
        if constexpr (!Epi::AFTER_DRAIN) { E(acc, cur, wr, wc, fr, fq); }
        if (!has_next) break;
#pragma unroll
        for (int a = 0; a < 2; ++a)
#pragma unroll
            for (int b = 0; b < 2; ++b)
#pragma unroll
                for (int m = 0; m < 4; ++m)
#pragma unroll
                    for (int n = 0; n < 2; ++n) acc[a][b][m][n] = (f32x4){0.f, 0.f, 0.f, 0.f};
        cur = nxt; cA = nA; cB = nB; ++ui;
        if constexpr (ALIGN_EPI) { if (wr == 1) PG8_BAR; }
    }
    PG8_WAIT_V(0);
    if constexpr (!ALIGN_EPI) { if (wr == 0) PG8_BAR; }
    PG8_BAR;
    if constexpr (Epi::AFTER_DRAIN) { E.fused(acc, cur, wr, wc, fr, fq, lds, wid, lane); }
#undef PG8_SA
#undef PG8_SB
#undef PG8_STAGE
#undef PG8_STAGE_A
#undef PG8_LDA
#undef PG8_LDB
#undef PG8_MMA
#undef PG8_WAIT_V
#undef PG8_WAIT_L
#undef PG8_BAR
#undef PG8_SCHED
#undef PG8_GTAB_DMA
#undef PG8_GTAB_READ
}
}
constexpr size_t MiB = 1u << 20;
constexpr size_t WS_CTL = 0, CTL_ZERO_BYTES = 1 * MiB;
constexpr size_t WS_ROWOFF = 1 * MiB;
constexpr size_t WS_RS = WS_ROWOFF + 512 * 1024;
constexpr size_t WS_GATE = WS_RS + 512 * 1024;
constexpr size_t WS_SEL = WS_GATE + 512 * 1024;
constexpr size_t WS_SSQ = WS_SEL + 256 * 1024;
constexpr size_t WS_SMALLW = 4 * MiB;
constexpr size_t WS_PWT = WS_SMALLW;
constexpr size_t WS_POOLWT = WS_PWT + 2 * 384 * 384 * 2;
constexpr size_t WS_GMWS = WS_POOLWT + 2 * 4 * 64 * 64 * 2;
constexpr size_t WS_XB = 6 * MiB;
constexpr size_t WS_MOE_WD = 38 * MiB;
constexpr size_t WS_MOE_WGU = 94 * MiB;
constexpr size_t WS_YP = 94 * MiB;
constexpr size_t WS_ACTM = 206 * MiB;
constexpr size_t WS_P = 206 * MiB;
constexpr size_t WS_Y = 262 * MiB;
constexpr size_t WS_ACT = 206 * MiB;
constexpr size_t WS_WIN = 294 * MiB;
constexpr size_t WS_WOUT = 301 * MiB;
constexpr size_t WS_WGU = 305 * MiB;
constexpr size_t WS_WD = 316 * MiB;
constexpr size_t WS_END = 444 * MiB;
static_assert(WS_SSQ + 4 * (size_t)M * 4 <= WS_SMALLW && WS_GMWS + 2 * 4 * 128 * 128 * 2 <= WS_XB && WS_XB + (size_t)M * D * 2 <= WS_MOE_WD, "ws map 1");
static_assert(WS_MOE_WD + (size_t)NE * D * DFE * 2 <= WS_MOE_WGU && WS_MOE_WGU + (size_t)NE * NGUE * D * 2 <= WS_ACTM && WS_YP + (size_t)PMAX * D * 2 <= WS_ACTM, "ws map 2");
static_assert(WS_ACTM + (size_t)PMAX * DFE * 2 <= WS_END && WS_P + (size_t)M * DIN * 2 <= WS_Y && WS_Y + (size_t)M * D * 2 <= WS_WIN && WS_ACT + (size_t)M * DFF * 2 <= WS_WIN, "ws map 3");
static_assert(WS_WIN + 2 * (size_t)DIN * D * 2 <= WS_WOUT && WS_WOUT + 2 * (size_t)D * D * 2 <= WS_WGU && WS_WGU + (size_t)NGU * D * 2 <= WS_WD && WS_WD + (size_t)D * DFF * 2 <= WS_END, "ws map 4");
constexpr int CW_BAR = 4096;
constexpr int CW_CNT = 131072;
constexpr int NPHASE = 13;
constexpr int RING_BYTES = 131072;
constexpr int GTAB_OFF = RING_BYTES;
constexpr int MISC_OFF = GTAB_OFF + 2048;
constexpr int LDS_BYTES = 147456;
static_assert(MISC_OFF + 256 <= LDS_BYTES, "LDS map");

typedef GAS unsigned gu32;
#define RLX_AGENT __ATOMIC_RELAXED, __HIP_MEMORY_SCOPE_AGENT
#define LDS_WAIT() asm volatile("s_waitcnt lgkmcnt(0)" ::: "memory")
#define VM_WAIT() asm volatile("s_waitcnt vmcnt(0)" ::: "memory")

#define XB_TMO      128
#define XB_XCNT(j)  (256  + 64 * (j))
#define XB_XSUB(j)  (1280 + 64 * (j))
#define XB_XGEN(j)  (2304 + 64 * (j))
#define XB_TOP      3328
#define XB_TOPGEN   3392
#define XCD_BAR_WORDS 3456
#define XB_SPIN_CAP (1u << 18)
__device__ __forceinline__ unsigned xb_ld(unsigned* p)              { return __hip_atomic_load(p, __ATOMIC_RELAXED, __HIP_MEMORY_SCOPE_AGENT); }
__device__ __forceinline__ unsigned xb_add(unsigned* p, unsigned v) { return __hip_atomic_fetch_add(p, v, __ATOMIC_RELAXED, __HIP_MEMORY_SCOPE_AGENT); }
__device__ __forceinline__ unsigned xb_xcc_id() { return (unsigned)__builtin_amdgcn_s_getreg((3 << 11) | 20) & 0xFu; }
#define XB_SPIN(cond, bar) do { unsigned _sp = 0; while (cond) { __builtin_amdgcn_s_sleep(1); \
    if ((++_sp & 255u) == 0u) { if (xb_ld(&(bar)[XB_TMO])) break; if (_sp > XB_SPIN_CAP) { atomicAdd(&(bar)[XB_TMO], 1u); break; } } } } while (0)
struct XcdBarrier { unsigned* bar; unsigned x; volatile LAS unsigned* st; };
__device__ __forceinline__ XcdBarrier xcd_barrier_post(unsigned* bar, volatile LAS unsigned* st) {
    XcdBarrier b; b.bar = bar; b.x = xb_xcc_id(); b.st = st;
    if (threadIdx.x == 0) (void)xb_add(&bar[XB_XCNT(b.x)], 1u);
    return b;
}
__device__ __forceinline__ void xcd_barrier_complete(unsigned* bar, unsigned x, unsigned& nloc, unsigned& nx) {
    const unsigned G = gridDim.x * gridDim.y * gridDim.z;
    unsigned sum, cnt, mine, sp = 0u;
    for (;;) {
        sum = 0u; cnt = 0u; mine = 0u;
#pragma unroll
        for (unsigned j = 0; j < 16; ++j) { const unsigned c = xb_ld(&bar[XB_XCNT(j)]); sum += c; cnt += (c > 0u) ? 1u : 0u; mine = (j == x) ? c : mine; }
        if (sum == G) break;
        __builtin_amdgcn_s_sleep(1);
        if ((++sp & 255u) == 0u) { if (xb_ld(&bar[XB_TMO])) break; if (sp > XB_SPIN_CAP) { atomicAdd(&bar[XB_TMO], 1u); break; } }
    }
    nloc = mine > 0u ? mine : 1u; nx = cnt > 0u ? cnt : 1u;
}
__device__ __forceinline__ void xcd_barrier(const XcdBarrier& b) {
    asm volatile("s_waitcnt vmcnt(0)" ::: "memory");
    __syncthreads();
    if (threadIdx.x == 0) {
        unsigned* bar = b.bar;
        __builtin_amdgcn_s_waitcnt(0);
        unsigned nloc = b.st[0], nx = b.st[1];
        if (nloc == 0u) { xcd_barrier_complete(bar, b.x, nloc, nx); b.st[0] = nloc; b.st[1] = nx; }
        const unsigned old = xb_add(&bar[XB_XSUB(b.x)], 1u);
        const unsigned gen = old / nloc;
        if (old + 1u == (gen + 1u) * nloc) {
            __builtin_amdgcn_fence(__ATOMIC_RELEASE, "agent");
            asm volatile("s_waitcnt vmcnt(0)" ::: "memory");
            const unsigned og = xb_add(&bar[XB_TOP], 1u);
            const unsigned tg = og / nx;
            if (og + 1u == (tg + 1u) * nx) xb_add(&bar[XB_TOPGEN], 1u);
            else XB_SPIN(xb_ld(&bar[XB_TOPGEN]) == tg, bar);
            __builtin_amdgcn_fence(__ATOMIC_ACQUIRE, "agent");
            xb_add(&bar[XB_XGEN(b.x)], 1u);
            asm volatile("s_waitcnt vmcnt(0)" ::: "memory");
        } else {
            XB_SPIN(xb_ld(&bar[XB_XGEN(b.x)]) == gen, bar);
            __builtin_amdgcn_fence(__ATOMIC_ACQUIRE, "agent");
            asm volatile("s_waitcnt vmcnt(0)" ::: "memory");
        }
    }
    __syncthreads();
}

struct Frame {
    LAS unsigned char* lds; volatile LAS unsigned* MISC; unsigned* ctl;
    int tid, lane, wave, vcu, G;
    const float* const* in; float* out; unsigned char* ws;
};

__device__ __forceinline__ const float* const* in_tab(Frame& F) { return F.in; }
struct TrJob { const float* src; bf16* dst; const float* gk; int K, N; };
__device__ __forceinline__ TrJob tr_mat(const float* W, int K, int N, bf16* WT, int mode, const float* gk, int r) {
    const int nblk = N / 32, kb = r / nblk, nb = r % nblk, n0 = 32 * nb, k0 = 64 * kb;
    const int drow = mode == 0 ? n0 : ((n0 >> 7) * 256 + (n0 & 127) + (mode == 2 ? 128 : 0));
    TrJob j; j.src = W + (size_t)k0 * N + n0; j.dst = WT + (size_t)drow * K + k0; j.gk = gk ? gk + k0 : nullptr; j.K = K; j.N = N; return j;
}
constexpr int TR_I_IN = (D / 64) * (DIN / 32), TR_I_OUT = (D / 64) * (D / 32), TR_I_G = (D / 64) * (DFF / 32), TR_I_D = (DFF / 64) * (D / 32), TR_I_MG = (D / 64) * (DFE / 32), TR_I_MD = (DFE / 64) * (D / 32), TR_I_PW = (DCV / 64) * (DCV / 32), TR_I_PL = 2;
constexpr int TR_NITEMS = 2 * TR_I_IN + 2 * TR_I_OUT + 2 * TR_I_G + TR_I_D + 2 * NE * TR_I_MG + NE * TR_I_MD + 2 * TR_I_PW + 8 * TR_I_PL;
__device__ __forceinline__ TrJob tr_decode(const float* const* in, unsigned char* ws, int r) {
    if (r < 2 * TR_I_IN) { const int l = r / TR_I_IN; return tr_mat(in[2] + (size_t)l * D * DIN, D, DIN, (bf16*)(ws + WS_WIN) + (size_t)l * DIN * D, 0, in[1] + l * D, r % TR_I_IN); } r -= 2 * TR_I_IN;
    if (r < 2 * TR_I_OUT) { const int l = r / TR_I_OUT; return tr_mat(in[14] + (size_t)l * D * D, D, D, (bf16*)(ws + WS_WOUT) + (size_t)l * D * D, 0, nullptr, r % TR_I_OUT); } r -= 2 * TR_I_OUT;
    if (r < TR_I_G) return tr_mat(in[16], D, DFF, (bf16*)(ws + WS_WGU), 1, in[15], r); r -= TR_I_G;
    if (r < TR_I_G) return tr_mat(in[17], D, DFF, (bf16*)(ws + WS_WGU), 2, in[15], r); r -= TR_I_G;
    if (r < TR_I_D) return tr_mat(in[18], DFF, D, (bf16*)(ws + WS_WD), 0, nullptr, r); r -= TR_I_D;
    if (r < NE * TR_I_MG) { const int e = r / TR_I_MG; return tr_mat(in[20] + (size_t)e * D * DFE, D, DFE, (bf16*)(ws + WS_MOE_WGU) + (size_t)e * NGUE * D, 1, in[15] + D, r % TR_I_MG); } r -= NE * TR_I_MG;
    if (r < NE * TR_I_MG) { const int e = r / TR_I_MG; return tr_mat(in[21] + (size_t)e * D * DFE, D, DFE, (bf16*)(ws + WS_MOE_WGU) + (size_t)e * NGUE * D, 2, in[15] + D, r % TR_I_MG); } r -= NE * TR_I_MG;
    if (r < NE * TR_I_MD) { const int e = r / TR_I_MD; return tr_mat(in[22] + (size_t)e * DFE * D, DFE, D, (bf16*)(ws + WS_MOE_WD) + (size_t)e * D * DFE, 0, nullptr, r % TR_I_MD); } r -= NE * TR_I_MD;
    if (r < 2 * TR_I_PW) { const int l = r / TR_I_PW; return tr_mat(in[12] + (size_t)l * DCV * DCV, DCV, DCV, (bf16*)(ws + WS_PWT) + (size_t)l * DCV * DCV, 0, nullptr, r % TR_I_PW); } r -= 2 * TR_I_PW;
    { const int gi = r / TR_I_PL; return tr_mat(in[3] + (size_t)gi * 64 * 64, 64, 64, (bf16*)(ws + WS_POOLWT) + (size_t)gi * 64 * 64, 0, nullptr, r % TR_I_PL); }
}
__device__ __forceinline__ void tr_load(const TrJob& j, f32x4 (&v)[8], int lane, int probe) {
    const int n4 = (lane & 7) * 4, kr = lane >> 3;
    if (probe == 2) {
#pragma unroll
        for (int i = 0; i < 8; ++i) v[i] = (f32x4){1.f, 2.f, 3.f, 4.f};
        return; }
#pragma unroll
    for (int i = 0; i < 8; ++i) { v[i] = *(const f32x4*)(j.src + (size_t)(kr + 8 * i) * j.N + n4); if (j.gk) v[i] = v[i] * j.gk[kr + 8 * i]; }
}
__device__ __forceinline__ void tr_store(const TrJob& j, const f32x4 (&v)[8], LAS float* scr, int lane, int probe) {
    const int n4 = (lane & 7) * 4, kr = lane >> 3;
#pragma unroll
    for (int i = 0; i < 8; ++i) { LAS float* d = scr + (kr + 8 * i) * 33 + n4; d[0] = v[i][0]; d[1] = v[i][1]; d[2] = v[i][2]; d[3] = v[i][3]; }
    LDS_WAIT(); asm volatile("" ::: "memory");
    const int c = lane & 7;
#pragma unroll
    for (int jj = 0; jj < 4; ++jj) { const int n = (lane >> 3) + 8 * jj; const LAS float* s = scr + (8 * c) * 33 + n;
        u32x4 o; o.x = cvt_pk_bf16(s[0 * 33], s[1 * 33]); o.y = cvt_pk_bf16(s[2 * 33], s[3 * 33]); o.z = cvt_pk_bf16(s[4 * 33], s[5 * 33]); o.w = cvt_pk_bf16(s[6 * 33], s[7 * 33]);
        if (probe == 1 || probe == 2) { asm volatile("" :: "v"(o.x), "v"(o.y), "v"(o.z), "v"(o.w)); } else *(GAS u32x4*)(j.dst + (size_t)n * j.K + 8 * c) = o; }
    LDS_WAIT(); asm volatile("" ::: "memory");
}
__device__ __forceinline__ void p0_prologue(Frame& F, int probe) {
    LAS float* scr = (LAS float*)(F.lds + F.wave * 16384);
    const int gw = F.vcu * 8 + F.wave, NGW = F.G * 8, lane = F.lane;
    const float* const* in = in_tab(F); unsigned char* ws = F.ws;
    { int it = gw; f32x4 va[8], vb[8]; TrJob ja, jb;
      if (it < TR_NITEMS) { ja = tr_decode(in, ws, it); tr_load(ja, va, lane, probe); }
      while (it < TR_NITEMS) {
          const int it2 = it + NGW; if (it2 < TR_NITEMS) { jb = tr_decode(in, ws, it2); tr_load(jb, vb, lane, probe); }
          tr_store(ja, va, scr, lane, probe);
          if (it2 >= TR_NITEMS) break;
          const int it3 = it2 + NGW; if (it3 < TR_NITEMS) { ja = tr_decode(in, ws, it3); tr_load(ja, va, lane, probe); }
          tr_store(jb, vb, scr, lane, probe);
          it = it3; } }
    { const float* src = in[6]; bf16* dst = (bf16*)(ws + WS_GMWS);
      for (int i = gw * 64 + lane; i < 2 * 4 * 128 * 128 / 8; i += NGW * 64) { const f32x4 a = *(const f32x4*)(src + (size_t)i * 8), b = *(const f32x4*)(src + (size_t)i * 8 + 4);
          u32x4 o; o.x = cvt_pk_bf16(a[0], a[1]); o.y = cvt_pk_bf16(a[2], a[3]); o.z = cvt_pk_bf16(b[0], b[1]); o.w = cvt_pk_bf16(b[2], b[3]); *(u32x4*)(dst + (size_t)i * 8) = o; } }
    { u32x4* t = (u32x4*)(ws + WS_ROWOFF); for (int i = gw * 64 + lane; i < NE * ECAP / 4; i += NGW * 64) t[i] = (u32x4){0u, 0u, 0u, 0u}; }
    { const float* x = in[0]; bf16* XB = (bf16*)(ws + WS_XB); float* ssq = (float*)(ws + WS_SSQ);
      for (int m = gw; m < M; m += NGW) { const f32x4* xr = (const f32x4*)(x + (size_t)m * D) + lane; f32x4 v[4]; float s = 0.f;
#pragma unroll
          for (int j = 0; j < 4; ++j) { v[j] = xr[64 * j]; s += (v[j][0] * v[j][0] + v[j][1] * v[j][1]) + (v[j][2] * v[j][2] + v[j][3] * v[j][3]); }
          s = wave_sum(s);
          u32x2* o = (u32x2*)(XB + (size_t)m * D) + lane;
#pragma unroll
          for (int j = 0; j < 4; ++j) { u32x2 w; w.x = cvt_pk_bf16(v[j][0], v[j][1]); w.y = cvt_pk_bf16(v[j][2], v[j][3]); o[64 * j] = w; }
          if (lane < 4) ssq[(size_t)lane * M + m] = lane == 0 ? s : 0.f; } }
}

__device__ __forceinline__ void unpack8(const u32x4 w, float (&f)[8]) { f[0] = bf_lo(w.x); f[1] = bf_hi(w.x); f[2] = bf_lo(w.y); f[3] = bf_hi(w.y); f[4] = bf_lo(w.z); f[5] = bf_hi(w.z); f[6] = bf_lo(w.w); f[7] = bf_hi(w.w); }
__device__ __forceinline__ void mixer_unit(Frame& F, int u, int layer) {
    LAS unsigned char* lds = F.lds; int tid = F.tid; asm volatile("" : "+v"(tid)); int lane = tid & 63; const int w = F.wave;
    const float* const* in = in_tab(F); unsigned char* ws = F.ws;
    const bf16* P = (const bf16*)(ws + WS_P); bf16* Y = (bf16*)(ws + WS_Y);
    const int r0 = 64 * u, s0 = r0 & (SEQ - 1), half = u & 1, blk0 = r0 & ~127;
#ifndef MIX_MASK
#define MIX_MASK 7
#endif
#ifndef MIX_REP
#define MIX_REP 0
#endif
    for (int mrep = 0; mrep < 1 + (MIX_REP & 1); ++mrep) if (MIX_MASK & 1) { constexpr int AIN = 0, YPL = 40448, YST = 528;
      const int g = w >> 1, th = w & 1, fr = lane & 15, fq = lane >> 4;
      u32x4 st[5];
#pragma unroll
      for (int i = 0; i < 5; ++i) { const int idx = tid + 512 * i, rr = idx >> 5, ch = idx & 31, pos = s0 - 15 + rr; st[i] = (u32x4){0u, 0u, 0u, 0u};
          if (idx < 79 * 32 && pos >= 0) st[i] = *(const u32x4*)(P + (size_t)(r0 - 15 + rr) * DIN + ch * 8); }
      const bf16* wt = (const bf16*)(ws + WS_POOLWT) + (size_t)(layer * 4 + g) * 64 * 64; const float* sc = in[4] + layer * DPOOL + g * 64;
      bf16x8 Bf[2][4]; f32x4 sc4[4];
#pragma unroll
      for (int ks = 0; ks < 2; ++ks)
#pragma unroll
          for (int nt = 0; nt < 4; ++nt) Bf[ks][nt] = *(const bf16x8*)(wt + (nt * 16 + fr) * 64 + ks * 32 + 8 * fq);
#pragma unroll
      for (int nt = 0; nt < 4; ++nt) sc4[nt] = *(const f32x4*)(sc + nt * 16 + 4 * fq);
#pragma unroll
      for (int i = 0; i < 5; ++i) { const int idx = tid + 512 * i; if (idx < 79 * 32) *(LAS u32x4*)(lds + AIN + (idx >> 5) * 512 + (idx & 31) * 16) = st[i]; }
      __syncthreads();
      { const int p = tid & 127, rq = tid >> 7, gp = p >> 5, win = 2 << gp; float S0 = 0.f, S1 = 0.f;
        for (int j = 1; j < win; ++j) { const unsigned a = *(const LAS unsigned*)(lds + AIN + (16 * rq + 15 - j) * 512 + p * 4); S0 += bf_lo(a); S1 += bf_hi(a); }
#pragma unroll 4
        for (int t = 0; t < 16; ++t) { const int lt = 16 * rq + t, rr = lt + 15; const unsigned a = *(const LAS unsigned*)(lds + AIN + rr * 512 + p * 4); const float a0 = bf_lo(a), a1 = bf_hi(a);
            S0 += a0; S1 += a1; const int pos1 = s0 + lt + 1; const float rn = __builtin_amdgcn_rcpf((float)(pos1 < win ? pos1 : win));
            *(LAS unsigned*)(lds + YPL + lt * YST + p * 4) = cvt_pk_bf16(S0 * rn - a0, S1 * rn - a1);
            const unsigned o = *(const LAS unsigned*)(lds + AIN + (rr - win + 1) * 512 + p * 4); S0 -= bf_lo(o); S1 -= bf_hi(o); } }
      __syncthreads();
      { f32x4 acc[2][4];
#pragma unroll
        for (int a = 0; a < 2; ++a)
#pragma unroll
            for (int b = 0; b < 4; ++b) acc[a][b] = (f32x4){0.f, 0.f, 0.f, 0.f};
#pragma unroll
        for (int ks = 0; ks < 2; ++ks) { bf16x8 A[2];
#pragma unroll
            for (int mt = 0; mt < 2; ++mt) A[mt] = *(const LAS bf16x8*)(lds + YPL + ((2 * th + mt) * 16 + fr) * YST + (g * 64 + ks * 32 + 8 * fq) * 2);
#pragma unroll
            for (int mt = 0; mt < 2; ++mt)
#pragma unroll
                for (int nt = 0; nt < 4; ++nt) acc[mt][nt] = __builtin_amdgcn_mfma_f32_16x16x32_bf16(Bf[ks][nt], A[mt], acc[mt][nt], 0, 0, 0); }
#pragma unroll
        for (int mt = 0; mt < 2; ++mt)
#pragma unroll
            for (int nt = 0; nt < 4; ++nt) { const int t = r0 + (2 * th + mt) * 16 + fr, d = nt * 16 + 4 * fq; const f32x4 v = acc[mt][nt] * sc4[nt];
                u32x2 o; o.x = cvt_pk_bf16(v[0], v[1]); o.y = cvt_pk_bf16(v[2], v[3]); *(u32x2*)(Y + (size_t)t * D + g * 64 + d) = o; } }
      __syncthreads(); }
    asm volatile("" : "+v"(tid)); lane = tid & 63;
    for (int mrep = 0; mrep < 1 + ((MIX_REP >> 1) & 1); ++mrep) if (MIX_MASK & 2) { constexpr int VN = 0, VST = 800; const int nj = half ? 128 : 64, nks = nj >> 5;
      const int h = w & 3, ih = w >> 2, fr = lane & 15, fq = lane >> 4, q4 = (lane & 15) >> 2, p4 = lane & 3;
      const bf16* wsb = (const bf16*)(ws + WS_GMWS) + (size_t)(layer * 4 + h) * 128 * 128;
      const float* gg = in[5] + layer * DGM; const float* bb = in[7] + (size_t)(layer * 4 + h) * 128;
      u32x4 raw[16]; const int nr = nj >> 3;
#pragma unroll
      for (int i = 0; i < 16; ++i) { raw[i] = (u32x4){0u, 0u, 0u, 0u}; if (i < nr && lane < 48) raw[i] = *(const u32x4*)(P + (size_t)(blk0 + i * 8 + w) * DIN + 640 + lane * 8); }
      bf16x8 Aw[4][2]; f32x4 g4[6]; float bi[2];
#pragma unroll
      for (int ks = 0; ks < 4; ++ks)
#pragma unroll
          for (int mt = 0; mt < 2; ++mt) { Aw[ks][mt] = (bf16x8){0, 0, 0, 0, 0, 0, 0, 0}; if (ks < nks) Aw[ks][mt] = *(const bf16x8*)(wsb + (size_t)(half * 64 + (2 * ih + mt) * 16 + fr) * 128 + ks * 32 + 8 * fq); }
#pragma unroll
      for (int ct = 0; ct < 6; ++ct) g4[ct] = *(const f32x4*)(gg + h * 96 + ct * 16 + 4 * fq);
#pragma unroll
      for (int mt = 0; mt < 2; ++mt) bi[mt] = bb[half * 64 + (2 * ih + mt) * 16 + fr];
#pragma unroll
      for (int i = 0; i < 16; ++i) { if (i < nr) { float f[8]; unpack8(raw[i], f); float s = 0.f;
#pragma unroll
              for (int q = 0; q < 8; ++q) s += f[q] * f[q];
              s = wave_sum(s); const float rs = 1.0f / sqrtf(s * (1.0f / DGM) + EPS);
              u32x4 o; o.x = cvt_pk_bf16(f[0] * rs, f[1] * rs); o.y = cvt_pk_bf16(f[2] * rs, f[3] * rs); o.z = cvt_pk_bf16(f[4] * rs, f[5] * rs); o.w = cvt_pk_bf16(f[6] * rs, f[7] * rs);
              if (lane < 48) *(LAS u32x4*)(lds + VN + (i * 8 + w) * VST + lane * 16) = o; } }
      u32x2 uu[2][6];
#pragma unroll
      for (int mt = 0; mt < 2; ++mt)
#pragma unroll
          for (int ct = 0; ct < 6; ++ct) uu[mt][ct] = *(const u32x2*)(P + (size_t)(r0 + (2 * ih + mt) * 16 + fr) * DIN + 256 + h * 96 + ct * 16 + 4 * fq);
      __syncthreads();
      { f32x4 acc[2][6];
#pragma unroll
        for (int a = 0; a < 2; ++a)
#pragma unroll
            for (int b = 0; b < 6; ++b) acc[a][b] = (f32x4){0.f, 0.f, 0.f, 0.f};
#pragma unroll
        for (int ks = 0; ks < 4; ++ks) { if (ks < nks) {
#pragma unroll
            for (int ct = 0; ct < 6; ++ct) { const unsigned ad = VN + (32 * ks + 8 * fq + q4) * VST + (h * 96 + ct * 16 + 4 * p4) * 2;
                const s16x4 t0 = __builtin_amdgcn_ds_read_tr16_b64_v4i16((LAS s16x4*)(lds + ad)), t1 = __builtin_amdgcn_ds_read_tr16_b64_v4i16((LAS s16x4*)(lds + ad + 4 * VST));
                bf16x8 B; B[0] = t0[0]; B[1] = t0[1]; B[2] = t0[2]; B[3] = t0[3]; B[4] = t1[0]; B[5] = t1[1]; B[6] = t1[2]; B[7] = t1[3];
#pragma unroll
                for (int mt = 0; mt < 2; ++mt) acc[mt][ct] = __builtin_amdgcn_mfma_f32_16x16x32_bf16(B, Aw[ks][mt], acc[mt][ct], 0, 0, 0); } } }
#pragma unroll
        for (int mt = 0; mt < 2; ++mt) { const int t = r0 + (2 * ih + mt) * 16 + fr;
#pragma unroll
            for (int ct = 0; ct < 6; ++ct) { const int c4 = h * 96 + ct * 16 + 4 * fq; const f32x4 z = acc[mt][ct] * g4[ct] + bi[mt]; const u32x2 uv = uu[mt][ct];
                u32x2 o; o.x = cvt_pk_bf16(bf_lo(uv.x) * z[0], bf_hi(uv.x) * z[1]); o.y = cvt_pk_bf16(bf_lo(uv.y) * z[2], bf_hi(uv.y) * z[3]); *(u32x2*)(Y + (size_t)t * D + 256 + c4) = o; } } }
      __syncthreads(); }
    asm volatile("" : "+v"(tid)); lane = tid & 63;
    for (int mrep = 0; mrep < 1 + ((MIX_REP >> 2) & 1); ++mrep) if (MIX_MASK & 4) { constexpr int HC = 0, TT = 72192, TST = 784;
      { u32x4 cvr[9], cgr[9];
#pragma unroll
        for (int i = 0; i < 9; ++i) { const int idx = tid + 512 * i, rr = idx / 48, ch = idx % 48, pos = s0 - 30 + rr; cvr[i] = (u32x4){0u, 0u, 0u, 0u}; cgr[i] = (u32x4){0u, 0u, 0u, 0u};
            if (idx < 94 * 48 && pos >= 0) { const bf16* pr = P + (size_t)(r0 - 30 + rr) * DIN; cvr[i] = *(const u32x4*)(pr + 1024 + ch * 8); cgr[i] = *(const u32x4*)(pr + 1408 + ch * 8); } }
#pragma unroll
        for (int i = 0; i < 9; ++i) { const int idx = tid + 512 * i, rr = idx / 48, ch = idx % 48; float a[8], b[8]; unpack8(cvr[i], a); unpack8(cgr[i], b);
#pragma unroll
            for (int q = 0; q < 8; ++q) a[q] *= fast_sigmoid(b[q]);
            u32x4 o; o.x = cvt_pk_bf16(a[0], a[1]); o.y = cvt_pk_bf16(a[2], a[3]); o.z = cvt_pk_bf16(a[4], a[5]); o.w = cvt_pk_bf16(a[6], a[7]);
            if (idx < 94 * 48) *(LAS u32x4*)(lds + HC + rr * 768 + ch * 16) = o; } }
      __syncthreads();
      asm volatile("" : "+v"(tid)); lane = tid & 63;
      const int fr = lane & 15, fq = lane >> 4; const bf16* pw = (const bf16*)(ws + WS_PWT) + (size_t)layer * DCV * DCV;
      bf16x8 Bp[4][3];
      { const float* dww = in[8] + (size_t)layer * 31 * DCV; const float* dwb = in[9] + layer * DCV; const float* lg = in[10] + layer * DCV; const float* lb = in[11] + layer * DCV;
        f32x2 g2[3], bt2[3];
#pragma unroll
        for (int q = 0; q < 3; ++q) { g2[q] = *(const f32x2*)(lg + 128 * q + 2 * lane); bt2[q] = *(const f32x2*)(lb + 128 * q + 2 * lane); }
        float dd[8][6];
#pragma unroll
        for (int q = 0; q < 3; ++q) { const int c = 128 * q + 2 * lane; f32x2 wj[31];
#pragma unroll
            for (int j = 0; j < 31; ++j) wj[j] = *(const f32x2*)(dww + j * DCV + c);
            const f32x2 b2 = *(const f32x2*)(dwb + c); float a0[8], a1[8];
#pragma unroll
            for (int r = 0; r < 8; ++r) { a0[r] = b2[0]; a1[r] = b2[1]; }
#pragma unroll
            for (int s = 0; s < 38; ++s) { const unsigned hv = *(const LAS unsigned*)(lds + HC + (8 * w + s) * 768 + c * 2); const float h0 = bf_lo(hv), h1 = bf_hi(hv);
#pragma unroll
                for (int r = 0; r < 8; ++r) { const int j = s - r; if (j >= 0 && j <= 30) { a0[r] += h0 * wj[j][0]; a1[r] += h1 * wj[j][1]; } } }
#pragma unroll
            for (int r = 0; r < 8; ++r) { dd[r][2 * q] = a0[r]; dd[r][2 * q + 1] = a1[r]; asm volatile("" : "+v"(dd[r][2 * q]), "+v"(dd[r][2 * q + 1])); }
            asm volatile("" ::: "memory"); }
#pragma unroll
        for (int ks = 0; ks < 4; ++ks)
#pragma unroll
            for (int nt = 0; nt < 3; ++nt) Bp[ks][nt] = *(const bf16x8*)(pw + (size_t)((3 * w + nt) * 16 + fr) * DCV + ks * 32 + 8 * fq);
#pragma unroll
        for (int r = 0; r < 8; ++r) { float s = 0.f;
#pragma unroll
            for (int q = 0; q < 6; ++q) s += dd[r][q];
            const float mu = wave_sum(s) * (1.0f / DCV); float v = 0.f;
#pragma unroll
            for (int q = 0; q < 6; ++q) { dd[r][q] -= mu; v += dd[r][q] * dd[r][q]; }
            const float rs = 1.0f / sqrtf(wave_sum(v) * (1.0f / DCV) + EPS);
#pragma unroll
            for (int q = 0; q < 3; ++q) { float y0 = dd[r][2 * q] * rs * g2[q][0] + bt2[q][0], y1 = dd[r][2 * q + 1] * rs * g2[q][1] + bt2[q][1]; y0 *= fast_sigmoid(y0); y1 *= fast_sigmoid(y1);
                *(LAS unsigned*)(lds + TT + (8 * w + r) * TST + (128 * q + 2 * lane) * 2) = cvt_pk_bf16(y0, y1); } } }
      __syncthreads();
      { f32x4 acc[4][3];
#pragma unroll
        for (int a = 0; a < 4; ++a)
#pragma unroll
            for (int b = 0; b < 3; ++b) acc[a][b] = (f32x4){0.f, 0.f, 0.f, 0.f};
        const f32x4* pb4 = (const f32x4*)(in[13] + layer * DCV); f32x4 pbv[3];
#pragma unroll
        for (int nt = 0; nt < 3; ++nt) pbv[nt] = pb4[(3 * w + nt) * 4 + fq];
#pragma unroll
        for (int kb = 0; kb < 3; ++kb) { bf16x8 Bn[4][3];
            if (kb < 2) {
#pragma unroll
                for (int ks = 0; ks < 4; ++ks)
#pragma unroll
                    for (int nt = 0; nt < 3; ++nt) Bn[ks][nt] = *(const bf16x8*)(pw + (size_t)((3 * w + nt) * 16 + fr) * DCV + (4 * (kb + 1) + ks) * 32 + 8 * fq); }
#pragma unroll
            for (int ks = 0; ks < 4; ++ks) { bf16x8 A[4];
#pragma unroll
                for (int mt = 0; mt < 4; ++mt) A[mt] = *(const LAS bf16x8*)(lds + TT + (mt * 16 + fr) * TST + ((4 * kb + ks) * 32 + 8 * fq) * 2);
#pragma unroll
                for (int mt = 0; mt < 4; ++mt)
#pragma unroll
                    for (int nt = 0; nt < 3; ++nt) acc[mt][nt] = __builtin_amdgcn_mfma_f32_16x16x32_bf16(Bp[ks][nt], A[mt], acc[mt][nt], 0, 0, 0); }
            if (kb < 2) {
#pragma unroll
                for (int ks = 0; ks < 4; ++ks)
#pragma unroll
                    for (int nt = 0; nt < 3; ++nt) Bp[ks][nt] = Bn[ks][nt]; } }
#pragma unroll
        for (int mt = 0; mt < 4; ++mt)
#pragma unroll
            for (int nt = 0; nt < 3; ++nt) { const int t = r0 + mt * 16 + fr, n4 = (3 * w + nt) * 16 + 4 * fq; const f32x4 v = acc[mt][nt] + pbv[nt];
                u32x2 o; o.x = cvt_pk_bf16(v[0], v[1]); o.y = cvt_pk_bf16(v[2], v[3]); *(u32x2*)(Y + (size_t)t * D + 640 + n4) = o; } }
      __syncthreads(); }
}

__device__ __forceinline__ void router_phase(Frame& F) {
    LAS unsigned char* lds = F.lds; const int lane = F.lane, w = F.wave; unsigned char* ws = F.ws;
    const float* const* in = in_tab(F); const float* X = F.out; const float* g2 = in[15] + D; const float* R = in[19];
    unsigned* rowoff = (unsigned*)(ws + WS_ROWOFF); float* rs_e = (float*)(ws + WS_RS); float* gate_e = (float*)(ws + WS_GATE); int* sel = (int*)(ws + WS_SEL);
    unsigned* cnt = F.ctl + CW_CNT;
    LAS int* se0 = (LAS int*)lds; LAS int* se1 = se0 + 64; LAS float* sw0 = (LAS float*)(se1 + 64); LAS float* sw1 = sw0 + 64; LAS float* srs = sw1 + 64;
    float Rg[4][4][8];
#pragma unroll
    for (int j = 0; j < 4; ++j)
#pragma unroll
        for (int q = 0; q < 4; ++q) { const int k = 4 * lane + 256 * j + q; const float gk = g2[k]; const f32x4 a = *(const f32x4*)(R + k * 8), b = *(const f32x4*)(R + k * 8 + 4);
            Rg[j][q][0] = a[0] * gk; Rg[j][q][1] = a[1] * gk; Rg[j][q][2] = a[2] * gk; Rg[j][q][3] = a[3] * gk; Rg[j][q][4] = b[0] * gk; Rg[j][q][5] = b[1] * gk; Rg[j][q][6] = b[2] * gk; Rg[j][q][7] = b[3] * gk; }
    for (int b = F.vcu; b < M / 64; b += F.G) {
        for (int i = 0; i < 8; ++i) { const int tl = 8 * w + i, t = 64 * b + tl; const f32x4* xr = (const f32x4*)(X + (size_t)t * D) + lane; float ss = 0.f, le[8];
#pragma unroll
            for (int e = 0; e < 8; ++e) le[e] = 0.f;
#pragma unroll
            for (int j = 0; j < 4; ++j) { const f32x4 v = xr[64 * j];
#pragma unroll
                for (int q = 0; q < 4; ++q) { ss += v[q] * v[q];
#pragma unroll
                    for (int e = 0; e < 8; ++e) le[e] += v[q] * Rg[j][q][e]; } }
            ss = wave_sum(ss);
#pragma unroll
            for (int e = 0; e < 8; ++e) le[e] = wave_sum(le[e]);
            const float rs = 1.0f / sqrtf(ss * (1.0f / D) + EPS);
            int i0 = 0; float l0 = le[0];
#pragma unroll
            for (int e = 1; e < 8; ++e) if (le[e] > l0) { l0 = le[e]; i0 = e; }
            int i1 = -1; float l1 = -3.0e38f;
#pragma unroll
            for (int e = 0; e < 8; ++e) if (e != i0 && le[e] > l1) { l1 = le[e]; i1 = e; }
            const float ex = expf((l1 - l0) * rs), w0 = 1.0f / (1.0f + ex), w1 = ex / (1.0f + ex);
            if (lane == 0) { se0[tl] = i0; se1[tl] = i1; sw0[tl] = w0; sw1[tl] = w1; srs[tl] = rs; } }
        __syncthreads();
        if (w == 0) { const int e0 = se0[lane], e1 = se1[lane]; int r0 = 0, r1 = 0; const unsigned long long lt = (1ull << lane) - 1ull;
#pragma unroll
            for (int e = 0; e < 8; ++e) { const unsigned long long m0 = __ballot(e0 == e), m1 = __ballot(e1 == e); const int n0 = __popcll(m0), n = n0 + __popcll(m1); unsigned base = 0u;
                if (lane == 0 && n > 0) base = __hip_atomic_fetch_add(cnt + 64 * e, (unsigned)n, RLX_AGENT);
                base = __shfl(base, 0);
                if (e0 == e) r0 = (int)base + __popcll(m0 & lt);
                if (e1 == e) r1 = (int)base + n0 + __popcll(m1 & lt); }
            const int t = 64 * b + lane; const float rs = srs[lane];
            rowoff[e0 * ECAP + r0] = (unsigned)t * (unsigned)(D * 2); rs_e[e0 * ECAP + r0] = rs; gate_e[e0 * ECAP + r0] = sw0[lane];
            rowoff[e1 * ECAP + r1] = (unsigned)t * (unsigned)(D * 2); rs_e[e1 * ECAP + r1] = rs; gate_e[e1 * ECAP + r1] = sw1[lane];
            *(int4*)(sel + 4 * t) = make_int4(e0, r0, e1, r1); }
        __syncthreads();
    }
}
__device__ __forceinline__ void moe_panels(Frame& F, int (&pb)[9]) {
    unsigned* cnt = F.ctl + CW_CNT; pb[0] = 0;
#pragma unroll
    for (int e = 0; e < 8; ++e) { const unsigned c = (unsigned)__builtin_amdgcn_readfirstlane(__hip_atomic_load(cnt + 64 * e, RLX_AGENT)); pb[e + 1] = pb[e] + (int)((c + 255u) >> 8); }
}
__device__ __forceinline__ void final_phase(Frame& F) {
    int pb[9]; moe_panels(F, pb);
    const int gw = F.vcu * 8 + F.wave, NGW = F.G * 8, lane = F.lane; unsigned char* ws = F.ws;
    const bf16* YP = (const bf16*)(ws + WS_YP); const int* sel = (const int*)(ws + WS_SEL); const float* fg = in_tab(F)[23]; float* X = F.out;
    f32x4 g4[4];
#pragma unroll
    for (int j = 0; j < 4; ++j) g4[j] = *((const f32x4*)fg + lane + 64 * j);
    for (int t = gw; t < M; t += NGW) { const int4 s = *(const int4*)(sel + 4 * t); int b0 = 0, b1 = 0;
#pragma unroll
        for (int e = 0; e < 8; ++e) { b0 = (s.x == e) ? pb[e] : b0; b1 = (s.z == e) ? pb[e] : b1; }
        const size_t p0 = (size_t)(256 * b0 + s.y), p1 = (size_t)(256 * b1 + s.w);
        const f32x4* xr = (const f32x4*)(X + (size_t)t * D) + lane; const u32x2* y0 = (const u32x2*)(YP + p0 * D) + lane; const u32x2* y1 = (const u32x2*)(YP + p1 * D) + lane;
        f32x4 v[4]; float ss = 0.f;
#pragma unroll
        for (int j = 0; j < 4; ++j) { const f32x4 xv = xr[64 * j]; const u32x2 a = y0[64 * j], b = y1[64 * j];
            v[j][0] = xv[0] + bf_lo(a.x) + bf_lo(b.x); v[j][1] = xv[1] + bf_hi(a.x) + bf_hi(b.x); v[j][2] = xv[2] + bf_lo(a.y) + bf_lo(b.y); v[j][3] = xv[3] + bf_hi(a.y) + bf_hi(b.y);
            ss += (v[j][0] * v[j][0] + v[j][1] * v[j][1]) + (v[j][2] * v[j][2] + v[j][3] * v[j][3]); }
        ss = wave_sum(ss); const float rs = 1.0f / sqrtf(ss * (1.0f / D) + EPS);
        f32x4* o = (f32x4*)(X + (size_t)t * D) + lane;
#pragma unroll
        for (int j = 0; j < 4; ++j) o[64 * j] = v[j] * rs * g4[j]; }
}

struct Args { const float* in[24]; float* out; unsigned char* ws; int ph_lo, ph_hi, li, pad; };
__global__ void __launch_bounds__(512, 2) fwd(Args args) {
    extern __shared__ __attribute__((aligned(16))) unsigned char lds_raw[];
    Frame F;
    F.lds = (LAS unsigned char*)lds_raw; F.MISC = (volatile LAS unsigned*)(F.lds + MISC_OFF);
    F.tid = threadIdx.x; F.lane = F.tid & 63; F.wave = __builtin_amdgcn_readfirstlane(F.tid >> 6);
    F.G = gridDim.x; { const int bx = blockIdx.x; F.vcu = (F.G % 8 == 0) ? (bx % 8) * (F.G / 8) + bx / 8 : bx; }
    F.in = args.in; F.out = args.out; F.ws = args.ws; F.ctl = (unsigned*)(args.ws + WS_CTL);
    for (int u = F.tid; u < (LDS_BYTES - MISC_OFF) / 4; u += 512) ((LAS unsigned*)(F.lds + MISC_OFF))[u] = 0u;
    __syncthreads();
    XcdBarrier bar = xcd_barrier_post(F.ctl + CW_BAR + args.li * XCD_BAR_WORDS, F.MISC + 8);
    const int lo = args.ph_lo, hi = args.ph_hi;
#ifndef PH_MASK
#define PH_MASK 0xFFFF
#endif
#define PH_ON(k) (((PH_MASK) >> (k)) & 1)
#ifndef REP_MASK
#define REP_MASK 0
#endif
#define REPS(k) (1 + (((REP_MASK) >> (k)) & 1))
#ifndef PRO_PROBE
#define PRO_PROBE 0
#endif
#ifndef EPI_PROBE
#define EPI_PROBE 0
#endif
#define IN(k) (lo <= (k) && (k) < hi)
#define SEAM(k) do { if (IN(k) && IN((k) + 1)) xcd_barrier(bar); } while (0)
    unsigned char* ws = args.ws; LAS unsigned* gtab = (LAS unsigned*)(F.lds + GTAB_OFF);
    bf16* XB = (bf16*)(ws + WS_XB); float* ssq = (float*)(ws + WS_SSQ);
    if (F.G != 256) return;

    if (PH_ON(0) && IN(0)) for (int rep = 0; rep < REPS(0); ++rep) { p0_prologue(F, rep == 0 ? 0 : PRO_PROBE); __syncthreads(); }
    SEAM(0);
#pragma unroll 1
    for (int layer = 0; layer < 2; ++layer) {
        const int pbase = 1 + layer * 5;
        if (PH_ON(1) && IN(pbase)) for (int rep = 0; rep < REPS(1); ++rep) { pg8::Gemm g{XB, (const bf16*)(ws + WS_WIN) + (size_t)layer * DIN * D, D, 0}; pg8::StaticOrder S; S.init(M, DIN, F.G, (int)blockIdx.x);
            pg8::EpiP E{(bf16*)(ws + WS_P), DIN, ssq}; pg8::gemm_phase<pg8::EpiP, pg8::StaticOrder, true, true>(F.lds, gtab, g, S, E); }
        SEAM(pbase);
        if (PH_ON(2) && IN(pbase + 1)) for (int rep = 0; rep < REPS(2); ++rep) { for (int u = F.vcu; u < M / 64; u += F.G) mixer_unit(F, u, layer); }
        SEAM(pbase + 1);
        if (PH_ON(3) && IN(pbase + 2)) for (int rep = 0; rep < (layer == 0 ? REPS(3) : 1); ++rep) { pg8::Gemm g{(const bf16*)(ws + WS_Y), (const bf16*)(ws + WS_WOUT) + (size_t)layer * D * D, D, 0}; pg8::StaticOrder S; S.init(M, D, F.G, (int)blockIdx.x);
            pg8::EpiResid E{layer == 0 ? in_tab(F)[0] : (const float*)args.out, args.out, XB, ssq}; pg8::gemm_phase<pg8::EpiResid, pg8::StaticOrder, false, true>(F.lds, gtab, g, S, E); }
        SEAM(pbase + 2);
        if (layer == 0) {
            if (PH_ON(4) && IN(4)) for (int rep = 0; rep < REPS(4); ++rep) { pg8::Gemm g{XB, (const bf16*)(ws + WS_WGU), D, 0}; pg8::StaticOrder S; S.init(M, NGU, F.G, (int)blockIdx.x);
                pg8::EpiSwiglu<false> E{(bf16*)(ws + WS_ACT), DFF, ssq, nullptr, nullptr, 0}; pg8::gemm_phase<pg8::EpiSwiglu<false>, pg8::StaticOrder, true, true>(F.lds, gtab, g, S, E); }
            SEAM(4);
            if (PH_ON(5) && IN(5)) { pg8::Gemm g{(const bf16*)(ws + WS_ACT), (const bf16*)(ws + WS_WD), DFF, 0}; pg8::StaticOrder S; S.init(M, D, F.G, (int)blockIdx.x);
                pg8::EpiResid E{(const float*)args.out, args.out, XB, ssq}; pg8::gemm_phase<pg8::EpiResid, pg8::StaticOrder, false, true>(F.lds, gtab, g, S, E); }
            SEAM(5);
        }
    }
    if (PH_ON(9) && IN(9)) router_phase(F);
    SEAM(9);
    if (PH_ON(10) && IN(10)) for (int rep = 0; rep < REPS(10); ++rep) { pg8::MoeOrderGather S; moe_panels(F, S.pb); S.nN = NGUE / 256; S.nwg = S.pb[8] * S.nN; S.G = F.G; S.c = (int)blockIdx.x; S.rowoff = (const unsigned*)(ws + WS_ROWOFF);
        pg8::Gemm g{XB, (const bf16*)(ws + WS_MOE_WGU), D, (size_t)NGUE * D};
        pg8::EpiSwiglu<true> E{(bf16*)(ws + WS_ACTM), DFE, nullptr, (const float*)(ws + WS_RS), (const float*)(ws + WS_GATE), rep == 0 ? 0 : EPI_PROBE};
        pg8::gemm_phase<pg8::EpiSwiglu<true>, pg8::MoeOrderGather, true, true>(F.lds, gtab, g, S, E); }
    SEAM(10);
    if (PH_ON(11) && IN(11)) for (int rep = 0; rep < REPS(11); ++rep) { pg8::MoeOrderDense S; moe_panels(F, S.pb); S.nN = D / 256; S.nwg = S.pb[8] * S.nN; S.G = F.G; S.c = (int)blockIdx.x; S.rowoff = nullptr;
        pg8::Gemm g{(const bf16*)(ws + WS_ACTM), (const bf16*)(ws + WS_MOE_WD), DFE, (size_t)D * DFE};
        pg8::EpiBf16 E{(bf16*)(ws + WS_YP), D};
        pg8::gemm_phase<pg8::EpiBf16, pg8::MoeOrderDense, true, true>(F.lds, gtab, g, S, E); }
    SEAM(11);
    if (PH_ON(12) && IN(12)) final_phase(F);
#undef IN
#undef SEAM
}
#ifndef MK_PER_PHASE
#define MK_PER_PHASE 0
#endif
extern "C" void kernel_launch(void* const* d_in, const int* in_sizes, int n_in, void* d_out, int out_size, void* d_ws, size_t ws_size, hipStream_t stream) {
    static int grid = 0;
    if (grid == 0) {
        if (n_in != 24 || out_size != M * D || ws_size < WS_END) { fprintf(stderr, "kernel_launch: unexpected shapes (n_in %d out %d ws %zu)\n", n_in, out_size, ws_size); grid = -1; return; }
        int dev = 0, cus = 0;
        if (hipGetDevice(&dev) != hipSuccess || hipDeviceGetAttribute(&cus, hipDeviceAttributeMultiprocessorCount, dev) != hipSuccess) { grid = -1; return; }
        if (hipFuncSetAttribute((const void*)fwd, hipFuncAttributeMaxDynamicSharedMemorySize, LDS_BYTES) != hipSuccess) { fprintf(stderr, "kernel_launch: hipFuncSetAttribute failed\n"); grid = -1; return; }
        int per_cu = 0;
        if (hipOccupancyMaxActiveBlocksPerMultiprocessor(&per_cu, (const void*)fwd, 512, LDS_BYTES) != hipSuccess || per_cu < 1) fprintf(stderr, "kernel_launch: occupancy query says %d\n", per_cu);
        (void)hipGetLastError();
        grid = cus;
        if (grid != 256) { fprintf(stderr, "kernel_launch: built for 256 CUs, found %d\n", grid); grid = -1; return; }
    }
    if (grid < 0) return;
    (void)hipMemsetAsync((char*)d_ws + WS_CTL, 0, CTL_ZERO_BYTES, stream);
    Args a{};
    for (int i = 0; i < 24; ++i) a.in[i] = (const float*)d_in[i];
    a.out = (float*)d_out; a.ws = (unsigned char*)d_ws; a.pad = 0;
#if MK_PER_PHASE
    for (int p = 0; p < NPHASE; ++p) { a.ph_lo = p; a.ph_hi = p + 1; a.li = p; hipLaunchKernelGGL(fwd, dim3(grid), dim3(512), LDS_BYTES, stream, a); }
#else
    a.ph_lo = 0; a.ph_hi = NPHASE; a.li = 0; hipLaunchKernelGGL(fwd, dim3(grid), dim3(512), LDS_BYTES, stream, a);
#endif
}
```

```cpp
#define MK_PER_PHASE 0
#include <hip/hip_runtime.h>
#include <cstdio>
#include <cstdint>
constexpr int M = 16384, D = 1024, SEQ = 8192, DIN = 1792, DFF = 2816, DFE = 3584, NE = 8;
constexpr int DPOOL = 256, DGM = 384, DCV = 384;
constexpr int NGU = 2 * DFF, NGUE = 2 * DFE;
constexpr int ECAP = 16384;
constexpr int PMAX = 2 * M + NE * 256;
constexpr float EPS = 1e-6f;

#define LAS __attribute__((address_space(3)))
#define GAS __attribute__((address_space(1)))
typedef unsigned short bf16;
typedef short bf16x8 __attribute__((ext_vector_type(8)));
typedef short s16x4 __attribute__((ext_vector_type(4)));
typedef float f32x4 __attribute__((ext_vector_type(4)));
typedef float f32x2 __attribute__((ext_vector_type(2)));
typedef unsigned u32x4 __attribute__((ext_vector_type(4)));
typedef unsigned u32x2 __attribute__((ext_vector_type(2)));

__device__ __forceinline__ unsigned cvt_pk_bf16(float lo, float hi) { unsigned r; asm volatile("v_cvt_pk_bf16_f32 %0, %1, %2" : "=v"(r) : "v"(lo), "v"(hi)); return r; }
__device__ __forceinline__ float bf_lo(unsigned w) { return __uint_as_float(w << 16); }
__device__ __forceinline__ float bf_hi(unsigned w) { return __uint_as_float(w & 0xffff0000u); }
__device__ __forceinline__ float fast_sigmoid(float x) { return __builtin_amdgcn_rcpf(1.0f + __builtin_amdgcn_exp2f(-1.4426950408889634f * x)); }
__device__ __forceinline__ float wave_sum(float v) {
#pragma unroll
    for (int o = 1; o < 64; o <<= 1) v += __shfl_xor(v, o);
    return v;
}

namespace pg8 {
constexpr int BM = 256, BK = 64, HALF = 128, HTB = HALF * BK * 2, STAGE_BYTES = 8 * HTB, NXCD = 8, WGM = 8;
__host__ __device__ __forceinline__ int lds_byte(int r, int c) { const int st = (r >> 4) * 2 + (c >> 5), rr = r & 15, cc = c & 31, ob = rr * 64 + cc * 2; return st * 1024 + (ob ^ (((ob >> 9) & 1) << 5)); }
__host__ __device__ __forceinline__ void stage_rc(int b, int& R, int& C) { const int st = b / 1024, sb = b % 1024, swz = sb ^ (((sb >> 9) & 1) << 5); R = (st >> 1) * 16 + swz / 64; C = (st & 1) * 32 + (swz % 64) / 2; }
__host__ __device__ __forceinline__ int perm32(int rho) { const int n = rho >> 4, i = rho & 15; return 8 * (i >> 2) + 4 * n + (i & 3); }

struct Unit { int pm, pn, e, tab, k0b, nt, slab; };
struct Gemm { const bf16* A; const bf16* Bt; int K; size_t bstride_e; };

__device__ __forceinline__ void order_map(int wgid, int nM, int nN, int& pm, int& pn) {
    const int nwg = nM * nN; { const int q = nwg / NXCD, r = nwg % NXCD, xcd = wgid % NXCD, off = wgid / NXCD; wgid = (xcd < r ? xcd * (q + 1) : r * (q + 1) + (xcd - r) * q) + off; }
    const int nig = WGM * nN, gid = wgid / nig, fm = gid * WGM, gsz = (nM - fm) < WGM ? (nM - fm) : WGM;
    pm = fm + ((wgid % nig) % gsz); pn = (wgid % nig) / gsz;
}
struct StaticOrder {
    static constexpr bool GATHER = false;
    int nM, nN, nwg, G, c;
    __device__ void init(int Mrows, int N, int G_, int c_) { nM = Mrows / BM; nN = N / BM; nwg = nM * nN; G = G_; c = c_; }
    __device__ __forceinline__ bool next(int i, Unit& u) const { const long L = (long)i * G + c; if (L >= nwg) return false; order_map((int)L, nM, nN, u.pm, u.pn); u.e = 0; u.tab = 0; u.k0b = 0; u.nt = 0; u.slab = -1; return true; }
    __device__ __forceinline__ const unsigned* a_table(const Unit&) const { return nullptr; }
};
struct MoeOrder {
    int pb[9]; int nN, nwg, G, c; const unsigned* rowoff;
    __device__ __forceinline__ bool next(int i, Unit& u) const {
        const long L = (long)i * G + c; if (L >= nwg) return false; order_map((int)L, pb[8], nN, u.pm, u.pn); u.k0b = 0; u.nt = 0; u.slab = -1;
        int e = 0;
#pragma unroll
        for (int k = 1; k < 8; ++k) e += (u.pm >= pb[k]) ? 1 : 0;
        int pbe = pb[0];
#pragma unroll
        for (int k = 1; k < 8; ++k) pbe = (e == k) ? pb[k] : pbe;
        u.e = e; u.tab = e * ECAP + 256 * (u.pm - pbe); return true;
    }
    __device__ __forceinline__ const unsigned* a_table(const Unit& u) const { return rowoff + u.tab; }
};
struct MoeOrderGather : MoeOrder { static constexpr bool GATHER = true; };
__host__ __device__ __forceinline__ int moe_split(int r, int G) { return r == 0 ? 1 : (r * 14 <= G ? 14 : (r * 7 <= G ? 7 : (r * 4 <= G ? 4 : (r * 2 <= G ? 2 : 1)))); }
struct MoeOrderDown {
    static constexpr bool GATHER = false;
    int pb[9]; int G, c, NPf, nfull, r, s;
    __device__ __forceinline__ void init(int G_, int c_) { G = G_; c = c_; const int total = pb[8] * 4; nfull = (total / G) * G; NPf = nfull / 4; r = total - nfull; s = moe_split(r, G); }
    __device__ __forceinline__ bool next(int i, Unit& u) const {
        const int L = i * G + c; u.tab = 0;
        if (L < nfull) { order_map(L, NPf, 4, u.pm, u.pn); u.k0b = 0; u.nt = 0; u.slab = -1; }
        else { const int j = L - nfull; if (j >= r * s) return false; const int lu = j / s, ks = j - lu * s; u.pm = NPf + (lu >> 2); u.pn = lu & 3; u.nt = (DFE / BK) / s; u.k0b = ks * u.nt * BK * 2; u.slab = s > 1 ? j : -1; }
        int e = 0;
#pragma unroll
        for (int k = 1; k < 8; ++k) e += (u.pm >= pb[k]) ? 1 : 0;
        u.e = e; return true;
    }
    __device__ __forceinline__ const unsigned* a_table(const Unit&) const { return nullptr; }
};

__device__ __forceinline__ float rstd_of(const float* ssq, int row) { const float s = (ssq[row] + ssq[M + row]) + (ssq[2 * M + row] + ssq[3 * M + row]); return 1.0f / sqrtf(s * (1.0f / D) + EPS); }

struct EpiP {
    static constexpr bool PERM = true, AFTER_DRAIN = false;
    bf16* O; int ldc; const float* ssq;
    __device__ __forceinline__ void operator()(const f32x4 (&acc)[2][2][4][2], const Unit& u, int wr, int wc, int fr, int fq) const {
        const int row0 = u.pm * BM + wr * 64 + fr, col0 = u.pn * BM + wc * 32 + 8 * fq;
#pragma unroll
        for (int ai = 0; ai < 2; ++ai)
#pragma unroll
            for (int m = 0; m < 4; ++m) { const int row = row0 + ai * HALF + m * 16; const float rs = rstd_of(ssq, row); bf16* rowp = O + (size_t)row * ldc + col0;
#pragma unroll
                for (int bj = 0; bj < 2; ++bj) { const f32x4 v0 = acc[ai][bj][m][0] * rs, v1 = acc[ai][bj][m][1] * rs;
                    u32x4 w; w.x = cvt_pk_bf16(v0[0], v0[1]); w.y = cvt_pk_bf16(v0[2], v0[3]); w.z = cvt_pk_bf16(v1[0], v1[1]); w.w = cvt_pk_bf16(v1[2], v1[3]);
                    *(u32x4*)(rowp + bj * HALF) = w; } }
    }
};
template <bool MOE> struct EpiSwiglu {
    static constexpr bool PERM = true, AFTER_DRAIN = false;
    bf16* O; int ldc; const float* ssq; const float* rs_e; const float* gate_e; int mode;
    __device__ __forceinline__ void operator()(const f32x4 (&acc)[2][2][4][2], const Unit& u, int wr, int wc, int fr, int fq) const {
        if (mode == 2) { asm volatile("" :: "v"(acc[0][0][0][0][0]), "v"(acc[1][1][3][1][3])); return; }
        const int lr0 = wr * 64 + fr, col0 = u.pn * HALF + wc * 32 + 8 * fq;
#pragma unroll
        for (int ai = 0; ai < 2; ++ai)
#pragma unroll
            for (int m = 0; m < 4; ++m) { const int lr = lr0 + ai * HALF + m * 16, row = u.pm * BM + lr; float rs, gw;
                if (MOE) { rs = rs_e[u.tab + lr]; gw = gate_e[u.tab + lr]; } else { rs = rstd_of(ssq, row); gw = 1.0f; }
                float o[8]; const float c1 = rs * -1.4426950408889634f, c2 = rs * rs * gw;
#pragma unroll
                for (int n = 0; n < 2; ++n) { const f32x4 ga = acc[ai][0][m][n], gu = ga * acc[ai][1][m][n] * c2, ex = ga * c1;
#pragma unroll
                    for (int q = 0; q < 4; ++q) o[n * 4 + q] = gu[q] * __builtin_amdgcn_rcpf(1.0f + __builtin_amdgcn_exp2f(ex[q])); }
                u32x4 w; w.x = cvt_pk_bf16(o[0], o[1]); w.y = cvt_pk_bf16(o[2], o[3]); w.z = cvt_pk_bf16(o[4], o[5]); w.w = cvt_pk_bf16(o[6], o[7]);
                if (mode == 1) { asm volatile("" :: "v"(w.x), "v"(w.y), "v"(w.z), "v"(w.w)); } else *(u32x4*)(O + (size_t)row * ldc + col0) = w; }
    }
};
struct EpiBf16 {
    static constexpr bool PERM = true, AFTER_DRAIN = false;
    bf16* O; int ldc; bf16* slabs;
    __device__ __forceinline__ void operator()(const f32x4 (&acc)[2][2][4][2], const Unit& u, int wr, int wc, int fr, int fq) const {
        const bool sl = u.slab >= 0; bf16* base = sl ? slabs + (size_t)u.slab * (BM * BM) : O; const int ld = sl ? BM : ldc;
        const int row0 = (sl ? 0 : u.pm * BM) + wr * 64 + fr, col0 = (sl ? 0 : u.pn * BM) + wc * 32 + 8 * fq;
#pragma unroll
        for (int ai = 0; ai < 2; ++ai)
#pragma unroll
            for (int m = 0; m < 4; ++m) { bf16* rowp = base + (size_t)(row0 + ai * HALF + m * 16) * ld + col0;
#pragma unroll
                for (int bj = 0; bj < 2; ++bj) { const f32x4 v0 = acc[ai][bj][m][0], v1 = acc[ai][bj][m][1];
                    u32x4 w; w.x = cvt_pk_bf16(v0[0], v0[1]); w.y = cvt_pk_bf16(v0[2], v0[3]); w.z = cvt_pk_bf16(v1[0], v1[1]); w.w = cvt_pk_bf16(v1[2], v1[3]);
                    *(u32x4*)(rowp + bj * HALF) = w; } }
    }
};
struct EpiResid {
    static constexpr bool PERM = false, AFTER_DRAIN = true;
    const float* xold; float* X; bf16* XB; float* ssq;
    __device__ __forceinline__ void fused(f32x4 (&acc)[2][2][4][2], const Unit& u, int wr, int wc, int fr, int fq, LAS unsigned char* lds, int wid, int lane) const {
        LAS float* Pt = (LAS float*)lds;
        const int col0 = u.pn * BM + wc * 32 + 4 * fq;
#pragma unroll
        for (int ai = 0; ai < 2; ++ai)
#pragma unroll
            for (int m = 0; m < 4; ++m) { const int r = ai * HALF + wr * 64 + m * 16 + fr; const size_t off = (size_t)(u.pm * BM + r) * D + col0; float s = 0.f;
#pragma unroll
                for (int bj = 0; bj < 2; ++bj)
#pragma unroll
                    for (int n = 0; n < 2; ++n) { const f32x4 bs = *(const f32x4*)(xold + off + bj * HALF + n * 16); const f32x4 o = bs + acc[ai][bj][m][n];
                        *(f32x4*)(X + off + bj * HALF + n * 16) = o; u32x2 w; w.x = cvt_pk_bf16(o[0], o[1]); w.y = cvt_pk_bf16(o[2], o[3]); *(u32x2*)(XB + off + bj * HALF + n * 16) = w;
                        s += (o[0] * o[0] + o[1] * o[1]) + (o[2] * o[2] + o[3] * o[3]); }
                s += __shfl_xor(s, 16); s += __shfl_xor(s, 32);
                if (fq == 0) Pt[r * 4 + wc] = s; }
        __syncthreads();
        const int t = wid * 64 + lane;
        if (t < 256) { const float s = (Pt[t * 4 + 0] + Pt[t * 4 + 1]) + (Pt[t * 4 + 2] + Pt[t * 4 + 3]); ssq[(size_t)u.pn * M + u.pm * BM + t] = s; }
        __syncthreads();
    }
};

template <class Epi, class Sched, bool ALIGN_EPI = false, bool SP2 = true>
__device__ __forceinline__ void gemm_phase(LAS unsigned char* lds, LAS unsigned* gtab, const Gemm g, const Sched& S, const Epi& E) {
    constexpr bool GATHER = Sched::GATHER;
    static_assert(!GATHER || SP2, "gather needs the SP2 loop (lgkmcnt(0) waits only)");
    int tid_ = threadIdx.x; asm volatile("" : "+v"(tid_));
    const int tid = tid_, wid = __builtin_amdgcn_readfirstlane(tid >> 6), lane = tid & 63, wr = wid >> 2, wc = wid & 3, fr = lane & 15, fq = lane >> 4;
    const int K = g.K; int nt = K / BK;
    unsigned voffA[2], voffB[2];
#pragma unroll
    for (int i = 0; i < 2; ++i) { int R, C; stage_rc(tid * 16 + i * 8192, R, C); const int Rb = Epi::PERM ? ((R & ~31) + perm32(R & 31)) : R;
        voffA[i] = (unsigned)(R * K + C) * 2u; voffB[i] = (unsigned)(Rb * K + C) * 2u; }
    const size_t kstep = (size_t)(BK * 2);
    const size_t hstep = (size_t)HALF * K * 2;
    const size_t tstep = 2 * hstep;
    const unsigned ldsw = (unsigned)wid * 1024u;
    const int aoff = lds_byte(wr * 64 + fr, fq * 8), boff = lds_byte(wc * 32 + fr, fq * 8);
#define PG8_SA(b, h) (((b) * 2 + (h)) * HTB)
#define PG8_SB(b, h) ((4 + (b) * 2 + (h)) * HTB)
#define PG8_STAGE(bufoff, gbase, voff) do { _Pragma("unroll") for (int _i = 0; _i < 2; ++_i) \
        __builtin_amdgcn_global_load_lds((const unsigned*)((const char*)(gbase) + (voff)[_i]), (LAS unsigned*)(lds + (bufoff) + ldsw + _i * 8192), 16, 0, 0); } while (0)
#define PG8_STAGE_A(bufoff, ubase, kb, h) do { if constexpr (GATHER) { PG8_STAGE(bufoff, (const char*)g.A + (kb), ga[h]); } else { PG8_STAGE(bufoff, (ubase) + (size_t)(h) * hstep + (kb), voffA); } } while (0)
#define PG8_LDA(dst, b, h) do { _Pragma("unroll") for (int m = 0; m < 4; ++m) _Pragma("unroll") for (int k = 0; k < 2; ++k) dst[m][k] = *(const LAS bf16x8*)(lds + PG8_SA(b, h) + aoff + m * 2048 + k * 1024); } while (0)
#define PG8_LDB(dst, b, h) do { _Pragma("unroll") for (int n = 0; n < 2; ++n) _Pragma("unroll") for (int k = 0; k < 2; ++k) dst[n][k] = *(const LAS bf16x8*)(lds + PG8_SB(b, h) + boff + n * 2048 + k * 1024); } while (0)
#define PG8_MMA(ai, bj, At, Bt) do { __builtin_amdgcn_s_setprio(1); _Pragma("unroll") for (int m = 0; m < 4; ++m) _Pragma("unroll") for (int n = 0; n < 2; ++n) _Pragma("unroll") for (int k = 0; k < 2; ++k) \
        acc[ai][bj][m][n] = __builtin_amdgcn_mfma_f32_16x16x32_bf16(Bt[n][k], At[m][k], acc[ai][bj][m][n], 0, 0, 0); __builtin_amdgcn_s_setprio(0); } while (0)
#define PG8_WAIT_V(n) asm volatile("s_waitcnt vmcnt(" #n ")" ::: "memory")
#define PG8_WAIT_L(n) asm volatile("s_waitcnt lgkmcnt(" #n ")" ::: "memory")
#define PG8_BAR __builtin_amdgcn_s_barrier()
#define PG8_SCHED __builtin_amdgcn_sched_barrier(0)
#define PG8_GTAB_DMA(un, slot) do { if (wid < 4) __builtin_amdgcn_global_load_lds(S.a_table(un) + wid * 64 + lane, (LAS unsigned*)(gtab + (slot) * 256 + wid * 64), 4, 0, 0); } while (0)
#define PG8_GTAB_READ(dst, slot) do { _Pragma("unroll") for (int _i = 0; _i < 2; ++_i) { int _R, _C; stage_rc(tid * 16 + _i * 8192, _R, _C); _Pragma("unroll") for (int _h = 0; _h < 2; ++_h) dst[_h][_i] = gtab[(slot) * 256 + _h * HALF + _R] + (unsigned)_C * 2u; } } while (0)
    Unit cur, nxt; int ui = 0;
    if (!S.next(0, cur)) return;
    f32x4 acc[2][2][4][2];
#pragma unroll
    for (int a = 0; a < 2; ++a)
#pragma unroll
        for (int b = 0; b < 2; ++b)
#pragma unroll
            for (int m = 0; m < 4; ++m)
#pragma unroll
                for (int n = 0; n < 2; ++n) acc[a][b][m][n] = (f32x4){0.f, 0.f, 0.f, 0.f};
    bf16x8 At[4][2], B0[2][2], B1[2][2];
    unsigned ga[2][2];
    if (cur.nt) nt = cur.nt;
    const char* cA = (const char*)g.A + (GATHER ? (size_t)0 : (size_t)cur.pm * tstep + cur.k0b); const char* cB = (const char*)g.Bt + ((size_t)cur.e * g.bstride_e) * 2 + (size_t)cur.pn * tstep + cur.k0b;
    if constexpr (GATHER) { PG8_GTAB_DMA(cur, 0); PG8_WAIT_V(0); PG8_BAR; PG8_GTAB_READ(ga, 0); }
    if constexpr (SP2) {
        PG8_STAGE(PG8_SB(0, 0), cB, voffB); PG8_STAGE(PG8_SB(0, 1), cB + hstep, voffB); PG8_STAGE_A(PG8_SA(0, 0), cA, 0, 0); PG8_STAGE_A(PG8_SA(0, 1), cA, 0, 1);
        if (wr == 1) PG8_BAR;
        PG8_WAIT_V(2); PG8_BAR;
        PG8_STAGE(PG8_SB(1, 0), cB + kstep, voffB); PG8_STAGE_A(PG8_SA(1, 0), cA, kstep, 0); PG8_STAGE(PG8_SB(1, 1), cB + hstep + kstep, voffB);
        PG8_WAIT_V(6); PG8_BAR;
    } else {
        PG8_STAGE(PG8_SB(0, 0), cB, voffB); PG8_STAGE_A(PG8_SA(0, 0), cA, 0, 0); PG8_STAGE(PG8_SB(0, 1), cB + hstep, voffB); PG8_STAGE_A(PG8_SA(0, 1), cA, 0, 1);
        if (wr == 1) PG8_BAR;
        PG8_WAIT_V(4); PG8_BAR;
        PG8_STAGE(PG8_SB(1, 0), cB + kstep, voffB); PG8_STAGE_A(PG8_SA(1, 0), cA, kstep, 0); PG8_STAGE(PG8_SB(1, 1), cB + hstep + kstep, voffB);
        PG8_WAIT_V(6); PG8_BAR;
    }
    for (;;) {
        const bool has_next = S.next(ui + 1, nxt);
        const char* nA = (has_next && !GATHER) ? (const char*)g.A + (size_t)nxt.pm * tstep + nxt.k0b : cA;
        const char* nB = has_next ? (const char*)g.Bt + ((size_t)nxt.e * g.bstride_e) * 2 + (size_t)nxt.pn * tstep + nxt.k0b : cB;
        for (int t = 0; t < nt; t += 2) {
            const bool last = (t == nt - 2);
            const size_t k1 = (size_t)(t + 1) * kstep;
            const char* a2 = last ? nA : cA; const size_t k2 = last ? 0 : (size_t)(t + 2) * kstep;
            const char* b2 = last ? nB : cB + (size_t)(t + 2) * kstep; const char* b3 = b2 + kstep;
            const size_t k3 = k2 + kstep;
            if constexpr (GATHER) {
                if (t == nt - 4 && has_next) PG8_GTAB_DMA(nxt, (ui + 1) & 1);
            }
            if constexpr (SP2) {
            PG8_LDB(B0, 0, 0); PG8_LDB(B1, 0, 1); PG8_SCHED; PG8_LDA(At, 0, 0); PG8_STAGE_A(PG8_SA(1, 1), cA, k1, 1);
            if constexpr (GATHER) { if (last && has_next) PG8_GTAB_READ(ga, (ui + 1) & 1); }
            PG8_WAIT_V(8); PG8_WAIT_L(0); PG8_BAR; PG8_MMA(0, 0, At, B0); PG8_MMA(0, 1, At, B1); PG8_BAR; PG8_SCHED;
            PG8_LDA(At, 0, 1); PG8_STAGE(PG8_SB(0, 0), b2, voffB); PG8_STAGE(PG8_SB(0, 1), b2 + hstep, voffB); PG8_STAGE_A(PG8_SA(0, 0), a2, k2, 0);
            PG8_WAIT_V(8); PG8_WAIT_L(0); PG8_BAR; PG8_MMA(1, 0, At, B0); PG8_MMA(1, 1, At, B1); PG8_BAR; PG8_SCHED;
            PG8_LDB(B0, 1, 0); PG8_LDB(B1, 1, 1); PG8_SCHED; PG8_LDA(At, 1, 0); PG8_STAGE_A(PG8_SA(0, 1), a2, k2, 1);
            PG8_WAIT_V(8); PG8_WAIT_L(0); PG8_BAR; PG8_MMA(0, 0, At, B0); PG8_MMA(0, 1, At, B1); PG8_BAR; PG8_SCHED;
            PG8_LDA(At, 1, 1); PG8_STAGE(PG8_SB(1, 0), b3, voffB); PG8_STAGE(PG8_SB(1, 1), b3 + hstep, voffB); PG8_STAGE_A(PG8_SA(1, 0), a2, k3, 0);
            PG8_WAIT_V(8); PG8_WAIT_L(0); PG8_BAR; PG8_MMA(1, 0, At, B0); PG8_MMA(1, 1, At, B1); PG8_BAR; PG8_SCHED;
            } else {
            PG8_LDB(B0, 0, 0); PG8_SCHED; PG8_LDA(At, 0, 0); PG8_STAGE_A(PG8_SA(1, 1), cA, k1, 1);
            PG8_WAIT_L(8); PG8_BAR; PG8_WAIT_L(0); PG8_MMA(0, 0, At, B0); PG8_BAR; PG8_SCHED;
            PG8_LDB(B1, 0, 1); PG8_STAGE(PG8_SB(0, 0), b2, voffB);
            PG8_BAR; PG8_WAIT_L(0); PG8_MMA(0, 1, At, B1); PG8_BAR;
            PG8_LDA(At, 0, 1); PG8_STAGE_A(PG8_SA(0, 0), a2, k2, 0);
            PG8_BAR; PG8_WAIT_L(0); PG8_MMA(1, 0, At, B0); PG8_BAR; PG8_SCHED;
            PG8_STAGE(PG8_SB(0, 1), b2 + hstep, voffB);
            PG8_WAIT_V(6); PG8_BAR; PG8_MMA(1, 1, At, B1); PG8_BAR;
            PG8_LDB(B0, 1, 0); PG8_SCHED; PG8_LDA(At, 1, 0); PG8_STAGE_A(PG8_SA(0, 1), a2, k2, 1);
            PG8_WAIT_L(8); PG8_BAR; PG8_WAIT_L(0); PG8_MMA(0, 0, At, B0); PG8_BAR; PG8_SCHED;
            PG8_LDB(B1, 1, 1); PG8_STAGE(PG8_SB(1, 0), b3, voffB);
            PG8_BAR; PG8_WAIT_L(0); PG8_MMA(0, 1, At, B1); PG8_BAR;
            PG8_LDA(At, 1, 1); PG8_STAGE_A(PG8_SA(1, 0), a2, k3, 0);
            PG8_BAR; PG8_WAIT_L(0); PG8_MMA(1, 0, At, B0); PG8_BAR; PG8_SCHED;
            PG8_STAGE(PG8_SB(1, 1), b3 + hstep, voffB);
            PG8_WAIT_V(6); PG8_BAR; PG8_MMA(1, 1, At, B1); PG8_BAR;
            }
        }
        if constexpr (ALIGN_EPI) { if (wr == 0) PG8_BAR; }
        if constexpr (!Epi::AFTER_DRAIN) { E(acc, cur, wr, wc, fr, fq); }
        if (!has_next) break;
#pragma unroll
        for (int a = 0; a < 2; ++a)
#pragma unroll
            for (int b = 0; b < 2; ++b)
#pragma unroll
                for (int m = 0; m < 4; ++m)
#pragma unroll
                    for (int n = 0; n < 2; ++n) acc[a][b][m][n] = (f32x4){0.f, 0.f, 0.f, 0.f};
        cur = nxt; cA = nA; cB = nB; ++ui; nt = cur.nt ? cur.nt : K / BK;
        if constexpr (ALIGN_EPI) { if (wr == 1) PG8_BAR; }
    }
    PG8_WAIT_V(0);
    if constexpr (!ALIGN_EPI) { if (wr == 0) PG8_BAR; }
    PG8_BAR;
    if constexpr (Epi::AFTER_DRAIN) { E.fused(acc, cur, wr, wc, fr, fq, lds, wid, lane); }
#undef PG8_SA
#undef PG8_SB
#undef PG8_STAGE
#undef PG8_STAGE_A
#undef PG8_LDA
#undef PG8_LDB
#undef PG8_MMA
#undef PG8_WAIT_V
#undef PG8_WAIT_L
#undef PG8_BAR
#undef PG8_SCHED
#undef PG8_GTAB_DMA
#undef PG8_GTAB_READ
}
}
constexpr size_t MiB = 1u << 20;
constexpr size_t WS_CTL = 0, CTL_ZERO_BYTES = 1 * MiB;
constexpr size_t WS_ROWOFF = 1 * MiB;
constexpr size_t WS_RS = WS_ROWOFF + 512 * 1024;
constexpr size_t WS_GATE = WS_RS + 512 * 1024;
constexpr size_t WS_SEL = WS_GATE + 512 * 1024;
constexpr size_t WS_SSQ = WS_SEL + 256 * 1024;
constexpr size_t WS_SMALLW = 4 * MiB;
constexpr size_t WS_PWT = WS_SMALLW;
constexpr size_t WS_POOLWT = WS_PWT + 2 * 384 * 384 * 2;
constexpr size_t WS_GMWS = WS_POOLWT + 2 * 4 * 64 * 64 * 2;
constexpr size_t WS_XB = 6 * MiB;
constexpr size_t WS_SLAB = 6 * MiB;
constexpr size_t WS_MOE_WD = 38 * MiB;
constexpr size_t WS_MOE_WGU = 94 * MiB;
constexpr size_t WS_YP = 94 * MiB;
constexpr size_t WS_ACTM = 206 * MiB;
constexpr size_t WS_P = 206 * MiB;
constexpr size_t WS_Y = 262 * MiB;
constexpr size_t WS_ACT = 206 * MiB;
constexpr size_t WS_WIN = 294 * MiB;
constexpr size_t WS_WOUT = 301 * MiB;
constexpr size_t WS_WGU = 305 * MiB;
constexpr size_t WS_WD = 316 * MiB;
constexpr size_t WS_END = 444 * MiB;
static_assert(WS_SSQ + 4 * (size_t)M * 4 <= WS_SMALLW && WS_GMWS + 2 * 4 * 128 * 128 * 2 <= WS_XB && WS_XB + (size_t)M * D * 2 <= WS_MOE_WD, "ws map 1");
static_assert(WS_MOE_WD + (size_t)NE * D * DFE * 2 <= WS_MOE_WGU && WS_MOE_WGU + (size_t)NE * NGUE * D * 2 <= WS_ACTM && WS_YP + (size_t)PMAX * D * 2 <= WS_ACTM, "ws map 2");
static_assert(WS_ACTM + (size_t)PMAX * DFE * 2 <= WS_END && WS_P + (size_t)M * DIN * 2 <= WS_Y && WS_Y + (size_t)M * D * 2 <= WS_WIN && WS_ACT + (size_t)M * DFF * 2 <= WS_WIN, "ws map 3");
static_assert(WS_WIN + 2 * (size_t)DIN * D * 2 <= WS_WOUT && WS_WOUT + 2 * (size_t)D * D * 2 <= WS_WGU && WS_WGU + (size_t)NGU * D * 2 <= WS_WD && WS_WD + (size_t)D * DFF * 2 <= WS_END, "ws map 4");
constexpr int CW_BAR = 4096;
constexpr int CW_CNT = 131072;
constexpr int NPHASE = 13;
constexpr int RING_BYTES = 131072;
constexpr int GTAB_OFF = RING_BYTES;
constexpr int MISC_OFF = GTAB_OFF + 2048;
constexpr int LDS_BYTES = 147456;
static_assert(MISC_OFF + 256 <= LDS_BYTES, "LDS map");

typedef GAS unsigned gu32;
#define RLX_AGENT __ATOMIC_RELAXED, __HIP_MEMORY_SCOPE_AGENT
#define LDS_WAIT() asm volatile("s_waitcnt lgkmcnt(0)" ::: "memory")
#define VM_WAIT() asm volatile("s_waitcnt vmcnt(0)" ::: "memory")

#define XB_TMO      128
#define XB_XCNT(j)  (256  + 64 * (j))
#define XB_XSUB(j)  (1280 + 64 * (j))
#define XB_XGEN(j)  (2304 + 64 * (j))
#define XB_TOP      3328
#define XB_TOPGEN   3392
#define XCD_BAR_WORDS 3456
#define XB_SPIN_CAP (1u << 18)
__device__ __forceinline__ unsigned xb_ld(unsigned* p)              { return __hip_atomic_load(p, __ATOMIC_RELAXED, __HIP_MEMORY_SCOPE_AGENT); }
__device__ __forceinline__ unsigned xb_add(unsigned* p, unsigned v) { return __hip_atomic_fetch_add(p, v, __ATOMIC_RELAXED, __HIP_MEMORY_SCOPE_AGENT); }
__device__ __forceinline__ unsigned xb_xcc_id() { return (unsigned)__builtin_amdgcn_s_getreg((3 << 11) | 20) & 0xFu; }
#define XB_SPIN(cond, bar) do { unsigned _sp = 0; while (cond) { __builtin_amdgcn_s_sleep(1); \
    if ((++_sp & 255u) == 0u) { if (xb_ld(&(bar)[XB_TMO])) break; if (_sp > XB_SPIN_CAP) { atomicAdd(&(bar)[XB_TMO], 1u); break; } } } } while (0)
struct XcdBarrier { unsigned* bar; unsigned x; volatile LAS unsigned* st; };
__device__ __forceinline__ XcdBarrier xcd_barrier_post(unsigned* bar, volatile LAS unsigned* st) {
    XcdBarrier b; b.bar = bar; b.x = xb_xcc_id(); b.st = st;
    if (threadIdx.x == 0) (void)xb_add(&bar[XB_XCNT(b.x)], 1u);
    return b;
}
__device__ __forceinline__ void xcd_barrier_complete(unsigned* bar, unsigned x, unsigned& nloc, unsigned& nx) {
    const unsigned G = gridDim.x * gridDim.y * gridDim.z;
    unsigned sum, cnt, mine, sp = 0u;
    for (;;) {
        sum = 0u; cnt = 0u; mine = 0u;
#pragma unroll
        for (unsigned j = 0; j < 16; ++j) { const unsigned c = xb_ld(&bar[XB_XCNT(j)]); sum += c; cnt += (c > 0u) ? 1u : 0u; mine = (j == x) ? c : mine; }
        if (sum == G) break;
        __builtin_amdgcn_s_sleep(1);
        if ((++sp & 255u) == 0u) { if (xb_ld(&bar[XB_TMO])) break; if (sp > XB_SPIN_CAP) { atomicAdd(&bar[XB_TMO], 1u); break; } }
    }
    nloc = mine > 0u ? mine : 1u; nx = cnt > 0u ? cnt : 1u;
}
__device__ __forceinline__ void xcd_barrier(const XcdBarrier& b) {
    asm volatile("s_waitcnt vmcnt(0)" ::: "memory");
    __syncthreads();
    if (threadIdx.x == 0) {
        unsigned* bar = b.bar;
        __builtin_amdgcn_s_waitcnt(0);
        unsigned nloc = b.st[0], nx = b.st[1];
        if (nloc == 0u) { xcd_barrier_complete(bar, b.x, nloc, nx); b.st[0] = nloc; b.st[1] = nx; }
        const unsigned old = xb_add(&bar[XB_XSUB(b.x)], 1u);
        const unsigned gen = old / nloc;
        if (old + 1u == (gen + 1u) * nloc) {
            __builtin_amdgcn_fence(__ATOMIC_RELEASE, "agent");
            asm volatile("s_waitcnt vmcnt(0)" ::: "memory");
            const unsigned og = xb_add(&bar[XB_TOP], 1u);
            const unsigned tg = og / nx;
            if (og + 1u == (tg + 1u) * nx) xb_add(&bar[XB_TOPGEN], 1u);
            else XB_SPIN(xb_ld(&bar[XB_TOPGEN]) == tg, bar);
            __builtin_amdgcn_fence(__ATOMIC_ACQUIRE, "agent");
            xb_add(&bar[XB_XGEN(b.x)], 1u);
            asm volatile("s_waitcnt vmcnt(0)" ::: "memory");
        } else {
            XB_SPIN(xb_ld(&bar[XB_XGEN(b.x)]) == gen, bar);
            __builtin_amdgcn_fence(__ATOMIC_ACQUIRE, "agent");
            asm volatile("s_waitcnt vmcnt(0)" ::: "memory");
        }
    }
    __syncthreads();
}

struct Frame {
    LAS unsigned char* lds; volatile LAS unsigned* MISC; unsigned* ctl;
    int tid, lane, wave, vcu, G;
    const float* const* in; float* out; unsigned char* ws;
};

__device__ __forceinline__ const float* const* in_tab(Frame& F) { return F.in; }
struct TrJob { const float* src; bf16* dst; const float* gk; int K, N; };
__device__ __forceinline__ TrJob tr_mat(const float* W, int K, int N, bf16* WT, int mode, const float* gk, int r) {
    const int nblk = N / 32, kb = r / nblk, nb = r % nblk, n0 = 32 * nb, k0 = 64 * kb;
    const int drow = mode == 0 ? n0 : ((n0 >> 7) * 256 + (n0 & 127) + (mode == 2 ? 128 : 0));
    TrJob j; j.src = W + (size_t)k0 * N + n0; j.dst = WT + (size_t)drow * K + k0; j.gk = gk ? gk + k0 : nullptr; j.K = K; j.N = N; return j;
}
constexpr int TR_I_IN = (D / 64) * (DIN / 32), TR_I_OUT = (D / 64) * (D / 32), TR_I_G = (D / 64) * (DFF / 32), TR_I_D = (DFF / 64) * (D / 32), TR_I_MG = (D / 64) * (DFE / 32), TR_I_MD = (DFE / 64) * (D / 32), TR_I_PW = (DCV / 64) * (DCV / 32), TR_I_PL = 2;
constexpr int TR_NITEMS = 2 * TR_I_IN + 2 * TR_I_OUT + 2 * TR_I_G + TR_I_D + 2 * NE * TR_I_MG + NE * TR_I_MD + 2 * TR_I_PW + 8 * TR_I_PL;
__device__ __forceinline__ TrJob tr_decode(const float* const* in, unsigned char* ws, int r) {
    if (r < 2 * TR_I_IN) { const int l = r / TR_I_IN; return tr_mat(in[2] + (size_t)l * D * DIN, D, DIN, (bf16*)(ws + WS_WIN) + (size_t)l * DIN * D, 0, in[1] + l * D, r % TR_I_IN); } r -= 2 * TR_I_IN;
    if (r < 2 * TR_I_OUT) { const int l = r / TR_I_OUT; return tr_mat(in[14] + (size_t)l * D * D, D, D, (bf16*)(ws + WS_WOUT) + (size_t)l * D * D, 0, nullptr, r % TR_I_OUT); } r -= 2 * TR_I_OUT;
    if (r < TR_I_G) return tr_mat(in[16], D, DFF, (bf16*)(ws + WS_WGU), 1, in[15], r); r -= TR_I_G;
    if (r < TR_I_G) return tr_mat(in[17], D, DFF, (bf16*)(ws + WS_WGU), 2, in[15], r); r -= TR_I_G;
    if (r < TR_I_D) return tr_mat(in[18], DFF, D, (bf16*)(ws + WS_WD), 0, nullptr, r); r -= TR_I_D;
    if (r < NE * TR_I_MG) { const int e = r / TR_I_MG; return tr_mat(in[20] + (size_t)e * D * DFE, D, DFE, (bf16*)(ws + WS_MOE_WGU) + (size_t)e * NGUE * D, 1, in[15] + D, r % TR_I_MG); } r -= NE * TR_I_MG;
    if (r < NE * TR_I_MG) { const int e = r / TR_I_MG; return tr_mat(in[21] + (size_t)e * D * DFE, D, DFE, (bf16*)(ws + WS_MOE_WGU) + (size_t)e * NGUE * D, 2, in[15] + D, r % TR_I_MG); } r -= NE * TR_I_MG;
    if (r < NE * TR_I_MD) { const int e = r / TR_I_MD; return tr_mat(in[22] + (size_t)e * DFE * D, DFE, D, (bf16*)(ws + WS_MOE_WD) + (size_t)e * D * DFE, 0, nullptr, r % TR_I_MD); } r -= NE * TR_I_MD;
    if (r < 2 * TR_I_PW) { const int l = r / TR_I_PW; return tr_mat(in[12] + (size_t)l * DCV * DCV, DCV, DCV, (bf16*)(ws + WS_PWT) + (size_t)l * DCV * DCV, 0, nullptr, r % TR_I_PW); } r -= 2 * TR_I_PW;
    { const int gi = r / TR_I_PL; return tr_mat(in[3] + (size_t)gi * 64 * 64, 64, 64, (bf16*)(ws + WS_POOLWT) + (size_t)gi * 64 * 64, 0, nullptr, r % TR_I_PL); }
}
__device__ __forceinline__ void tr_load(const TrJob& j, f32x4 (&v)[8], int lane, int probe) {
    const int n4 = (lane & 7) * 4, kr = lane >> 3;
    if (probe == 2) {
#pragma unroll
        for (int i = 0; i < 8; ++i) v[i] = (f32x4){1.f, 2.f, 3.f, 4.f};
        return; }
#pragma unroll
    for (int i = 0; i < 8; ++i) { v[i] = *(const f32x4*)(j.src + (size_t)(kr + 8 * i) * j.N + n4); if (j.gk) v[i] = v[i] * j.gk[kr + 8 * i]; }
}
__device__ __forceinline__ void tr_store(const TrJob& j, const f32x4 (&v)[8], LAS float* scr, int lane, int probe) {
    const int n4 = (lane & 7) * 4, kr = lane >> 3;
#pragma unroll
    for (int i = 0; i < 8; ++i) { LAS float* d = scr + (kr + 8 * i) * 33 + n4; d[0] = v[i][0]; d[1] = v[i][1]; d[2] = v[i][2]; d[3] = v[i][3]; }
    LDS_WAIT(); asm volatile("" ::: "memory");
    const int c = lane & 7;
#pragma unroll
    for (int jj = 0; jj < 4; ++jj) { const int n = (lane >> 3) + 8 * jj; const LAS float* s = scr + (8 * c) * 33 + n;
        u32x4 o; o.x = cvt_pk_bf16(s[0 * 33], s[1 * 33]); o.y = cvt_pk_bf16(s[2 * 33], s[3 * 33]); o.z = cvt_pk_bf16(s[4 * 33], s[5 * 33]); o.w = cvt_pk_bf16(s[6 * 33], s[7 * 33]);
        if (probe == 1 || probe == 2) { asm volatile("" :: "v"(o.x), "v"(o.y), "v"(o.z), "v"(o.w)); } else *(GAS u32x4*)(j.dst + (size_t)n * j.K + 8 * c) = o; }
    LDS_WAIT(); asm volatile("" ::: "memory");
}
__device__ __forceinline__ void p0_prologue(Frame& F, int probe) {
    LAS float* scr = (LAS float*)(F.lds + F.wave * 16384);
    const int gw = F.vcu * 8 + F.wave, NGW = F.G * 8, lane = F.lane;
    const float* const* in = in_tab(F); unsigned char* ws = F.ws;
    { int it = gw; f32x4 va[8], vb[8]; TrJob ja, jb;
      if (it < TR_NITEMS) { ja = tr_decode(in, ws, it); tr_load(ja, va, lane, probe); }
      while (it < TR_NITEMS) {
          const int it2 = it + NGW; if (it2 < TR_NITEMS) { jb = tr_decode(in, ws, it2); tr_load(jb, vb, lane, probe); }
          tr_store(ja, va, scr, lane, probe);
          if (it2 >= TR_NITEMS) break;
          const int it3 = it2 + NGW; if (it3 < TR_NITEMS) { ja = tr_decode(in, ws, it3); tr_load(ja, va, lane, probe); }
          tr_store(jb, vb, scr, lane, probe);
          it = it3; } }
    { const float* src = in[6]; bf16* dst = (bf16*)(ws + WS_GMWS);
      for (int i = gw * 64 + lane; i < 2 * 4 * 128 * 128 / 8; i += NGW * 64) { const f32x4 a = *(const f32x4*)(src + (size_t)i * 8), b = *(const f32x4*)(src + (size_t)i * 8 + 4);
          u32x4 o; o.x = cvt_pk_bf16(a[0], a[1]); o.y = cvt_pk_bf16(a[2], a[3]); o.z = cvt_pk_bf16(b[0], b[1]); o.w = cvt_pk_bf16(b[2], b[3]); *(u32x4*)(dst + (size_t)i * 8) = o; } }
    { u32x4* t = (u32x4*)(ws + WS_ROWOFF); for (int i = gw * 64 + lane; i < NE * ECAP / 4; i += NGW * 64) t[i] = (u32x4){0u, 0u, 0u, 0u}; }
    { const float* x = in[0]; bf16* XB = (bf16*)(ws + WS_XB); float* ssq = (float*)(ws + WS_SSQ);
      for (int m = gw; m < M; m += NGW) { const f32x4* xr = (const f32x4*)(x + (size_t)m * D) + lane; f32x4 v[4]; float s = 0.f;
#pragma unroll
          for (int j = 0; j < 4; ++j) { v[j] = xr[64 * j]; s += (v[j][0] * v[j][0] + v[j][1] * v[j][1]) + (v[j][2] * v[j][2] + v[j][3] * v[j][3]); }
          s = wave_sum(s);
          u32x2* o = (u32x2*)(XB + (size_t)m * D) + lane;
#pragma unroll
          for (int j = 0; j < 4; ++j) { u32x2 w; w.x = cvt_pk_bf16(v[j][0], v[j][1]); w.y = cvt_pk_bf16(v[j][2], v[j][3]); o[64 * j] = w; }
          if (lane < 4) ssq[(size_t)lane * M + m] = lane == 0 ? s : 0.f; } }
}

__device__ __forceinline__ void unpack8(const u32x4 w, float (&f)[8]) { f[0] = bf_lo(w.x); f[1] = bf_hi(w.x); f[2] = bf_lo(w.y); f[3] = bf_hi(w.y); f[4] = bf_lo(w.z); f[5] = bf_hi(w.z); f[6] = bf_lo(w.w); f[7] = bf_hi(w.w); }
__device__ __forceinline__ void mixer_unit(Frame& F, int u, int layer) {
    LAS unsigned char* lds = F.lds; int tid = F.tid; asm volatile("" : "+v"(tid)); int lane = tid & 63; const int w = F.wave;
    const float* const* in = in_tab(F); unsigned char* ws = F.ws;
    const bf16* P = (const bf16*)(ws + WS_P); bf16* Y = (bf16*)(ws + WS_Y);
    const int r0 = 64 * u, s0 = r0 & (SEQ - 1), half = u & 1, blk0 = r0 & ~127;
#ifndef MIX_MASK
#define MIX_MASK 7
#endif
#ifndef MIX_REP
#define MIX_REP 0
#endif
    for (int mrep = 0; mrep < 1 + (MIX_REP & 1); ++mrep) if (MIX_MASK & 1) { constexpr int AIN = 0, YPL = 40448, YST = 528;
      const int g = w >> 1, th = w & 1, fr = lane & 15, fq = lane >> 4;
      u32x4 st[5];
#pragma unroll
      for (int i = 0; i < 5; ++i) { const int idx = tid + 512 * i, rr = idx >> 5, ch = idx & 31, pos = s0 - 15 + rr; st[i] = (u32x4){0u, 0u, 0u, 0u};
          if (idx < 79 * 32 && pos >= 0) st[i] = *(const u32x4*)(P + (size_t)(r0 - 15 + rr) * DIN + ch * 8); }
      const bf16* wt = (const bf16*)(ws + WS_POOLWT) + (size_t)(layer * 4 + g) * 64 * 64; const float* sc = in[4] + layer * DPOOL + g * 64;
      bf16x8 Bf[2][4]; f32x4 sc4[4];
#pragma unroll
      for (int ks = 0; ks < 2; ++ks)
#pragma unroll
          for (int nt = 0; nt < 4; ++nt) Bf[ks][nt] = *(const bf16x8*)(wt + (nt * 16 + fr) * 64 + ks * 32 + 8 * fq);
#pragma unroll
      for (int nt = 0; nt < 4; ++nt) sc4[nt] = *(const f32x4*)(sc + nt * 16 + 4 * fq);
#pragma unroll
      for (int i = 0; i < 5; ++i) { const int idx = tid + 512 * i; if (idx < 79 * 32) *(LAS u32x4*)(lds + AIN + (idx >> 5) * 512 + (idx & 31) * 16) = st[i]; }
      __syncthreads();
      { const int p = tid & 127, rq = tid >> 7, gp = p >> 5, win = 2 << gp; float S0 = 0.f, S1 = 0.f;
        for (int j = 1; j < win; ++j) { const unsigned a = *(const LAS unsigned*)(lds + AIN + (16 * rq + 15 - j) * 512 + p * 4); S0 += bf_lo(a); S1 += bf_hi(a); }
#pragma unroll 4
        for (int t = 0; t < 16; ++t) { const int lt = 16 * rq + t, rr = lt + 15; const unsigned a = *(const LAS unsigned*)(lds + AIN + rr * 512 + p * 4); const float a0 = bf_lo(a), a1 = bf_hi(a);
            S0 += a0; S1 += a1; const int pos1 = s0 + lt + 1; const float rn = __builtin_amdgcn_rcpf((float)(pos1 < win ? pos1 : win));
            *(LAS unsigned*)(lds + YPL + lt * YST + p * 4) = cvt_pk_bf16(S0 * rn - a0, S1 * rn - a1);
            const unsigned o = *(const LAS unsigned*)(lds + AIN + (rr - win + 1) * 512 + p * 4); S0 -= bf_lo(o); S1 -= bf_hi(o); } }
      __syncthreads();
      { f32x4 acc[2][4];
#pragma unroll
        for (int a = 0; a < 2; ++a)
#pragma unroll
            for (int b = 0; b < 4; ++b) acc[a][b] = (f32x4){0.f, 0.f, 0.f, 0.f};
#pragma unroll
        for (int ks = 0; ks < 2; ++ks) { bf16x8 A[2];
#pragma unroll
            for (int mt = 0; mt < 2; ++mt) A[mt] = *(const LAS bf16x8*)(lds + YPL + ((2 * th + mt) * 16 + fr) * YST + (g * 64 + ks * 32 + 8 * fq) * 2);
#pragma unroll
            for (int mt = 0; mt < 2; ++mt)
#pragma unroll
                for (int nt = 0; nt < 4; ++nt) acc[mt][nt] = __builtin_amdgcn_mfma_f32_16x16x32_bf16(Bf[ks][nt], A[mt], acc[mt][nt], 0, 0, 0); }
#pragma unroll
        for (int mt = 0; mt < 2; ++mt)
#pragma unroll
            for (int nt = 0; nt < 4; ++nt) { const int t = r0 + (2 * th + mt) * 16 + fr, d = nt * 16 + 4 * fq; const f32x4 v = acc[mt][nt] * sc4[nt];
                u32x2 o; o.x = cvt_pk_bf16(v[0], v[1]); o.y = cvt_pk_bf16(v[2], v[3]); *(u32x2*)(Y + (size_t)t * D + g * 64 + d) = o; } }
      __syncthreads(); }
    asm volatile("" : "+v"(tid)); lane = tid & 63;
    for (int mrep = 0; mrep < 1 + ((MIX_REP >> 1) & 1); ++mrep) if (MIX_MASK & 2) { constexpr int VN = 0, VST = 800; const int nj = half ? 128 : 64, nks = nj >> 5;
      const int h = w & 3, ih = w >> 2, fr = lane & 15, fq = lane >> 4, q4 = (lane & 15) >> 2, p4 = lane & 3;
      const bf16* wsb = (const bf16*)(ws + WS_GMWS) + (size_t)(layer * 4 + h) * 128 * 128;
      const float* gg = in[5] + layer * DGM; const float* bb = in[7] + (size_t)(layer * 4 + h) * 128;
      u32x4 raw[16]; const int nr = nj >> 3;
#pragma unroll
      for (int i = 0; i < 16; ++i) { raw[i] = (u32x4){0u, 0u, 0u, 0u}; if (i < nr && lane < 48) raw[i] = *(const u32x4*)(P + (size_t)(blk0 + i * 8 + w) * DIN + 640 + lane * 8); }
      bf16x8 Aw[4][2]; f32x4 g4[6]; float bi[2];
#pragma unroll
      for (int ks = 0; ks < 4; ++ks)
#pragma unroll
          for (int mt = 0; mt < 2; ++mt) { Aw[ks][mt] = (bf16x8){0, 0, 0, 0, 0, 0, 0, 0}; if (ks < nks) Aw[ks][mt] = *(const bf16x8*)(wsb + (size_t)(half * 64 + (2 * ih + mt) * 16 + fr) * 128 + ks * 32 + 8 * fq); }
#pragma unroll
      for (int ct = 0; ct < 6; ++ct) g4[ct] = *(const f32x4*)(gg + h * 96 + ct * 16 + 4 * fq);
#pragma unroll
      for (int mt = 0; mt < 2; ++mt) bi[mt] = bb[half * 64 + (2 * ih + mt) * 16 + fr];
#pragma unroll
      for (int i = 0; i < 16; ++i) { if (i < nr) { float f[8]; unpack8(raw[i], f); float s = 0.f;
#pragma unroll
              for (int q = 0; q < 8; ++q) s += f[q] * f[q];
              s = wave_sum(s); const float rs = 1.0f / sqrtf(s * (1.0f / DGM) + EPS);
              u32x4 o; o.x = cvt_pk_bf16(f[0] * rs, f[1] * rs); o.y = cvt_pk_bf16(f[2] * rs, f[3] * rs); o.z = cvt_pk_bf16(f[4] * rs, f[5] * rs); o.w = cvt_pk_bf16(f[6] * rs, f[7] * rs);
              if (lane < 48) *(LAS u32x4*)(lds + VN + (i * 8 + w) * VST + lane * 16) = o; } }
      u32x2 uu[2][6];
#pragma unroll
      for (int mt = 0; mt < 2; ++mt)
#pragma unroll
          for (int ct = 0; ct < 6; ++ct) uu[mt][ct] = *(const u32x2*)(P + (size_t)(r0 + (2 * ih + mt) * 16 + fr) * DIN + 256 + h * 96 + ct * 16 + 4 * fq);
      __syncthreads();
      { f32x4 acc[2][6];
#pragma unroll
        for (int a = 0; a < 2; ++a)
#pragma unroll
            for (int b = 0; b < 6; ++b) acc[a][b] = (f32x4){0.f, 0.f, 0.f, 0.f};
#pragma unroll
        for (int ks = 0; ks < 4; ++ks) { if (ks < nks) {
#pragma unroll
            for (int ct = 0; ct < 6; ++ct) { const unsigned ad = VN + (32 * ks + 8 * fq + q4) * VST + (h * 96 + ct * 16 + 4 * p4) * 2;
                const s16x4 t0 = __builtin_amdgcn_ds_read_tr16_b64_v4i16((LAS s16x4*)(lds + ad)), t1 = __builtin_amdgcn_ds_read_tr16_b64_v4i16((LAS s16x4*)(lds + ad + 4 * VST));
                bf16x8 B; B[0] = t0[0]; B[1] = t0[1]; B[2] = t0[2]; B[3] = t0[3]; B[4] = t1[0]; B[5] = t1[1]; B[6] = t1[2]; B[7] = t1[3];
#pragma unroll
                for (int mt = 0; mt < 2; ++mt) acc[mt][ct] = __builtin_amdgcn_mfma_f32_16x16x32_bf16(B, Aw[ks][mt], acc[mt][ct], 0, 0, 0); } } }
#pragma unroll
        for (int mt = 0; mt < 2; ++mt) { const int t = r0 + (2 * ih + mt) * 16 + fr;
#pragma unroll
            for (int ct = 0; ct < 6; ++ct) { const int c4 = h * 96 + ct * 16 + 4 * fq; const f32x4 z = acc[mt][ct] * g4[ct] + bi[mt]; const u32x2 uv = uu[mt][ct];
                u32x2 o; o.x = cvt_pk_bf16(bf_lo(uv.x) * z[0], bf_hi(uv.x) * z[1]); o.y = cvt_pk_bf16(bf_lo(uv.y) * z[2], bf_hi(uv.y) * z[3]); *(u32x2*)(Y + (size_t)t * D + 256 + c4) = o; } } }
      __syncthreads(); }
    asm volatile("" : "+v"(tid)); lane = tid & 63;
    for (int mrep = 0; mrep < 1 + ((MIX_REP >> 2) & 1); ++mrep) if (MIX_MASK & 4) { constexpr int HC = 0, TT = 72192, TST = 784;
      { u32x4 cvr[9], cgr[9];
#pragma unroll
        for (int i = 0; i < 9; ++i) { const int idx = tid + 512 * i, rr = idx / 48, ch = idx % 48, pos = s0 - 30 + rr; cvr[i] = (u32x4){0u, 0u, 0u, 0u}; cgr[i] = (u32x4){0u, 0u, 0u, 0u};
            if (idx < 94 * 48 && pos >= 0) { const bf16* pr = P + (size_t)(r0 - 30 + rr) * DIN; cvr[i] = *(const u32x4*)(pr + 1024 + ch * 8); cgr[i] = *(const u32x4*)(pr + 1408 + ch * 8); } }
#pragma unroll
        for (int i = 0; i < 9; ++i) { const int idx = tid + 512 * i, rr = idx / 48, ch = idx % 48; float a[8], b[8]; unpack8(cvr[i], a); unpack8(cgr[i], b);
#pragma unroll
            for (int q = 0; q < 8; ++q) a[q] *= fast_sigmoid(b[q]);
            u32x4 o; o.x = cvt_pk_bf16(a[0], a[1]); o.y = cvt_pk_bf16(a[2], a[3]); o.z = cvt_pk_bf16(a[4], a[5]); o.w = cvt_pk_bf16(a[6], a[7]);
            if (idx < 94 * 48) *(LAS u32x4*)(lds + HC + rr * 768 + ch * 16) = o; } }
      __syncthreads();
      asm volatile("" : "+v"(tid)); lane = tid & 63;
      const int fr = lane & 15, fq = lane >> 4; const bf16* pw = (const bf16*)(ws + WS_PWT) + (size_t)layer * DCV * DCV;
      bf16x8 Bp[4][3];
      { const float* dww = in[8] + (size_t)layer * 31 * DCV; const float* dwb = in[9] + layer * DCV; const float* lg = in[10] + layer * DCV; const float* lb = in[11] + layer * DCV;
        f32x2 g2[3], bt2[3];
#pragma unroll
        for (int q = 0; q < 3; ++q) { g2[q] = *(const f32x2*)(lg + 128 * q + 2 * lane); bt2[q] = *(const f32x2*)(lb + 128 * q + 2 * lane); }
        float dd[8][6];
#pragma unroll
        for (int q = 0; q < 3; ++q) { const int c = 128 * q + 2 * lane; f32x2 wj[31];
#pragma unroll
            for (int j = 0; j < 31; ++j) wj[j] = *(const f32x2*)(dww + j * DCV + c);
            const f32x2 b2 = *(const f32x2*)(dwb + c); float a0[8], a1[8];
#pragma unroll
            for (int r = 0; r < 8; ++r) { a0[r] = b2[0]; a1[r] = b2[1]; }
#pragma unroll
            for (int s = 0; s < 38; ++s) { const unsigned hv = *(const LAS unsigned*)(lds + HC + (8 * w + s) * 768 + c * 2); const float h0 = bf_lo(hv), h1 = bf_hi(hv);
#pragma unroll
                for (int r = 0; r < 8; ++r) { const int j = s - r; if (j >= 0 && j <= 30) { a0[r] += h0 * wj[j][0]; a1[r] += h1 * wj[j][1]; } } }
#pragma unroll
            for (int r = 0; r < 8; ++r) { dd[r][2 * q] = a0[r]; dd[r][2 * q + 1] = a1[r]; asm volatile("" : "+v"(dd[r][2 * q]), "+v"(dd[r][2 * q + 1])); }
            asm volatile("" ::: "memory"); }
#pragma unroll
        for (int ks = 0; ks < 4; ++ks)
#pragma unroll
            for (int nt = 0; nt < 3; ++nt) Bp[ks][nt] = *(const bf16x8*)(pw + (size_t)((3 * w + nt) * 16 + fr) * DCV + ks * 32 + 8 * fq);
#pragma unroll
        for (int r = 0; r < 8; ++r) { float s = 0.f;
#pragma unroll
            for (int q = 0; q < 6; ++q) s += dd[r][q];
            const float mu = wave_sum(s) * (1.0f / DCV); float v = 0.f;
#pragma unroll
            for (int q = 0; q < 6; ++q) { dd[r][q] -= mu; v += dd[r][q] * dd[r][q]; }
            const float rs = 1.0f / sqrtf(wave_sum(v) * (1.0f / DCV) + EPS);
#pragma unroll
            for (int q = 0; q < 3; ++q) { float y0 = dd[r][2 * q] * rs * g2[q][0] + bt2[q][0], y1 = dd[r][2 * q + 1] * rs * g2[q][1] + bt2[q][1]; y0 *= fast_sigmoid(y0); y1 *= fast_sigmoid(y1);
                *(LAS unsigned*)(lds + TT + (8 * w + r) * TST + (128 * q + 2 * lane) * 2) = cvt_pk_bf16(y0, y1); } } }
      __syncthreads();
      { f32x4 acc[4][3];
#pragma unroll
        for (int a = 0; a < 4; ++a)
#pragma unroll
            for (int b = 0; b < 3; ++b) acc[a][b] = (f32x4){0.f, 0.f, 0.f, 0.f};
        const f32x4* pb4 = (const f32x4*)(in[13] + layer * DCV); f32x4 pbv[3];
#pragma unroll
        for (int nt = 0; nt < 3; ++nt) pbv[nt] = pb4[(3 * w + nt) * 4 + fq];
#pragma unroll
        for (int kb = 0; kb < 3; ++kb) { bf16x8 Bn[4][3];
            if (kb < 2) {
#pragma unroll
                for (int ks = 0; ks < 4; ++ks)
#pragma unroll
                    for (int nt = 0; nt < 3; ++nt) Bn[ks][nt] = *(const bf16x8*)(pw + (size_t)((3 * w + nt) * 16 + fr) * DCV + (4 * (kb + 1) + ks) * 32 + 8 * fq); }
#pragma unroll
            for (int ks = 0; ks < 4; ++ks) { bf16x8 A[4];
#pragma unroll
                for (int mt = 0; mt < 4; ++mt) A[mt] = *(const LAS bf16x8*)(lds + TT + (mt * 16 + fr) * TST + ((4 * kb + ks) * 32 + 8 * fq) * 2);
#pragma unroll
                for (int mt = 0; mt < 4; ++mt)
#pragma unroll
                    for (int nt = 0; nt < 3; ++nt) acc[mt][nt] = __builtin_amdgcn_mfma_f32_16x16x32_bf16(Bp[ks][nt], A[mt], acc[mt][nt], 0, 0, 0); }
            if (kb < 2) {
#pragma unroll
                for (int ks = 0; ks < 4; ++ks)
#pragma unroll
                    for (int nt = 0; nt < 3; ++nt) Bp[ks][nt] = Bn[ks][nt]; } }
#pragma unroll
        for (int mt = 0; mt < 4; ++mt)
#pragma unroll
            for (int nt = 0; nt < 3; ++nt) { const int t = r0 + mt * 16 + fr, n4 = (3 * w + nt) * 16 + 4 * fq; const f32x4 v = acc[mt][nt] + pbv[nt];
                u32x2 o; o.x = cvt_pk_bf16(v[0], v[1]); o.y = cvt_pk_bf16(v[2], v[3]); *(u32x2*)(Y + (size_t)t * D + 640 + n4) = o; } }
      __syncthreads(); }
}

__device__ __forceinline__ void router_phase(Frame& F) {
    LAS unsigned char* lds = F.lds; const int lane = F.lane, w = F.wave; unsigned char* ws = F.ws;
    const float* const* in = in_tab(F); const float* X = F.out; const float* g2 = in[15] + D; const float* R = in[19];
    unsigned* rowoff = (unsigned*)(ws + WS_ROWOFF); float* rs_e = (float*)(ws + WS_RS); float* gate_e = (float*)(ws + WS_GATE); int* sel = (int*)(ws + WS_SEL);
    unsigned* cnt = F.ctl + CW_CNT;
    LAS int* se0 = (LAS int*)lds; LAS int* se1 = se0 + 64; LAS float* sw0 = (LAS float*)(se1 + 64); LAS float* sw1 = sw0 + 64; LAS float* srs = sw1 + 64;
    float Rg[4][4][8];
#pragma unroll
    for (int j = 0; j < 4; ++j)
#pragma unroll
        for (int q = 0; q < 4; ++q) { const int k = 4 * lane + 256 * j + q; const float gk = g2[k]; const f32x4 a = *(const f32x4*)(R + k * 8), b = *(const f32x4*)(R + k * 8 + 4);
            Rg[j][q][0] = a[0] * gk; Rg[j][q][1] = a[1] * gk; Rg[j][q][2] = a[2] * gk; Rg[j][q][3] = a[3] * gk; Rg[j][q][4] = b[0] * gk; Rg[j][q][5] = b[1] * gk; Rg[j][q][6] = b[2] * gk; Rg[j][q][7] = b[3] * gk; }
    for (int b = F.vcu; b < M / 64; b += F.G) {
        for (int i = 0; i < 8; ++i) { const int tl = 8 * w + i, t = 64 * b + tl; const f32x4* xr = (const f32x4*)(X + (size_t)t * D) + lane; float ss = 0.f, le[8];
#pragma unroll
            for (int e = 0; e < 8; ++e) le[e] = 0.f;
#pragma unroll
            for (int j = 0; j < 4; ++j) { const f32x4 v = xr[64 * j];
#pragma unroll
                for (int q = 0; q < 4; ++q) { ss += v[q] * v[q];
#pragma unroll
                    for (int e = 0; e < 8; ++e) le[e] += v[q] * Rg[j][q][e]; } }
            ss = wave_sum(ss);
#pragma unroll
            for (int e = 0; e < 8; ++e) le[e] = wave_sum(le[e]);
            const float rs = 1.0f / sqrtf(ss * (1.0f / D) + EPS);
            int i0 = 0; float l0 = le[0];
#pragma unroll
            for (int e = 1; e < 8; ++e) if (le[e] > l0) { l0 = le[e]; i0 = e; }
            int i1 = -1; float l1 = -3.0e38f;
#pragma unroll
            for (int e = 0; e < 8; ++e) if (e != i0 && le[e] > l1) { l1 = le[e]; i1 = e; }
            const float ex = expf((l1 - l0) * rs), w0 = 1.0f / (1.0f + ex), w1 = ex / (1.0f + ex);
            if (lane == 0) { se0[tl] = i0; se1[tl] = i1; sw0[tl] = w0; sw1[tl] = w1; srs[tl] = rs; } }
        __syncthreads();
        if (w == 0) { const int e0 = se0[lane], e1 = se1[lane]; int r0 = 0, r1 = 0; const unsigned long long lt = (1ull << lane) - 1ull;
#pragma unroll
            for (int e = 0; e < 8; ++e) { const unsigned long long m0 = __ballot(e0 == e), m1 = __ballot(e1 == e); const int n0 = __popcll(m0), n = n0 + __popcll(m1); unsigned base = 0u;
                if (lane == 0 && n > 0) base = __hip_atomic_fetch_add(cnt + 64 * e, (unsigned)n, RLX_AGENT);
                base = __shfl(base, 0);
                if (e0 == e) r0 = (int)base + __popcll(m0 & lt);
                if (e1 == e) r1 = (int)base + n0 + __popcll(m1 & lt); }
            const int t = 64 * b + lane; const float rs = srs[lane];
            rowoff[e0 * ECAP + r0] = (unsigned)t * (unsigned)(D * 2); rs_e[e0 * ECAP + r0] = rs; gate_e[e0 * ECAP + r0] = sw0[lane];
            rowoff[e1 * ECAP + r1] = (unsigned)t * (unsigned)(D * 2); rs_e[e1 * ECAP + r1] = rs; gate_e[e1 * ECAP + r1] = sw1[lane];
            *(int4*)(sel + 4 * t) = make_int4(e0, r0, e1, r1); }
        __syncthreads();
    }
}
__device__ __forceinline__ void moe_panels(Frame& F, int (&pb)[9]) {
    unsigned* cnt = F.ctl + CW_CNT; pb[0] = 0;
#pragma unroll
    for (int e = 0; e < 8; ++e) { const unsigned c = (unsigned)__builtin_amdgcn_readfirstlane(__hip_atomic_load(cnt + 64 * e, RLX_AGENT)); pb[e + 1] = pb[e] + (int)((c + 255u) >> 8); }
}
__device__ __forceinline__ void final_phase(Frame& F) {
    int pb[9]; moe_panels(F, pb);
    const int total = pb[8] * 4, nfull = (total / F.G) * F.G, NPf = nfull / 4, sp = pg8::moe_split(total - nfull, F.G); const bf16* slabs = (const bf16*)(F.ws + WS_SLAB);
    const int gw = F.vcu * 8 + F.wave, NGW = F.G * 8, lane = F.lane; unsigned char* ws = F.ws;
    const bf16* YP = (const bf16*)(ws + WS_YP); const int* sel = (const int*)(ws + WS_SEL); const float* fg = in_tab(F)[23]; float* X = F.out;
    f32x4 g4[4];
#pragma unroll
    for (int j = 0; j < 4; ++j) g4[j] = *((const f32x4*)fg + lane + 64 * j);
    for (int t = gw; t < M; t += NGW) { const int4 s = *(const int4*)(sel + 4 * t); int b0 = 0, b1 = 0;
#pragma unroll
        for (int e = 0; e < 8; ++e) { b0 = (s.x == e) ? pb[e] : b0; b1 = (s.z == e) ? pb[e] : b1; }
        const int pr[2] = {256 * b0 + s.y, 256 * b1 + s.w};
        const f32x4* xr = (const f32x4*)(X + (size_t)t * D) + lane;
        f32x4 v[4];
#pragma unroll
        for (int j = 0; j < 4; ++j) v[j] = xr[64 * j];
#pragma unroll
        for (int k = 0; k < 2; ++k) { const int pm = pr[k] >> 8, lr = pr[k] & 255;
            if (sp > 1 && pm >= NPf) {
#pragma unroll
                for (int j = 0; j < 4; ++j) { const bf16* sb = slabs + (size_t)(((pm - NPf) * 4 + j) * sp) * 65536 + lr * 256 + 4 * lane; u32x2 a[14];
#pragma unroll
                    for (int ks = 0; ks < 14; ++ks) { a[ks] = (u32x2){0u, 0u}; if (ks < sp) a[ks] = *(const u32x2*)(sb + (size_t)ks * 65536); }
#pragma unroll
                    for (int ks = 0; ks < 14; ++ks) { v[j][0] += bf_lo(a[ks].x); v[j][1] += bf_hi(a[ks].x); v[j][2] += bf_lo(a[ks].y); v[j][3] += bf_hi(a[ks].y); } }
            } else { const u32x2* y = (const u32x2*)(YP + (size_t)pr[k] * D) + lane;
#pragma unroll
                for (int j = 0; j < 4; ++j) { const u32x2 a = y[64 * j]; v[j][0] += bf_lo(a.x); v[j][1] += bf_hi(a.x); v[j][2] += bf_lo(a.y); v[j][3] += bf_hi(a.y); } } }
        float ss = 0.f;
#pragma unroll
        for (int j = 0; j < 4; ++j) ss += (v[j][0] * v[j][0] + v[j][1] * v[j][1]) + (v[j][2] * v[j][2] + v[j][3] * v[j][3]);
        ss = wave_sum(ss); const float rs = 1.0f / sqrtf(ss * (1.0f / D) + EPS);
        f32x4* o = (f32x4*)(X + (size_t)t * D) + lane;
#pragma unroll
        for (int j = 0; j < 4; ++j) o[64 * j] = v[j] * rs * g4[j]; }
}

struct Args { const float* in[24]; float* out; unsigned char* ws; int ph_lo, ph_hi, li, pad; };
__global__ void __launch_bounds__(512, 2) fwd(Args args) {
    extern __shared__ __attribute__((aligned(16))) unsigned char lds_raw[];
    Frame F;
    F.lds = (LAS unsigned char*)lds_raw; F.MISC = (volatile LAS unsigned*)(F.lds + MISC_OFF);
    F.tid = threadIdx.x; F.lane = F.tid & 63; F.wave = __builtin_amdgcn_readfirstlane(F.tid >> 6);
    F.G = gridDim.x; { const int bx = blockIdx.x; F.vcu = (F.G % 8 == 0) ? (bx % 8) * (F.G / 8) + bx / 8 : bx; }
    F.in = args.in; F.out = args.out; F.ws = args.ws; F.ctl = (unsigned*)(args.ws + WS_CTL);
    for (int u = F.tid; u < (LDS_BYTES - MISC_OFF) / 4; u += 512) ((LAS unsigned*)(F.lds + MISC_OFF))[u] = 0u;
    __syncthreads();
    XcdBarrier bar = xcd_barrier_post(F.ctl + CW_BAR + args.li * XCD_BAR_WORDS, F.MISC + 8);
    const int lo = args.ph_lo, hi = args.ph_hi;
#ifndef PH_MASK
#define PH_MASK 0xFFFF
#endif
#define PH_ON(k) (((PH_MASK) >> (k)) & 1)
#ifndef REP_MASK
#define REP_MASK 0
#endif
#define REPS(k) (1 + (((REP_MASK) >> (k)) & 1))
#ifndef PRO_PROBE
#define PRO_PROBE 0
#endif
#ifndef EPI_PROBE
#define EPI_PROBE 0
#endif
#define IN(k) (lo <= (k) && (k) < hi)
#define SEAM(k) do { if (IN(k) && IN((k) + 1)) xcd_barrier(bar); } while (0)
    unsigned char* ws = args.ws; LAS unsigned* gtab = (LAS unsigned*)(F.lds + GTAB_OFF);
    bf16* XB = (bf16*)(ws + WS_XB); float* ssq = (float*)(ws + WS_SSQ);
    if (F.G != 256) return;

    if (PH_ON(0) && IN(0)) for (int rep = 0; rep < REPS(0); ++rep) { p0_prologue(F, rep == 0 ? 0 : PRO_PROBE); __syncthreads(); }
    SEAM(0);
#pragma unroll 1
    for (int layer = 0; layer < 2; ++layer) {
        const int pbase = 1 + layer * 5;
        if (PH_ON(1) && IN(pbase)) for (int rep = 0; rep < REPS(1); ++rep) { pg8::Gemm g{XB, (const bf16*)(ws + WS_WIN) + (size_t)layer * DIN * D, D, 0}; pg8::StaticOrder S; S.init(M, DIN, F.G, (int)blockIdx.x);
            pg8::EpiP E{(bf16*)(ws + WS_P), DIN, ssq}; pg8::gemm_phase<pg8::EpiP, pg8::StaticOrder, true, true>(F.lds, gtab, g, S, E); }
        SEAM(pbase);
        if (PH_ON(2) && IN(pbase + 1)) for (int rep = 0; rep < REPS(2); ++rep) { for (int u = F.vcu; u < M / 64; u += F.G) mixer_unit(F, u, layer); }
        SEAM(pbase + 1);
        if (PH_ON(3) && IN(pbase + 2)) for (int rep = 0; rep < (layer == 0 ? REPS(3) : 1); ++rep) { pg8::Gemm g{(const bf16*)(ws + WS_Y), (const bf16*)(ws + WS_WOUT) + (size_t)layer * D * D, D, 0}; pg8::StaticOrder S; S.init(M, D, F.G, (int)blockIdx.x);
            pg8::EpiResid E{layer == 0 ? in_tab(F)[0] : (const float*)args.out, args.out, XB, ssq}; pg8::gemm_phase<pg8::EpiResid, pg8::StaticOrder, false, true>(F.lds, gtab, g, S, E); }
        SEAM(pbase + 2);
        if (layer == 0) {
            if (PH_ON(4) && IN(4)) for (int rep = 0; rep < REPS(4); ++rep) { pg8::Gemm g{XB, (const bf16*)(ws + WS_WGU), D, 0}; pg8::StaticOrder S; S.init(M, NGU, F.G, (int)blockIdx.x);
                pg8::EpiSwiglu<false> E{(bf16*)(ws + WS_ACT), DFF, ssq, nullptr, nullptr, 0}; pg8::gemm_phase<pg8::EpiSwiglu<false>, pg8::StaticOrder, true, true>(F.lds, gtab, g, S, E); }
            SEAM(4);
            if (PH_ON(5) && IN(5)) { pg8::Gemm g{(const bf16*)(ws + WS_ACT), (const bf16*)(ws + WS_WD), DFF, 0}; pg8::StaticOrder S; S.init(M, D, F.G, (int)blockIdx.x);
                pg8::EpiResid E{(const float*)args.out, args.out, XB, ssq}; pg8::gemm_phase<pg8::EpiResid, pg8::StaticOrder, false, true>(F.lds, gtab, g, S, E); }
            SEAM(5);
        }
    }
    if (PH_ON(9) && IN(9)) router_phase(F);
    SEAM(9);
    if (PH_ON(10) && IN(10)) for (int rep = 0; rep < REPS(10); ++rep) { pg8::MoeOrderGather S; moe_panels(F, S.pb); S.nN = NGUE / 256; S.nwg = S.pb[8] * S.nN; S.G = F.G; S.c = (int)blockIdx.x; S.rowoff = (const unsigned*)(ws + WS_ROWOFF);
        pg8::Gemm g{XB, (const bf16*)(ws + WS_MOE_WGU), D, (size_t)NGUE * D};
        pg8::EpiSwiglu<true> E{(bf16*)(ws + WS_ACTM), DFE, nullptr, (const float*)(ws + WS_RS), (const float*)(ws + WS_GATE), rep == 0 ? 0 : EPI_PROBE};
        pg8::gemm_phase<pg8::EpiSwiglu<true>, pg8::MoeOrderGather, true, true>(F.lds, gtab, g, S, E); }
    SEAM(10);
    if (PH_ON(11) && IN(11)) for (int rep = 0; rep < REPS(11); ++rep) { pg8::MoeOrderDown S; moe_panels(F, S.pb); S.init(F.G, (int)blockIdx.x);
        pg8::Gemm g{(const bf16*)(ws + WS_ACTM), (const bf16*)(ws + WS_MOE_WD), DFE, (size_t)D * DFE};
        pg8::EpiBf16 E{(bf16*)(ws + WS_YP), D, (bf16*)(ws + WS_SLAB)};
        pg8::gemm_phase<pg8::EpiBf16, pg8::MoeOrderDown, true, true>(F.lds, gtab, g, S, E); }
    SEAM(11);
    if (PH_ON(12) && IN(12)) final_phase(F);
#undef IN
#undef SEAM
}
#ifndef MK_PER_PHASE
#define MK_PER_PHASE 0
#endif
extern "C" void kernel_launch(void* const* d_in, const int* in_sizes, int n_in, void* d_out, int out_size, void* d_ws, size_t ws_size, hipStream_t stream) {
    static int grid = 0;
    if (grid == 0) {
        if (n_in != 24 || out_size != M * D || ws_size < WS_END) { fprintf(stderr, "kernel_launch: unexpected shapes (n_in %d out %d ws %zu)\n", n_in, out_size, ws_size); grid = -1; return; }
        int dev = 0, cus = 0;
        if (hipGetDevice(&dev) != hipSuccess || hipDeviceGetAttribute(&cus, hipDeviceAttributeMultiprocessorCount, dev) != hipSuccess) { grid = -1; return; }
        if (hipFuncSetAttribute((const void*)fwd, hipFuncAttributeMaxDynamicSharedMemorySize, LDS_BYTES) != hipSuccess) { fprintf(stderr, "kernel_launch: hipFuncSetAttribute failed\n"); grid = -1; return; }
        int per_cu = 0;
        if (hipOccupancyMaxActiveBlocksPerMultiprocessor(&per_cu, (const void*)fwd, 512, LDS_BYTES) != hipSuccess || per_cu < 1) fprintf(stderr, "kernel_launch: occupancy query says %d\n", per_cu);
        (void)hipGetLastError();
        grid = cus;
        if (grid != 256) { fprintf(stderr, "kernel_launch: built for 256 CUs, found %d\n", grid); grid = -1; return; }
    }
    if (grid < 0) return;
    (void)hipMemsetAsync((char*)d_ws + WS_CTL, 0, CTL_ZERO_BYTES, stream);
    Args a{};
    for (int i = 0; i < 24; ++i) a.in[i] = (const float*)d_in[i];
    a.out = (float*)d_out; a.ws = (unsigned char*)d_ws; a.pad = 0;
#if MK_PER_PHASE
    for (int p = 0; p < NPHASE; ++p) { a.ph_lo = p; a.ph_hi = p + 1; a.li = p; hipLaunchKernelGGL(fwd, dim3(grid), dim3(512), LDS_BYTES, stream, a); }
#else
    a.ph_lo = 0; a.ph_hi = NPHASE; a.li = 0; hipLaunchKernelGGL(fwd, dim3(grid), dim3(512), LDS_BYTES, stream, a);
#endif
}
```

```cpp
#define MK_PER_PHASE 0
#include <hip/hip_runtime.h>
#include <cstdio>
#include <cstdint>
constexpr int M = 16384, D = 1024, SEQ = 8192, DIN = 1792, DFF = 2816, DFE = 3584, NE = 8;
constexpr int DPOOL = 256, DGM = 384, DCV = 384;
constexpr int NGU = 2 * DFF, NGUE = 2 * DFE;
constexpr int ECAP = 16384;
constexpr int PMAX = 2 * M + NE * 256;
constexpr float EPS = 1e-6f;

#define LAS __attribute__((address_space(3)))
#define GAS __attribute__((address_space(1)))
typedef unsigned short bf16;
typedef short bf16x8 __attribute__((ext_vector_type(8)));
typedef short s16x4 __attribute__((ext_vector_type(4)));
typedef float f32x4 __attribute__((ext_vector_type(4)));
typedef float f32x2 __attribute__((ext_vector_type(2)));
typedef unsigned u32x4 __attribute__((ext_vector_type(4)));
typedef unsigned u32x2 __attribute__((ext_vector_type(2)));

__device__ __forceinline__ unsigned cvt_pk_bf16(float lo, float hi) { unsigned r; asm volatile("v_cvt_pk_bf16_f32 %0, %1, %2" : "=v"(r) : "v"(lo), "v"(hi)); return r; }
__device__ __forceinline__ float bf_lo(unsigned w) { return __uint_as_float(w << 16); }
__device__ __forceinline__ float bf_hi(unsigned w) { return __uint_as_float(w & 0xffff0000u); }
__device__ __forceinline__ float fast_sigmoid(float x) { return __builtin_amdgcn_rcpf(1.0f + __builtin_amdgcn_exp2f(-1.4426950408889634f * x)); }
__device__ __forceinline__ float wave_sum(float v) {
#pragma unroll
    for (int o = 1; o < 64; o <<= 1) v += __shfl_xor(v, o);
    return v;
}

namespace pg8 {
constexpr int BM = 256, BK = 64, HALF = 128, HTB = HALF * BK * 2, STAGE_BYTES = 8 * HTB, NXCD = 8, WGM = 8;
__host__ __device__ __forceinline__ int lds_byte(int r, int c) { const int st = (r >> 4) * 2 + (c >> 5), rr = r & 15, cc = c & 31, ob = rr * 64 + cc * 2; return st * 1024 + (ob ^ (((ob >> 9) & 1) << 5)); }
__host__ __device__ __forceinline__ void stage_rc(int b, int& R, int& C) { const int st = b / 1024, sb = b % 1024, swz = sb ^ (((sb >> 9) & 1) << 5); R = (st >> 1) * 16 + swz / 64; C = (st & 1) * 32 + (swz % 64) / 2; }
__host__ __device__ __forceinline__ int perm32(int rho) { const int n = rho >> 4, i = rho & 15; return 8 * (i >> 2) + 4 * n + (i & 3); }

struct Unit { int pm, pn, e, tab, k0b, nt, slab; };
struct Gemm { const bf16* A; const bf16* Bt; int K; size_t bstride_e; };

__device__ __forceinline__ void order_map(int wgid, int nM, int nN, int& pm, int& pn) {
    const int nwg = nM * nN; { const int q = nwg / NXCD, r = nwg % NXCD, xcd = wgid % NXCD, off = wgid / NXCD; wgid = (xcd < r ? xcd * (q + 1) : r * (q + 1) + (xcd - r) * q) + off; }
    const int nig = WGM * nN, gid = wgid / nig, fm = gid * WGM, gsz = (nM - fm) < WGM ? (nM - fm) : WGM;
    pm = fm + ((wgid % nig) % gsz); pn = (wgid % nig) / gsz;
}
struct StaticOrder {
    static constexpr bool GATHER = false;
    int nM, nN, nwg, G, c;
    __device__ void init(int Mrows, int N, int G_, int c_) { nM = Mrows / BM; nN = N / BM; nwg = nM * nN; G = G_; c = c_; }
    __device__ __forceinline__ bool next(int i, Unit& u) const { const long L = (long)i * G + c; if (L >= nwg) return false; order_map((int)L, nM, nN, u.pm, u.pn); u.e = 0; u.tab = 0; u.k0b = 0; u.nt = 0; u.slab = -1; return true; }
    __device__ __forceinline__ const unsigned* a_table(const Unit&) const { return nullptr; }
};
struct MoeOrder {
    int pb[9]; int nN, nwg, G, c; const unsigned* rowoff;
    __device__ __forceinline__ bool next(int i, Unit& u) const {
        const long L = (long)i * G + c; if (L >= nwg) return false; order_map((int)L, pb[8], nN, u.pm, u.pn); u.k0b = 0; u.nt = 0; u.slab = -1;
        int e = 0;
#pragma unroll
        for (int k = 1; k < 8; ++k) e += (u.pm >= pb[k]) ? 1 : 0;
        int pbe = pb[0];
#pragma unroll
        for (int k = 1; k < 8; ++k) pbe = (e == k) ? pb[k] : pbe;
        u.e = e; u.tab = e * ECAP + 256 * (u.pm - pbe); return true;
    }
    __device__ __forceinline__ const unsigned* a_table(const Unit& u) const { return rowoff + u.tab; }
};
struct MoeOrderGather : MoeOrder { static constexpr bool GATHER = true; };
__host__ __device__ __forceinline__ int moe_split(int r, int G) { return r == 0 ? 1 : (r * 14 <= G ? 14 : (r * 7 <= G ? 7 : (r * 4 <= G ? 4 : (r * 2 <= G ? 2 : 1)))); }
struct MoeOrderDown {
    static constexpr bool GATHER = false;
    int pb[9]; int G, c, NPf, nfull, r, s;
    __device__ __forceinline__ void init(int G_, int c_) { G = G_; c = c_; const int total = pb[8] * 4; nfull = (total / G) * G; NPf = nfull / 4; r = total - nfull; s = moe_split(r, G); }
    __device__ __forceinline__ bool next(int i, Unit& u) const {
        const int L = i * G + c; u.tab = 0;
        if (L < nfull) { order_map(L, NPf, 4, u.pm, u.pn); u.k0b = 0; u.nt = 0; u.slab = -1; }
        else { const int j = L - nfull; if (j >= r * s) return false; const int lu = j / s, ks = j - lu * s; u.pm = NPf + (lu >> 2); u.pn = lu & 3; u.nt = (DFE / BK) / s; u.k0b = ks * u.nt * BK * 2; u.slab = s > 1 ? j : -1; }
        int e = 0;
#pragma unroll
        for (int k = 1; k < 8; ++k) e += (u.pm >= pb[k]) ? 1 : 0;
        u.e = e; return true;
    }
    __device__ __forceinline__ const unsigned* a_table(const Unit&) const { return nullptr; }
};

__device__ __forceinline__ float rstd_of(const float* ssq, int row) { const float s = (ssq[row] + ssq[M + row]) + (ssq[2 * M + row] + ssq[3 * M + row]); return 1.0f / sqrtf(s * (1.0f / D) + EPS); }

struct EpiP {
    static constexpr bool PERM = true, AFTER_DRAIN = false;
    bf16* O; int ldc; const float* ssq;
    __device__ __forceinline__ void operator()(const f32x4 (&acc)[2][2][4][2], const Unit& u, int wr, int wc, int fr, int fq) const {
        const int row0 = u.pm * BM + wr * 64 + fr, col0 = u.pn * BM + wc * 32 + 8 * fq;
#pragma unroll
        for (int ai = 0; ai < 2; ++ai)
#pragma unroll
            for (int m = 0; m < 4; ++m) { const int row = row0 + ai * HALF + m * 16; const float rs = rstd_of(ssq, row); bf16* rowp = O + (size_t)row * ldc + col0;
#pragma unroll
                for (int bj = 0; bj < 2; ++bj) { const f32x4 v0 = acc[ai][bj][m][0] * rs, v1 = acc[ai][bj][m][1] * rs;
                    u32x4 w; w.x = cvt_pk_bf16(v0[0], v0[1]); w.y = cvt_pk_bf16(v0[2], v0[3]); w.z = cvt_pk_bf16(v1[0], v1[1]); w.w = cvt_pk_bf16(v1[2], v1[3]);
                    *(u32x4*)(rowp + bj * HALF) = w; } }
    }
};
template <bool MOE> struct EpiSwiglu {
    static constexpr bool PERM = true, AFTER_DRAIN = false;
    bf16* O; int ldc; const float* ssq; const float* rs_e; const float* gate_e; int mode;
    __device__ __forceinline__ void operator()(const f32x4 (&acc)[2][2][4][2], const Unit& u, int wr, int wc, int fr, int fq) const {
        if (mode == 2) { asm volatile("" :: "v"(acc[0][0][0][0][0]), "v"(acc[1][1][3][1][3])); return; }
        const int lr0 = wr * 64 + fr, col0 = u.pn * HALF + wc * 32 + 8 * fq;
#pragma unroll
        for (int ai = 0; ai < 2; ++ai)
#pragma unroll
            for (int m = 0; m < 4; ++m) { const int lr = lr0 + ai * HALF + m * 16, row = u.pm * BM + lr; float rs, gw;
                if (MOE) { rs = rs_e[u.tab + lr]; gw = gate_e[u.tab + lr]; } else { rs = rstd_of(ssq, row); gw = 1.0f; }
                float o[8]; const float c1 = rs * -1.4426950408889634f, c2 = rs * rs * gw;
#pragma unroll
                for (int n = 0; n < 2; ++n) { const f32x4 ga = acc[ai][0][m][n], gu = ga * acc[ai][1][m][n] * c2, ex = ga * c1;
#pragma unroll
                    for (int q = 0; q < 4; ++q) o[n * 4 + q] = gu[q] * __builtin_amdgcn_rcpf(1.0f + __builtin_amdgcn_exp2f(ex[q])); }
                u32x4 w; w.x = cvt_pk_bf16(o[0], o[1]); w.y = cvt_pk_bf16(o[2], o[3]); w.z = cvt_pk_bf16(o[4], o[5]); w.w = cvt_pk_bf16(o[6], o[7]);
                if (mode == 1) { asm volatile("" :: "v"(w.x), "v"(w.y), "v"(w.z), "v"(w.w)); } else *(u32x4*)(O + (size_t)row * ldc + col0) = w; }
    }
};
struct EpiBf16 {
    static constexpr bool PERM = true, AFTER_DRAIN = false;
    bf16* O; int ldc; bf16* slabs;
    __device__ __forceinline__ void operator()(const f32x4 (&acc)[2][2][4][2], const Unit& u, int wr, int wc, int fr, int fq) const {
        const bool sl = u.slab >= 0; bf16* base = sl ? slabs + (size_t)u.slab * (BM * BM) : O; const int ld = sl ? BM : ldc;
        const int row0 = (sl ? 0 : u.pm * BM) + wr * 64 + fr, col0 = (sl ? 0 : u.pn * BM) + wc * 32 + 8 * fq;
#pragma unroll
        for (int ai = 0; ai < 2; ++ai)
#pragma unroll
            for (int m = 0; m < 4; ++m) { bf16* rowp = base + (size_t)(row0 + ai * HALF + m * 16) * ld + col0;
#pragma unroll
                for (int bj = 0; bj < 2; ++bj) { const f32x4 v0 = acc[ai][bj][m][0], v1 = acc[ai][bj][m][1];
                    u32x4 w; w.x = cvt_pk_bf16(v0[0], v0[1]); w.y = cvt_pk_bf16(v0[2], v0[3]); w.z = cvt_pk_bf16(v1[0], v1[1]); w.w = cvt_pk_bf16(v1[2], v1[3]);
                    *(u32x4*)(rowp + bj * HALF) = w; } }
    }
};
struct EpiResid {
    static constexpr bool PERM = false, AFTER_DRAIN = true;
    const float* xold; float* X; bf16* XB; float* ssq;
    __device__ __forceinline__ void fused(f32x4 (&acc)[2][2][4][2], const Unit& u, int wr, int wc, int fr, int fq, LAS unsigned char* lds, int wid, int lane) const {
        LAS float* Pt = (LAS float*)lds;
        const int col0 = u.pn * BM + wc * 32 + 4 * fq;
#pragma unroll
        for (int ai = 0; ai < 2; ++ai)
#pragma unroll
            for (int m = 0; m < 4; ++m) { const int r = ai * HALF + wr * 64 + m * 16 + fr; const size_t off = (size_t)(u.pm * BM + r) * D + col0; float s = 0.f;
#pragma unroll
                for (int bj = 0; bj < 2; ++bj)
#pragma unroll
                    for (int n = 0; n < 2; ++n) { const f32x4 bs = *(const f32x4*)(xold + off + bj * HALF + n * 16); const f32x4 o = bs + acc[ai][bj][m][n];
                        *(f32x4*)(X + off + bj * HALF + n * 16) = o; u32x2 w; w.x = cvt_pk_bf16(o[0], o[1]); w.y = cvt_pk_bf16(o[2], o[3]); *(u32x2*)(XB + off + bj * HALF + n * 16) = w;
                        s += (o[0] * o[0] + o[1] * o[1]) + (o[2] * o[2] + o[3] * o[3]); }
                s += __shfl_xor(s, 16); s += __shfl_xor(s, 32);
                if (fq == 0) Pt[r * 4 + wc] = s; }
        __syncthreads();
        const int t = wid * 64 + lane;
        if (t < 256) { const float s = (Pt[t * 4 + 0] + Pt[t * 4 + 1]) + (Pt[t * 4 + 2] + Pt[t * 4 + 3]); ssq[(size_t)u.pn * M + u.pm * BM + t] = s; }
        __syncthreads();
    }
};

template <class Epi, class Sched, bool ALIGN_EPI = false, bool SP2 = true>
__device__ __forceinline__ void gemm_phase(LAS unsigned char* lds, LAS unsigned* gtab, const Gemm g, const Sched& S, const Epi& E) {
    constexpr bool GATHER = Sched::GATHER;
    static_assert(!GATHER || SP2, "gather needs the SP2 loop (lgkmcnt(0) waits only)");
    int tid_ = threadIdx.x; asm volatile("" : "+v"(tid_));
    const int tid = tid_, wid = __builtin_amdgcn_readfirstlane(tid >> 6), lane = tid & 63, wr = wid >> 2, wc = wid & 3, fr = lane & 15, fq = lane >> 4;
    const int K = g.K; int nt = K / BK;
    unsigned voffA[2], voffB[2];
#pragma unroll
    for (int i = 0; i < 2; ++i) { int R, C; stage_rc(tid * 16 + i * 8192, R, C); const int Rb = Epi::PERM ? ((R & ~31) + perm32(R & 31)) : R;
        voffA[i] = (unsigned)(R * K + C) * 2u; voffB[i] = (unsigned)(Rb * K + C) * 2u; }
    const size_t kstep = (size_t)(BK * 2);
    const size_t hstep = (size_t)HALF * K * 2;
    const size_t tstep = 2 * hstep;
    const unsigned ldsw = (unsigned)wid * 1024u;
    const int aoff = lds_byte(wr * 64 + fr, fq * 8), boff = lds_byte(wc * 32 + fr, fq * 8);
#define PG8_SA(b, h) (((b) * 2 + (h)) * HTB)
#define PG8_SB(b, h) ((4 + (b) * 2 + (h)) * HTB)
#define PG8_STAGE(bufoff, gbase, voff) do { _Pragma("unroll") for (int _i = 0; _i < 2; ++_i) \
        __builtin_amdgcn_global_load_lds((const unsigned*)((const char*)(gbase) + (voff)[_i]), (LAS unsigned*)(lds + (bufoff) + ldsw + _i * 8192), 16, 0, 0); } while (0)
#define PG8_STAGE_A(bufoff, ubase, kb, h) do { if constexpr (GATHER) { PG8_STAGE(bufoff, (const char*)g.A + (kb), ga[h]); } else { PG8_STAGE(bufoff, (ubase) + (size_t)(h) * hstep + (kb), voffA); } } while (0)
#define PG8_LDA(dst, b, h) do { _Pragma("unroll") for (int m = 0; m < 4; ++m) _Pragma("unroll") for (int k = 0; k < 2; ++k) dst[m][k] = *(const LAS bf16x8*)(lds + PG8_SA(b, h) + aoff + m * 2048 + k * 1024); } while (0)
#define PG8_LDB(dst, b, h) do { _Pragma("unroll") for (int n = 0; n < 2; ++n) _Pragma("unroll") for (int k = 0; k < 2; ++k) dst[n][k] = *(const LAS bf16x8*)(lds + PG8_SB(b, h) + boff + n * 2048 + k * 1024); } while (0)
#define PG8_MMA(ai, bj, At, Bt) do { __builtin_amdgcn_s_setprio(1); _Pragma("unroll") for (int m = 0; m < 4; ++m) _Pragma("unroll") for (int n = 0; n < 2; ++n) _Pragma("unroll") for (int k = 0; k < 2; ++k) \
        acc[ai][bj][m][n] = __builtin_amdgcn_mfma_f32_16x16x32_bf16(Bt[n][k], At[m][k], acc[ai][bj][m][n], 0, 0, 0); __builtin_amdgcn_s_setprio(0); } while (0)
#define PG8_WAIT_V(n) asm volatile("s_waitcnt vmcnt(" #n ")" ::: "memory")
#define PG8_WAIT_L(n) asm volatile("s_waitcnt lgkmcnt(" #n ")" ::: "memory")
#define PG8_BAR __builtin_amdgcn_s_barrier()
#define PG8_SCHED __builtin_amdgcn_sched_barrier(0)
#define PG8_GTAB_DMA(un, slot) do { if (wid < 4) __builtin_amdgcn_global_load_lds(S.a_table(un) + wid * 64 + lane, (LAS unsigned*)(gtab + (slot) * 256 + wid * 64), 4, 0, 0); } while (0)
#define PG8_GTAB_READ(dst, slot) do { _Pragma("unroll") for (int _i = 0; _i < 2; ++_i) { int _R, _C; stage_rc(tid * 16 + _i * 8192, _R, _C); _Pragma("unroll") for (int _h = 0; _h < 2; ++_h) dst[_h][_i] = gtab[(slot) * 256 + _h * HALF + _R] + (unsigned)_C * 2u; } } while (0)
    Unit cur, nxt; int ui = 0;
    if (!S.next(0, cur)) return;
    f32x4 acc[2][2][4][2];
#pragma unroll
    for (int a = 0; a < 2; ++a)
#pragma unroll
        for (int b = 0; b < 2; ++b)
#pragma unroll
            for (int m = 0; m < 4; ++m)
#pragma unroll
                for (int n = 0; n < 2; ++n) acc[a][b][m][n] = (f32x4){0.f, 0.f, 0.f, 0.f};
    bf16x8 At[4][2], B0[2][2], B1[2][2];
    unsigned ga[2][2];
    if (cur.nt) nt = cur.nt;
    const char* cA = (const char*)g.A + (GATHER ? (size_t)0 : (size_t)cur.pm * tstep + cur.k0b); const char* cB = (const char*)g.Bt + ((size_t)cur.e * g.bstride_e) * 2 + (size_t)cur.pn * tstep + cur.k0b;
    if constexpr (GATHER) { PG8_GTAB_DMA(cur, 0); PG8_WAIT_V(0); PG8_BAR; PG8_GTAB_READ(ga, 0); }
    if constexpr (SP2) {
        PG8_STAGE(PG8_SB(0, 0), cB, voffB); PG8_STAGE(PG8_SB(0, 1), cB + hstep, voffB); PG8_STAGE_A(PG8_SA(0, 0), cA, 0, 0); PG8_STAGE_A(PG8_SA(0, 1), cA, 0, 1);
        if (wr == 1) PG8_BAR;
        PG8_WAIT_V(2); PG8_BAR;
        PG8_STAGE(PG8_SB(1, 0), cB + kstep, voffB); PG8_STAGE_A(PG8_SA(1, 0), cA, kstep, 0); PG8_STAGE(PG8_SB(1, 1), cB + hstep + kstep, voffB);
        PG8_WAIT_V(6); PG8_BAR;
    } else {
        PG8_STAGE(PG8_SB(0, 0), cB, voffB); PG8_STAGE_A(PG8_SA(0, 0), cA, 0, 0); PG8_STAGE(PG8_SB(0, 1), cB + hstep, voffB); PG8_STAGE_A(PG8_SA(0, 1), cA, 0, 1);
        if (wr == 1) PG8_BAR;
        PG8_WAIT_V(4); PG8_BAR;
        PG8_STAGE(PG8_SB(1, 0), cB + kstep, voffB); PG8_STAGE_A(PG8_SA(1, 0), cA, kstep, 0); PG8_STAGE(PG8_SB(1, 1), cB + hstep + kstep, voffB);
        PG8_WAIT_V(6); PG8_BAR;
    }
    for (;;) {
        const bool has_next = S.next(ui + 1, nxt);
        const char* nA = (has_next && !GATHER) ? (const char*)g.A + (size_t)nxt.pm * tstep + nxt.k0b : cA;
        const char* nB = has_next ? (const char*)g.Bt + ((size_t)nxt.e * g.bstride_e) * 2 + (size_t)nxt.pn * tstep + nxt.k0b : cB;
        for (int t = 0; t < nt; t += 2) {
            const bool last = (t == nt - 2);
            const size_t k1 = (size_t)(t + 1) * kstep;
            const char* a2 = last ? nA : cA; const size_t k2 = last ? 0 : (size_t)(t + 2) * kstep;
            const char* b2 = last ? nB : cB + (size_t)(t + 2) * kstep; const char* b3 = b2 + kstep;
            const size_t k3 = k2 + kstep;
            if constexpr (GATHER) {
                if (t == nt - 4 && has_next) PG8_GTAB_DMA(nxt, (ui + 1) & 1);
            }
            if constexpr (SP2) {
            PG8_LDB(B0, 0, 0); PG8_LDB(B1, 0, 1); PG8_SCHED; PG8_LDA(At, 0, 0); PG8_STAGE_A(PG8_SA(1, 1), cA, k1, 1);
            if constexpr (GATHER) { if (last && has_next) PG8_GTAB_READ(ga, (ui + 1) & 1); }
            PG8_WAIT_V(8); PG8_WAIT_L(0); PG8_BAR; PG8_MMA(0, 0, At, B0); PG8_MMA(0, 1, At, B1); PG8_BAR; PG8_SCHED;
            PG8_LDA(At, 0, 1); PG8_STAGE(PG8_SB(0, 0), b2, voffB); PG8_STAGE(PG8_SB(0, 1), b2 + hstep, voffB); PG8_STAGE_A(PG8_SA(0, 0), a2, k2, 0);
            PG8_WAIT_V(8); PG8_WAIT_L(0); PG8_BAR; PG8_MMA(1, 0, At, B0); PG8_MMA(1, 1, At, B1); PG8_BAR; PG8_SCHED;
            PG8_LDB(B0, 1, 0); PG8_LDB(B1, 1, 1); PG8_SCHED; PG8_LDA(At, 1, 0); PG8_STAGE_A(PG8_SA(0, 1), a2, k2, 1);
            PG8_WAIT_V(8); PG8_WAIT_L(0); PG8_BAR; PG8_MMA(0, 0, At, B0); PG8_MMA(0, 1, At, B1); PG8_BAR; PG8_SCHED;
            PG8_LDA(At, 1, 1); PG8_STAGE(PG8_SB(1, 0), b3, voffB); PG8_STAGE(PG8_SB(1, 1), b3 + hstep, voffB); PG8_STAGE_A(PG8_SA(1, 0), a2, k3, 0);
            PG8_WAIT_V(8); PG8_WAIT_L(0); PG8_BAR; PG8_MMA(1, 0, At, B0); PG8_MMA(1, 1, At, B1); PG8_BAR; PG8_SCHED;
            } else {
            PG8_LDB(B0, 0, 0); PG8_SCHED; PG8_LDA(At, 0, 0); PG8_STAGE_A(PG8_SA(1, 1), cA, k1, 1);
            PG8_WAIT_L(8); PG8_BAR; PG8_WAIT_L(0); PG8_MMA(0, 0, At, B0); PG8_BAR; PG8_SCHED;
            PG8_LDB(B1, 0, 1); PG8_STAGE(PG8_SB(0, 0), b2, voffB);
            PG8_BAR; PG8_WAIT_L(0); PG8_MMA(0, 1, At, B1); PG8_BAR;
            PG8_LDA(At, 0, 1); PG8_STAGE_A(PG8_SA(0, 0), a2, k2, 0);
            PG8_BAR; PG8_WAIT_L(0); PG8_MMA(1, 0, At, B0); PG8_BAR; PG8_SCHED;
            PG8_STAGE(PG8_SB(0, 1), b2 + hstep, voffB);
            PG8_WAIT_V(6); PG8_BAR; PG8_MMA(1, 1, At, B1); PG8_BAR;
            PG8_LDB(B0, 1, 0); PG8_SCHED; PG8_LDA(At, 1, 0); PG8_STAGE_A(PG8_SA(0, 1), a2, k2, 1);
            PG8_WAIT_L(8); PG8_BAR; PG8_WAIT_L(0); PG8_MMA(0, 0, At, B0); PG8_BAR; PG8_SCHED;
            PG8_LDB(B1, 1, 1); PG8_STAGE(PG8_SB(1, 0), b3, voffB);
            PG8_BAR; PG8_WAIT_L(0); PG8_MMA(0, 1, At, B1); PG8_BAR;
            PG8_LDA(At, 1, 1); PG8_STAGE_A(PG8_SA(1, 0), a2, k3, 0);
            PG8_BAR; PG8_WAIT_L(0); PG8_MMA(1, 0, At, B0); PG8_BAR; PG8_SCHED;
            PG8_STAGE(PG8_SB(1, 1), b3 + hstep, voffB);
            PG8_WAIT_V(6); PG8_BAR; PG8_MMA(1, 1, At, B1); PG8_BAR;
            }
        }
        if constexpr (ALIGN_EPI) { if (wr == 0) PG8_BAR; }
        if constexpr (!Epi::AFTER_DRAIN) { E(acc, cur, wr, wc, fr, fq); }
        if (!has_next) break;
#pragma unroll
        for (int a = 0; a < 2; ++a)
#pragma unroll
            for (int b = 0; b < 2; ++b)
#pragma unroll
                for (int m = 0; m < 4; ++m)
#pragma unroll
                    for (int n = 0; n < 2; ++n) acc[a][b][m][n] = (f32x4){0.f, 0.f, 0.f, 0.f};
        cur = nxt; cA = nA; cB = nB; ++ui; nt = cur.nt ? cur.nt : K / BK;
        if constexpr (ALIGN_EPI) { if (wr == 1) PG8_BAR; }
    }
    PG8_WAIT_V(0);
    if constexpr (!ALIGN_EPI) { if (wr == 0) PG8_BAR; }
    PG8_BAR;
    if constexpr (Epi::AFTER_DRAIN) { E.fused(acc, cur, wr, wc, fr, fq, lds, wid, lane); }
#undef PG8_SA
#undef PG8_SB
#undef PG8_STAGE
#undef PG8_STAGE_A
#undef PG8_LDA
#undef PG8_LDB
#undef PG8_MMA
#undef PG8_WAIT_V
#undef PG8_WAIT_L
#undef PG8_BAR
#undef PG8_SCHED
#undef PG8_GTAB_DMA
#undef PG8_GTAB_READ
}
}
constexpr size_t MiB = 1u << 20;
constexpr size_t WS_CTL = 0, CTL_ZERO_BYTES = 1 * MiB;
constexpr size_t WS_ROWOFF = 1 * MiB;
constexpr size_t WS_RS = WS_ROWOFF + 512 * 1024;
constexpr size_t WS_GATE = WS_RS + 512 * 1024;
constexpr size_t WS_SEL = WS_GATE + 512 * 1024;
constexpr size_t WS_SSQ = WS_SEL + 256 * 1024;
constexpr size_t WS_SMALLW = 4 * MiB;
constexpr size_t WS_PWT = WS_SMALLW;
constexpr size_t WS_POOLWT = WS_PWT + 2 * 384 * 384 * 2;
constexpr size_t WS_GMWS = WS_POOLWT + 2 * 4 * 64 * 64 * 2;
constexpr size_t WS_XB = 6 * MiB;
constexpr size_t WS_SLAB = 6 * MiB;
constexpr size_t WS_MOE_WD = 38 * MiB;
constexpr size_t WS_MOE_WGU = 94 * MiB;
constexpr size_t WS_YP = 94 * MiB;
constexpr size_t WS_ACTM = 206 * MiB;
constexpr size_t WS_P = 206 * MiB;
constexpr size_t WS_Y = 262 * MiB;
constexpr size_t WS_ACT = 206 * MiB;
constexpr size_t WS_WIN = 294 * MiB;
constexpr size_t WS_WOUT = 301 * MiB;
constexpr size_t WS_WGU = 305 * MiB;
constexpr size_t WS_WD = 316 * MiB;
constexpr size_t WS_END = 444 * MiB;
static_assert(WS_SSQ + 4 * (size_t)M * 4 <= WS_SMALLW && WS_GMWS + 2 * 4 * 128 * 128 * 2 <= WS_XB && WS_XB + (size_t)M * D * 2 <= WS_MOE_WD, "ws map 1");
static_assert(WS_MOE_WD + (size_t)NE * D * DFE * 2 <= WS_MOE_WGU && WS_MOE_WGU + (size_t)NE * NGUE * D * 2 <= WS_ACTM && WS_YP + (size_t)PMAX * D * 2 <= WS_ACTM, "ws map 2");
static_assert(WS_ACTM + (size_t)PMAX * DFE * 2 <= WS_END && WS_P + (size_t)M * DIN * 2 <= WS_Y && WS_Y + (size_t)M * D * 2 <= WS_WIN && WS_ACT + (size_t)M * DFF * 2 <= WS_WIN, "ws map 3");
static_assert(WS_WIN + 2 * (size_t)DIN * D * 2 <= WS_WOUT && WS_WOUT + 2 * (size_t)D * D * 2 <= WS_WGU && WS_WGU + (size_t)NGU * D * 2 <= WS_WD && WS_WD + (size_t)D * DFF * 2 <= WS_END, "ws map 4");
constexpr int CW_BAR = 4096;
constexpr int CW_CNT = 131072;
constexpr int CW_CVT = 140000;
constexpr int NPHASE = 13;
constexpr int RING_BYTES = 131072;
constexpr int GTAB_OFF = RING_BYTES;
constexpr int MISC_OFF = GTAB_OFF + 2048;
constexpr int INTAB_OFF = MISC_OFF + 256;
constexpr int LDS_BYTES = 147456;
static_assert(MISC_OFF + 256 <= LDS_BYTES, "LDS map");

typedef GAS unsigned gu32;
#define RLX_AGENT __ATOMIC_RELAXED, __HIP_MEMORY_SCOPE_AGENT
#define LDS_WAIT() asm volatile("s_waitcnt lgkmcnt(0)" ::: "memory")
#define VM_WAIT() asm volatile("s_waitcnt vmcnt(0)" ::: "memory")

#define XB_TMO      128
#define XB_XCNT(j)  (256  + 64 * (j))
#define XB_XSUB(j)  (1280 + 64 * (j))
#define XB_XGEN(j)  (2304 + 64 * (j))
#define XB_TOP      3328
#define XB_TOPGEN   3392
#define XCD_BAR_WORDS 3456
#define XB_SPIN_CAP (1u << 18)
__device__ __forceinline__ unsigned xb_ld(unsigned* p)              { return __hip_atomic_load(p, __ATOMIC_RELAXED, __HIP_MEMORY_SCOPE_AGENT); }
__device__ __forceinline__ unsigned xb_add(unsigned* p, unsigned v) { return __hip_atomic_fetch_add(p, v, __ATOMIC_RELAXED, __HIP_MEMORY_SCOPE_AGENT); }
__device__ __forceinline__ unsigned xb_xcc_id() { return (unsigned)__builtin_amdgcn_s_getreg((3 << 11) | 20) & 0xFu; }
#define XB_SPIN(cond, bar) do { unsigned _sp = 0; while (cond) { __builtin_amdgcn_s_sleep(1); \
    if ((++_sp & 255u) == 0u) { if (xb_ld(&(bar)[XB_TMO])) break; if (_sp > XB_SPIN_CAP) { atomicAdd(&(bar)[XB_TMO], 1u); break; } } } } while (0)
struct XcdBarrier { unsigned* bar; unsigned x; volatile LAS unsigned* st; };
__device__ __forceinline__ XcdBarrier xcd_barrier_post(unsigned* bar, volatile LAS unsigned* st) {
    XcdBarrier b; b.bar = bar; b.x = xb_xcc_id(); b.st = st;
    if (threadIdx.x == 0) (void)xb_add(&bar[XB_XCNT(b.x)], 1u);
    return b;
}
__device__ __forceinline__ void xcd_barrier_complete(unsigned* bar, unsigned x, unsigned& nloc, unsigned& nx) {
    const unsigned G = gridDim.x * gridDim.y * gridDim.z;
    unsigned sum, cnt, mine, sp = 0u;
    for (;;) {
        sum = 0u; cnt = 0u; mine = 0u;
#pragma unroll
        for (unsigned j = 0; j < 16; ++j) { const unsigned c = xb_ld(&bar[XB_XCNT(j)]); sum += c; cnt += (c > 0u) ? 1u : 0u; mine = (j == x) ? c : mine; }
        if (sum == G) break;
        __builtin_amdgcn_s_sleep(1);
        if ((++sp & 255u) == 0u) { if (xb_ld(&bar[XB_TMO])) break; if (sp > XB_SPIN_CAP) { atomicAdd(&bar[XB_TMO], 1u); break; } }
    }
    nloc = mine > 0u ? mine : 1u; nx = cnt > 0u ? cnt : 1u;
}
__device__ __forceinline__ void xcd_barrier(const XcdBarrier& b) {
    asm volatile("s_waitcnt vmcnt(0)" ::: "memory");
    __syncthreads();
    if (threadIdx.x == 0) {
        unsigned* bar = b.bar;
        __builtin_amdgcn_s_waitcnt(0);
        unsigned nloc = b.st[0], nx = b.st[1];
        if (nloc == 0u) { xcd_barrier_complete(bar, b.x, nloc, nx); b.st[0] = nloc; b.st[1] = nx; }
        const unsigned old = xb_add(&bar[XB_XSUB(b.x)], 1u);
        const unsigned gen = old / nloc;
        if (old + 1u == (gen + 1u) * nloc) {
            __builtin_amdgcn_fence(__ATOMIC_RELEASE, "agent");
            asm volatile("s_waitcnt vmcnt(0)" ::: "memory");
            const unsigned og = xb_add(&bar[XB_TOP], 1u);
            const unsigned tg = og / nx;
            if (og + 1u == (tg + 1u) * nx) xb_add(&bar[XB_TOPGEN], 1u);
            else XB_SPIN(xb_ld(&bar[XB_TOPGEN]) == tg, bar);
            __builtin_amdgcn_fence(__ATOMIC_ACQUIRE, "agent");
            xb_add(&bar[XB_XGEN(b.x)], 1u);
            asm volatile("s_waitcnt vmcnt(0)" ::: "memory");
        } else {
            XB_SPIN(xb_ld(&bar[XB_XGEN(b.x)]) == gen, bar);
            __builtin_amdgcn_fence(__ATOMIC_ACQUIRE, "agent");
            asm volatile("s_waitcnt vmcnt(0)" ::: "memory");
        }
    }
    __syncthreads();
}

struct InTab { const LAS unsigned long long* t;
    __device__ __forceinline__ const float* operator[](int k) const { const unsigned long long v = t[k]; const unsigned lo = __builtin_amdgcn_readfirstlane((unsigned)v), hi = __builtin_amdgcn_readfirstlane((unsigned)(v >> 32));
        return (const float*)(((unsigned long long)hi << 32) | lo); } };
struct Frame {
    LAS unsigned char* lds; volatile LAS unsigned* MISC; unsigned* ctl;
    int tid, lane, wave, vcu, G;
    InTab in; float* out; unsigned char* ws;
};

__device__ __forceinline__ InTab in_tab(Frame& F) { return F.in; }
struct TrJob { const float* src; bf16* dst; const float* gk; int K, N; };
__device__ __forceinline__ TrJob tr_mat(const float* W, int K, int N, bf16* WT, int mode, const float* gk, int r) {
    const int nblk = N / 32, kb = r / nblk, nb = r % nblk, n0 = 32 * nb, k0 = 64 * kb;
    const int drow = mode == 0 ? n0 : ((n0 >> 7) * 256 + (n0 & 127) + (mode == 2 ? 128 : 0));
    TrJob j; j.src = W + (size_t)k0 * N + n0; j.dst = WT + (size_t)drow * K + k0; j.gk = gk ? gk + k0 : nullptr; j.K = K; j.N = N; return j;
}
constexpr int TR_I_IN = (D / 64) * (DIN / 32), TR_I_OUT = (D / 64) * (D / 32), TR_I_G = (D / 64) * (DFF / 32), TR_I_D = (DFF / 64) * (D / 32), TR_I_MG = (D / 64) * (DFE / 32), TR_I_MD = (DFE / 64) * (D / 32), TR_I_PW = (DCV / 64) * (DCV / 32), TR_I_PL = 2;
constexpr int TR_A_END = TR_I_IN + TR_I_OUT + 2 * TR_I_G + TR_I_D + 2 * TR_I_PW + 8 * TR_I_PL;
constexpr int TR_B_END = TR_A_END + TR_I_IN + TR_I_OUT;
constexpr int TR_C_END = TR_B_END + 2 * NE * TR_I_MG;
constexpr int TR_D_END = TR_C_END + NE * TR_I_MD;
__device__ __forceinline__ TrJob tr_decode(const InTab in, unsigned char* ws, int r) {
    if (r < TR_I_IN) return tr_mat(in[2], D, DIN, (bf16*)(ws + WS_WIN), 0, in[1], r); r -= TR_I_IN;
    if (r < TR_I_OUT) return tr_mat(in[14], D, D, (bf16*)(ws + WS_WOUT), 0, nullptr, r); r -= TR_I_OUT;
    if (r < TR_I_G) return tr_mat(in[16], D, DFF, (bf16*)(ws + WS_WGU), 1, in[15], r); r -= TR_I_G;
    if (r < TR_I_G) return tr_mat(in[17], D, DFF, (bf16*)(ws + WS_WGU), 2, in[15], r); r -= TR_I_G;
    if (r < TR_I_D) return tr_mat(in[18], DFF, D, (bf16*)(ws + WS_WD), 0, nullptr, r); r -= TR_I_D;
    if (r < 2 * TR_I_PW) { const int l = r / TR_I_PW; return tr_mat(in[12] + (size_t)l * DCV * DCV, DCV, DCV, (bf16*)(ws + WS_PWT) + (size_t)l * DCV * DCV, 0, nullptr, r % TR_I_PW); } r -= 2 * TR_I_PW;
    if (r < 8 * TR_I_PL) { const int gi = r / TR_I_PL; return tr_mat(in[3] + (size_t)gi * 64 * 64, 64, 64, (bf16*)(ws + WS_POOLWT) + (size_t)gi * 64 * 64, 0, nullptr, r % TR_I_PL); } r -= 8 * TR_I_PL;
    if (r < TR_I_IN) return tr_mat(in[2] + (size_t)D * DIN, D, DIN, (bf16*)(ws + WS_WIN) + (size_t)DIN * D, 0, in[1] + D, r); r -= TR_I_IN;
    if (r < TR_I_OUT) return tr_mat(in[14] + (size_t)D * D, D, D, (bf16*)(ws + WS_WOUT) + (size_t)D * D, 0, nullptr, r); r -= TR_I_OUT;
    if (r < 2 * NE * TR_I_MG) { const int e = r / (2 * TR_I_MG), q = r % (2 * TR_I_MG), up = q / TR_I_MG;
        return tr_mat(in[20 + up] + (size_t)e * D * DFE, D, DFE, (bf16*)(ws + WS_MOE_WGU) + (size_t)e * NGUE * D, 1 + up, in[15] + D, q % TR_I_MG); } r -= 2 * NE * TR_I_MG;
    { const int e = r / TR_I_MD; return tr_mat(in[22] + (size_t)e * DFE * D, DFE, D, (bf16*)(ws + WS_MOE_WD) + (size_t)e * D * DFE, 0, nullptr, r % TR_I_MD); }
}
__device__ __forceinline__ void tr_load(const TrJob& j, f32x4 (&v)[8], int lane, int probe) {
    const int n4 = (lane & 7) * 4, kr = lane >> 3;
    if (probe == 2) {
#pragma unroll
        for (int i = 0; i < 8; ++i) v[i] = (f32x4){1.f, 2.f, 3.f, 4.f};
        return; }
#pragma unroll
    for (int i = 0; i < 8; ++i) { v[i] = *(const f32x4*)(j.src + (size_t)(kr + 8 * i) * j.N + n4); if (j.gk) v[i] = v[i] * j.gk[kr + 8 * i]; }
}
__device__ __forceinline__ void tr_store(const TrJob& j, const f32x4 (&v)[8], LAS float* scr, int lane, int probe) {
    const int n4 = (lane & 7) * 4, kr = lane >> 3;
#pragma unroll
    for (int i = 0; i < 8; ++i) { LAS float* d = scr + (kr + 8 * i) * 33 + n4; d[0] = v[i][0]; d[1] = v[i][1]; d[2] = v[i][2]; d[3] = v[i][3]; }
    LDS_WAIT(); asm volatile("" ::: "memory");
    const int c = lane & 7;
#pragma unroll
    for (int jj = 0; jj < 4; ++jj) { const int n = (lane >> 3) + 8 * jj; const LAS float* s = scr + (8 * c) * 33 + n;
        u32x4 o; o.x = cvt_pk_bf16(s[0 * 33], s[1 * 33]); o.y = cvt_pk_bf16(s[2 * 33], s[3 * 33]); o.z = cvt_pk_bf16(s[4 * 33], s[5 * 33]); o.w = cvt_pk_bf16(s[6 * 33], s[7 * 33]);
        if (probe == 1 || probe == 2) { asm volatile("" :: "v"(o.x), "v"(o.y), "v"(o.z), "v"(o.w)); } else *(GAS u32x4*)(j.dst + (size_t)n * j.K + 8 * c) = o; }
    LDS_WAIT(); asm volatile("" ::: "memory");
}
__device__ __forceinline__ void tr_run(Frame& F, int first, int count, int widx, int nw, int probe) {
    LAS float* scr = (LAS float*)(F.lds + F.wave * 16384); int lane = F.lane; asm volatile("" : "+v"(lane)); const InTab in = in_tab(F); unsigned char* ws = F.ws;
    const int end = first + count; f32x4 v[4][8]; TrJob j[4];
#pragma unroll
    for (int k = 0; k < 4; ++k) { const int it = first + widx + k * nw; if (it < end) { j[k] = tr_decode(in, ws, it); tr_load(j[k], v[k], lane, probe); } }
    for (int it = first + widx; it < end; it += 4 * nw) {
#pragma unroll
        for (int k = 0; k < 4; ++k) { const int ik = it + k * nw, nx = ik + 4 * nw;
            if (ik < end) tr_store(j[k], v[k], scr, lane, probe);
            if (nx < end) { j[k] = tr_decode(in, ws, nx); tr_load(j[k], v[k], lane, probe); } } }
}
constexpr int HID_PER_WAVE = 2, H1_N = 64 * 8 * HID_PER_WAVE, H4_N = 128 * 8 * HID_PER_WAVE, H6_N = 64 * 8 * HID_PER_WAVE, H10_WG = 96, H10_N = H10_WG * 8 * HID_PER_WAVE;
constexpr int H1_BEG = TR_A_END, H4_BEG = H1_BEG + H1_N, H6_BEG = H4_BEG + H4_N, H6_END = H6_BEG + H6_N, H10_BEG = TR_D_END - H10_N;
static_assert(H6_END <= TR_C_END && H10_BEG >= TR_C_END, "hidden conversion shares");
__device__ __forceinline__ void tail_convert(Frame& F, int first, int count, int rank, int nwg_idle) {
    if (rank >= 0 && rank < nwg_idle) tr_run(F, first, count, rank * 8 + F.wave, nwg_idle * 8, 0);
}

__device__ __forceinline__ void p0_prologue(Frame& F, int probe) {
    LAS float* scr = (LAS float*)(F.lds + F.wave * 16384);
    int lane = F.lane; asm volatile("" : "+v"(lane));
    const int gw = F.vcu * 8 + F.wave, NGW = F.G * 8;
    const InTab in = in_tab(F); unsigned char* ws = F.ws;
    tr_run(F, 0, TR_A_END, gw, NGW, probe);
    tr_run(F, H6_END, H10_BEG - H6_END, gw, NGW, probe);
    { const float* src = in[6]; bf16* dst = (bf16*)(ws + WS_GMWS);
      for (int i = gw * 64 + lane; i < 2 * 4 * 128 * 128 / 8; i += NGW * 64) { const f32x4 a = *(const f32x4*)(src + (size_t)i * 8), b = *(const f32x4*)(src + (size_t)i * 8 + 4);
          u32x4 o; o.x = cvt_pk_bf16(a[0], a[1]); o.y = cvt_pk_bf16(a[2], a[3]); o.z = cvt_pk_bf16(b[0], b[1]); o.w = cvt_pk_bf16(b[2], b[3]); *(u32x4*)(dst + (size_t)i * 8) = o; } }
    { u32x4* t = (u32x4*)(ws + WS_ROWOFF); for (int i = gw * 64 + lane; i < NE * ECAP / 4; i += NGW * 64) t[i] = (u32x4){0u, 0u, 0u, 0u}; }
    { const float* x = in[0]; bf16* XB = (bf16*)(ws + WS_XB); float* ssq = (float*)(ws + WS_SSQ);
      for (int m = gw; m < M; m += NGW) { const f32x4* xr = (const f32x4*)(x + (size_t)m * D) + lane; f32x4 v[4]; float s = 0.f;
#pragma unroll
          for (int j = 0; j < 4; ++j) { v[j] = xr[64 * j]; s += (v[j][0] * v[j][0] + v[j][1] * v[j][1]) + (v[j][2] * v[j][2] + v[j][3] * v[j][3]); }
          s = wave_sum(s);
          u32x2* o = (u32x2*)(XB + (size_t)m * D) + lane;
#pragma unroll
          for (int j = 0; j < 4; ++j) { u32x2 w; w.x = cvt_pk_bf16(v[j][0], v[j][1]); w.y = cvt_pk_bf16(v[j][2], v[j][3]); o[64 * j] = w; }
          if (lane < 4) ssq[(size_t)lane * M + m] = lane == 0 ? s : 0.f; } }
}

__device__ __forceinline__ void unpack8(const u32x4 w, float (&f)[8]) { f[0] = bf_lo(w.x); f[1] = bf_hi(w.x); f[2] = bf_lo(w.y); f[3] = bf_hi(w.y); f[4] = bf_lo(w.z); f[5] = bf_hi(w.z); f[6] = bf_lo(w.w); f[7] = bf_hi(w.w); }
__device__ __forceinline__ void mixer_unit(Frame& F, int u, int layer) {
    LAS unsigned char* lds = F.lds; int tid = F.tid; asm volatile("" : "+v"(tid)); int lane = tid & 63; const int w = F.wave;
    const InTab in = in_tab(F); unsigned char* ws = F.ws;
    const bf16* P = (const bf16*)(ws + WS_P); bf16* Y = (bf16*)(ws + WS_Y);
    const int r0 = 64 * u, s0 = r0 & (SEQ - 1), half = u & 1, blk0 = r0 & ~127;
#ifndef MIX_MASK
#define MIX_MASK 7
#endif
#ifndef MIX_REP
#define MIX_REP 0
#endif
    for (int mrep = 0; mrep < 1 + (MIX_REP & 1); ++mrep) if (MIX_MASK & 1) { constexpr int AIN = 0, YPL = 40448, YST = 528;
      const int g = w >> 1, th = w & 1, fr = lane & 15, fq = lane >> 4;
      u32x4 st[5];
#pragma unroll
      for (int i = 0; i < 5; ++i) { const int idx = tid + 512 * i, rr = idx >> 5, ch = idx & 31, pos = s0 - 15 + rr; st[i] = (u32x4){0u, 0u, 0u, 0u};
          if (idx < 79 * 32 && pos >= 0) st[i] = *(const u32x4*)(P + (size_t)(r0 - 15 + rr) * DIN + ch * 8); }
      const bf16* wt = (const bf16*)(ws + WS_POOLWT) + (size_t)(layer * 4 + g) * 64 * 64; const float* sc = in[4] + layer * DPOOL + g * 64;
      bf16x8 Bf[2][4]; f32x4 sc4[4];
#pragma unroll
      for (int ks = 0; ks < 2; ++ks)
#pragma unroll
          for (int nt = 0; nt < 4; ++nt) Bf[ks][nt] = *(const bf16x8*)(wt + (nt * 16 + fr) * 64 + ks * 32 + 8 * fq);
#pragma unroll
      for (int nt = 0; nt < 4; ++nt) sc4[nt] = *(const f32x4*)(sc + nt * 16 + 4 * fq);
#pragma unroll
      for (int i = 0; i < 5; ++i) { const int idx = tid + 512 * i; if (idx < 79 * 32) *(LAS u32x4*)(lds + AIN + (idx >> 5) * 512 + (idx & 31) * 16) = st[i]; }
      __syncthreads();
      { const int p = tid & 127, rq = tid >> 7, gp = p >> 5, win = 2 << gp; float S0 = 0.f, S1 = 0.f;
        for (int j = 1; j < win; ++j) { const unsigned a = *(const LAS unsigned*)(lds + AIN + (16 * rq + 15 - j) * 512 + p * 4); S0 += bf_lo(a); S1 += bf_hi(a); }
#pragma unroll 4
        for (int t = 0; t < 16; ++t) { const int lt = 16 * rq + t, rr = lt + 15; const unsigned a = *(const LAS unsigned*)(lds + AIN + rr * 512 + p * 4); const float a0 = bf_lo(a), a1 = bf_hi(a);
            S0 += a0; S1 += a1; const int pos1 = s0 + lt + 1; const float rn = __builtin_amdgcn_rcpf((float)(pos1 < win ? pos1 : win));
            *(LAS unsigned*)(lds + YPL + lt * YST + p * 4) = cvt_pk_bf16(S0 * rn - a0, S1 * rn - a1);
            const unsigned o = *(const LAS unsigned*)(lds + AIN + (rr - win + 1) * 512 + p * 4); S0 -= bf_lo(o); S1 -= bf_hi(o); } }
      __syncthreads();
      { f32x4 acc[2][4];
#pragma unroll
        for (int a = 0; a < 2; ++a)
#pragma unroll
            for (int b = 0; b < 4; ++b) acc[a][b] = (f32x4){0.f, 0.f, 0.f, 0.f};
#pragma unroll
        for (int ks = 0; ks < 2; ++ks) { bf16x8 A[2];
#pragma unroll
            for (int mt = 0; mt < 2; ++mt) A[mt] = *(const LAS bf16x8*)(lds + YPL + ((2 * th + mt) * 16 + fr) * YST + (g * 64 + ks * 32 + 8 * fq) * 2);
#pragma unroll
            for (int mt = 0; mt < 2; ++mt)
#pragma unroll
                for (int nt = 0; nt < 4; ++nt) acc[mt][nt] = __builtin_amdgcn_mfma_f32_16x16x32_bf16(Bf[ks][nt], A[mt], acc[mt][nt], 0, 0, 0); }
#pragma unroll
        for (int mt = 0; mt < 2; ++mt)
#pragma unroll
            for (int nt = 0; nt < 4; ++nt) { const int t = r0 + (2 * th + mt) * 16 + fr, d = nt * 16 + 4 * fq; const f32x4 v = acc[mt][nt] * sc4[nt];
                u32x2 o; o.x = cvt_pk_bf16(v[0], v[1]); o.y = cvt_pk_bf16(v[2], v[3]); *(u32x2*)(Y + (size_t)t * D + g * 64 + d) = o; } }
      __syncthreads(); }
    asm volatile("" : "+v"(tid)); lane = tid & 63;
    for (int mrep = 0; mrep < 1 + ((MIX_REP >> 1) & 1); ++mrep) if (MIX_MASK & 2) { constexpr int VN = 0, VST = 800; const int nj = half ? 128 : 64, nks = nj >> 5;
      const int h = w & 3, ih = w >> 2, fr = lane & 15, fq = lane >> 4, q4 = (lane & 15) >> 2, p4 = lane & 3;
      const bf16* wsb = (const bf16*)(ws + WS_GMWS) + (size_t)(layer * 4 + h) * 128 * 128;
      const float* gg = in[5] + layer * DGM; const float* bb = in[7] + (size_t)(layer * 4 + h) * 128;
      u32x4 raw[16]; const int nr = nj >> 3;
#pragma unroll
      for (int i = 0; i < 16; ++i) { raw[i] = (u32x4){0u, 0u, 0u, 0u}; if (i < nr && lane < 48) raw[i] = *(const u32x4*)(P + (size_t)(blk0 + i * 8 + w) * DIN + 640 + lane * 8); }
      bf16x8 Aw[4][2]; f32x4 g4[6]; float bi[2];
#pragma unroll
      for (int ks = 0; ks < 4; ++ks)
#pragma unroll
          for (int mt = 0; mt < 2; ++mt) { Aw[ks][mt] = (bf16x8){0, 0, 0, 0, 0, 0, 0, 0}; if (ks < nks) Aw[ks][mt] = *(const bf16x8*)(wsb + (size_t)(half * 64 + (2 * ih + mt) * 16 + fr) * 128 + ks * 32 + 8 * fq); }
#pragma unroll
      for (int ct = 0; ct < 6; ++ct) g4[ct] = *(const f32x4*)(gg + h * 96 + ct * 16 + 4 * fq);
#pragma unroll
      for (int mt = 0; mt < 2; ++mt) bi[mt] = bb[half * 64 + (2 * ih + mt) * 16 + fr];
#pragma unroll
      for (int i = 0; i < 16; ++i) { if (i < nr) { float f[8]; unpack8(raw[i], f); float s = 0.f;
#pragma unroll
              for (int q = 0; q < 8; ++q) s += f[q] * f[q];
              s = wave_sum(s); const float rs = 1.0f / sqrtf(s * (1.0f / DGM) + EPS);
              u32x4 o; o.x = cvt_pk_bf16(f[0] * rs, f[1] * rs); o.y = cvt_pk_bf16(f[2] * rs, f[3] * rs); o.z = cvt_pk_bf16(f[4] * rs, f[5] * rs); o.w = cvt_pk_bf16(f[6] * rs, f[7] * rs);
              if (lane < 48) *(LAS u32x4*)(lds + VN + (i * 8 + w) * VST + lane * 16) = o; } }
      u32x2 uu[2][6];
#pragma unroll
      for (int mt = 0; mt < 2; ++mt)
#pragma unroll
          for (int ct = 0; ct < 6; ++ct) uu[mt][ct] = *(const u32x2*)(P + (size_t)(r0 + (2 * ih + mt) * 16 + fr) * DIN + 256 + h * 96 + ct * 16 + 4 * fq);
      __syncthreads();
      { f32x4 acc[2][6];
#pragma unroll
        for (int a = 0; a < 2; ++a)
#pragma unroll
            for (int b = 0; b < 6; ++b) acc[a][b] = (f32x4){0.f, 0.f, 0.f, 0.f};
#pragma unroll
        for (int ks = 0; ks < 4; ++ks) { if (ks < nks) {
#pragma unroll
            for (int ct = 0; ct < 6; ++ct) { const unsigned ad = VN + (32 * ks + 8 * fq + q4) * VST + (h * 96 + ct * 16 + 4 * p4) * 2;
                const s16x4 t0 = __builtin_amdgcn_ds_read_tr16_b64_v4i16((LAS s16x4*)(lds + ad)), t1 = __builtin_amdgcn_ds_read_tr16_b64_v4i16((LAS s16x4*)(lds + ad + 4 * VST));
                bf16x8 B; B[0] = t0[0]; B[1] = t0[1]; B[2] = t0[2]; B[3] = t0[3]; B[4] = t1[0]; B[5] = t1[1]; B[6] = t1[2]; B[7] = t1[3];
#pragma unroll
                for (int mt = 0; mt < 2; ++mt) acc[mt][ct] = __builtin_amdgcn_mfma_f32_16x16x32_bf16(B, Aw[ks][mt], acc[mt][ct], 0, 0, 0); } } }
#pragma unroll
        for (int mt = 0; mt < 2; ++mt) { const int t = r0 + (2 * ih + mt) * 16 + fr;
#pragma unroll
            for (int ct = 0; ct < 6; ++ct) { const int c4 = h * 96 + ct * 16 + 4 * fq; const f32x4 z = acc[mt][ct] * g4[ct] + bi[mt]; const u32x2 uv = uu[mt][ct];
                u32x2 o; o.x = cvt_pk_bf16(bf_lo(uv.x) * z[0], bf_hi(uv.x) * z[1]); o.y = cvt_pk_bf16(bf_lo(uv.y) * z[2], bf_hi(uv.y) * z[3]); *(u32x2*)(Y + (size_t)t * D + 256 + c4) = o; } } }
      __syncthreads(); }
    asm volatile("" : "+v"(tid)); lane = tid & 63;
    for (int mrep = 0; mrep < 1 + ((MIX_REP >> 2) & 1); ++mrep) if (MIX_MASK & 4) { constexpr int HC = 0, TT = 72192, TST = 784;
      { u32x4 cvr[9], cgr[9];
#pragma unroll
        for (int i = 0; i < 9; ++i) { const int idx = tid + 512 * i, rr = idx / 48, ch = idx % 48, pos = s0 - 30 + rr; cvr[i] = (u32x4){0u, 0u, 0u, 0u}; cgr[i] = (u32x4){0u, 0u, 0u, 0u};
            if (idx < 94 * 48 && pos >= 0) { const bf16* pr = P + (size_t)(r0 - 30 + rr) * DIN; cvr[i] = *(const u32x4*)(pr + 1024 + ch * 8); cgr[i] = *(const u32x4*)(pr + 1408 + ch * 8); } }
#pragma unroll
        for (int i = 0; i < 9; ++i) { const int idx = tid + 512 * i, rr = idx / 48, ch = idx % 48; float a[8], b[8]; unpack8(cvr[i], a); unpack8(cgr[i], b);
#pragma unroll
            for (int q = 0; q < 8; ++q) a[q] *= fast_sigmoid(b[q]);
            u32x4 o; o.x = cvt_pk_bf16(a[0], a[1]); o.y = cvt_pk_bf16(a[2], a[3]); o.z = cvt_pk_bf16(a[4], a[5]); o.w = cvt_pk_bf16(a[6], a[7]);
            if (idx < 94 * 48) *(LAS u32x4*)(lds + HC + rr * 768 + ch * 16) = o; } }
      __syncthreads();
      asm volatile("" : "+v"(tid)); lane = tid & 63;
      const int fr = lane & 15, fq = lane >> 4; const bf16* pw = (const bf16*)(ws + WS_PWT) + (size_t)layer * DCV * DCV;
      bf16x8 Bp[4][3];
      { const float* dww = in[8] + (size_t)layer * 31 * DCV; const float* dwb = in[9] + layer * DCV; const float* lg = in[10] + layer * DCV; const float* lb = in[11] + layer * DCV;
        f32x2 g2[3], bt2[3];
#pragma unroll
        for (int q = 0; q < 3; ++q) { g2[q] = *(const f32x2*)(lg + 128 * q + 2 * lane); bt2[q] = *(const f32x2*)(lb + 128 * q + 2 * lane); }
        float dd[8][6];
#pragma unroll
        for (int q = 0; q < 3; ++q) { const int c = 128 * q + 2 * lane; f32x2 wj[31];
#pragma unroll
            for (int j = 0; j < 31; ++j) wj[j] = *(const f32x2*)(dww + j * DCV + c);
            const f32x2 b2 = *(const f32x2*)(dwb + c); float a0[8], a1[8];
#pragma unroll
            for (int r = 0; r < 8; ++r) { a0[r] = b2[0]; a1[r] = b2[1]; }
#pragma unroll
            for (int s = 0; s < 38; ++s) { const unsigned hv = *(const LAS unsigned*)(lds + HC + (8 * w + s) * 768 + c * 2); const float h0 = bf_lo(hv), h1 = bf_hi(hv);
#pragma unroll
                for (int r = 0; r < 8; ++r) { const int j = s - r; if (j >= 0 && j <= 30) { a0[r] += h0 * wj[j][0]; a1[r] += h1 * wj[j][1]; } } }
#pragma unroll
            for (int r = 0; r < 8; ++r) { dd[r][2 * q] = a0[r]; dd[r][2 * q + 1] = a1[r]; asm volatile("" : "+v"(dd[r][2 * q]), "+v"(dd[r][2 * q + 1])); }
            asm volatile("" ::: "memory"); }
#pragma unroll
        for (int ks = 0; ks < 4; ++ks)
#pragma unroll
            for (int nt = 0; nt < 3; ++nt) Bp[ks][nt] = *(const bf16x8*)(pw + (size_t)((3 * w + nt) * 16 + fr) * DCV + ks * 32 + 8 * fq);
#pragma unroll
        for (int r = 0; r < 8; ++r) { float s = 0.f;
#pragma unroll
            for (int q = 0; q < 6; ++q) s += dd[r][q];
            const float mu = wave_sum(s) * (1.0f / DCV); float v = 0.f;
#pragma unroll
            for (int q = 0; q < 6; ++q) { dd[r][q] -= mu; v += dd[r][q] * dd[r][q]; }
            const float rs = 1.0f / sqrtf(wave_sum(v) * (1.0f / DCV) + EPS);
#pragma unroll
            for (int q = 0; q < 3; ++q) { float y0 = dd[r][2 * q] * rs * g2[q][0] + bt2[q][0], y1 = dd[r][2 * q + 1] * rs * g2[q][1] + bt2[q][1]; y0 *= fast_sigmoid(y0); y1 *= fast_sigmoid(y1);
                *(LAS unsigned*)(lds + TT + (8 * w + r) * TST + (128 * q + 2 * lane) * 2) = cvt_pk_bf16(y0, y1); } } }
      __syncthreads();
      { f32x4 acc[4][3];
#pragma unroll
        for (int a = 0; a < 4; ++a)
#pragma unroll
            for (int b = 0; b < 3; ++b) acc[a][b] = (f32x4){0.f, 0.f, 0.f, 0.f};
        const f32x4* pb4 = (const f32x4*)(in[13] + layer * DCV); f32x4 pbv[3];
#pragma unroll
        for (int nt = 0; nt < 3; ++nt) pbv[nt] = pb4[(3 * w + nt) * 4 + fq];
#pragma unroll
        for (int kb = 0; kb < 3; ++kb) { bf16x8 Bn[4][3];
            if (kb < 2) {
#pragma unroll
                for (int ks = 0; ks < 4; ++ks)
#pragma unroll
                    for (int nt = 0; nt < 3; ++nt) Bn[ks][nt] = *(const bf16x8*)(pw + (size_t)((3 * w + nt) * 16 + fr) * DCV + (4 * (kb + 1) + ks) * 32 + 8 * fq); }
#pragma unroll
            for (int ks = 0; ks < 4; ++ks) { bf16x8 A[4];
#pragma unroll
                for (int mt = 0; mt < 4; ++mt) A[mt] = *(const LAS bf16x8*)(lds + TT + (mt * 16 + fr) * TST + ((4 * kb + ks) * 32 + 8 * fq) * 2);
#pragma unroll
                for (int mt = 0; mt < 4; ++mt)
#pragma unroll
                    for (int nt = 0; nt < 3; ++nt) acc[mt][nt] = __builtin_amdgcn_mfma_f32_16x16x32_bf16(Bp[ks][nt], A[mt], acc[mt][nt], 0, 0, 0); }
            if (kb < 2) {
#pragma unroll
                for (int ks = 0; ks < 4; ++ks)
#pragma unroll
                    for (int nt = 0; nt < 3; ++nt) Bp[ks][nt] = Bn[ks][nt]; } }
#pragma unroll
        for (int mt = 0; mt < 4; ++mt)
#pragma unroll
            for (int nt = 0; nt < 3; ++nt) { const int t = r0 + mt * 16 + fr, n4 = (3 * w + nt) * 16 + 4 * fq; const f32x4 v = acc[mt][nt] + pbv[nt];
                u32x2 o; o.x = cvt_pk_bf16(v[0], v[1]); o.y = cvt_pk_bf16(v[2], v[3]); *(u32x2*)(Y + (size_t)t * D + 640 + n4) = o; } }
      __syncthreads(); }
}

__device__ __forceinline__ void router_phase(Frame& F) {
    LAS unsigned char* lds = F.lds; int lane = F.lane; asm volatile("" : "+v"(lane)); const int w = F.wave; unsigned char* ws = F.ws;
    const InTab in = in_tab(F); const float* X = F.out; const float* g2 = in[15] + D; const float* R = in[19];
    unsigned* rowoff = (unsigned*)(ws + WS_ROWOFF); float* rs_e = (float*)(ws + WS_RS); float* gate_e = (float*)(ws + WS_GATE); int* sel = (int*)(ws + WS_SEL);
    unsigned* cnt = F.ctl + CW_CNT;
    LAS int* se0 = (LAS int*)lds; LAS int* se1 = se0 + 64; LAS float* sw0 = (LAS float*)(se1 + 64); LAS float* sw1 = sw0 + 64; LAS float* srs = sw1 + 64;
    float Rg[4][4][8];
#pragma unroll
    for (int j = 0; j < 4; ++j)
#pragma unroll
        for (int q = 0; q < 4; ++q) { const int k = 4 * lane + 256 * j + q; const float gk = g2[k]; const f32x4 a = *(const f32x4*)(R + k * 8), b = *(const f32x4*)(R + k * 8 + 4);
            Rg[j][q][0] = a[0] * gk; Rg[j][q][1] = a[1] * gk; Rg[j][q][2] = a[2] * gk; Rg[j][q][3] = a[3] * gk; Rg[j][q][4] = b[0] * gk; Rg[j][q][5] = b[1] * gk; Rg[j][q][6] = b[2] * gk; Rg[j][q][7] = b[3] * gk; }
    for (int b = F.vcu; b < M / 64; b += F.G) {
        for (int i = 0; i < 8; ++i) { const int tl = 8 * w + i, t = 64 * b + tl; const f32x4* xr = (const f32x4*)(X + (size_t)t * D) + lane; float ss = 0.f, le[8];
#pragma unroll
            for (int e = 0; e < 8; ++e) le[e] = 0.f;
#pragma unroll
            for (int j = 0; j < 4; ++j) { const f32x4 v = xr[64 * j];
#pragma unroll
                for (int q = 0; q < 4; ++q) { ss += v[q] * v[q];
#pragma unroll
                    for (int e = 0; e < 8; ++e) le[e] += v[q] * Rg[j][q][e]; } }
            ss = wave_sum(ss);
#pragma unroll
            for (int e = 0; e < 8; ++e) le[e] = wave_sum(le[e]);
            const float rs = 1.0f / sqrtf(ss * (1.0f / D) + EPS);
            int i0 = 0; float l0 = le[0];
#pragma unroll
            for (int e = 1; e < 8; ++e) if (le[e] > l0) { l0 = le[e]; i0 = e; }
            int i1 = -1; float l1 = -3.0e38f;
#pragma unroll
            for (int e = 0; e < 8; ++e) if (e != i0 && le[e] > l1) { l1 = le[e]; i1 = e; }
            const float ex = expf((l1 - l0) * rs), w0 = 1.0f / (1.0f + ex), w1 = ex / (1.0f + ex);
            if (lane == 0) { se0[tl] = i0; se1[tl] = i1; sw0[tl] = w0; sw1[tl] = w1; srs[tl] = rs; } }
        __syncthreads();
        if (w == 0) { const int e0 = se0[lane], e1 = se1[lane]; int r0 = 0, r1 = 0; const unsigned long long lt = (1ull << lane) - 1ull;
#pragma unroll
            for (int e = 0; e < 8; ++e) { const unsigned long long m0 = __ballot(e0 == e), m1 = __ballot(e1 == e); const int n0 = __popcll(m0), n = n0 + __popcll(m1); unsigned base = 0u;
                if (lane == 0 && n > 0) base = __hip_atomic_fetch_add(cnt + 64 * e, (unsigned)n, RLX_AGENT);
                base = __shfl(base, 0);
                if (e0 == e) r0 = (int)base + __popcll(m0 & lt);
                if (e1 == e) r1 = (int)base + n0 + __popcll(m1 & lt); }
            const int t = 64 * b + lane; const float rs = srs[lane];
            rowoff[e0 * ECAP + r0] = (unsigned)t * (unsigned)(D * 2); rs_e[e0 * ECAP + r0] = rs; gate_e[e0 * ECAP + r0] = sw0[lane];
            rowoff[e1 * ECAP + r1] = (unsigned)t * (unsigned)(D * 2); rs_e[e1 * ECAP + r1] = rs; gate_e[e1 * ECAP + r1] = sw1[lane];
            *(int4*)(sel + 4 * t) = make_int4(e0, r0, e1, r1); }
        __syncthreads();
    }
}
__device__ __forceinline__ void moe_panels(Frame& F, int (&pb)[9]) {
    unsigned* cnt = F.ctl + CW_CNT; pb[0] = 0;
#pragma unroll
    for (int e = 0; e < 8; ++e) { const unsigned c = (unsigned)__builtin_amdgcn_readfirstlane(__hip_atomic_load(cnt + 64 * e, RLX_AGENT)); pb[e + 1] = pb[e] + (int)((c + 255u) >> 8); }
}
__device__ __forceinline__ void final_phase(Frame& F) {
    int pb[9]; moe_panels(F, pb);
    const int total = pb[8] * 4, nfull = (total / F.G) * F.G, NPf = nfull / 4, sp = pg8::moe_split(total - nfull, F.G); const bf16* slabs = (const bf16*)(F.ws + WS_SLAB);
    int lane = F.lane; asm volatile("" : "+v"(lane));
    const int gw = F.vcu * 8 + F.wave, NGW = F.G * 8; unsigned char* ws = F.ws;
    const bf16* YP = (const bf16*)(ws + WS_YP); const int* sel = (const int*)(ws + WS_SEL); const float* fg = in_tab(F)[23]; float* X = F.out;
    f32x4 g4[4];
#pragma unroll
    for (int j = 0; j < 4; ++j) g4[j] = *((const f32x4*)fg + lane + 64 * j);
    for (int t = gw; t < M; t += NGW) { const int4 s = *(const int4*)(sel + 4 * t); int b0 = 0, b1 = 0;
#pragma unroll
        for (int e = 0; e < 8; ++e) { b0 = (s.x == e) ? pb[e] : b0; b1 = (s.z == e) ? pb[e] : b1; }
        const int pr[2] = {256 * b0 + s.y, 256 * b1 + s.w};
        const f32x4* xr = (const f32x4*)(X + (size_t)t * D) + lane;
        f32x4 v[4];
#pragma unroll
        for (int j = 0; j < 4; ++j) v[j] = xr[64 * j];
#pragma unroll
        for (int k = 0; k < 2; ++k) { const int pm = pr[k] >> 8, lr = pr[k] & 255;
            if (sp > 1 && pm >= NPf) {
#pragma unroll
                for (int j = 0; j < 4; ++j) { const bf16* sb = slabs + (size_t)(((pm - NPf) * 4 + j) * sp) * 65536 + lr * 256 + 4 * lane; u32x2 a[14];
#pragma unroll
                    for (int ks = 0; ks < 14; ++ks) { a[ks] = (u32x2){0u, 0u}; if (ks < sp) a[ks] = *(const u32x2*)(sb + (size_t)ks * 65536); }
#pragma unroll
                    for (int ks = 0; ks < 14; ++ks) { v[j][0] += bf_lo(a[ks].x); v[j][1] += bf_hi(a[ks].x); v[j][2] += bf_lo(a[ks].y); v[j][3] += bf_hi(a[ks].y); } }
            } else { const u32x2* y = (const u32x2*)(YP + (size_t)pr[k] * D) + lane;
#pragma unroll
                for (int j = 0; j < 4; ++j) { const u32x2 a = y[64 * j]; v[j][0] += bf_lo(a.x); v[j][1] += bf_hi(a.x); v[j][2] += bf_lo(a.y); v[j][3] += bf_hi(a.y); } } }
        float ss = 0.f;
#pragma unroll
        for (int j = 0; j < 4; ++j) ss += (v[j][0] * v[j][0] + v[j][1] * v[j][1]) + (v[j][2] * v[j][2] + v[j][3] * v[j][3]);
        ss = wave_sum(ss); const float rs = 1.0f / sqrtf(ss * (1.0f / D) + EPS);
        f32x4* o = (f32x4*)(X + (size_t)t * D) + lane;
#pragma unroll
        for (int j = 0; j < 4; ++j) o[64 * j] = v[j] * rs * g4[j]; }
}

struct Args { const float* in[24]; float* out; unsigned char* ws; int ph_lo, ph_hi, li, pad; };
__global__ void __launch_bounds__(512, 2) fwd(Args args) {
    extern __shared__ __attribute__((aligned(16))) unsigned char lds_raw[];
    Frame F;
    F.lds = (LAS unsigned char*)lds_raw; F.MISC = (volatile LAS unsigned*)(F.lds + MISC_OFF);
    F.tid = threadIdx.x; F.lane = F.tid & 63; F.wave = __builtin_amdgcn_readfirstlane(F.tid >> 6);
    F.G = gridDim.x; { const int bx = blockIdx.x; F.vcu = (F.G % 8 == 0) ? (bx % 8) * (F.G / 8) + bx / 8 : bx; }
    F.in.t = (const LAS unsigned long long*)(F.lds + INTAB_OFF); F.out = args.out; F.ws = args.ws; F.ctl = (unsigned*)(args.ws + WS_CTL);
    for (int u = F.tid; u < 64; u += 512) ((LAS unsigned*)(F.lds + MISC_OFF))[u] = 0u;
    if (F.tid < 24) ((LAS unsigned long long*)(F.lds + INTAB_OFF))[F.tid] = (unsigned long long)args.in[F.tid];
    __syncthreads();
    XcdBarrier bar = xcd_barrier_post(F.ctl + CW_BAR + args.li * XCD_BAR_WORDS, F.MISC + 8);
    const int lo = args.ph_lo, hi = args.ph_hi;
#ifndef PH_MASK
#define PH_MASK 0xFFFF
#endif
#define PH_ON(k) (((PH_MASK) >> (k)) & 1)
#ifndef REP_MASK
#define REP_MASK 0
#endif
#define REPS(k) (1 + (((REP_MASK) >> (k)) & 1))
#ifndef PRO_PROBE
#define PRO_PROBE 0
#endif
#ifndef CVT_BEFORE
#define CVT_BEFORE 0
#endif
#ifndef EPI_PROBE
#define EPI_PROBE 0
#endif
#define IN(k) (lo <= (k) && (k) < hi)
#define SEAM(k) do { if (IN(k) && IN((k) + 1)) xcd_barrier(bar); } while (0)
    unsigned char* ws = args.ws; LAS unsigned* gtab = (LAS unsigned*)(F.lds + GTAB_OFF);
    bf16* XB = (bf16*)(ws + WS_XB); float* ssq = (float*)(ws + WS_SSQ);
    if (F.G != 256) return;

    if (PH_ON(0) && IN(0)) for (int rep = 0; rep < REPS(0); ++rep) { p0_prologue(F, rep == 0 ? 0 : PRO_PROBE); __syncthreads(); }
    SEAM(0);
#pragma unroll 1
    for (int layer = 0; layer < 2; ++layer) {
        const int pbase = 1 + layer * 5;
        if (PH_ON(1) && IN(pbase)) for (int rep = 0; rep < REPS(1); ++rep) { pg8::Gemm g{XB, (const bf16*)(ws + WS_WIN) + (size_t)layer * DIN * D, D, 0}; pg8::StaticOrder S; S.init(M, DIN, F.G, (int)blockIdx.x);
            pg8::EpiP E{(bf16*)(ws + WS_P), DIN, ssq}; pg8::gemm_phase<pg8::EpiP, pg8::StaticOrder, true, true>(F.lds, gtab, g, S, E);
            if (rep == 0) tail_convert(F, layer ? H6_BEG : H1_BEG, H1_N, (int)blockIdx.x - 192, 64); }
        SEAM(pbase);
        if (PH_ON(2) && IN(pbase + 1)) for (int rep = 0; rep < REPS(2); ++rep) { for (int u = F.vcu; u < M / 64; u += F.G) mixer_unit(F, u, layer); }
        SEAM(pbase + 1);
        if (PH_ON(3) && IN(pbase + 2)) for (int rep = 0; rep < (layer == 0 ? REPS(3) : 1); ++rep) { pg8::Gemm g{(const bf16*)(ws + WS_Y), (const bf16*)(ws + WS_WOUT) + (size_t)layer * D * D, D, 0}; pg8::StaticOrder S; S.init(M, D, F.G, (int)blockIdx.x);
            pg8::EpiResid E{layer == 0 ? in_tab(F)[0] : (const float*)args.out, args.out, XB, ssq}; pg8::gemm_phase<pg8::EpiResid, pg8::StaticOrder, false, true>(F.lds, gtab, g, S, E); }
        SEAM(pbase + 2);
        if (layer == 0) {
            if (PH_ON(4) && IN(4)) for (int rep = 0; rep < REPS(4); ++rep) { pg8::Gemm g{XB, (const bf16*)(ws + WS_WGU), D, 0}; pg8::StaticOrder S; S.init(M, NGU, F.G, (int)blockIdx.x);
                pg8::EpiSwiglu<false> E{(bf16*)(ws + WS_ACT), DFF, ssq, nullptr, nullptr, 0}; pg8::gemm_phase<pg8::EpiSwiglu<false>, pg8::StaticOrder, true, true>(F.lds, gtab, g, S, E);
                if (rep == 0) tail_convert(F, H4_BEG, H4_N, (int)blockIdx.x - 128, 128); }
            SEAM(4);
            if (PH_ON(5) && IN(5)) { pg8::Gemm g{(const bf16*)(ws + WS_ACT), (const bf16*)(ws + WS_WD), DFF, 0}; pg8::StaticOrder S; S.init(M, D, F.G, (int)blockIdx.x);
                pg8::EpiResid E{(const float*)args.out, args.out, XB, ssq}; pg8::gemm_phase<pg8::EpiResid, pg8::StaticOrder, false, true>(F.lds, gtab, g, S, E); }
            SEAM(5);
        }
    }
    if (PH_ON(9) && IN(9)) router_phase(F);
    SEAM(9);
    if (PH_ON(10) && IN(10)) for (int rep = 0; rep < REPS(10); ++rep) { pg8::MoeOrderGather S; moe_panels(F, S.pb); S.nN = NGUE / 256; S.nwg = S.pb[8] * S.nN; S.G = F.G; S.c = (int)blockIdx.x; S.rowoff = (const unsigned*)(ws + WS_ROWOFF);
        pg8::Gemm g{XB, (const bf16*)(ws + WS_MOE_WGU), D, (size_t)NGUE * D};
        pg8::EpiSwiglu<true> E{(bf16*)(ws + WS_ACTM), DFE, nullptr, (const float*)(ws + WS_RS), (const float*)(ws + WS_GATE), rep == 0 ? 0 : EPI_PROBE};
        pg8::gemm_phase<pg8::EpiSwiglu<true>, pg8::MoeOrderGather, true, true>(F.lds, gtab, g, S, E);
        if (rep == 0) tail_convert(F, H10_BEG, H10_N, ((int)blockIdx.x - (S.nwg % F.G) + F.G) % F.G, H10_WG); }
    SEAM(10);
    if (PH_ON(11) && IN(11)) for (int rep = 0; rep < REPS(11); ++rep) { pg8::MoeOrderDown S; moe_panels(F, S.pb); S.init(F.G, (int)blockIdx.x);
        pg8::Gemm g{(const bf16*)(ws + WS_ACTM), (const bf16*)(ws + WS_MOE_WD), DFE, (size_t)D * DFE};
        pg8::EpiBf16 E{(bf16*)(ws + WS_YP), D, (bf16*)(ws + WS_SLAB)};
        pg8::gemm_phase<pg8::EpiBf16, pg8::MoeOrderDown, true, true>(F.lds, gtab, g, S, E); }
    SEAM(11);
    if (PH_ON(12) && IN(12)) final_phase(F);
#undef IN
#undef SEAM
}
#ifndef MK_PER_PHASE
#define MK_PER_PHASE 0
#endif
extern "C" void kernel_launch(void* const* d_in, const int* in_sizes, int n_in, void* d_out, int out_size, void* d_ws, size_t ws_size, hipStream_t stream) {
    static int grid = 0;
    if (grid == 0) {
        if (n_in != 24 || out_size != M * D || ws_size < WS_END) { fprintf(stderr, "kernel_launch: unexpected shapes (n_in %d out %d ws %zu)\n", n_in, out_size, ws_size); grid = -1; return; }
        int dev = 0, cus = 0;
        if (hipGetDevice(&dev) != hipSuccess || hipDeviceGetAttribute(&cus, hipDeviceAttributeMultiprocessorCount, dev) != hipSuccess) { grid = -1; return; }
        if (hipFuncSetAttribute((const void*)fwd, hipFuncAttributeMaxDynamicSharedMemorySize, LDS_BYTES) != hipSuccess) { fprintf(stderr, "kernel_launch: hipFuncSetAttribute failed\n"); grid = -1; return; }
        int per_cu = 0;
        if (hipOccupancyMaxActiveBlocksPerMultiprocessor(&per_cu, (const void*)fwd, 512, LDS_BYTES) != hipSuccess || per_cu < 1) fprintf(stderr, "kernel_launch: occupancy query says %d\n", per_cu);
        (void)hipGetLastError();
        grid = cus;
        if (grid != 256) { fprintf(stderr, "kernel_launch: built for 256 CUs, found %d\n", grid); grid = -1; return; }
    }
    if (grid < 0) return;
    (void)hipMemsetAsync((char*)d_ws + WS_CTL, 0, CTL_ZERO_BYTES, stream);
    Args a{};
    for (int i = 0; i < 24; ++i) a.in[i] = (const float*)d_in[i];
    a.out = (float*)d_out; a.ws = (unsigned char*)d_ws; a.pad = 0;
#if MK_PER_PHASE
    for (int p = 0; p < NPHASE; ++p) { a.ph_lo = p; a.ph_hi = p + 1; a.li = p; hipLaunchKernelGGL(fwd, dim3(grid), dim3(512), LDS_BYTES, stream, a); }
#else
    a.ph_lo = 0; a.ph_hi = NPHASE; a.li = 0; hipLaunchKernelGGL(fwd, dim3(grid), dim3(512), LDS_BYTES, stream, a);
#endif
}
```

```cpp
#define MK_PER_PHASE 0
#include <hip/hip_runtime.h>
#include <cstdio>
#include <cstdint>
constexpr int M = 16384, D = 1024, SEQ = 8192, DIN = 1792, DFF = 2816, DFE = 3584, NE = 8;
constexpr int DPOOL = 256, DGM = 384, DCV = 384;
constexpr int NGU = 2 * DFF, NGUE = 2 * DFE;
constexpr int ECAP = 16384;
constexpr int PMAX = 2 * M + NE * 256;
constexpr float EPS = 1e-6f;

#define LAS __attribute__((address_space(3)))
#define GAS __attribute__((address_space(1)))
typedef unsigned short bf16;
typedef short bf16x8 __attribute__((ext_vector_type(8)));
typedef short s16x4 __attribute__((ext_vector_type(4)));
typedef float f32x4 __attribute__((ext_vector_type(4)));
typedef float f32x2 __attribute__((ext_vector_type(2)));
typedef unsigned u32x4 __attribute__((ext_vector_type(4)));
typedef unsigned u32x2 __attribute__((ext_vector_type(2)));

__device__ __forceinline__ unsigned cvt_pk_bf16(float lo, float hi) { unsigned r; asm volatile("v_cvt_pk_bf16_f32 %0, %1, %2" : "=v"(r) : "v"(lo), "v"(hi)); return r; }
__device__ __forceinline__ float bf_lo(unsigned w) { return __uint_as_float(w << 16); }
__device__ __forceinline__ float bf_hi(unsigned w) { return __uint_as_float(w & 0xffff0000u); }
__device__ __forceinline__ float fast_sigmoid(float x) { return __builtin_amdgcn_rcpf(1.0f + __builtin_amdgcn_exp2f(-1.4426950408889634f * x)); }
template <int CTRL> __device__ __forceinline__ float dpp_f(float v) { return __int_as_float(__builtin_amdgcn_update_dpp(0, __float_as_int(v), CTRL, 0xF, 0xF, true)); }
__device__ __forceinline__ float wave_sum(float v) {
    v += dpp_f<0xB1>(v); v += dpp_f<0x4E>(v); v += dpp_f<0x141>(v); v += dpp_f<0x140>(v);
    const int iv = __float_as_int(v);
    return (__int_as_float(__builtin_amdgcn_readlane(iv, 0)) + __int_as_float(__builtin_amdgcn_readlane(iv, 16))) + (__int_as_float(__builtin_amdgcn_readlane(iv, 32)) + __int_as_float(__builtin_amdgcn_readlane(iv, 48)));
}

namespace pg8 {
constexpr int BM = 256, BK = 64, HALF = 128, HTB = HALF * BK * 2, STAGE_BYTES = 8 * HTB, NXCD = 8, WGM = 8;
__host__ __device__ __forceinline__ int lds_byte(int r, int c) { const int st = (r >> 4) * 2 + (c >> 5), rr = r & 15, cc = c & 31, ob = rr * 64 + cc * 2; return st * 1024 + (ob ^ (((ob >> 9) & 1) << 5)); }
__host__ __device__ __forceinline__ void stage_rc(int b, int& R, int& C) { const int st = b / 1024, sb = b % 1024, swz = sb ^ (((sb >> 9) & 1) << 5); R = (st >> 1) * 16 + swz / 64; C = (st & 1) * 32 + (swz % 64) / 2; }
__host__ __device__ __forceinline__ int perm32(int rho) { const int n = rho >> 4, i = rho & 15; return 8 * (i >> 2) + 4 * n + (i & 3); }

struct Unit { int pm, pn, e, tab, k0b, nt, slab; };
struct Gemm { const bf16* A; const bf16* Bt; int K; size_t bstride_e; };

__device__ __forceinline__ void order_map(int wgid, int nM, int nN, int& pm, int& pn) {
    const int nwg = nM * nN; { const int q = nwg / NXCD, r = nwg % NXCD, xcd = wgid % NXCD, off = wgid / NXCD; wgid = (xcd < r ? xcd * (q + 1) : r * (q + 1) + (xcd - r) * q) + off; }
    const int nig = WGM * nN, gid = wgid / nig, fm = gid * WGM, gsz = (nM - fm) < WGM ? (nM - fm) : WGM;
    pm = fm + ((wgid % nig) % gsz); pn = (wgid % nig) / gsz;
}
struct StaticOrder {
    static constexpr bool GATHER = false;
    int nM, nN, nwg, G, c;
    __device__ void init(int Mrows, int N, int G_, int c_) { nM = Mrows / BM; nN = N / BM; nwg = nM * nN; G = G_; c = c_; }
    __device__ __forceinline__ bool next(int i, Unit& u) const { const long L = (long)i * G + c; if (L >= nwg) return false; order_map((int)L, nM, nN, u.pm, u.pn); u.e = 0; u.tab = 0; u.k0b = 0; u.nt = 0; u.slab = -1; return true; }
    __device__ __forceinline__ const unsigned* a_table(const Unit&) const { return nullptr; }
};
struct MoeOrder {
    int pb[9]; int nN, nwg, G, c; const unsigned* rowoff;
    __device__ __forceinline__ bool next(int i, Unit& u) const {
        const long L = (long)i * G + c; if (L >= nwg) return false; order_map((int)L, pb[8], nN, u.pm, u.pn); u.k0b = 0; u.nt = 0; u.slab = -1;
        int e = 0;
#pragma unroll
        for (int k = 1; k < 8; ++k) e += (u.pm >= pb[k]) ? 1 : 0;
        int pbe = pb[0];
#pragma unroll
        for (int k = 1; k < 8; ++k) pbe = (e == k) ? pb[k] : pbe;
        u.e = e; u.tab = e * ECAP + 256 * (u.pm - pbe); return true;
    }
    __device__ __forceinline__ const unsigned* a_table(const Unit& u) const { return rowoff + u.tab; }
};
struct MoeOrderGather : MoeOrder { static constexpr bool GATHER = true; };
__host__ __device__ __forceinline__ int moe_split(int r, int G) { return r == 0 ? 1 : (r * 14 <= G ? 14 : (r * 7 <= G ? 7 : (r * 4 <= G ? 4 : (r * 2 <= G ? 2 : 1)))); }
struct MoeOrderDown {
    static constexpr bool GATHER = false;
    int pb[9]; int G, c, NPf, nfull, r, s;
    __device__ __forceinline__ void init(int G_, int c_) { G = G_; c = c_; const int total = pb[8] * 4; nfull = (total / G) * G; NPf = nfull / 4; r = total - nfull; s = moe_split(r, G); }
    __device__ __forceinline__ bool next(int i, Unit& u) const {
        const int L = i * G + c; u.tab = 0;
        if (L < nfull) { order_map(L, NPf, 4, u.pm, u.pn); u.k0b = 0; u.nt = 0; u.slab = -1; }
        else { const int j = L - nfull; if (j >= r * s) return false; const int lu = j / s, ks = j - lu * s; u.pm = NPf + (lu >> 2); u.pn = lu & 3; u.nt = (DFE / BK) / s; u.k0b = ks * u.nt * BK * 2; u.slab = s > 1 ? j : -1; }
        int e = 0;
#pragma unroll
        for (int k = 1; k < 8; ++k) e += (u.pm >= pb[k]) ? 1 : 0;
        u.e = e; return true;
    }
    __device__ __forceinline__ const unsigned* a_table(const Unit&) const { return nullptr; }
};

__device__ __forceinline__ float rstd_of(const float* ssq, int row) { const float s = (ssq[row] + ssq[M + row]) + (ssq[2 * M + row] + ssq[3 * M + row]); return 1.0f / sqrtf(s * (1.0f / D) + EPS); }

struct EpiP {
    static constexpr bool PERM = true, AFTER_DRAIN = false;
    bf16* O; int ldc; const float* ssq;
    __device__ __forceinline__ void operator()(const f32x4 (&acc)[2][2][4][2], const Unit& u, int wr, int wc, int fr, int fq) const {
        const int row0 = u.pm * BM + wr * 64 + fr, col0 = u.pn * BM + wc * 32 + 8 * fq;
#pragma unroll
        for (int ai = 0; ai < 2; ++ai)
#pragma unroll
            for (int m = 0; m < 4; ++m) { const int row = row0 + ai * HALF + m * 16; const float rs = rstd_of(ssq, row); bf16* rowp = O + (size_t)row * ldc + col0;
#pragma unroll
                for (int bj = 0; bj < 2; ++bj) { const f32x4 v0 = acc[ai][bj][m][0] * rs, v1 = acc[ai][bj][m][1] * rs;
                    u32x4 w; w.x = cvt_pk_bf16(v0[0], v0[1]); w.y = cvt_pk_bf16(v0[2], v0[3]); w.z = cvt_pk_bf16(v1[0], v1[1]); w.w = cvt_pk_bf16(v1[2], v1[3]);
                    *(u32x4*)(rowp + bj * HALF) = w; } }
    }
};
template <bool MOE> struct EpiSwiglu {
    static constexpr bool PERM = true, AFTER_DRAIN = false;
    bf16* O; int ldc; const float* ssq; const float* rs_e; const float* gate_e; int mode;
    __device__ __forceinline__ void operator()(const f32x4 (&acc)[2][2][4][2], const Unit& u, int wr, int wc, int fr, int fq) const {
        if (mode == 2) { asm volatile("" :: "v"(acc[0][0][0][0][0]), "v"(acc[1][1][3][1][3])); return; }
        const int lr0 = wr * 64 + fr, col0 = u.pn * HALF + wc * 32 + 8 * fq;
#pragma unroll
        for (int ai = 0; ai < 2; ++ai)
#pragma unroll
            for (int m = 0; m < 4; ++m) { const int lr = lr0 + ai * HALF + m * 16, row = u.pm * BM + lr; float rs, gw;
                if (MOE) { rs = rs_e[u.tab + lr]; gw = gate_e[u.tab + lr]; } else { rs = rstd_of(ssq, row); gw = 1.0f; }
                float o[8]; const float c1 = rs * -1.4426950408889634f, c2 = rs * rs * gw;
#pragma unroll
                for (int n = 0; n < 2; ++n) { const f32x4 ga = acc[ai][0][m][n], gu = ga * acc[ai][1][m][n] * c2, ex = ga * c1;
#pragma unroll
                    for (int q = 0; q < 4; ++q) o[n * 4 + q] = gu[q] * __builtin_amdgcn_rcpf(1.0f + __builtin_amdgcn_exp2f(ex[q])); }
                u32x4 w; w.x = cvt_pk_bf16(o[0], o[1]); w.y = cvt_pk_bf16(o[2], o[3]); w.z = cvt_pk_bf16(o[4], o[5]); w.w = cvt_pk_bf16(o[6], o[7]);
                if (mode == 1) { asm volatile("" :: "v"(w.x), "v"(w.y), "v"(w.z), "v"(w.w)); } else *(u32x4*)(O + (size_t)row * ldc + col0) = w; }
    }
};
struct EpiBf16 {
    static constexpr bool PERM = true, AFTER_DRAIN = false;
    bf16* O; int ldc; bf16* slabs;
    __device__ __forceinline__ void operator()(const f32x4 (&acc)[2][2][4][2], const Unit& u, int wr, int wc, int fr, int fq) const {
        const bool sl = u.slab >= 0; bf16* base = sl ? slabs + (size_t)u.slab * (BM * BM) : O; const int ld = sl ? BM : ldc;
        const int row0 = (sl ? 0 : u.pm * BM) + wr * 64 + fr, col0 = (sl ? 0 : u.pn * BM) + wc * 32 + 8 * fq;
#pragma unroll
        for (int ai = 0; ai < 2; ++ai)
#pragma unroll
            for (int m = 0; m < 4; ++m) { bf16* rowp = base + (size_t)(row0 + ai * HALF + m * 16) * ld + col0;
#pragma unroll
                for (int bj = 0; bj < 2; ++bj) { const f32x4 v0 = acc[ai][bj][m][0], v1 = acc[ai][bj][m][1];
                    u32x4 w; w.x = cvt_pk_bf16(v0[0], v0[1]); w.y = cvt_pk_bf16(v0[2], v0[3]); w.z = cvt_pk_bf16(v1[0], v1[1]); w.w = cvt_pk_bf16(v1[2], v1[3]);
                    *(u32x4*)(rowp + bj * HALF) = w; } }
    }
};
struct EpiResid {
    static constexpr bool PERM = false, AFTER_DRAIN = true;
    const float* xold32; float* X32; bf16* XB; float* ssq;
    __device__ __forceinline__ void fused(f32x4 (&acc)[2][2][4][2], const Unit& u, int wr, int wc, int fr, int fq, LAS unsigned char* lds, int wid, int lane) const {
        LAS float* Pt = (LAS float*)lds;
        const int col0 = u.pn * BM + wc * 32 + 4 * fq;
#pragma unroll
        for (int ai = 0; ai < 2; ++ai)
#pragma unroll
            for (int m = 0; m < 4; ++m) { const int r = ai * HALF + wr * 64 + m * 16 + fr; const size_t off = (size_t)(u.pm * BM + r) * D + col0; float s = 0.f;
#pragma unroll
                for (int bj = 0; bj < 2; ++bj)
#pragma unroll
                    for (int n = 0; n < 2; ++n) { f32x4 bs;
                        if (xold32) bs = *(const f32x4*)(xold32 + off + bj * HALF + n * 16);
                        else { const u32x2 b2 = *(const u32x2*)(XB + off + bj * HALF + n * 16); bs = (f32x4){bf_lo(b2.x), bf_hi(b2.x), bf_lo(b2.y), bf_hi(b2.y)}; }
                        const f32x4 o = bs + acc[ai][bj][m][n];
                        if (X32) *(f32x4*)(X32 + off + bj * HALF + n * 16) = o;
                        u32x2 w; w.x = cvt_pk_bf16(o[0], o[1]); w.y = cvt_pk_bf16(o[2], o[3]); *(u32x2*)(XB + off + bj * HALF + n * 16) = w;
                        s += (o[0] * o[0] + o[1] * o[1]) + (o[2] * o[2] + o[3] * o[3]); }
                s += __shfl_xor(s, 16); s += __shfl_xor(s, 32);
                if (fq == 0) Pt[r * 4 + wc] = s; }
        __syncthreads();
        const int t = wid * 64 + lane;
        if (t < 256) { const float s = (Pt[t * 4 + 0] + Pt[t * 4 + 1]) + (Pt[t * 4 + 2] + Pt[t * 4 + 3]); ssq[(size_t)u.pn * M + u.pm * BM + t] = s; }
        __syncthreads();
    }
};

template <class Epi, class Sched, bool ALIGN_EPI = false, bool SP2 = true>
__device__ __forceinline__ void gemm_phase(LAS unsigned char* lds, LAS unsigned* gtab, const Gemm g, const Sched& S, const Epi& E) {
    constexpr bool GATHER = Sched::GATHER;
    static_assert(!GATHER || SP2, "gather needs the SP2 loop (lgkmcnt(0) waits only)");
    int tid_ = threadIdx.x; asm volatile("" : "+v"(tid_));
    const int tid = tid_, wid = __builtin_amdgcn_readfirstlane(tid >> 6), lane = tid & 63, wr = wid >> 2, wc = wid & 3, fr = lane & 15, fq = lane >> 4;
    const int K = g.K; int nt = K / BK;
    unsigned voffA[2], voffB[2];
#pragma unroll
    for (int i = 0; i < 2; ++i) { int R, C; stage_rc(tid * 16 + i * 8192, R, C); const int Rb = Epi::PERM ? ((R & ~31) + perm32(R & 31)) : R;
        voffA[i] = (unsigned)(R * K + C) * 2u; voffB[i] = (unsigned)(Rb * K + C) * 2u; }
    const size_t kstep = (size_t)(BK * 2);
    const size_t hstep = (size_t)HALF * K * 2;
    const size_t tstep = 2 * hstep;
    const unsigned ldsw = (unsigned)wid * 1024u;
    const int aoff = lds_byte(wr * 64 + fr, fq * 8), boff = lds_byte(wc * 32 + fr, fq * 8);
#define PG8_SA(b, h) (((b) * 2 + (h)) * HTB)
#define PG8_SB(b, h) ((4 + (b) * 2 + (h)) * HTB)
#define PG8_STAGE(bufoff, gbase, voff) do { _Pragma("unroll") for (int _i = 0; _i < 2; ++_i) \
        __builtin_amdgcn_global_load_lds((const unsigned*)((const char*)(gbase) + (voff)[_i]), (LAS unsigned*)(lds + (bufoff) + ldsw + _i * 8192), 16, 0, 0); } while (0)
#define PG8_STAGE_A(bufoff, ubase, kb, h) do { if constexpr (GATHER) { PG8_STAGE(bufoff, (const char*)g.A + (kb), ga[h]); } else { PG8_STAGE(bufoff, (ubase) + (size_t)(h) * hstep + (kb), voffA); } } while (0)
#define PG8_LDA(dst, b, h) do { _Pragma("unroll") for (int m = 0; m < 4; ++m) _Pragma("unroll") for (int k = 0; k < 2; ++k) dst[m][k] = *(const LAS bf16x8*)(lds + PG8_SA(b, h) + aoff + m * 2048 + k * 1024); } while (0)
#define PG8_LDB(dst, b, h) do { _Pragma("unroll") for (int n = 0; n < 2; ++n) _Pragma("unroll") for (int k = 0; k < 2; ++k) dst[n][k] = *(const LAS bf16x8*)(lds + PG8_SB(b, h) + boff + n * 2048 + k * 1024); } while (0)
#define PG8_MMA(ai, bj, At, Bt) do { __builtin_amdgcn_s_setprio(1); _Pragma("unroll") for (int m = 0; m < 4; ++m) _Pragma("unroll") for (int n = 0; n < 2; ++n) _Pragma("unroll") for (int k = 0; k < 2; ++k) \
        acc[ai][bj][m][n] = __builtin_amdgcn_mfma_f32_16x16x32_bf16(Bt[n][k], At[m][k], acc[ai][bj][m][n], 0, 0, 0); __builtin_amdgcn_s_setprio(0); } while (0)
#define PG8_WAIT_V(n) asm volatile("s_waitcnt vmcnt(" #n ")" ::: "memory")
#define PG8_WAIT_L(n) asm volatile("s_waitcnt lgkmcnt(" #n ")" ::: "memory")
#define PG8_BAR __builtin_amdgcn_s_barrier()
#define PG8_SCHED __builtin_amdgcn_sched_barrier(0)
#define PG8_GTAB_DMA(un, slot) do { if (wid < 4) __builtin_amdgcn_global_load_lds(S.a_table(un) + wid * 64 + lane, (LAS unsigned*)(gtab + (slot) * 256 + wid * 64), 4, 0, 0); } while (0)
#define PG8_GTAB_READ(dst, slot) do { _Pragma("unroll") for (int _i = 0; _i < 2; ++_i) { int _R, _C; stage_rc(tid * 16 + _i * 8192, _R, _C); _Pragma("unroll") for (int _h = 0; _h < 2; ++_h) dst[_h][_i] = gtab[(slot) * 256 + _h * HALF + _R] + (unsigned)_C * 2u; } } while (0)
    Unit cur, nxt; int ui = 0;
    if (!S.next(0, cur)) return;
    f32x4 acc[2][2][4][2];
#pragma unroll
    for (int a = 0; a < 2; ++a)
#pragma unroll
        for (int b = 0; b < 2; ++b)
#pragma unroll
            for (int m = 0; m < 4; ++m)
#pragma unroll
                for (int n = 0; n < 2; ++n) acc[a][b][m][n] = (f32x4){0.f, 0.f, 0.f, 0.f};
    bf16x8 At[4][2], B0[2][2], B1[2][2];
    unsigned ga[2][2];
    if (cur.nt) nt = cur.nt;
    const char* cA = (const char*)g.A + (GATHER ? (size_t)0 : (size_t)cur.pm * tstep + cur.k0b); const char* cB = (const char*)g.Bt + ((size_t)cur.e * g.bstride_e) * 2 + (size_t)cur.pn * tstep + cur.k0b;
    if constexpr (GATHER) { PG8_GTAB_DMA(cur, 0); PG8_WAIT_V(0); PG8_BAR; PG8_GTAB_READ(ga, 0); }
    if constexpr (SP2) {
        PG8_STAGE(PG8_SB(0, 0), cB, voffB); PG8_STAGE(PG8_SB(0, 1), cB + hstep, voffB); PG8_STAGE_A(PG8_SA(0, 0), cA, 0, 0); PG8_STAGE_A(PG8_SA(0, 1), cA, 0, 1);
        if (wr == 1) PG8_BAR;
        PG8_WAIT_V(2); PG8_BAR;
        PG8_STAGE(PG8_SB(1, 0), cB + kstep, voffB); PG8_STAGE_A(PG8_SA(1, 0), cA, kstep, 0); PG8_STAGE(PG8_SB(1, 1), cB + hstep + kstep, voffB);
        PG8_WAIT_V(6); PG8_BAR;
    } else {
        PG8_STAGE(PG8_SB(0, 0), cB, voffB); PG8_STAGE_A(PG8_SA(0, 0), cA, 0, 0); PG8_STAGE(PG8_SB(0, 1), cB + hstep, voffB); PG8_STAGE_A(PG8_SA(0, 1), cA, 0, 1);
        if (wr == 1) PG8_BAR;
        PG8_WAIT_V(4); PG8_BAR;
        PG8_STAGE(PG8_SB(1, 0), cB + kstep, voffB); PG8_STAGE_A(PG8_SA(1, 0), cA, kstep, 0); PG8_STAGE(PG8_SB(1, 1), cB + hstep + kstep, voffB);
        PG8_WAIT_V(6); PG8_BAR;
    }
    for (;;) {
        const bool has_next = S.next(ui + 1, nxt);
        const char* nA = (has_next && !GATHER) ? (const char*)g.A + (size_t)nxt.pm * tstep + nxt.k0b : cA;
        const char* nB = has_next ? (const char*)g.Bt + ((size_t)nxt.e * g.bstride_e) * 2 + (size_t)nxt.pn * tstep + nxt.k0b : cB;
        for (int t = 0; t < nt; t += 2) {
            const bool last = (t == nt - 2);
            const size_t k1 = (size_t)(t + 1) * kstep;
            const char* a2 = last ? nA : cA; const size_t k2 = last ? 0 : (size_t)(t + 2) * kstep;
            const char* b2 = last ? nB : cB + (size_t)(t + 2) * kstep; const char* b3 = b2 + kstep;
            const size_t k3 = k2 + kstep;
            if constexpr (GATHER) {
                if (t == nt - 4 && has_next) PG8_GTAB_DMA(nxt, (ui + 1) & 1);
            }
            if constexpr (SP2) {
            PG8_LDB(B0, 0, 0); PG8_LDB(B1, 0, 1); PG8_SCHED; PG8_LDA(At, 0, 0); PG8_STAGE_A(PG8_SA(1, 1), cA, k1, 1);
            if constexpr (GATHER) { if (last && has_next) PG8_GTAB_READ(ga, (ui + 1) & 1); }
            PG8_WAIT_V(8); PG8_WAIT_L(0); PG8_BAR; PG8_MMA(0, 0, At, B0); PG8_MMA(0, 1, At, B1); PG8_BAR; PG8_SCHED;
            PG8_LDA(At, 0, 1); PG8_STAGE(PG8_SB(0, 0), b2, voffB); PG8_STAGE(PG8_SB(0, 1), b2 + hstep, voffB); PG8_STAGE_A(PG8_SA(0, 0), a2, k2, 0);
            PG8_WAIT_V(8); PG8_WAIT_L(0); PG8_BAR; PG8_MMA(1, 0, At, B0); PG8_MMA(1, 1, At, B1); PG8_BAR; PG8_SCHED;
            PG8_LDB(B0, 1, 0); PG8_LDB(B1, 1, 1); PG8_SCHED; PG8_LDA(At, 1, 0); PG8_STAGE_A(PG8_SA(0, 1), a2, k2, 1);
            PG8_WAIT_V(8); PG8_WAIT_L(0); PG8_BAR; PG8_MMA(0, 0, At, B0); PG8_MMA(0, 1, At, B1); PG8_BAR; PG8_SCHED;
            PG8_LDA(At, 1, 1); PG8_STAGE(PG8_SB(1, 0), b3, voffB); PG8_STAGE(PG8_SB(1, 1), b3 + hstep, voffB); PG8_STAGE_A(PG8_SA(1, 0), a2, k3, 0);
            PG8_WAIT_V(8); PG8_WAIT_L(0); PG8_BAR; PG8_MMA(1, 0, At, B0); PG8_MMA(1, 1, At, B1); PG8_BAR; PG8_SCHED;
            } else {
            PG8_LDB(B0, 0, 0); PG8_SCHED; PG8_LDA(At, 0, 0); PG8_STAGE_A(PG8_SA(1, 1), cA, k1, 1);
            PG8_WAIT_L(8); PG8_BAR; PG8_WAIT_L(0); PG8_MMA(0, 0, At, B0); PG8_BAR; PG8_SCHED;
            PG8_LDB(B1, 0, 1); PG8_STAGE(PG8_SB(0, 0), b2, voffB);
            PG8_BAR; PG8_WAIT_L(0); PG8_MMA(0, 1, At, B1); PG8_BAR;
            PG8_LDA(At, 0, 1); PG8_STAGE_A(PG8_SA(0, 0), a2, k2, 0);
            PG8_BAR; PG8_WAIT_L(0); PG8_MMA(1, 0, At, B0); PG8_BAR; PG8_SCHED;
            PG8_STAGE(PG8_SB(0, 1), b2 + hstep, voffB);
            PG8_WAIT_V(6); PG8_BAR; PG8_MMA(1, 1, At, B1); PG8_BAR;
            PG8_LDB(B0, 1, 0); PG8_SCHED; PG8_LDA(At, 1, 0); PG8_STAGE_A(PG8_SA(0, 1), a2, k2, 1);
            PG8_WAIT_L(8); PG8_BAR; PG8_WAIT_L(0); PG8_MMA(0, 0, At, B0); PG8_BAR; PG8_SCHED;
            PG8_LDB(B1, 1, 1); PG8_STAGE(PG8_SB(1, 0), b3, voffB);
            PG8_BAR; PG8_WAIT_L(0); PG8_MMA(0, 1, At, B1); PG8_BAR;
            PG8_LDA(At, 1, 1); PG8_STAGE_A(PG8_SA(1, 0), a2, k3, 0);
            PG8_BAR; PG8_WAIT_L(0); PG8_MMA(1, 0, At, B0); PG8_BAR; PG8_SCHED;
            PG8_STAGE(PG8_SB(1, 1), b3 + hstep, voffB);
            PG8_WAIT_V(6); PG8_BAR; PG8_MMA(1, 1, At, B1); PG8_BAR;
            }
        }
        if constexpr (ALIGN_EPI) { if (wr == 0) PG8_BAR; }
        if constexpr (!Epi::AFTER_DRAIN) { E(acc, cur, wr, wc, fr, fq); }
        if (!has_next) break;
#pragma unroll
        for (int a = 0; a < 2; ++a)
#pragma unroll
            for (int b = 0; b < 2; ++b)
#pragma unroll
                for (int m = 0; m < 4; ++m)
#pragma unroll
                    for (int n = 0; n < 2; ++n) acc[a][b][m][n] = (f32x4){0.f, 0.f, 0.f, 0.f};
        cur = nxt; cA = nA; cB = nB; ++ui; nt = cur.nt ? cur.nt : K / BK;
        if constexpr (ALIGN_EPI) { if (wr == 1) PG8_BAR; }
    }
    PG8_WAIT_V(0);
    if constexpr (!ALIGN_EPI) { if (wr == 0) PG8_BAR; }
    PG8_BAR;
    if constexpr (Epi::AFTER_DRAIN) { E.fused(acc, cur, wr, wc, fr, fq, lds, wid, lane); }
#undef PG8_SA
#undef PG8_SB
#undef PG8_STAGE
#undef PG8_STAGE_A
#undef PG8_LDA
#undef PG8_LDB
#undef PG8_MMA
#undef PG8_WAIT_V
#undef PG8_WAIT_L
#undef PG8_BAR
#undef PG8_SCHED
#undef PG8_GTAB_DMA
#undef PG8_GTAB_READ
}
}
constexpr size_t MiB = 1u << 20;
constexpr size_t WS_CTL = 0, CTL_ZERO_BYTES = 1 * MiB;
constexpr size_t WS_ROWOFF = 1 * MiB;
constexpr size_t WS_RS = WS_ROWOFF + 512 * 1024;
constexpr size_t WS_GATE = WS_RS + 512 * 1024;
constexpr size_t WS_SEL = WS_GATE + 512 * 1024;
constexpr size_t WS_SSQ = WS_SEL + 256 * 1024;
constexpr size_t WS_SMALLW = 4 * MiB;
constexpr size_t WS_PWT = WS_SMALLW;
constexpr size_t WS_POOLWT = WS_PWT + 2 * 384 * 384 * 2;
constexpr size_t WS_GMWS = WS_POOLWT + 2 * 4 * 64 * 64 * 2;
constexpr size_t WS_XB = 6 * MiB;
constexpr size_t WS_SLAB = 6 * MiB;
constexpr size_t WS_MOE_WD = 38 * MiB;
constexpr size_t WS_MOE_WGU = 94 * MiB;
constexpr size_t WS_YP = 94 * MiB;
constexpr size_t WS_ACTM = 206 * MiB;
constexpr size_t WS_P = 206 * MiB;
constexpr size_t WS_Y = 262 * MiB;
constexpr size_t WS_ACT = 206 * MiB;
constexpr size_t WS_WIN = 294 * MiB;
constexpr size_t WS_WOUT = 301 * MiB;
constexpr size_t WS_WGU = 305 * MiB;
constexpr size_t WS_WD = 316 * MiB;
constexpr size_t WS_END = 444 * MiB;
static_assert(WS_SSQ + 4 * (size_t)M * 4 <= WS_SMALLW && WS_GMWS + 2 * 4 * 128 * 128 * 2 <= WS_XB && WS_XB + (size_t)M * D * 2 <= WS_MOE_WD, "ws map 1");
static_assert(WS_MOE_WD + (size_t)NE * D * DFE * 2 <= WS_MOE_WGU && WS_MOE_WGU + (size_t)NE * NGUE * D * 2 <= WS_ACTM && WS_YP + (size_t)PMAX * D * 2 <= WS_ACTM, "ws map 2");
static_assert(WS_ACTM + (size_t)PMAX * DFE * 2 <= WS_END && WS_P + (size_t)M * DIN * 2 <= WS_Y && WS_Y + (size_t)M * D * 2 <= WS_WIN && WS_ACT + (size_t)M * DFF * 2 <= WS_WIN, "ws map 3");
static_assert(WS_WIN + 2 * (size_t)DIN * D * 2 <= WS_WOUT && WS_WOUT + 2 * (size_t)D * D * 2 <= WS_WGU && WS_WGU + (size_t)NGU * D * 2 <= WS_WD && WS_WD + (size_t)D * DFF * 2 <= WS_END, "ws map 4");
constexpr int CW_BAR = 4096;
constexpr int CW_CNT = 131072;
constexpr int CW_CVT = 140000;
constexpr int NPHASE = 13;
constexpr int RING_BYTES = 131072;
constexpr int GTAB_OFF = RING_BYTES;
constexpr int MISC_OFF = GTAB_OFF + 2048;
constexpr int INTAB_OFF = MISC_OFF + 256;
constexpr int LDS_BYTES = 147456;
static_assert(MISC_OFF + 256 <= LDS_BYTES, "LDS map");

typedef GAS unsigned gu32;
#define RLX_AGENT __ATOMIC_RELAXED, __HIP_MEMORY_SCOPE_AGENT
#define LDS_WAIT() asm volatile("s_waitcnt lgkmcnt(0)" ::: "memory")
#define VM_WAIT() asm volatile("s_waitcnt vmcnt(0)" ::: "memory")

#define XB_TMO      128
#define XB_XCNT(j)  (256  + 64 * (j))
#define XB_XSUB(j)  (1280 + 64 * (j))
#define XB_XGEN(j)  (2304 + 64 * (j))
#define XB_TOP      3328
#define XB_TOPGEN   3392
#define XCD_BAR_WORDS 3456
#define XB_SPIN_CAP (1u << 18)
__device__ __forceinline__ unsigned xb_ld(unsigned* p)              { return __hip_atomic_load(p, __ATOMIC_RELAXED, __HIP_MEMORY_SCOPE_AGENT); }
__device__ __forceinline__ unsigned xb_add(unsigned* p, unsigned v) { return __hip_atomic_fetch_add(p, v, __ATOMIC_RELAXED, __HIP_MEMORY_SCOPE_AGENT); }
__device__ __forceinline__ unsigned xb_xcc_id() { return (unsigned)__builtin_amdgcn_s_getreg((3 << 11) | 20) & 0xFu; }
#define XB_SPIN(cond, bar) do { unsigned _sp = 0; while (cond) { __builtin_amdgcn_s_sleep(1); \
    if ((++_sp & 255u) == 0u) { if (xb_ld(&(bar)[XB_TMO])) break; if (_sp > XB_SPIN_CAP) { atomicAdd(&(bar)[XB_TMO], 1u); break; } } } } while (0)
struct XcdBarrier { unsigned* bar; unsigned x; volatile LAS unsigned* st; };
__device__ __forceinline__ XcdBarrier xcd_barrier_post(unsigned* bar, volatile LAS unsigned* st) {
    XcdBarrier b; b.bar = bar; b.x = xb_xcc_id(); b.st = st;
    if (threadIdx.x == 0) (void)xb_add(&bar[XB_XCNT(b.x)], 1u);
    return b;
}
__device__ __forceinline__ void xcd_barrier_complete(unsigned* bar, unsigned x, unsigned& nloc, unsigned& nx) {
    const unsigned G = gridDim.x * gridDim.y * gridDim.z;
    unsigned sum, cnt, mine, sp = 0u;
    for (;;) {
        sum = 0u; cnt = 0u; mine = 0u;
#pragma unroll
        for (unsigned j = 0; j < 16; ++j) { const unsigned c = xb_ld(&bar[XB_XCNT(j)]); sum += c; cnt += (c > 0u) ? 1u : 0u; mine = (j == x) ? c : mine; }
        if (sum == G) break;
        __builtin_amdgcn_s_sleep(1);
        if ((++sp & 255u) == 0u) { if (xb_ld(&bar[XB_TMO])) break; if (sp > XB_SPIN_CAP) { atomicAdd(&bar[XB_TMO], 1u); break; } }
    }
    nloc = mine > 0u ? mine : 1u; nx = cnt > 0u ? cnt : 1u;
}
__device__ __forceinline__ void xcd_barrier(const XcdBarrier& b) {
    asm volatile("s_waitcnt vmcnt(0)" ::: "memory");
    __syncthreads();
    if (threadIdx.x == 0) {
        unsigned* bar = b.bar;
        __builtin_amdgcn_s_waitcnt(0);
        unsigned nloc = b.st[0], nx = b.st[1];
        if (nloc == 0u) { xcd_barrier_complete(bar, b.x, nloc, nx); b.st[0] = nloc; b.st[1] = nx; }
        const unsigned old = xb_add(&bar[XB_XSUB(b.x)], 1u);
        const unsigned gen = old / nloc;
        if (old + 1u == (gen + 1u) * nloc) {
            __builtin_amdgcn_fence(__ATOMIC_RELEASE, "agent");
            asm volatile("s_waitcnt vmcnt(0)" ::: "memory");
            const unsigned og = xb_add(&bar[XB_TOP], 1u);
            const unsigned tg = og / nx;
            if (og + 1u == (tg + 1u) * nx) xb_add(&bar[XB_TOPGEN], 1u);
            else XB_SPIN(xb_ld(&bar[XB_TOPGEN]) == tg, bar);
            __builtin_amdgcn_fence(__ATOMIC_ACQUIRE, "agent");
            xb_add(&bar[XB_XGEN(b.x)], 1u);
            asm volatile("s_waitcnt vmcnt(0)" ::: "memory");
        } else {
            XB_SPIN(xb_ld(&bar[XB_XGEN(b.x)]) == gen, bar);
            __builtin_amdgcn_fence(__ATOMIC_ACQUIRE, "agent");
            asm volatile("s_waitcnt vmcnt(0)" ::: "memory");
        }
    }
    __syncthreads();
}

struct InTab { const LAS unsigned long long* t;
    __device__ __forceinline__ const float* operator[](int k) const { const unsigned long long v = t[k]; const unsigned lo = __builtin_amdgcn_readfirstlane((unsigned)v), hi = __builtin_amdgcn_readfirstlane((unsigned)(v >> 32));
        return (const float*)(((unsigned long long)hi << 32) | lo); } };
struct Frame {
    LAS unsigned char* lds; volatile LAS unsigned* MISC; unsigned* ctl;
    int tid, lane, wave, vcu, G;
    InTab in; float* out; unsigned char* ws;
};

__device__ __forceinline__ InTab in_tab(Frame& F) { return F.in; }
struct TrJob { const float* src; bf16* dst; const float* gk; int K, N; };
__device__ __forceinline__ TrJob tr_mat(const float* W, int K, int N, bf16* WT, int mode, const float* gk, int r) {
    const int nblk = N / 32, kb = r / nblk, nb = r % nblk, n0 = 32 * nb, k0 = 64 * kb;
    const int drow = mode == 0 ? n0 : ((n0 >> 7) * 256 + (n0 & 127) + (mode == 2 ? 128 : 0));
    TrJob j; j.src = W + (size_t)k0 * N + n0; j.dst = WT + (size_t)drow * K + k0; j.gk = gk ? gk + k0 : nullptr; j.K = K; j.N = N; return j;
}
constexpr int TR_I_IN = (D / 64) * (DIN / 32), TR_I_OUT = (D / 64) * (D / 32), TR_I_G = (D / 64) * (DFF / 32), TR_I_D = (DFF / 64) * (D / 32), TR_I_MG = (D / 64) * (DFE / 32), TR_I_MD = (DFE / 64) * (D / 32), TR_I_PW = (DCV / 64) * (DCV / 32), TR_I_PL = 2;
constexpr int TR_A_END = TR_I_IN + TR_I_OUT + 2 * TR_I_G + TR_I_D + 2 * TR_I_PW + 8 * TR_I_PL;
constexpr int TR_B_END = TR_A_END + TR_I_IN + TR_I_OUT;
constexpr int TR_C_END = TR_B_END + 2 * NE * TR_I_MG;
constexpr int TR_D_END = TR_C_END + NE * TR_I_MD;
__device__ __forceinline__ TrJob tr_decode(const InTab in, unsigned char* ws, int r) {
    if (r < TR_I_IN) return tr_mat(in[2], D, DIN, (bf16*)(ws + WS_WIN), 0, in[1], r); r -= TR_I_IN;
    if (r < TR_I_OUT) return tr_mat(in[14], D, D, (bf16*)(ws + WS_WOUT), 0, nullptr, r); r -= TR_I_OUT;
    if (r < TR_I_G) return tr_mat(in[16], D, DFF, (bf16*)(ws + WS_WGU), 1, in[15], r); r -= TR_I_G;
    if (r < TR_I_G) return tr_mat(in[17], D, DFF, (bf16*)(ws + WS_WGU), 2, in[15], r); r -= TR_I_G;
    if (r < TR_I_D) return tr_mat(in[18], DFF, D, (bf16*)(ws + WS_WD), 0, nullptr, r); r -= TR_I_D;
    if (r < 2 * TR_I_PW) { const int l = r / TR_I_PW; return tr_mat(in[12] + (size_t)l * DCV * DCV, DCV, DCV, (bf16*)(ws + WS_PWT) + (size_t)l * DCV * DCV, 0, nullptr, r % TR_I_PW); } r -= 2 * TR_I_PW;
    if (r < 8 * TR_I_PL) { const int gi = r / TR_I_PL; return tr_mat(in[3] + (size_t)gi * 64 * 64, 64, 64, (bf16*)(ws + WS_POOLWT) + (size_t)gi * 64 * 64, 0, nullptr, r % TR_I_PL); } r -= 8 * TR_I_PL;
    if (r < TR_I_IN) return tr_mat(in[2] + (size_t)D * DIN, D, DIN, (bf16*)(ws + WS_WIN) + (size_t)DIN * D, 0, in[1] + D, r); r -= TR_I_IN;
    if (r < TR_I_OUT) return tr_mat(in[14] + (size_t)D * D, D, D, (bf16*)(ws + WS_WOUT) + (size_t)D * D, 0, nullptr, r); r -= TR_I_OUT;
    if (r < 2 * NE * TR_I_MG) { const int e = r / (2 * TR_I_MG), q = r % (2 * TR_I_MG), up = q / TR_I_MG;
        return tr_mat(in[20 + up] + (size_t)e * D * DFE, D, DFE, (bf16*)(ws + WS_MOE_WGU) + (size_t)e * NGUE * D, 1 + up, in[15] + D, q % TR_I_MG); } r -= 2 * NE * TR_I_MG;
    { const int e = r / TR_I_MD; return tr_mat(in[22] + (size_t)e * DFE * D, DFE, D, (bf16*)(ws + WS_MOE_WD) + (size_t)e * D * DFE, 0, nullptr, r % TR_I_MD); }
}
__device__ __forceinline__ void tr_load(const TrJob& j, f32x4 (&v)[8], int lane, int probe) {
    const int n4 = (lane & 7) * 4, kr = lane >> 3;
    if (probe == 2) {
#pragma unroll
        for (int i = 0; i < 8; ++i) v[i] = (f32x4){1.f, 2.f, 3.f, 4.f};
        return; }
#pragma unroll
    for (int i = 0; i < 8; ++i) { v[i] = *(const f32x4*)(j.src + (size_t)(kr + 8 * i) * j.N + n4); if (j.gk) v[i] = v[i] * j.gk[kr + 8 * i]; }
}
__device__ __forceinline__ void tr_store(const TrJob& j, const f32x4 (&v)[8], LAS float* scr, int lane, int probe) {
    const int n4 = (lane & 7) * 4, kr = lane >> 3;
#pragma unroll
    for (int i = 0; i < 8; ++i) { LAS float* d = scr + (kr + 8 * i) * 33 + n4; d[0] = v[i][0]; d[1] = v[i][1]; d[2] = v[i][2]; d[3] = v[i][3]; }
    LDS_WAIT(); asm volatile("" ::: "memory");
    const int c = lane & 7;
#pragma unroll
    for (int jj = 0; jj < 4; ++jj) { const int n = (lane >> 3) + 8 * jj; const LAS float* s = scr + (8 * c) * 33 + n;
        u32x4 o; o.x = cvt_pk_bf16(s[0 * 33], s[1 * 33]); o.y = cvt_pk_bf16(s[2 * 33], s[3 * 33]); o.z = cvt_pk_bf16(s[4 * 33], s[5 * 33]); o.w = cvt_pk_bf16(s[6 * 33], s[7 * 33]);
        if (probe == 1 || probe == 2) { asm volatile("" :: "v"(o.x), "v"(o.y), "v"(o.z), "v"(o.w)); } else *(GAS u32x4*)(j.dst + (size_t)n * j.K + 8 * c) = o; }
    LDS_WAIT(); asm volatile("" ::: "memory");
}
__device__ __forceinline__ void tr_run(Frame& F, int first, int count, int widx, int nw, int probe) {
    LAS float* scr = (LAS float*)(F.lds + F.wave * 16384); int lane = F.lane; asm volatile("" : "+v"(lane)); const InTab in = in_tab(F); unsigned char* ws = F.ws;
    const int end = first + count; f32x4 v[4][8]; TrJob j[4];
#pragma unroll
    for (int k = 0; k < 4; ++k) { const int it = first + widx + k * nw; if (it < end) { j[k] = tr_decode(in, ws, it); tr_load(j[k], v[k], lane, probe); } }
    for (int it = first + widx; it < end; it += 4 * nw) {
#pragma unroll
        for (int k = 0; k < 4; ++k) { const int ik = it + k * nw, nx = ik + 4 * nw;
            if (ik < end) tr_store(j[k], v[k], scr, lane, probe);
            if (nx < end) { j[k] = tr_decode(in, ws, nx); tr_load(j[k], v[k], lane, probe); } } }
}
constexpr int HID_PER_WAVE = 2, H1_N = 64 * 8 * HID_PER_WAVE, H4_N = 128 * 8 * HID_PER_WAVE, H6_N = 64 * 8 * HID_PER_WAVE, H10_WG = 96, H10_N = H10_WG * 8 * HID_PER_WAVE;
constexpr int H1_BEG = TR_A_END, H4_BEG = H1_BEG + H1_N, H6_BEG = H4_BEG + H4_N, H6_END = H6_BEG + H6_N, H10_BEG = TR_D_END - H10_N;
static_assert(H6_END <= TR_C_END && H10_BEG >= TR_C_END, "hidden conversion shares");
__device__ __forceinline__ void tail_convert(Frame& F, int first, int count, int rank, int nwg_idle) {
    if (rank >= 0 && rank < nwg_idle) tr_run(F, first, count, rank * 8 + F.wave, nwg_idle * 8, 0);
}

__device__ __forceinline__ void p0_prologue(Frame& F, int probe) {
    LAS float* scr = (LAS float*)(F.lds + F.wave * 16384);
    int lane = F.lane; asm volatile("" : "+v"(lane));
    const int gw = F.vcu * 8 + F.wave, NGW = F.G * 8;
    const InTab in = in_tab(F); unsigned char* ws = F.ws;
    tr_run(F, 0, TR_A_END, gw, NGW, probe);
    tr_run(F, H6_END, H10_BEG - H6_END, gw, NGW, probe);
    { const float* src = in[6]; bf16* dst = (bf16*)(ws + WS_GMWS);
      for (int i = gw * 64 + lane; i < 2 * 4 * 128 * 128 / 8; i += NGW * 64) { const f32x4 a = *(const f32x4*)(src + (size_t)i * 8), b = *(const f32x4*)(src + (size_t)i * 8 + 4);
          u32x4 o; o.x = cvt_pk_bf16(a[0], a[1]); o.y = cvt_pk_bf16(a[2], a[3]); o.z = cvt_pk_bf16(b[0], b[1]); o.w = cvt_pk_bf16(b[2], b[3]); *(u32x4*)(dst + (size_t)i * 8) = o; } }
    { u32x4* t = (u32x4*)(ws + WS_ROWOFF); for (int i = gw * 64 + lane; i < NE * ECAP / 4; i += NGW * 64) t[i] = (u32x4){0u, 0u, 0u, 0u}; }
    { const float* x = in[0]; bf16* XB = (bf16*)(ws + WS_XB); float* ssq = (float*)(ws + WS_SSQ);
      for (int m = gw; m < M; m += NGW) { const f32x4* xr = (const f32x4*)(x + (size_t)m * D) + lane; f32x4 v[4]; float s = 0.f;
#pragma unroll
          for (int j = 0; j < 4; ++j) { v[j] = xr[64 * j]; s += (v[j][0] * v[j][0] + v[j][1] * v[j][1]) + (v[j][2] * v[j][2] + v[j][3] * v[j][3]); }
          s = wave_sum(s);
          u32x2* o = (u32x2*)(XB + (size_t)m * D) + lane;
#pragma unroll
          for (int j = 0; j < 4; ++j) { u32x2 w; w.x = cvt_pk_bf16(v[j][0], v[j][1]); w.y = cvt_pk_bf16(v[j][2], v[j][3]); o[64 * j] = w; }
          if (lane < 4) ssq[(size_t)lane * M + m] = lane == 0 ? s : 0.f; } }
}

__device__ __forceinline__ void unpack8(const u32x4 w, float (&f)[8]) { f[0] = bf_lo(w.x); f[1] = bf_hi(w.x); f[2] = bf_lo(w.y); f[3] = bf_hi(w.y); f[4] = bf_lo(w.z); f[5] = bf_hi(w.z); f[6] = bf_lo(w.w); f[7] = bf_hi(w.w); }
__device__ __forceinline__ void mixer_unit(Frame& F, int u, int layer) {
    LAS unsigned char* lds = F.lds; int tid = F.tid; asm volatile("" : "+v"(tid)); int lane = tid & 63; const int w = F.wave;
    const InTab in = in_tab(F); unsigned char* ws = F.ws;
    const bf16* P = (const bf16*)(ws + WS_P); bf16* Y = (bf16*)(ws + WS_Y);
    const int r0 = 64 * u, s0 = r0 & (SEQ - 1), half = u & 1, blk0 = r0 & ~127;
#ifndef MIX_MASK
#define MIX_MASK 7
#endif
#ifndef MIX_REP
#define MIX_REP 0
#endif
    for (int mrep = 0; mrep < 1 + (MIX_REP & 1); ++mrep) if (MIX_MASK & 1) { constexpr int AIN = 0, YPL = 40448, YST = 528;
      const int g = w >> 1, th = w & 1, fr = lane & 15, fq = lane >> 4;
      u32x4 st[5];
#pragma unroll
      for (int i = 0; i < 5; ++i) { const int idx = tid + 512 * i, rr = idx >> 5, ch = idx & 31, pos = s0 - 15 + rr; st[i] = (u32x4){0u, 0u, 0u, 0u};
          if (idx < 79 * 32 && pos >= 0) st[i] = *(const u32x4*)(P + (size_t)(r0 - 15 + rr) * DIN + ch * 8); }
      const bf16* wt = (const bf16*)(ws + WS_POOLWT) + (size_t)(layer * 4 + g) * 64 * 64; const float* sc = in[4] + layer * DPOOL + g * 64;
      bf16x8 Bf[2][4]; f32x4 sc4[4];
#pragma unroll
      for (int ks = 0; ks < 2; ++ks)
#pragma unroll
          for (int nt = 0; nt < 4; ++nt) Bf[ks][nt] = *(const bf16x8*)(wt + (nt * 16 + fr) * 64 + ks * 32 + 8 * fq);
#pragma unroll
      for (int nt = 0; nt < 4; ++nt) sc4[nt] = *(const f32x4*)(sc + nt * 16 + 4 * fq);
#pragma unroll
      for (int i = 0; i < 5; ++i) { const int idx = tid + 512 * i; if (idx < 79 * 32) *(LAS u32x4*)(lds + AIN + (idx >> 5) * 512 + (idx & 31) * 16) = st[i]; }
      __syncthreads();
      { const int p = tid & 127, rq = tid >> 7, gp = p >> 5, win = 2 << gp; float S0 = 0.f, S1 = 0.f;
        for (int j = 1; j < win; ++j) { const unsigned a = *(const LAS unsigned*)(lds + AIN + (16 * rq + 15 - j) * 512 + p * 4); S0 += bf_lo(a); S1 += bf_hi(a); }
#pragma unroll 4
        for (int t = 0; t < 16; ++t) { const int lt = 16 * rq + t, rr = lt + 15; const unsigned a = *(const LAS unsigned*)(lds + AIN + rr * 512 + p * 4); const float a0 = bf_lo(a), a1 = bf_hi(a);
            S0 += a0; S1 += a1; const int pos1 = s0 + lt + 1; const float rn = __builtin_amdgcn_rcpf((float)(pos1 < win ? pos1 : win));
            *(LAS unsigned*)(lds + YPL + lt * YST + p * 4) = cvt_pk_bf16(S0 * rn - a0, S1 * rn - a1);
            const unsigned o = *(const LAS unsigned*)(lds + AIN + (rr - win + 1) * 512 + p * 4); S0 -= bf_lo(o); S1 -= bf_hi(o); } }
      __syncthreads();
      { f32x4 acc[2][4];
#pragma unroll
        for (int a = 0; a < 2; ++a)
#pragma unroll
            for (int b = 0; b < 4; ++b) acc[a][b] = (f32x4){0.f, 0.f, 0.f, 0.f};
#pragma unroll
        for (int ks = 0; ks < 2; ++ks) { bf16x8 A[2];
#pragma unroll
            for (int mt = 0; mt < 2; ++mt) A[mt] = *(const LAS bf16x8*)(lds + YPL + ((2 * th + mt) * 16 + fr) * YST + (g * 64 + ks * 32 + 8 * fq) * 2);
#pragma unroll
            for (int mt = 0; mt < 2; ++mt)
#pragma unroll
                for (int nt = 0; nt < 4; ++nt) acc[mt][nt] = __builtin_amdgcn_mfma_f32_16x16x32_bf16(Bf[ks][nt], A[mt], acc[mt][nt], 0, 0, 0); }
#pragma unroll
        for (int mt = 0; mt < 2; ++mt)
#pragma unroll
            for (int nt = 0; nt < 4; ++nt) { const int t = r0 + (2 * th + mt) * 16 + fr, d = nt * 16 + 4 * fq; const f32x4 v = acc[mt][nt] * sc4[nt];
                u32x2 o; o.x = cvt_pk_bf16(v[0], v[1]); o.y = cvt_pk_bf16(v[2], v[3]); *(u32x2*)(Y + (size_t)t * D + g * 64 + d) = o; } }
      __syncthreads(); }
    asm volatile("" : "+v"(tid)); lane = tid & 63;
    for (int mrep = 0; mrep < 1 + ((MIX_REP >> 1) & 1); ++mrep) if (MIX_MASK & 2) { constexpr int VN = 0, VST = 800; const int nj = half ? 128 : 64, nks = nj >> 5;
      const int h = w & 3, ih = w >> 2, fr = lane & 15, fq = lane >> 4, q4 = (lane & 15) >> 2, p4 = lane & 3;
      const bf16* wsb = (const bf16*)(ws + WS_GMWS) + (size_t)(layer * 4 + h) * 128 * 128;
      const float* gg = in[5] + layer * DGM; const float* bb = in[7] + (size_t)(layer * 4 + h) * 128;
      u32x4 raw[16]; const int nr = nj >> 3;
#pragma unroll
      for (int i = 0; i < 16; ++i) { raw[i] = (u32x4){0u, 0u, 0u, 0u}; if (i < nr && lane < 48) raw[i] = *(const u32x4*)(P + (size_t)(blk0 + i * 8 + w) * DIN + 640 + lane * 8); }
      bf16x8 Aw[4][2]; f32x4 g4[6]; float bi[2];
#pragma unroll
      for (int ks = 0; ks < 4; ++ks)
#pragma unroll
          for (int mt = 0; mt < 2; ++mt) { Aw[ks][mt] = (bf16x8){0, 0, 0, 0, 0, 0, 0, 0}; if (ks < nks) Aw[ks][mt] = *(const bf16x8*)(wsb + (size_t)(half * 64 + (2 * ih + mt) * 16 + fr) * 128 + ks * 32 + 8 * fq); }
#pragma unroll
      for (int ct = 0; ct < 6; ++ct) g4[ct] = *(const f32x4*)(gg + h * 96 + ct * 16 + 4 * fq);
#pragma unroll
      for (int mt = 0; mt < 2; ++mt) bi[mt] = bb[half * 64 + (2 * ih + mt) * 16 + fr];
#pragma unroll
      for (int i = 0; i < 16; ++i) { if (i < nr) { float f[8]; unpack8(raw[i], f); float s = 0.f;
#pragma unroll
              for (int q = 0; q < 8; ++q) s += f[q] * f[q];
              s = wave_sum(s); const float rs = 1.0f / sqrtf(s * (1.0f / DGM) + EPS);
              u32x4 o; o.x = cvt_pk_bf16(f[0] * rs, f[1] * rs); o.y = cvt_pk_bf16(f[2] * rs, f[3] * rs); o.z = cvt_pk_bf16(f[4] * rs, f[5] * rs); o.w = cvt_pk_bf16(f[6] * rs, f[7] * rs);
              if (lane < 48) *(LAS u32x4*)(lds + VN + (i * 8 + w) * VST + lane * 16) = o; } }
      u32x2 uu[2][6];
#pragma unroll
      for (int mt = 0; mt < 2; ++mt)
#pragma unroll
          for (int ct = 0; ct < 6; ++ct) uu[mt][ct] = *(const u32x2*)(P + (size_t)(r0 + (2 * ih + mt) * 16 + fr) * DIN + 256 + h * 96 + ct * 16 + 4 * fq);
      __syncthreads();
      { f32x4 acc[2][6];
#pragma unroll
        for (int a = 0; a < 2; ++a)
#pragma unroll
            for (int b = 0; b < 6; ++b) acc[a][b] = (f32x4){0.f, 0.f, 0.f, 0.f};
#pragma unroll
        for (int ks = 0; ks < 4; ++ks) { if (ks < nks) {
#pragma unroll
            for (int ct = 0; ct < 6; ++ct) { const unsigned ad = VN + (32 * ks + 8 * fq + q4) * VST + (h * 96 + ct * 16 + 4 * p4) * 2;
                const s16x4 t0 = __builtin_amdgcn_ds_read_tr16_b64_v4i16((LAS s16x4*)(lds + ad)), t1 = __builtin_amdgcn_ds_read_tr16_b64_v4i16((LAS s16x4*)(lds + ad + 4 * VST));
                bf16x8 B; B[0] = t0[0]; B[1] = t0[1]; B[2] = t0[2]; B[3] = t0[3]; B[4] = t1[0]; B[5] = t1[1]; B[6] = t1[2]; B[7] = t1[3];
#pragma unroll
                for (int mt = 0; mt < 2; ++mt) acc[mt][ct] = __builtin_amdgcn_mfma_f32_16x16x32_bf16(B, Aw[ks][mt], acc[mt][ct], 0, 0, 0); } } }
#pragma unroll
        for (int mt = 0; mt < 2; ++mt) { const int t = r0 + (2 * ih + mt) * 16 + fr;
#pragma unroll
            for (int ct = 0; ct < 6; ++ct) { const int c4 = h * 96 + ct * 16 + 4 * fq; const f32x4 z = acc[mt][ct] * g4[ct] + bi[mt]; const u32x2 uv = uu[mt][ct];
                u32x2 o; o.x = cvt_pk_bf16(bf_lo(uv.x) * z[0], bf_hi(uv.x) * z[1]); o.y = cvt_pk_bf16(bf_lo(uv.y) * z[2], bf_hi(uv.y) * z[3]); *(u32x2*)(Y + (size_t)t * D + 256 + c4) = o; } } }
      __syncthreads(); }
    asm volatile("" : "+v"(tid)); lane = tid & 63;
    for (int mrep = 0; mrep < 1 + ((MIX_REP >> 2) & 1); ++mrep) if (MIX_MASK & 4) { constexpr int HC = 0, TT = 72192, TST = 784;
#ifndef CONV_REP
#define CONV_REP 0
#endif
      for (int crep = 0; crep < 1 + (CONV_REP & 1); ++crep) { u32x4 cvr[9], cgr[9];
#pragma unroll
        for (int i = 0; i < 9; ++i) { const int idx = tid + 512 * i, rr = idx / 48, ch = idx % 48, pos = s0 - 30 + rr; cvr[i] = (u32x4){0u, 0u, 0u, 0u}; cgr[i] = (u32x4){0u, 0u, 0u, 0u};
            if (idx < 94 * 48 && pos >= 0) { const bf16* pr = P + (size_t)(r0 - 30 + rr) * DIN; cvr[i] = *(const u32x4*)(pr + 1024 + ch * 8); cgr[i] = *(const u32x4*)(pr + 1408 + ch * 8); } }
#pragma unroll
        for (int i = 0; i < 9; ++i) { const int idx = tid + 512 * i, rr = idx / 48, ch = idx % 48; float a[8], b[8]; unpack8(cvr[i], a); unpack8(cgr[i], b);
#pragma unroll
            for (int q = 0; q < 8; ++q) a[q] *= fast_sigmoid(b[q]);
            u32x4 o; o.x = cvt_pk_bf16(a[0], a[1]); o.y = cvt_pk_bf16(a[2], a[3]); o.z = cvt_pk_bf16(a[4], a[5]); o.w = cvt_pk_bf16(a[6], a[7]);
            if (idx < 94 * 48) *(LAS u32x4*)(lds + HC + rr * 768 + ch * 16) = o; } }
      __syncthreads();
      asm volatile("" : "+v"(tid)); lane = tid & 63;
      const int fr = lane & 15, fq = lane >> 4; const bf16* pw = (const bf16*)(ws + WS_PWT) + (size_t)layer * DCV * DCV;
      bf16x8 Bp[4][3];
      for (int crep = 0; crep < 1 + ((CONV_REP >> 1) & 1); ++crep) { const float* dww = in[8] + (size_t)layer * 31 * DCV; const float* dwb = in[9] + layer * DCV; const float* lg = in[10] + layer * DCV; const float* lb = in[11] + layer * DCV;
        f32x2 g2[3], bt2[3];
#pragma unroll
        for (int q = 0; q < 3; ++q) { g2[q] = *(const f32x2*)(lg + 128 * q + 2 * lane); bt2[q] = *(const f32x2*)(lb + 128 * q + 2 * lane); }
        float dd[8][6];
#pragma unroll
        for (int q = 0; q < 3; ++q) { const int c = 128 * q + 2 * lane; f32x2 wj[31];
#pragma unroll
            for (int j = 0; j < 31; ++j) wj[j] = *(const f32x2*)(dww + j * DCV + c);
            const f32x2 b2 = *(const f32x2*)(dwb + c); float a0[8], a1[8];
#pragma unroll
            for (int r = 0; r < 8; ++r) { a0[r] = b2[0]; a1[r] = b2[1]; }
#pragma unroll
            for (int s = 0; s < 38; ++s) { const unsigned hv = *(const LAS unsigned*)(lds + HC + (8 * w + s) * 768 + c * 2); const float h0 = bf_lo(hv), h1 = bf_hi(hv);
#pragma unroll
                for (int r = 0; r < 8; ++r) { const int j = s - r; if (j >= 0 && j <= 30) { a0[r] += h0 * wj[j][0]; a1[r] += h1 * wj[j][1]; } } }
#pragma unroll
            for (int r = 0; r < 8; ++r) { dd[r][2 * q] = a0[r]; dd[r][2 * q + 1] = a1[r]; asm volatile("" : "+v"(dd[r][2 * q]), "+v"(dd[r][2 * q + 1])); }
            asm volatile("" ::: "memory"); }
#pragma unroll
        for (int ks = 0; ks < 4; ++ks)
#pragma unroll
            for (int nt = 0; nt < 3; ++nt) Bp[ks][nt] = *(const bf16x8*)(pw + (size_t)((3 * w + nt) * 16 + fr) * DCV + ks * 32 + 8 * fq);
#pragma unroll
        for (int r = 0; r < 8; ++r) { float s = 0.f;
#pragma unroll
            for (int q = 0; q < 6; ++q) s += dd[r][q];
            const float mu = wave_sum(s) * (1.0f / DCV); float v = 0.f;
#pragma unroll
            for (int q = 0; q < 6; ++q) { dd[r][q] -= mu; v += dd[r][q] * dd[r][q]; }
            const float rs = 1.0f / sqrtf(wave_sum(v) * (1.0f / DCV) + EPS);
#pragma unroll
            for (int q = 0; q < 3; ++q) { float y0 = dd[r][2 * q] * rs * g2[q][0] + bt2[q][0], y1 = dd[r][2 * q + 1] * rs * g2[q][1] + bt2[q][1]; y0 *= fast_sigmoid(y0); y1 *= fast_sigmoid(y1);
                *(LAS unsigned*)(lds + TT + (8 * w + r) * TST + (128 * q + 2 * lane) * 2) = cvt_pk_bf16(y0, y1); } } }
      __syncthreads();
      for (int crep = 0; crep < 1 + ((CONV_REP >> 2) & 1); ++crep) { f32x4 acc[4][3];
#pragma unroll
        for (int a = 0; a < 4; ++a)
#pragma unroll
            for (int b = 0; b < 3; ++b) acc[a][b] = (f32x4){0.f, 0.f, 0.f, 0.f};
        const f32x4* pb4 = (const f32x4*)(in[13] + layer * DCV); f32x4 pbv[3];
#pragma unroll
        for (int nt = 0; nt < 3; ++nt) pbv[nt] = pb4[(3 * w + nt) * 4 + fq];
#pragma unroll
        for (int kb = 0; kb < 3; ++kb) { bf16x8 Bn[4][3];
            if (kb < 2) {
#pragma unroll
                for (int ks = 0; ks < 4; ++ks)
#pragma unroll
                    for (int nt = 0; nt < 3; ++nt) Bn[ks][nt] = *(const bf16x8*)(pw + (size_t)((3 * w + nt) * 16 + fr) * DCV + (4 * (kb + 1) + ks) * 32 + 8 * fq); }
#pragma unroll
            for (int ks = 0; ks < 4; ++ks) { bf16x8 A[4];
#pragma unroll
                for (int mt = 0; mt < 4; ++mt) A[mt] = *(const LAS bf16x8*)(lds + TT + (mt * 16 + fr) * TST + ((4 * kb + ks) * 32 + 8 * fq) * 2);
#pragma unroll
                for (int mt = 0; mt < 4; ++mt)
#pragma unroll
                    for (int nt = 0; nt < 3; ++nt) acc[mt][nt] = __builtin_amdgcn_mfma_f32_16x16x32_bf16(Bp[ks][nt], A[mt], acc[mt][nt], 0, 0, 0); }
            if (kb < 2) {
#pragma unroll
                for (int ks = 0; ks < 4; ++ks)
#pragma unroll
                    for (int nt = 0; nt < 3; ++nt) Bp[ks][nt] = Bn[ks][nt]; } }
#pragma unroll
        for (int mt = 0; mt < 4; ++mt)
#pragma unroll
            for (int nt = 0; nt < 3; ++nt) { const int t = r0 + mt * 16 + fr, n4 = (3 * w + nt) * 16 + 4 * fq; const f32x4 v = acc[mt][nt] + pbv[nt];
                u32x2 o; o.x = cvt_pk_bf16(v[0], v[1]); o.y = cvt_pk_bf16(v[2], v[3]); *(u32x2*)(Y + (size_t)t * D + 640 + n4) = o; } }
      __syncthreads(); }
}

__device__ __forceinline__ void router_phase(Frame& F) {
    LAS unsigned char* lds = F.lds; int lane = F.lane; asm volatile("" : "+v"(lane)); const int w = F.wave; unsigned char* ws = F.ws;
    const InTab in = in_tab(F); const float* X = F.out; const float* g2 = in[15] + D; const float* R = in[19];
    unsigned* rowoff = (unsigned*)(ws + WS_ROWOFF); float* rs_e = (float*)(ws + WS_RS); float* gate_e = (float*)(ws + WS_GATE); int* sel = (int*)(ws + WS_SEL);
    unsigned* cnt = F.ctl + CW_CNT;
    LAS int* se0 = (LAS int*)lds; LAS int* se1 = se0 + 64; LAS float* sw0 = (LAS float*)(se1 + 64); LAS float* sw1 = sw0 + 64; LAS float* srs = sw1 + 64;
    float Rg[4][4][8];
#pragma unroll
    for (int j = 0; j < 4; ++j)
#pragma unroll
        for (int q = 0; q < 4; ++q) { const int k = 4 * lane + 256 * j + q; const float gk = g2[k]; const f32x4 a = *(const f32x4*)(R + k * 8), b = *(const f32x4*)(R + k * 8 + 4);
            Rg[j][q][0] = a[0] * gk; Rg[j][q][1] = a[1] * gk; Rg[j][q][2] = a[2] * gk; Rg[j][q][3] = a[3] * gk; Rg[j][q][4] = b[0] * gk; Rg[j][q][5] = b[1] * gk; Rg[j][q][6] = b[2] * gk; Rg[j][q][7] = b[3] * gk; }
    for (int b = F.vcu; b < M / 64; b += F.G) {
        for (int i = 0; i < 8; ++i) { const int tl = 8 * w + i, t = 64 * b + tl; const f32x4* xr = (const f32x4*)(X + (size_t)t * D) + lane; float ss = 0.f, le[8];
#pragma unroll
            for (int e = 0; e < 8; ++e) le[e] = 0.f;
#pragma unroll
            for (int j = 0; j < 4; ++j) { const f32x4 v = xr[64 * j];
#pragma unroll
                for (int q = 0; q < 4; ++q) { ss += v[q] * v[q];
#pragma unroll
                    for (int e = 0; e < 8; ++e) le[e] += v[q] * Rg[j][q][e]; } }
            ss = wave_sum(ss);
#pragma unroll
            for (int e = 0; e < 8; ++e) le[e] = wave_sum(le[e]);
            const float rs = 1.0f / sqrtf(ss * (1.0f / D) + EPS);
            int i0 = 0; float l0 = le[0];
#pragma unroll
            for (int e = 1; e < 8; ++e) if (le[e] > l0) { l0 = le[e]; i0 = e; }
            int i1 = -1; float l1 = -3.0e38f;
#pragma unroll
            for (int e = 0; e < 8; ++e) if (e != i0 && le[e] > l1) { l1 = le[e]; i1 = e; }
            const float ex = expf((l1 - l0) * rs), w0 = 1.0f / (1.0f + ex), w1 = ex / (1.0f + ex);
            if (lane == 0) { se0[tl] = i0; se1[tl] = i1; sw0[tl] = w0; sw1[tl] = w1; srs[tl] = rs; } }
        __syncthreads();
        if (w == 0) { const int e0 = se0[lane], e1 = se1[lane]; int r0 = 0, r1 = 0; const unsigned long long lt = (1ull << lane) - 1ull;
#pragma unroll
            for (int e = 0; e < 8; ++e) { const unsigned long long m0 = __ballot(e0 == e), m1 = __ballot(e1 == e); const int n0 = __popcll(m0), n = n0 + __popcll(m1); unsigned base = 0u;
                if (lane == 0 && n > 0) base = __hip_atomic_fetch_add(cnt + 64 * e, (unsigned)n, RLX_AGENT);
                base = __shfl(base, 0);
                if (e0 == e) r0 = (int)base + __popcll(m0 & lt);
                if (e1 == e) r1 = (int)base + n0 + __popcll(m1 & lt); }
            const int t = 64 * b + lane; const float rs = srs[lane];
            rowoff[e0 * ECAP + r0] = (unsigned)t * (unsigned)(D * 2); rs_e[e0 * ECAP + r0] = rs; gate_e[e0 * ECAP + r0] = sw0[lane];
            rowoff[e1 * ECAP + r1] = (unsigned)t * (unsigned)(D * 2); rs_e[e1 * ECAP + r1] = rs; gate_e[e1 * ECAP + r1] = sw1[lane];
            *(int4*)(sel + 4 * t) = make_int4(e0, r0, e1, r1); }
        __syncthreads();
    }
}
__device__ __forceinline__ void moe_panels(Frame& F, int (&pb)[9]) {
    unsigned* cnt = F.ctl + CW_CNT; pb[0] = 0;
#pragma unroll
    for (int e = 0; e < 8; ++e) { const unsigned c = (unsigned)__builtin_amdgcn_readfirstlane(__hip_atomic_load(cnt + 64 * e, RLX_AGENT)); pb[e + 1] = pb[e] + (int)((c + 255u) >> 8); }
}
__device__ __forceinline__ void final_phase(Frame& F) {
    int pb[9]; moe_panels(F, pb);
    const int total = pb[8] * 4, nfull = (total / F.G) * F.G, NPf = nfull / 4, sp = pg8::moe_split(total - nfull, F.G); const bf16* slabs = (const bf16*)(F.ws + WS_SLAB);
    int lane = F.lane; asm volatile("" : "+v"(lane));
    const int gw = F.vcu * 8 + F.wave, NGW = F.G * 8; unsigned char* ws = F.ws;
    const bf16* YP = (const bf16*)(ws + WS_YP); const int* sel = (const int*)(ws + WS_SEL); const float* fg = in_tab(F)[23]; float* X = F.out;
    f32x4 g4[4];
#pragma unroll
    for (int j = 0; j < 4; ++j) g4[j] = *((const f32x4*)fg + lane + 64 * j);
    for (int t = gw; t < M; t += NGW) { const int4 s = *(const int4*)(sel + 4 * t); int b0 = 0, b1 = 0;
#pragma unroll
        for (int e = 0; e < 8; ++e) { b0 = (s.x == e) ? pb[e] : b0; b1 = (s.z == e) ? pb[e] : b1; }
        const int pr[2] = {256 * b0 + s.y, 256 * b1 + s.w};
        const f32x4* xr = (const f32x4*)(X + (size_t)t * D) + lane;
        f32x4 v[4];
#pragma unroll
        for (int j = 0; j < 4; ++j) v[j] = xr[64 * j];
#pragma unroll
        for (int k = 0; k < 2; ++k) { const int pm = pr[k] >> 8, lr = pr[k] & 255;
            if (sp > 1 && pm >= NPf) {
#pragma unroll
                for (int j = 0; j < 4; ++j) { const bf16* sb = slabs + (size_t)(((pm - NPf) * 4 + j) * sp) * 65536 + lr * 256 + 4 * lane; u32x2 a[14];
#pragma unroll
                    for (int ks = 0; ks < 14; ++ks) { a[ks] = (u32x2){0u, 0u}; if (ks < sp) a[ks] = *(const u32x2*)(sb + (size_t)ks * 65536); }
#pragma unroll
                    for (int ks = 0; ks < 14; ++ks) { v[j][0] += bf_lo(a[ks].x); v[j][1] += bf_hi(a[ks].x); v[j][2] += bf_lo(a[ks].y); v[j][3] += bf_hi(a[ks].y); } }
            } else { const u32x2* y = (const u32x2*)(YP + (size_t)pr[k] * D) + lane;
#pragma unroll
                for (int j = 0; j < 4; ++j) { const u32x2 a = y[64 * j]; v[j][0] += bf_lo(a.x); v[j][1] += bf_hi(a.x); v[j][2] += bf_lo(a.y); v[j][3] += bf_hi(a.y); } } }
        float ss = 0.f;
#pragma unroll
        for (int j = 0; j < 4; ++j) ss += (v[j][0] * v[j][0] + v[j][1] * v[j][1]) + (v[j][2] * v[j][2] + v[j][3] * v[j][3]);
        ss = wave_sum(ss); const float rs = 1.0f / sqrtf(ss * (1.0f / D) + EPS);
        f32x4* o = (f32x4*)(X + (size_t)t * D) + lane;
#pragma unroll
        for (int j = 0; j < 4; ++j) o[64 * j] = v[j] * rs * g4[j]; }
}

struct Args { const float* in[24]; float* out; unsigned char* ws; int ph_lo, ph_hi, li, pad; };
__global__ void __launch_bounds__(512, 2) fwd(Args args) {
    extern __shared__ __attribute__((aligned(16))) unsigned char lds_raw[];
    Frame F;
    F.lds = (LAS unsigned char*)lds_raw; F.MISC = (volatile LAS unsigned*)(F.lds + MISC_OFF);
    F.tid = threadIdx.x; F.lane = F.tid & 63; F.wave = __builtin_amdgcn_readfirstlane(F.tid >> 6);
    F.G = gridDim.x; { const int bx = blockIdx.x; F.vcu = (F.G % 8 == 0) ? (bx % 8) * (F.G / 8) + bx / 8 : bx; }
    F.in.t = (const LAS unsigned long long*)(F.lds + INTAB_OFF); F.out = args.out; F.ws = args.ws; F.ctl = (unsigned*)(args.ws + WS_CTL);
    for (int u = F.tid; u < 64; u += 512) ((LAS unsigned*)(F.lds + MISC_OFF))[u] = 0u;
    if (F.tid < 24) ((LAS unsigned long long*)(F.lds + INTAB_OFF))[F.tid] = (unsigned long long)args.in[F.tid];
    __syncthreads();
    XcdBarrier bar = xcd_barrier_post(F.ctl + CW_BAR + args.li * XCD_BAR_WORDS, F.MISC + 8);
    const int lo = args.ph_lo, hi = args.ph_hi;
#ifndef PH_MASK
#define PH_MASK 0xFFFF
#endif
#define PH_ON(k) (((PH_MASK) >> (k)) & 1)
#ifndef REP_MASK
#define REP_MASK 0
#endif
#define REPS(k) (1 + (((REP_MASK) >> (k)) & 1))
#ifndef PRO_PROBE
#define PRO_PROBE 0
#endif
#ifndef CVT_BEFORE
#define CVT_BEFORE 0
#endif
#ifndef EPI_PROBE
#define EPI_PROBE 0
#endif
#define IN(k) (lo <= (k) && (k) < hi)
#define SEAM(k) do { if (IN(k) && IN((k) + 1)) xcd_barrier(bar); } while (0)
    unsigned char* ws = args.ws; LAS unsigned* gtab = (LAS unsigned*)(F.lds + GTAB_OFF);
    bf16* XB = (bf16*)(ws + WS_XB); float* ssq = (float*)(ws + WS_SSQ);
    if (F.G != 256) return;

    if (PH_ON(0) && IN(0)) for (int rep = 0; rep < REPS(0); ++rep) { p0_prologue(F, rep == 0 ? 0 : PRO_PROBE); __syncthreads(); }
    SEAM(0);
#pragma unroll 1
    for (int layer = 0; layer < 2; ++layer) {
        const int pbase = 1 + layer * 5;
        if (PH_ON(1) && IN(pbase)) for (int rep = 0; rep < REPS(1); ++rep) { pg8::Gemm g{XB, (const bf16*)(ws + WS_WIN) + (size_t)layer * DIN * D, D, 0}; pg8::StaticOrder S; S.init(M, DIN, F.G, (int)blockIdx.x);
            pg8::EpiP E{(bf16*)(ws + WS_P), DIN, ssq}; pg8::gemm_phase<pg8::EpiP, pg8::StaticOrder, true, true>(F.lds, gtab, g, S, E);
            if (rep == 0) tail_convert(F, layer ? H6_BEG : H1_BEG, H1_N, (int)blockIdx.x - 192, 64); }
        SEAM(pbase);
        if (PH_ON(2) && IN(pbase + 1)) for (int rep = 0; rep < REPS(2); ++rep) { for (int u = F.vcu; u < M / 64; u += F.G) mixer_unit(F, u, layer); }
        SEAM(pbase + 1);
        if (PH_ON(3) && IN(pbase + 2)) for (int rep = 0; rep < (layer == 0 ? REPS(3) : 1); ++rep) { pg8::Gemm g{(const bf16*)(ws + WS_Y), (const bf16*)(ws + WS_WOUT) + (size_t)layer * D * D, D, 0}; pg8::StaticOrder S; S.init(M, D, F.G, (int)blockIdx.x);
            pg8::EpiResid E{layer == 0 ? in_tab(F)[0] : (const float*)nullptr, layer == 0 ? (float*)nullptr : args.out, XB, ssq}; pg8::gemm_phase<pg8::EpiResid, pg8::StaticOrder, false, true>(F.lds, gtab, g, S, E); }
        SEAM(pbase + 2);
        if (layer == 0) {
            if (PH_ON(4) && IN(4)) for (int rep = 0; rep < REPS(4); ++rep) { pg8::Gemm g{XB, (const bf16*)(ws + WS_WGU), D, 0}; pg8::StaticOrder S; S.init(M, NGU, F.G, (int)blockIdx.x);
                pg8::EpiSwiglu<false> E{(bf16*)(ws + WS_ACT), DFF, ssq, nullptr, nullptr, 0}; pg8::gemm_phase<pg8::EpiSwiglu<false>, pg8::StaticOrder, true, true>(F.lds, gtab, g, S, E);
                if (rep == 0) tail_convert(F, H4_BEG, H4_N, (int)blockIdx.x - 128, 128); }
            SEAM(4);
            if (PH_ON(5) && IN(5)) { pg8::Gemm g{(const bf16*)(ws + WS_ACT), (const bf16*)(ws + WS_WD), DFF, 0}; pg8::StaticOrder S; S.init(M, D, F.G, (int)blockIdx.x);
                pg8::EpiResid E{(const float*)nullptr, (float*)nullptr, XB, ssq}; pg8::gemm_phase<pg8::EpiResid, pg8::StaticOrder, false, true>(F.lds, gtab, g, S, E); }
            SEAM(5);
        }
    }
    if (PH_ON(9) && IN(9)) router_phase(F);
    SEAM(9);
    if (PH_ON(10) && IN(10)) for (int rep = 0; rep < REPS(10); ++rep) { pg8::MoeOrderGather S; moe_panels(F, S.pb); S.nN = NGUE / 256; S.nwg = S.pb[8] * S.nN; S.G = F.G; S.c = (int)blockIdx.x; S.rowoff = (const unsigned*)(ws + WS_ROWOFF);
        pg8::Gemm g{XB, (const bf16*)(ws + WS_MOE_WGU), D, (size_t)NGUE * D};
        pg8::EpiSwiglu<true> E{(bf16*)(ws + WS_ACTM), DFE, nullptr, (const float*)(ws + WS_RS), (const float*)(ws + WS_GATE), rep == 0 ? 0 : EPI_PROBE};
        pg8::gemm_phase<pg8::EpiSwiglu<true>, pg8::MoeOrderGather, true, true>(F.lds, gtab, g, S, E);
        if (rep == 0) tail_convert(F, H10_BEG, H10_N, ((int)blockIdx.x - (S.nwg % F.G) + F.G) % F.G, H10_WG); }
    SEAM(10);
    if (PH_ON(11) && IN(11)) for (int rep = 0; rep < REPS(11); ++rep) { pg8::MoeOrderDown S; moe_panels(F, S.pb); S.init(F.G, (int)blockIdx.x);
        pg8::Gemm g{(const bf16*)(ws + WS_ACTM), (const bf16*)(ws + WS_MOE_WD), DFE, (size_t)D * DFE};
        pg8::EpiBf16 E{(bf16*)(ws + WS_YP), D, (bf16*)(ws + WS_SLAB)};
        pg8::gemm_phase<pg8::EpiBf16, pg8::MoeOrderDown, true, true>(F.lds, gtab, g, S, E); }
    SEAM(11);
    if (PH_ON(12) && IN(12)) final_phase(F);
#undef IN
#undef SEAM
}
#ifndef MK_PER_PHASE
#define MK_PER_PHASE 0
#endif
extern "C" void kernel_launch(void* const* d_in, const int* in_sizes, int n_in, void* d_out, int out_size, void* d_ws, size_t ws_size, hipStream_t stream) {
    static int grid = 0;
    if (grid == 0) {
        if (n_in != 24 || out_size != M * D || ws_size < WS_END) { fprintf(stderr, "kernel_launch: unexpected shapes (n_in %d out %d ws %zu)\n", n_in, out_size, ws_size); grid = -1; return; }
        int dev = 0, cus = 0;
        if (hipGetDevice(&dev) != hipSuccess || hipDeviceGetAttribute(&cus, hipDeviceAttributeMultiprocessorCount, dev) != hipSuccess) { grid = -1; return; }
        if (hipFuncSetAttribute((const void*)fwd, hipFuncAttributeMaxDynamicSharedMemorySize, LDS_BYTES) != hipSuccess) { fprintf(stderr, "kernel_launch: hipFuncSetAttribute failed\n"); grid = -1; return; }
        int per_cu = 0;
        if (hipOccupancyMaxActiveBlocksPerMultiprocessor(&per_cu, (const void*)fwd, 512, LDS_BYTES) != hipSuccess || per_cu < 1) fprintf(stderr, "kernel_launch: occupancy query says %d\n", per_cu);
        (void)hipGetLastError();
        grid = cus;
        if (grid != 256) { fprintf(stderr, "kernel_launch: built for 256 CUs, found %d\n", grid); grid = -1; return; }
    }
    if (grid < 0) return;
    (void)hipMemsetAsync((char*)d_ws + WS_CTL, 0, CTL_ZERO_BYTES, stream);
    Args a{};
    for (int i = 0; i < 24; ++i) a.in[i] = (const float*)d_in[i];
    a.out = (float*)d_out; a.ws = (unsigned char*)d_ws; a.pad = 0;
#if MK_PER_PHASE
    for (int p = 0; p < NPHASE; ++p) { a.ph_lo = p; a.ph_hi = p + 1; a.li = p; hipLaunchKernelGGL(fwd, dim3(grid), dim3(512), LDS_BYTES, stream, a); }
#else
    a.ph_lo = 0; a.ph_hi = NPHASE; a.li = 0; hipLaunchKernelGGL(fwd, dim3(grid), dim3(512), LDS_BYTES, stream, a);
#endif
}
```

```cpp
#define MK_PER_PHASE 0
#include <hip/hip_runtime.h>
#include <cstdio>
#include <cstdint>
constexpr int M = 16384, D = 1024, SEQ = 8192, DIN = 1792, DFF = 2816, DFE = 3584, NE = 8;
constexpr int DPOOL = 256, DGM = 384, DCV = 384;
constexpr int NGU = 2 * DFF, NGUE = 2 * DFE;
constexpr int ECAP = 16384;
constexpr int PMAX = 2 * M + NE * 256;
constexpr float EPS = 1e-6f;

#define LAS __attribute__((address_space(3)))
#define GAS __attribute__((address_space(1)))
typedef unsigned short bf16;
typedef short bf16x8 __attribute__((ext_vector_type(8)));
typedef short s16x4 __attribute__((ext_vector_type(4)));
typedef float f32x4 __attribute__((ext_vector_type(4)));
typedef float f32x2 __attribute__((ext_vector_type(2)));
typedef unsigned u32x4 __attribute__((ext_vector_type(4)));
typedef unsigned u32x2 __attribute__((ext_vector_type(2)));

__device__ __forceinline__ unsigned cvt_pk_bf16(float lo, float hi) { unsigned r; asm volatile("v_cvt_pk_bf16_f32 %0, %1, %2" : "=v"(r) : "v"(lo), "v"(hi)); return r; }
__device__ __forceinline__ float bf_lo(unsigned w) { return __uint_as_float(w << 16); }
__device__ __forceinline__ float bf_hi(unsigned w) { return __uint_as_float(w & 0xffff0000u); }
__device__ __forceinline__ float fast_sigmoid(float x) { return __builtin_amdgcn_rcpf(1.0f + __builtin_amdgcn_exp2f(-1.4426950408889634f * x)); }
template <int CTRL> __device__ __forceinline__ float dpp_f(float v) { return __int_as_float(__builtin_amdgcn_update_dpp(0, __float_as_int(v), CTRL, 0xF, 0xF, true)); }
__device__ __forceinline__ float wave_sum(float v) {
    v += dpp_f<0xB1>(v); v += dpp_f<0x4E>(v); v += dpp_f<0x141>(v); v += dpp_f<0x140>(v);
    const int iv = __float_as_int(v);
    return (__int_as_float(__builtin_amdgcn_readlane(iv, 0)) + __int_as_float(__builtin_amdgcn_readlane(iv, 16))) + (__int_as_float(__builtin_amdgcn_readlane(iv, 32)) + __int_as_float(__builtin_amdgcn_readlane(iv, 48)));
}

namespace pg8 {
constexpr int BM = 256, BK = 64, HALF = 128, HTB = HALF * BK * 2, STAGE_BYTES = 8 * HTB, NXCD = 8, WGM = 8;
__host__ __device__ __forceinline__ int lds_byte(int r, int c) { const int st = (r >> 4) * 2 + (c >> 5), rr = r & 15, cc = c & 31, ob = rr * 64 + cc * 2; return st * 1024 + (ob ^ (((ob >> 9) & 1) << 5)); }
__host__ __device__ __forceinline__ void stage_rc(int b, int& R, int& C) { const int st = b / 1024, sb = b % 1024, swz = sb ^ (((sb >> 9) & 1) << 5); R = (st >> 1) * 16 + swz / 64; C = (st & 1) * 32 + (swz % 64) / 2; }
__host__ __device__ __forceinline__ int perm32(int rho) { const int n = rho >> 4, i = rho & 15; return 8 * (i >> 2) + 4 * n + (i & 3); }

struct Unit { int pm, pn, e, tab, k0b, nt, slab; };
struct Gemm { const bf16* A; const bf16* Bt; int K; size_t bstride_e; };

__device__ __forceinline__ void order_map(int wgid, int nM, int nN, int& pm, int& pn) {
    const int nwg = nM * nN; { const int q = nwg / NXCD, r = nwg % NXCD, xcd = wgid % NXCD, off = wgid / NXCD; wgid = (xcd < r ? xcd * (q + 1) : r * (q + 1) + (xcd - r) * q) + off; }
    const int nig = WGM * nN, gid = wgid / nig, fm = gid * WGM, gsz = (nM - fm) < WGM ? (nM - fm) : WGM;
    pm = fm + ((wgid % nig) % gsz); pn = (wgid % nig) / gsz;
}
struct StaticOrder {
    static constexpr bool GATHER = false;
    int nM, nN, nwg, G, c;
    __device__ void init(int Mrows, int N, int G_, int c_) { nM = Mrows / BM; nN = N / BM; nwg = nM * nN; G = G_; c = c_; }
    __device__ __forceinline__ bool next(int i, Unit& u) const { const long L = (long)i * G + c; if (L >= nwg) return false; order_map((int)L, nM, nN, u.pm, u.pn); u.e = 0; u.tab = 0; u.k0b = 0; u.nt = 0; u.slab = -1; return true; }
    __device__ __forceinline__ const unsigned* a_table(const Unit&) const { return nullptr; }
};
struct MoeOrder {
    int pb[9]; int nN, nwg, G, c; const unsigned* rowoff;
    __device__ __forceinline__ bool next(int i, Unit& u) const {
        const long L = (long)i * G + c; if (L >= nwg) return false; order_map((int)L, pb[8], nN, u.pm, u.pn); u.k0b = 0; u.nt = 0; u.slab = -1;
        int e = 0;
#pragma unroll
        for (int k = 1; k < 8; ++k) e += (u.pm >= pb[k]) ? 1 : 0;
        int pbe = pb[0];
#pragma unroll
        for (int k = 1; k < 8; ++k) pbe = (e == k) ? pb[k] : pbe;
        u.e = e; u.tab = e * ECAP + 256 * (u.pm - pbe); return true;
    }
    __device__ __forceinline__ const unsigned* a_table(const Unit& u) const { return rowoff + u.tab; }
};
struct MoeOrderGather : MoeOrder { static constexpr bool GATHER = true; };
__host__ __device__ __forceinline__ int moe_split(int r, int G) { return r == 0 ? 1 : (r * 14 <= G ? 14 : (r * 7 <= G ? 7 : (r * 4 <= G ? 4 : (r * 2 <= G ? 2 : 1)))); }
struct MoeOrderDown {
    static constexpr bool GATHER = false;
    int pb[9]; int G, c, NPf, nfull, r, s;
    __device__ __forceinline__ void init(int G_, int c_) { G = G_; c = c_; const int total = pb[8] * 4; nfull = (total / G) * G; NPf = nfull / 4; r = total - nfull; s = moe_split(r, G); }
    __device__ __forceinline__ bool next(int i, Unit& u) const {
        const int L = i * G + c; u.tab = 0;
        if (L < nfull) { order_map(L, NPf, 4, u.pm, u.pn); u.k0b = 0; u.nt = 0; u.slab = -1; }
        else { const int j = L - nfull; if (j >= r * s) return false; const int lu = j / s, ks = j - lu * s; u.pm = NPf + (lu >> 2); u.pn = lu & 3; u.nt = (DFE / BK) / s; u.k0b = ks * u.nt * BK * 2; u.slab = s > 1 ? j : -1; }
        int e = 0;
#pragma unroll
        for (int k = 1; k < 8; ++k) e += (u.pm >= pb[k]) ? 1 : 0;
        u.e = e; return true;
    }
    __device__ __forceinline__ const unsigned* a_table(const Unit&) const { return nullptr; }
};

__device__ __forceinline__ float rstd_of(const float* ssq, int row) { const float s = (ssq[row] + ssq[M + row]) + (ssq[2 * M + row] + ssq[3 * M + row]); return 1.0f / sqrtf(s * (1.0f / D) + EPS); }

struct EpiP {
    static constexpr bool PERM = true, AFTER_DRAIN = false;
    bf16* O; int ldc; const float* ssq;
    __device__ __forceinline__ void operator()(const f32x4 (&acc)[2][2][4][2], const Unit& u, int wr, int wc, int fr, int fq) const {
        const int row0 = u.pm * BM + wr * 64 + fr, col0 = u.pn * BM + wc * 32 + 8 * fq;
#pragma unroll
        for (int ai = 0; ai < 2; ++ai)
#pragma unroll
            for (int m = 0; m < 4; ++m) { const int row = row0 + ai * HALF + m * 16; const float rs = rstd_of(ssq, row); bf16* rowp = O + (size_t)row * ldc + col0;
#pragma unroll
                for (int bj = 0; bj < 2; ++bj) { const f32x4 v0 = acc[ai][bj][m][0] * rs, v1 = acc[ai][bj][m][1] * rs;
                    u32x4 w; w.x = cvt_pk_bf16(v0[0], v0[1]); w.y = cvt_pk_bf16(v0[2], v0[3]); w.z = cvt_pk_bf16(v1[0], v1[1]); w.w = cvt_pk_bf16(v1[2], v1[3]);
                    *(u32x4*)(rowp + bj * HALF) = w; } }
    }
};
template <bool MOE> struct EpiSwiglu {
    static constexpr bool PERM = true, AFTER_DRAIN = false;
    bf16* O; int ldc; const float* ssq; const float* rs_e; const float* gate_e; int mode;
    __device__ __forceinline__ void operator()(const f32x4 (&acc)[2][2][4][2], const Unit& u, int wr, int wc, int fr, int fq) const {
        if (mode == 2) { asm volatile("" :: "v"(acc[0][0][0][0][0]), "v"(acc[1][1][3][1][3])); return; }
        const int lr0 = wr * 64 + fr, col0 = u.pn * HALF + wc * 32 + 8 * fq;
#pragma unroll
        for (int ai = 0; ai < 2; ++ai)
#pragma unroll
            for (int m = 0; m < 4; ++m) { const int lr = lr0 + ai * HALF + m * 16, row = u.pm * BM + lr; float rs, gw;
                if (MOE) { rs = rs_e[u.tab + lr]; gw = gate_e[u.tab + lr]; } else { rs = rstd_of(ssq, row); gw = 1.0f; }
                float o[8]; const float c1 = rs * -1.4426950408889634f, c2 = rs * rs * gw;
#pragma unroll
                for (int n = 0; n < 2; ++n) { const f32x4 ga = acc[ai][0][m][n], gu = ga * acc[ai][1][m][n] * c2, ex = ga * c1;
#pragma unroll
                    for (int q = 0; q < 4; ++q) o[n * 4 + q] = gu[q] * __builtin_amdgcn_rcpf(1.0f + __builtin_amdgcn_exp2f(ex[q])); }
                u32x4 w; w.x = cvt_pk_bf16(o[0], o[1]); w.y = cvt_pk_bf16(o[2], o[3]); w.z = cvt_pk_bf16(o[4], o[5]); w.w = cvt_pk_bf16(o[6], o[7]);
                if (mode == 1) { asm volatile("" :: "v"(w.x), "v"(w.y), "v"(w.z), "v"(w.w)); } else *(u32x4*)(O + (size_t)row * ldc + col0) = w; }
    }
};
struct EpiBf16 {
    static constexpr bool PERM = true, AFTER_DRAIN = false;
    bf16* O; int ldc; bf16* slabs;
    __device__ __forceinline__ void operator()(const f32x4 (&acc)[2][2][4][2], const Unit& u, int wr, int wc, int fr, int fq) const {
        const bool sl = u.slab >= 0; bf16* base = sl ? slabs + (size_t)u.slab * (BM * BM) : O; const int ld = sl ? BM : ldc;
        const int row0 = (sl ? 0 : u.pm * BM) + wr * 64 + fr, col0 = (sl ? 0 : u.pn * BM) + wc * 32 + 8 * fq;
#pragma unroll
        for (int ai = 0; ai < 2; ++ai)
#pragma unroll
            for (int m = 0; m < 4; ++m) { bf16* rowp = base + (size_t)(row0 + ai * HALF + m * 16) * ld + col0;
#pragma unroll
                for (int bj = 0; bj < 2; ++bj) { const f32x4 v0 = acc[ai][bj][m][0], v1 = acc[ai][bj][m][1];
                    u32x4 w; w.x = cvt_pk_bf16(v0[0], v0[1]); w.y = cvt_pk_bf16(v0[2], v0[3]); w.z = cvt_pk_bf16(v1[0], v1[1]); w.w = cvt_pk_bf16(v1[2], v1[3]);
                    *(u32x4*)(rowp + bj * HALF) = w; } }
    }
};
struct EpiResid {
    static constexpr bool PERM = false, AFTER_DRAIN = true;
    const float* xold32; float* X32; bf16* XB; float* ssq;
    __device__ __forceinline__ void fused(f32x4 (&acc)[2][2][4][2], const Unit& u, int wr, int wc, int fr, int fq, LAS unsigned char* lds, int wid, int lane) const {
        LAS float* Pt = (LAS float*)lds;
        const int col0 = u.pn * BM + wc * 32 + 4 * fq;
#pragma unroll
        for (int ai = 0; ai < 2; ++ai)
#pragma unroll
            for (int m = 0; m < 4; ++m) { const int r = ai * HALF + wr * 64 + m * 16 + fr; const size_t off = (size_t)(u.pm * BM + r) * D + col0; float s = 0.f;
#pragma unroll
                for (int bj = 0; bj < 2; ++bj)
#pragma unroll
                    for (int n = 0; n < 2; ++n) { f32x4 bs;
                        if (xold32) bs = *(const f32x4*)(xold32 + off + bj * HALF + n * 16);
                        else { const u32x2 b2 = *(const u32x2*)(XB + off + bj * HALF + n * 16); bs = (f32x4){bf_lo(b2.x), bf_hi(b2.x), bf_lo(b2.y), bf_hi(b2.y)}; }
                        const f32x4 o = bs + acc[ai][bj][m][n];
                        if (X32) *(f32x4*)(X32 + off + bj * HALF + n * 16) = o;
                        u32x2 w; w.x = cvt_pk_bf16(o[0], o[1]); w.y = cvt_pk_bf16(o[2], o[3]); *(u32x2*)(XB + off + bj * HALF + n * 16) = w;
                        s += (o[0] * o[0] + o[1] * o[1]) + (o[2] * o[2] + o[3] * o[3]); }
                s += __shfl_xor(s, 16); s += __shfl_xor(s, 32);
                if (fq == 0) Pt[r * 4 + wc] = s; }
        __syncthreads();
        const int t = wid * 64 + lane;
        if (t < 256) { const float s = (Pt[t * 4 + 0] + Pt[t * 4 + 1]) + (Pt[t * 4 + 2] + Pt[t * 4 + 3]); ssq[(size_t)u.pn * M + u.pm * BM + t] = s; }
        __syncthreads();
    }
};

template <class Epi, class Sched, bool ALIGN_EPI = false, bool SP2 = true>
__device__ __forceinline__ void gemm_phase(LAS unsigned char* lds, LAS unsigned* gtab, const Gemm g, const Sched& S, const Epi& E) {
    constexpr bool GATHER = Sched::GATHER;
    static_assert(!GATHER || SP2, "gather needs the SP2 loop (lgkmcnt(0) waits only)");
    int tid_ = threadIdx.x; asm volatile("" : "+v"(tid_));
    const int tid = tid_, wid = __builtin_amdgcn_readfirstlane(tid >> 6), lane = tid & 63, wr = wid >> 2, wc = wid & 3, fr = lane & 15, fq = lane >> 4;
    const int K = g.K; int nt = K / BK;
    unsigned voffA[2], voffB[2];
#pragma unroll
    for (int i = 0; i < 2; ++i) { int R, C; stage_rc(tid * 16 + i * 8192, R, C); const int Rb = Epi::PERM ? ((R & ~31) + perm32(R & 31)) : R;
        voffA[i] = (unsigned)(R * K + C) * 2u; voffB[i] = (unsigned)(Rb * K + C) * 2u; }
    const size_t kstep = (size_t)(BK * 2);
    const size_t hstep = (size_t)HALF * K * 2;
    const size_t tstep = 2 * hstep;
    const unsigned ldsw = (unsigned)wid * 1024u;
    const int aoff = lds_byte(wr * 64 + fr, fq * 8), boff = lds_byte(wc * 32 + fr, fq * 8);
#define PG8_SA(b, h) (((b) * 2 + (h)) * HTB)
#define PG8_SB(b, h) ((4 + (b) * 2 + (h)) * HTB)
#define PG8_STAGE(bufoff, gbase, voff) do { _Pragma("unroll") for (int _i = 0; _i < 2; ++_i) \
        __builtin_amdgcn_global_load_lds((const unsigned*)((const char*)(gbase) + (voff)[_i]), (LAS unsigned*)(lds + (bufoff) + ldsw + _i * 8192), 16, 0, 0); } while (0)
#define PG8_STAGE_A(bufoff, ubase, kb, h) do { if constexpr (GATHER) { PG8_STAGE(bufoff, (const char*)g.A + (kb), ga[h]); } else { PG8_STAGE(bufoff, (ubase) + (size_t)(h) * hstep + (kb), voffA); } } while (0)
#define PG8_LDA(dst, b, h) do { _Pragma("unroll") for (int m = 0; m < 4; ++m) _Pragma("unroll") for (int k = 0; k < 2; ++k) dst[m][k] = *(const LAS bf16x8*)(lds + PG8_SA(b, h) + aoff + m * 2048 + k * 1024); } while (0)
#define PG8_LDB(dst, b, h) do { _Pragma("unroll") for (int n = 0; n < 2; ++n) _Pragma("unroll") for (int k = 0; k < 2; ++k) dst[n][k] = *(const LAS bf16x8*)(lds + PG8_SB(b, h) + boff + n * 2048 + k * 1024); } while (0)
#define PG8_MMA(ai, bj, At, Bt) do { __builtin_amdgcn_s_setprio(1); _Pragma("unroll") for (int m = 0; m < 4; ++m) _Pragma("unroll") for (int n = 0; n < 2; ++n) _Pragma("unroll") for (int k = 0; k < 2; ++k) \
        acc[ai][bj][m][n] = __builtin_amdgcn_mfma_f32_16x16x32_bf16(Bt[n][k], At[m][k], acc[ai][bj][m][n], 0, 0, 0); __builtin_amdgcn_s_setprio(0); } while (0)
#define PG8_WAIT_V(n) asm volatile("s_waitcnt vmcnt(" #n ")" ::: "memory")
#define PG8_WAIT_L(n) asm volatile("s_waitcnt lgkmcnt(" #n ")" ::: "memory")
#define PG8_BAR __builtin_amdgcn_s_barrier()
#define PG8_SCHED __builtin_amdgcn_sched_barrier(0)
#define PG8_GTAB_DMA(un, slot) do { if (wid < 4) __builtin_amdgcn_global_load_lds(S.a_table(un) + wid * 64 + lane, (LAS unsigned*)(gtab + (slot) * 256 + wid * 64), 4, 0, 0); } while (0)
#define PG8_GTAB_READ(dst, slot) do { _Pragma("unroll") for (int _i = 0; _i < 2; ++_i) { int _R, _C; stage_rc(tid * 16 + _i * 8192, _R, _C); _Pragma("unroll") for (int _h = 0; _h < 2; ++_h) dst[_h][_i] = gtab[(slot) * 256 + _h * HALF + _R] + (unsigned)_C * 2u; } } while (0)
    Unit cur, nxt; int ui = 0;
    if (!S.next(0, cur)) return;
    f32x4 acc[2][2][4][2];
#pragma unroll
    for (int a = 0; a < 2; ++a)
#pragma unroll
        for (int b = 0; b < 2; ++b)
#pragma unroll
            for (int m = 0; m < 4; ++m)
#pragma unroll
                for (int n = 0; n < 2; ++n) acc[a][b][m][n] = (f32x4){0.f, 0.f, 0.f, 0.f};
    bf16x8 At[4][2], B0[2][2], B1[2][2];
    unsigned ga[2][2];
    if (cur.nt) nt = cur.nt;
    const char* cA = (const char*)g.A + (GATHER ? (size_t)0 : (size_t)cur.pm * tstep + cur.k0b); const char* cB = (const char*)g.Bt + ((size_t)cur.e * g.bstride_e) * 2 + (size_t)cur.pn * tstep + cur.k0b;
    if constexpr (GATHER) { PG8_GTAB_DMA(cur, 0); PG8_WAIT_V(0); PG8_BAR; PG8_GTAB_READ(ga, 0); }
    if constexpr (SP2) {
        PG8_STAGE(PG8_SB(0, 0), cB, voffB); PG8_STAGE(PG8_SB(0, 1), cB + hstep, voffB); PG8_STAGE_A(PG8_SA(0, 0), cA, 0, 0); PG8_STAGE_A(PG8_SA(0, 1), cA, 0, 1);
        if (wr == 1) PG8_BAR;
        PG8_WAIT_V(2); PG8_BAR;
        PG8_STAGE(PG8_SB(1, 0), cB + kstep, voffB); PG8_STAGE_A(PG8_SA(1, 0), cA, kstep, 0); PG8_STAGE(PG8_SB(1, 1), cB + hstep + kstep, voffB);
        PG8_WAIT_V(6); PG8_BAR;
    } else {
        PG8_STAGE(PG8_SB(0, 0), cB, voffB); PG8_STAGE_A(PG8_SA(0, 0), cA, 0, 0); PG8_STAGE(PG8_SB(0, 1), cB + hstep, voffB); PG8_STAGE_A(PG8_SA(0, 1), cA, 0, 1);
        if (wr == 1) PG8_BAR;
        PG8_WAIT_V(4); PG8_BAR;
        PG8_STAGE(PG8_SB(1, 0), cB + kstep, voffB); PG8_STAGE_A(PG8_SA(1, 0), cA, kstep, 0); PG8_STAGE(PG8_SB(1, 1), cB + hstep + kstep, voffB);
        PG8_WAIT_V(6); PG8_BAR;
    }
    for (;;) {
        const bool has_next = S.next(ui + 1, nxt);
        const char* nA = (has_next && !GATHER) ? (const char*)g.A + (size_t)nxt.pm * tstep + nxt.k0b : cA;
        const char* nB = has_next ? (const char*)g.Bt + ((size_t)nxt.e * g.bstride_e) * 2 + (size_t)nxt.pn * tstep + nxt.k0b : cB;
        for (int t = 0; t < nt; t += 2) {
            const bool last = (t == nt - 2);
            const size_t k1 = (size_t)(t + 1) * kstep;
            const char* a2 = last ? nA : cA; const size_t k2 = last ? 0 : (size_t)(t + 2) * kstep;
            const char* b2 = last ? nB : cB + (size_t)(t + 2) * kstep; const char* b3 = b2 + kstep;
            const size_t k3 = k2 + kstep;
            if constexpr (GATHER) {
                if (t == nt - 4 && has_next) PG8_GTAB_DMA(nxt, (ui + 1) & 1);
            }
            if constexpr (SP2) {
            PG8_LDB(B0, 0, 0); PG8_LDB(B1, 0, 1); PG8_SCHED; PG8_LDA(At, 0, 0); PG8_STAGE_A(PG8_SA(1, 1), cA, k1, 1);
            if constexpr (GATHER) { if (last && has_next) PG8_GTAB_READ(ga, (ui + 1) & 1); }
            PG8_WAIT_V(8); PG8_WAIT_L(0); PG8_BAR; PG8_MMA(0, 0, At, B0); PG8_MMA(0, 1, At, B1); PG8_BAR; PG8_SCHED;
            PG8_LDA(At, 0, 1); PG8_STAGE(PG8_SB(0, 0), b2, voffB); PG8_STAGE(PG8_SB(0, 1), b2 + hstep, voffB); PG8_STAGE_A(PG8_SA(0, 0), a2, k2, 0);
            PG8_WAIT_V(8); PG8_WAIT_L(0); PG8_BAR; PG8_MMA(1, 0, At, B0); PG8_MMA(1, 1, At, B1); PG8_BAR; PG8_SCHED;
            PG8_LDB(B0, 1, 0); PG8_LDB(B1, 1, 1); PG8_SCHED; PG8_LDA(At, 1, 0); PG8_STAGE_A(PG8_SA(0, 1), a2, k2, 1);
            PG8_WAIT_V(8); PG8_WAIT_L(0); PG8_BAR; PG8_MMA(0, 0, At, B0); PG8_MMA(0, 1, At, B1); PG8_BAR; PG8_SCHED;
            PG8_LDA(At, 1, 1); PG8_STAGE(PG8_SB(1, 0), b3, voffB); PG8_STAGE(PG8_SB(1, 1), b3 + hstep, voffB); PG8_STAGE_A(PG8_SA(1, 0), a2, k3, 0);
            PG8_WAIT_V(8); PG8_WAIT_L(0); PG8_BAR; PG8_MMA(1, 0, At, B0); PG8_MMA(1, 1, At, B1); PG8_BAR; PG8_SCHED;
            } else {
            PG8_LDB(B0, 0, 0); PG8_SCHED; PG8_LDA(At, 0, 0); PG8_STAGE_A(PG8_SA(1, 1), cA, k1, 1);
            PG8_WAIT_L(8); PG8_BAR; PG8_WAIT_L(0); PG8_MMA(0, 0, At, B0); PG8_BAR; PG8_SCHED;
            PG8_LDB(B1, 0, 1); PG8_STAGE(PG8_SB(0, 0), b2, voffB);
            PG8_BAR; PG8_WAIT_L(0); PG8_MMA(0, 1, At, B1); PG8_BAR;
            PG8_LDA(At, 0, 1); PG8_STAGE_A(PG8_SA(0, 0), a2, k2, 0);
            PG8_BAR; PG8_WAIT_L(0); PG8_MMA(1, 0, At, B0); PG8_BAR; PG8_SCHED;
            PG8_STAGE(PG8_SB(0, 1), b2 + hstep, voffB);
            PG8_WAIT_V(6); PG8_BAR; PG8_MMA(1, 1, At, B1); PG8_BAR;
            PG8_LDB(B0, 1, 0); PG8_SCHED; PG8_LDA(At, 1, 0); PG8_STAGE_A(PG8_SA(0, 1), a2, k2, 1);
            PG8_WAIT_L(8); PG8_BAR; PG8_WAIT_L(0); PG8_MMA(0, 0, At, B0); PG8_BAR; PG8_SCHED;
            PG8_LDB(B1, 1, 1); PG8_STAGE(PG8_SB(1, 0), b3, voffB);
            PG8_BAR; PG8_WAIT_L(0); PG8_MMA(0, 1, At, B1); PG8_BAR;
            PG8_LDA(At, 1, 1); PG8_STAGE_A(PG8_SA(1, 0), a2, k3, 0);
            PG8_BAR; PG8_WAIT_L(0); PG8_MMA(1, 0, At, B0); PG8_BAR; PG8_SCHED;
            PG8_STAGE(PG8_SB(1, 1), b3 + hstep, voffB);
            PG8_WAIT_V(6); PG8_BAR; PG8_MMA(1, 1, At, B1); PG8_BAR;
            }
        }
        if constexpr (ALIGN_EPI) { if (wr == 0) PG8_BAR; }
        if constexpr (!Epi::AFTER_DRAIN) { E(acc, cur, wr, wc, fr, fq); }
        if (!has_next) break;
#pragma unroll
        for (int a = 0; a < 2; ++a)
#pragma unroll
            for (int b = 0; b < 2; ++b)
#pragma unroll
                for (int m = 0; m < 4; ++m)
#pragma unroll
                    for (int n = 0; n < 2; ++n) acc[a][b][m][n] = (f32x4){0.f, 0.f, 0.f, 0.f};
        cur = nxt; cA = nA; cB = nB; ++ui; nt = cur.nt ? cur.nt : K / BK;
        if constexpr (ALIGN_EPI) { if (wr == 1) PG8_BAR; }
    }
    PG8_WAIT_V(0);
    if constexpr (!ALIGN_EPI) { if (wr == 0) PG8_BAR; }
    PG8_BAR;
    if constexpr (Epi::AFTER_DRAIN) { E.fused(acc, cur, wr, wc, fr, fq, lds, wid, lane); }
#undef PG8_SA
#undef PG8_SB
#undef PG8_STAGE
#undef PG8_STAGE_A
#undef PG8_LDA
#undef PG8_LDB
#undef PG8_MMA
#undef PG8_WAIT_V
#undef PG8_WAIT_L
#undef PG8_BAR
#undef PG8_SCHED
#undef PG8_GTAB_DMA
#undef PG8_GTAB_READ
}
}
constexpr size_t MiB = 1u << 20;
constexpr size_t WS_CTL = 0, CTL_ZERO_BYTES = 1 * MiB;
constexpr size_t WS_ROWOFF = 1 * MiB;
constexpr size_t WS_RS = WS_ROWOFF + 512 * 1024;
constexpr size_t WS_GATE = WS_RS + 512 * 1024;
constexpr size_t WS_SEL = WS_GATE + 512 * 1024;
constexpr size_t WS_SSQ = WS_SEL + 256 * 1024;
constexpr size_t WS_SMALLW = 4 * MiB;
constexpr size_t WS_PWT = WS_SMALLW;
constexpr size_t WS_POOLWT = WS_PWT + 2 * 384 * 384 * 2;
constexpr size_t WS_GMWS = WS_POOLWT + 2 * 4 * 64 * 64 * 2;
constexpr size_t WS_XB = 6 * MiB;
constexpr size_t WS_SLAB = 162 * MiB;
constexpr size_t WS_XB2 = WS_XB;
constexpr size_t WS_MOE_WD = 38 * MiB;
constexpr size_t WS_MOE_WGU = 94 * MiB;
constexpr size_t WS_YP = 94 * MiB;
constexpr size_t WS_ACTM = 206 * MiB;
constexpr size_t WS_P = 206 * MiB;
constexpr size_t WS_Y = 262 * MiB;
constexpr size_t WS_ACT = 206 * MiB;
constexpr size_t WS_WIN = 294 * MiB;
constexpr size_t WS_WOUT = 301 * MiB;
constexpr size_t WS_WGU = 305 * MiB;
constexpr size_t WS_WD = 316 * MiB;
constexpr size_t WS_END = 444 * MiB;
static_assert(WS_SSQ + 4 * (size_t)M * 4 <= WS_SMALLW && WS_GMWS + 2 * 4 * 128 * 128 * 2 <= WS_XB && WS_XB + (size_t)M * D * 2 <= WS_MOE_WD, "ws map 1");
static_assert(WS_SLAB >= WS_YP + (size_t)PMAX * D * 2 && WS_SLAB + 256 * (size_t)65536 * 2 <= WS_ACTM, "slabs");
static_assert(WS_MOE_WD + (size_t)NE * D * DFE * 2 <= WS_MOE_WGU && WS_MOE_WGU + (size_t)NE * NGUE * D * 2 <= WS_ACTM && WS_YP + (size_t)PMAX * D * 2 <= WS_ACTM, "ws map 2");
static_assert(WS_ACTM + (size_t)PMAX * DFE * 2 <= WS_END && WS_P + (size_t)M * DIN * 2 <= WS_Y && WS_Y + (size_t)M * D * 2 <= WS_WIN && WS_ACT + (size_t)M * DFF * 2 <= WS_WIN, "ws map 3");
static_assert(WS_WIN + 2 * (size_t)DIN * D * 2 <= WS_WOUT && WS_WOUT + 2 * (size_t)D * D * 2 <= WS_WGU && WS_WGU + (size_t)NGU * D * 2 <= WS_WD && WS_WD + (size_t)D * DFF * 2 <= WS_END, "ws map 4");
constexpr int CW_BAR = 4096;
constexpr int CW_CNT = 131072;
constexpr int CW_CVT = 140000;
constexpr int NPHASE = 13;
constexpr int RING_BYTES = 131072;
constexpr int GTAB_OFF = RING_BYTES;
constexpr int MISC_OFF = GTAB_OFF + 2048;
constexpr int INTAB_OFF = MISC_OFF + 256;
constexpr int LDS_BYTES = 147456;
static_assert(MISC_OFF + 256 <= LDS_BYTES, "LDS map");

typedef GAS unsigned gu32;
#define RLX_AGENT __ATOMIC_RELAXED, __HIP_MEMORY_SCOPE_AGENT
#define LDS_WAIT() asm volatile("s_waitcnt lgkmcnt(0)" ::: "memory")
#define VM_WAIT() asm volatile("s_waitcnt vmcnt(0)" ::: "memory")

#define XB_TMO      128
#define XB_XCNT(j)  (256  + 64 * (j))
#define XB_XSUB(j)  (1280 + 64 * (j))
#define XB_XGEN(j)  (2304 + 64 * (j))
#define XB_TOP      3328
#define XB_TOPGEN   3392
#define XCD_BAR_WORDS 3456
#define XB_SPIN_CAP (1u << 18)
__device__ __forceinline__ unsigned xb_ld(unsigned* p)              { return __hip_atomic_load(p, __ATOMIC_RELAXED, __HIP_MEMORY_SCOPE_AGENT); }
__device__ __forceinline__ unsigned xb_add(unsigned* p, unsigned v) { return __hip_atomic_fetch_add(p, v, __ATOMIC_RELAXED, __HIP_MEMORY_SCOPE_AGENT); }
__device__ __forceinline__ unsigned xb_xcc_id() { return (unsigned)__builtin_amdgcn_s_getreg((3 << 11) | 20) & 0xFu; }
#define XB_SPIN(cond, bar) do { unsigned _sp = 0; while (cond) { __builtin_amdgcn_s_sleep(1); \
    if ((++_sp & 255u) == 0u) { if (xb_ld(&(bar)[XB_TMO])) break; if (_sp > XB_SPIN_CAP) { atomicAdd(&(bar)[XB_TMO], 1u); break; } } } } while (0)
struct XcdBarrier { unsigned* bar; unsigned x; volatile LAS unsigned* st; };
__device__ __forceinline__ XcdBarrier xcd_barrier_post(unsigned* bar, volatile LAS unsigned* st) {
    XcdBarrier b; b.bar = bar; b.x = xb_xcc_id(); b.st = st;
    if (threadIdx.x == 0) (void)xb_add(&bar[XB_XCNT(b.x)], 1u);
    return b;
}
__device__ __forceinline__ void xcd_barrier_complete(unsigned* bar, unsigned x, unsigned& nloc, unsigned& nx) {
    const unsigned G = gridDim.x * gridDim.y * gridDim.z;
    unsigned sum, cnt, mine, sp = 0u;
    for (;;) {
        sum = 0u; cnt = 0u; mine = 0u;
#pragma unroll
        for (unsigned j = 0; j < 16; ++j) { const unsigned c = xb_ld(&bar[XB_XCNT(j)]); sum += c; cnt += (c > 0u) ? 1u : 0u; mine = (j == x) ? c : mine; }
        if (sum == G) break;
        __builtin_amdgcn_s_sleep(1);
        if ((++sp & 255u) == 0u) { if (xb_ld(&bar[XB_TMO])) break; if (sp > XB_SPIN_CAP) { atomicAdd(&bar[XB_TMO], 1u); break; } }
    }
    nloc = mine > 0u ? mine : 1u; nx = cnt > 0u ? cnt : 1u;
}
__device__ __forceinline__ void xcd_barrier(const XcdBarrier& b) {
    asm volatile("s_waitcnt vmcnt(0)" ::: "memory");
    __syncthreads();
    if (threadIdx.x == 0) {
        unsigned* bar = b.bar;
        __builtin_amdgcn_s_waitcnt(0);
        unsigned nloc = b.st[0], nx = b.st[1];
        if (nloc == 0u) { xcd_barrier_complete(bar, b.x, nloc, nx); b.st[0] = nloc; b.st[1] = nx; }
        const unsigned old = xb_add(&bar[XB_XSUB(b.x)], 1u);
        const unsigned gen = old / nloc;
        if (old + 1u == (gen + 1u) * nloc) {
            __builtin_amdgcn_fence(__ATOMIC_RELEASE, "agent");
            asm volatile("s_waitcnt vmcnt(0)" ::: "memory");
            const unsigned og = xb_add(&bar[XB_TOP], 1u);
            const unsigned tg = og / nx;
            if (og + 1u == (tg + 1u) * nx) xb_add(&bar[XB_TOPGEN], 1u);
            else XB_SPIN(xb_ld(&bar[XB_TOPGEN]) == tg, bar);
            __builtin_amdgcn_fence(__ATOMIC_ACQUIRE, "agent");
            xb_add(&bar[XB_XGEN(b.x)], 1u);
            asm volatile("s_waitcnt vmcnt(0)" ::: "memory");
        } else {
            XB_SPIN(xb_ld(&bar[XB_XGEN(b.x)]) == gen, bar);
            __builtin_amdgcn_fence(__ATOMIC_ACQUIRE, "agent");
            asm volatile("s_waitcnt vmcnt(0)" ::: "memory");
        }
    }
    __syncthreads();
}

struct InTab { const LAS unsigned long long* t;
    __device__ __forceinline__ const float* operator[](int k) const { const unsigned long long v = t[k]; const unsigned lo = __builtin_amdgcn_readfirstlane((unsigned)v), hi = __builtin_amdgcn_readfirstlane((unsigned)(v >> 32));
        return (const float*)(((unsigned long long)hi << 32) | lo); } };
struct Frame {
    LAS unsigned char* lds; volatile LAS unsigned* MISC; unsigned* ctl;
    int tid, lane, wave, vcu, G;
    InTab in; float* out; unsigned char* ws;
};

__device__ __forceinline__ InTab in_tab(Frame& F) { return F.in; }
struct TrJob { const float* src; bf16* dst; const float* gk; int K, N; };
__device__ __forceinline__ TrJob tr_mat(const float* W, int K, int N, bf16* WT, int mode, const float* gk, int r) {
    const int nblk = N / 32, kb = r / nblk, nb = r % nblk, n0 = 32 * nb, k0 = 64 * kb;
    const int drow = mode == 0 ? n0 : ((n0 >> 7) * 256 + (n0 & 127) + (mode == 2 ? 128 : 0));
    TrJob j; j.src = W + (size_t)k0 * N + n0; j.dst = WT + (size_t)drow * K + k0; j.gk = gk ? gk + k0 : nullptr; j.K = K; j.N = N; return j;
}
constexpr int TR_I_IN = (D / 64) * (DIN / 32), TR_I_OUT = (D / 64) * (D / 32), TR_I_G = (D / 64) * (DFF / 32), TR_I_D = (DFF / 64) * (D / 32), TR_I_MG = (D / 64) * (DFE / 32), TR_I_MD = (DFE / 64) * (D / 32), TR_I_PW = (DCV / 64) * (DCV / 32), TR_I_PL = 2;
constexpr int TR_A_END = TR_I_IN + TR_I_OUT + 2 * TR_I_G + TR_I_D + 2 * TR_I_PW + 8 * TR_I_PL;
constexpr int TR_B_END = TR_A_END + TR_I_IN + TR_I_OUT;
constexpr int TR_C_END = TR_B_END + 2 * NE * TR_I_MG;
constexpr int TR_D_END = TR_C_END + NE * TR_I_MD;
__device__ __forceinline__ TrJob tr_decode(const InTab in, unsigned char* ws, int r) {
    if (r < TR_I_IN) return tr_mat(in[2], D, DIN, (bf16*)(ws + WS_WIN), 0, in[1], r); r -= TR_I_IN;
    if (r < TR_I_OUT) return tr_mat(in[14], D, D, (bf16*)(ws + WS_WOUT), 0, nullptr, r); r -= TR_I_OUT;
    if (r < TR_I_G) return tr_mat(in[16], D, DFF, (bf16*)(ws + WS_WGU), 1, in[15], r); r -= TR_I_G;
    if (r < TR_I_G) return tr_mat(in[17], D, DFF, (bf16*)(ws + WS_WGU), 2, in[15], r); r -= TR_I_G;
    if (r < TR_I_D) return tr_mat(in[18], DFF, D, (bf16*)(ws + WS_WD), 0, nullptr, r); r -= TR_I_D;
    if (r < 2 * TR_I_PW) { const int l = r / TR_I_PW; return tr_mat(in[12] + (size_t)l * DCV * DCV, DCV, DCV, (bf16*)(ws + WS_PWT) + (size_t)l * DCV * DCV, 0, nullptr, r % TR_I_PW); } r -= 2 * TR_I_PW;
    if (r < 8 * TR_I_PL) { const int gi = r / TR_I_PL; return tr_mat(in[3] + (size_t)gi * 64 * 64, 64, 64, (bf16*)(ws + WS_POOLWT) + (size_t)gi * 64 * 64, 0, nullptr, r % TR_I_PL); } r -= 8 * TR_I_PL;
    if (r < TR_I_IN) return tr_mat(in[2] + (size_t)D * DIN, D, DIN, (bf16*)(ws + WS_WIN) + (size_t)DIN * D, 0, in[1] + D, r); r -= TR_I_IN;
    if (r < TR_I_OUT) return tr_mat(in[14] + (size_t)D * D, D, D, (bf16*)(ws + WS_WOUT) + (size_t)D * D, 0, nullptr, r); r -= TR_I_OUT;
    if (r < 2 * NE * TR_I_MG) { const int e = r / (2 * TR_I_MG), q = r % (2 * TR_I_MG), up = q / TR_I_MG;
        return tr_mat(in[20 + up] + (size_t)e * D * DFE, D, DFE, (bf16*)(ws + WS_MOE_WGU) + (size_t)e * NGUE * D, 1 + up, in[15] + D, q % TR_I_MG); } r -= 2 * NE * TR_I_MG;
    { const int e = r / TR_I_MD; return tr_mat(in[22] + (size_t)e * DFE * D, DFE, D, (bf16*)(ws + WS_MOE_WD) + (size_t)e * D * DFE, 0, nullptr, r % TR_I_MD); }
}
__device__ __forceinline__ void tr_load(const TrJob& j, f32x4 (&v)[8], int lane, int probe) {
    const int n4 = (lane & 7) * 4, kr = lane >> 3;
    if (probe == 2) {
#pragma unroll
        for (int i = 0; i < 8; ++i) v[i] = (f32x4){1.f, 2.f, 3.f, 4.f};
        return; }
#pragma unroll
    for (int i = 0; i < 8; ++i) { v[i] = *(const f32x4*)(j.src + (size_t)(kr + 8 * i) * j.N + n4); if (j.gk) v[i] = v[i] * j.gk[kr + 8 * i]; }
}
__device__ __forceinline__ void tr_store(const TrJob& j, const f32x4 (&v)[8], LAS float* scr, int lane, int probe) {
    const int n4 = (lane & 7) * 4, kr = lane >> 3;
#pragma unroll
    for (int i = 0; i < 8; ++i) { LAS float* d = scr + (kr + 8 * i) * 33 + n4; d[0] = v[i][0]; d[1] = v[i][1]; d[2] = v[i][2]; d[3] = v[i][3]; }
    LDS_WAIT(); asm volatile("" ::: "memory");
    const int c = lane & 7;
#pragma unroll
    for (int jj = 0; jj < 4; ++jj) { const int n = (lane >> 3) + 8 * jj; const LAS float* s = scr + (8 * c) * 33 + n;
        u32x4 o; o.x = cvt_pk_bf16(s[0 * 33], s[1 * 33]); o.y = cvt_pk_bf16(s[2 * 33], s[3 * 33]); o.z = cvt_pk_bf16(s[4 * 33], s[5 * 33]); o.w = cvt_pk_bf16(s[6 * 33], s[7 * 33]);
        if (probe == 1 || probe == 2) { asm volatile("" :: "v"(o.x), "v"(o.y), "v"(o.z), "v"(o.w)); } else *(GAS u32x4*)(j.dst + (size_t)n * j.K + 8 * c) = o; }
    LDS_WAIT(); asm volatile("" ::: "memory");
}
__device__ __forceinline__ void tr_run(Frame& F, int first, int count, int widx, int nw, int probe) {
    LAS float* scr = (LAS float*)(F.lds + F.wave * 16384); int lane = F.lane; asm volatile("" : "+v"(lane)); const InTab in = in_tab(F); unsigned char* ws = F.ws;
    const int end = first + count; f32x4 v[4][8]; TrJob j[4];
#pragma unroll
    for (int k = 0; k < 4; ++k) { const int it = first + widx + k * nw; if (it < end) { j[k] = tr_decode(in, ws, it); tr_load(j[k], v[k], lane, probe); } }
    for (int it = first + widx; it < end; it += 4 * nw) {
#pragma unroll
        for (int k = 0; k < 4; ++k) { const int ik = it + k * nw, nx = ik + 4 * nw;
            if (ik < end) tr_store(j[k], v[k], scr, lane, probe);
            if (nx < end) { j[k] = tr_decode(in, ws, nx); tr_load(j[k], v[k], lane, probe); } } }
}
constexpr int HID_PER_WAVE = 2, H1_N = 64 * 8 * HID_PER_WAVE, H4_N = 128 * 8 * HID_PER_WAVE, H6_N = 64 * 8 * HID_PER_WAVE, H10_WG = 96, H10_N = H10_WG * 8 * HID_PER_WAVE;
constexpr int H1_BEG = TR_A_END, H4_BEG = H1_BEG + H1_N, H6_BEG = H4_BEG + H4_N, H6_END = H6_BEG + H6_N, H10_BEG = TR_D_END - H10_N;
static_assert(H6_END <= TR_C_END && H10_BEG >= TR_C_END, "hidden conversion shares");
__device__ __forceinline__ void tail_convert(Frame& F, int first, int count, int rank, int nwg_idle) {
    if (rank >= 0 && rank < nwg_idle) tr_run(F, first, count, rank * 8 + F.wave, nwg_idle * 8, 0);
}

__device__ __forceinline__ void p0_prologue(Frame& F, int probe) {
    LAS float* scr = (LAS float*)(F.lds + F.wave * 16384);
    int lane = F.lane; asm volatile("" : "+v"(lane));
    const int gw = F.vcu * 8 + F.wave, NGW = F.G * 8;
    const InTab in = in_tab(F); unsigned char* ws = F.ws;
    tr_run(F, 0, TR_A_END, gw, NGW, probe);
    tr_run(F, H6_END, H10_BEG - H6_END, gw, NGW, probe);
    { const float* src = in[6]; bf16* dst = (bf16*)(ws + WS_GMWS);
      for (int i = gw * 64 + lane; i < 2 * 4 * 128 * 128 / 8; i += NGW * 64) { const f32x4 a = *(const f32x4*)(src + (size_t)i * 8), b = *(const f32x4*)(src + (size_t)i * 8 + 4);
          u32x4 o; o.x = cvt_pk_bf16(a[0], a[1]); o.y = cvt_pk_bf16(a[2], a[3]); o.z = cvt_pk_bf16(b[0], b[1]); o.w = cvt_pk_bf16(b[2], b[3]); *(u32x4*)(dst + (size_t)i * 8) = o; } }
    { u32x4* t = (u32x4*)(ws + WS_ROWOFF); for (int i = gw * 64 + lane; i < NE * ECAP / 4; i += NGW * 64) t[i] = (u32x4){0u, 0u, 0u, 0u}; }
    { const float* x = in[0]; bf16* XB = (bf16*)(ws + WS_XB); float* ssq = (float*)(ws + WS_SSQ);
      for (int m = gw; m < M; m += NGW) { const f32x4* xr = (const f32x4*)(x + (size_t)m * D) + lane; f32x4 v[4]; float s = 0.f;
#pragma unroll
          for (int j = 0; j < 4; ++j) { v[j] = xr[64 * j]; s += (v[j][0] * v[j][0] + v[j][1] * v[j][1]) + (v[j][2] * v[j][2] + v[j][3] * v[j][3]); }
          s = wave_sum(s);
          u32x2* o = (u32x2*)(XB + (size_t)m * D) + lane;
#pragma unroll
          for (int j = 0; j < 4; ++j) { u32x2 w; w.x = cvt_pk_bf16(v[j][0], v[j][1]); w.y = cvt_pk_bf16(v[j][2], v[j][3]); o[64 * j] = w; }
          if (lane < 4) ssq[(size_t)lane * M + m] = lane == 0 ? s : 0.f; } }
}

__device__ __forceinline__ void unpack8(const u32x4 w, float (&f)[8]) { f[0] = bf_lo(w.x); f[1] = bf_hi(w.x); f[2] = bf_lo(w.y); f[3] = bf_hi(w.y); f[4] = bf_lo(w.z); f[5] = bf_hi(w.z); f[6] = bf_lo(w.w); f[7] = bf_hi(w.w); }
__device__ __forceinline__ void mixer_unit(Frame& F, int u, int layer) {
    LAS unsigned char* lds = F.lds; int tid = F.tid; asm volatile("" : "+v"(tid)); int lane = tid & 63; const int w = F.wave;
    const InTab in = in_tab(F); unsigned char* ws = F.ws;
    const bf16* P = (const bf16*)(ws + WS_P); bf16* Y = (bf16*)(ws + WS_Y);
    const int r0 = 64 * u, s0 = r0 & (SEQ - 1), half = u & 1, blk0 = r0 & ~127;
#ifndef MIX_MASK
#define MIX_MASK 7
#endif
#ifndef MIX_REP
#define MIX_REP 0
#endif
    for (int mrep = 0; mrep < 1 + (MIX_REP & 1); ++mrep) if (MIX_MASK & 1) { constexpr int AIN = 0, YPL = 40448, YST = 528;
      const int g = w >> 1, th = w & 1, fr = lane & 15, fq = lane >> 4;
      u32x4 st[5];
#pragma unroll
      for (int i = 0; i < 5; ++i) { const int idx = tid + 512 * i, rr = idx >> 5, ch = idx & 31, pos = s0 - 15 + rr; st[i] = (u32x4){0u, 0u, 0u, 0u};
          if (idx < 79 * 32 && pos >= 0) st[i] = *(const u32x4*)(P + (size_t)(r0 - 15 + rr) * DIN + ch * 8); }
      const bf16* wt = (const bf16*)(ws + WS_POOLWT) + (size_t)(layer * 4 + g) * 64 * 64; const float* sc = in[4] + layer * DPOOL + g * 64;
      bf16x8 Bf[2][4]; f32x4 sc4[4];
#pragma unroll
      for (int ks = 0; ks < 2; ++ks)
#pragma unroll
          for (int nt = 0; nt < 4; ++nt) Bf[ks][nt] = *(const bf16x8*)(wt + (nt * 16 + fr) * 64 + ks * 32 + 8 * fq);
#pragma unroll
      for (int nt = 0; nt < 4; ++nt) sc4[nt] = *(const f32x4*)(sc + nt * 16 + 4 * fq);
#pragma unroll
      for (int i = 0; i < 5; ++i) { const int idx = tid + 512 * i; if (idx < 79 * 32) *(LAS u32x4*)(lds + AIN + (idx >> 5) * 512 + (idx & 31) * 16) = st[i]; }
      __syncthreads();
      { const int p = tid & 127, rq = tid >> 7, gp = p >> 5, win = 2 << gp; float S0 = 0.f, S1 = 0.f;
        for (int j = 1; j < win; ++j) { const unsigned a = *(const LAS unsigned*)(lds + AIN + (16 * rq + 15 - j) * 512 + p * 4); S0 += bf_lo(a); S1 += bf_hi(a); }
#pragma unroll 4
        for (int t = 0; t < 16; ++t) { const int lt = 16 * rq + t, rr = lt + 15; const unsigned a = *(const LAS unsigned*)(lds + AIN + rr * 512 + p * 4); const float a0 = bf_lo(a), a1 = bf_hi(a);
            S0 += a0; S1 += a1; const int pos1 = s0 + lt + 1; const float rn = __builtin_amdgcn_rcpf((float)(pos1 < win ? pos1 : win));
            *(LAS unsigned*)(lds + YPL + lt * YST + p * 4) = cvt_pk_bf16(S0 * rn - a0, S1 * rn - a1);
            const unsigned o = *(const LAS unsigned*)(lds + AIN + (rr - win + 1) * 512 + p * 4); S0 -= bf_lo(o); S1 -= bf_hi(o); } }
      __syncthreads();
      { f32x4 acc[2][4];
#pragma unroll
        for (int a = 0; a < 2; ++a)
#pragma unroll
            for (int b = 0; b < 4; ++b) acc[a][b] = (f32x4){0.f, 0.f, 0.f, 0.f};
#pragma unroll
        for (int ks = 0; ks < 2; ++ks) { bf16x8 A[2];
#pragma unroll
            for (int mt = 0; mt < 2; ++mt) A[mt] = *(const LAS bf16x8*)(lds + YPL + ((2 * th + mt) * 16 + fr) * YST + (g * 64 + ks * 32 + 8 * fq) * 2);
#pragma unroll
            for (int mt = 0; mt < 2; ++mt)
#pragma unroll
                for (int nt = 0; nt < 4; ++nt) acc[mt][nt] = __builtin_amdgcn_mfma_f32_16x16x32_bf16(Bf[ks][nt], A[mt], acc[mt][nt], 0, 0, 0); }
#pragma unroll
        for (int mt = 0; mt < 2; ++mt)
#pragma unroll
            for (int nt = 0; nt < 4; ++nt) { const int t = r0 + (2 * th + mt) * 16 + fr, d = nt * 16 + 4 * fq; const f32x4 v = acc[mt][nt] * sc4[nt];
                u32x2 o; o.x = cvt_pk_bf16(v[0], v[1]); o.y = cvt_pk_bf16(v[2], v[3]); *(u32x2*)(Y + (size_t)t * D + g * 64 + d) = o; } }
      __syncthreads(); }
    asm volatile("" : "+v"(tid)); lane = tid & 63;
    for (int mrep = 0; mrep < 1 + ((MIX_REP >> 1) & 1); ++mrep) if (MIX_MASK & 2) { constexpr int VN = 0, VST = 800; const int nj = half ? 128 : 64, nks = nj >> 5;
      const int h = w & 3, ih = w >> 2, fr = lane & 15, fq = lane >> 4, q4 = (lane & 15) >> 2, p4 = lane & 3;
      const bf16* wsb = (const bf16*)(ws + WS_GMWS) + (size_t)(layer * 4 + h) * 128 * 128;
      const float* gg = in[5] + layer * DGM; const float* bb = in[7] + (size_t)(layer * 4 + h) * 128;
      u32x4 raw[16]; const int nr = nj >> 3;
#pragma unroll
      for (int i = 0; i < 16; ++i) { raw[i] = (u32x4){0u, 0u, 0u, 0u}; if (i < nr && lane < 48) raw[i] = *(const u32x4*)(P + (size_t)(blk0 + i * 8 + w) * DIN + 640 + lane * 8); }
      bf16x8 Aw[4][2]; f32x4 g4[6]; float bi[2];
#pragma unroll
      for (int ks = 0; ks < 4; ++ks)
#pragma unroll
          for (int mt = 0; mt < 2; ++mt) { Aw[ks][mt] = (bf16x8){0, 0, 0, 0, 0, 0, 0, 0}; if (ks < nks) Aw[ks][mt] = *(const bf16x8*)(wsb + (size_t)(half * 64 + (2 * ih + mt) * 16 + fr) * 128 + ks * 32 + 8 * fq); }
#pragma unroll
      for (int ct = 0; ct < 6; ++ct) g4[ct] = *(const f32x4*)(gg + h * 96 + ct * 16 + 4 * fq);
#pragma unroll
      for (int mt = 0; mt < 2; ++mt) bi[mt] = bb[half * 64 + (2 * ih + mt) * 16 + fr];
#pragma unroll
      for (int i = 0; i < 16; ++i) { if (i < nr) { float f[8]; unpack8(raw[i], f); float s = 0.f;
#pragma unroll
              for (int q = 0; q < 8; ++q) s += f[q] * f[q];
              s = wave_sum(s); const float rs = 1.0f / sqrtf(s * (1.0f / DGM) + EPS);
              u32x4 o; o.x = cvt_pk_bf16(f[0] * rs, f[1] * rs); o.y = cvt_pk_bf16(f[2] * rs, f[3] * rs); o.z = cvt_pk_bf16(f[4] * rs, f[5] * rs); o.w = cvt_pk_bf16(f[6] * rs, f[7] * rs);
              if (lane < 48) *(LAS u32x4*)(lds + VN + (i * 8 + w) * VST + lane * 16) = o; } }
      u32x2 uu[2][6];
#pragma unroll
      for (int mt = 0; mt < 2; ++mt)
#pragma unroll
          for (int ct = 0; ct < 6; ++ct) uu[mt][ct] = *(const u32x2*)(P + (size_t)(r0 + (2 * ih + mt) * 16 + fr) * DIN + 256 + h * 96 + ct * 16 + 4 * fq);
      __syncthreads();
      { f32x4 acc[2][6];
#pragma unroll
        for (int a = 0; a < 2; ++a)
#pragma unroll
            for (int b = 0; b < 6; ++b) acc[a][b] = (f32x4){0.f, 0.f, 0.f, 0.f};
#pragma unroll
        for (int ks = 0; ks < 4; ++ks) { if (ks < nks) {
#pragma unroll
            for (int ct = 0; ct < 6; ++ct) { const unsigned ad = VN + (32 * ks + 8 * fq + q4) * VST + (h * 96 + ct * 16 + 4 * p4) * 2;
                const s16x4 t0 = __builtin_amdgcn_ds_read_tr16_b64_v4i16((LAS s16x4*)(lds + ad)), t1 = __builtin_amdgcn_ds_read_tr16_b64_v4i16((LAS s16x4*)(lds + ad + 4 * VST));
                bf16x8 B; B[0] = t0[0]; B[1] = t0[1]; B[2] = t0[2]; B[3] = t0[3]; B[4] = t1[0]; B[5] = t1[1]; B[6] = t1[2]; B[7] = t1[3];
#pragma unroll
                for (int mt = 0; mt < 2; ++mt) acc[mt][ct] = __builtin_amdgcn_mfma_f32_16x16x32_bf16(B, Aw[ks][mt], acc[mt][ct], 0, 0, 0); } } }
#pragma unroll
        for (int mt = 0; mt < 2; ++mt) { const int t = r0 + (2 * ih + mt) * 16 + fr;
#pragma unroll
            for (int ct = 0; ct < 6; ++ct) { const int c4 = h * 96 + ct * 16 + 4 * fq; const f32x4 z = acc[mt][ct] * g4[ct] + bi[mt]; const u32x2 uv = uu[mt][ct];
                u32x2 o; o.x = cvt_pk_bf16(bf_lo(uv.x) * z[0], bf_hi(uv.x) * z[1]); o.y = cvt_pk_bf16(bf_lo(uv.y) * z[2], bf_hi(uv.y) * z[3]); *(u32x2*)(Y + (size_t)t * D + 256 + c4) = o; } } }
      __syncthreads(); }
    asm volatile("" : "+v"(tid)); lane = tid & 63;
    for (int mrep = 0; mrep < 1 + ((MIX_REP >> 2) & 1); ++mrep) if (MIX_MASK & 4) { constexpr int HC = 0, TT = 72192, TST = 784;
#ifndef CONV_REP
#define CONV_REP 0
#endif
      for (int crep = 0; crep < 1 + (CONV_REP & 1); ++crep) { u32x4 cvr[9], cgr[9];
#pragma unroll
        for (int i = 0; i < 9; ++i) { const int idx = tid + 512 * i, rr = idx / 48, ch = idx % 48, pos = s0 - 30 + rr; cvr[i] = (u32x4){0u, 0u, 0u, 0u}; cgr[i] = (u32x4){0u, 0u, 0u, 0u};
            if (idx < 94 * 48 && pos >= 0) { const bf16* pr = P + (size_t)(r0 - 30 + rr) * DIN; cvr[i] = *(const u32x4*)(pr + 1024 + ch * 8); cgr[i] = *(const u32x4*)(pr + 1408 + ch * 8); } }
#pragma unroll
        for (int i = 0; i < 9; ++i) { const int idx = tid + 512 * i, rr = idx / 48, ch = idx % 48; float a[8], b[8]; unpack8(cvr[i], a); unpack8(cgr[i], b);
#pragma unroll
            for (int q = 0; q < 8; ++q) a[q] *= fast_sigmoid(b[q]);
            u32x4 o; o.x = cvt_pk_bf16(a[0], a[1]); o.y = cvt_pk_bf16(a[2], a[3]); o.z = cvt_pk_bf16(a[4], a[5]); o.w = cvt_pk_bf16(a[6], a[7]);
            if (idx < 94 * 48) *(LAS u32x4*)(lds + HC + rr * 768 + ch * 16) = o; } }
      __syncthreads();
      asm volatile("" : "+v"(tid)); lane = tid & 63;
      const int fr = lane & 15, fq = lane >> 4; const bf16* pw = (const bf16*)(ws + WS_PWT) + (size_t)layer * DCV * DCV;
      bf16x8 Bp[4][3];
      for (int crep = 0; crep < 1 + ((CONV_REP >> 1) & 1); ++crep) { const float* dww = in[8] + (size_t)layer * 31 * DCV; const float* dwb = in[9] + layer * DCV; const float* lg = in[10] + layer * DCV; const float* lb = in[11] + layer * DCV;
        f32x2 g2[3], bt2[3];
#pragma unroll
        for (int q = 0; q < 3; ++q) { g2[q] = *(const f32x2*)(lg + 128 * q + 2 * lane); bt2[q] = *(const f32x2*)(lb + 128 * q + 2 * lane); }
        float dd[8][6];
#pragma unroll
        for (int q = 0; q < 3; ++q) { const int c = 128 * q + 2 * lane; f32x2 wj[31];
#pragma unroll
            for (int j = 0; j < 31; ++j) wj[j] = *(const f32x2*)(dww + j * DCV + c);
            const f32x2 b2 = *(const f32x2*)(dwb + c); float a0[8], a1[8];
#pragma unroll
            for (int r = 0; r < 8; ++r) { a0[r] = b2[0]; a1[r] = b2[1]; }
#pragma unroll
            for (int s = 0; s < 38; ++s) { const unsigned hv = *(const LAS unsigned*)(lds + HC + (8 * w + s) * 768 + c * 2); const float h0 = bf_lo(hv), h1 = bf_hi(hv);
#pragma unroll
                for (int r = 0; r < 8; ++r) { const int j = s - r; if (j >= 0 && j <= 30) { a0[r] += h0 * wj[j][0]; a1[r] += h1 * wj[j][1]; } } }
#pragma unroll
            for (int r = 0; r < 8; ++r) { dd[r][2 * q] = a0[r]; dd[r][2 * q + 1] = a1[r]; asm volatile("" : "+v"(dd[r][2 * q]), "+v"(dd[r][2 * q + 1])); }
            asm volatile("" ::: "memory"); }
#pragma unroll
        for (int ks = 0; ks < 4; ++ks)
#pragma unroll
            for (int nt = 0; nt < 3; ++nt) Bp[ks][nt] = *(const bf16x8*)(pw + (size_t)((3 * w + nt) * 16 + fr) * DCV + ks * 32 + 8 * fq);
#pragma unroll
        for (int r = 0; r < 8; ++r) { float s = 0.f;
#pragma unroll
            for (int q = 0; q < 6; ++q) s += dd[r][q];
            const float mu = wave_sum(s) * (1.0f / DCV); float v = 0.f;
#pragma unroll
            for (int q = 0; q < 6; ++q) { dd[r][q] -= mu; v += dd[r][q] * dd[r][q]; }
            const float rs = 1.0f / sqrtf(wave_sum(v) * (1.0f / DCV) + EPS);
#pragma unroll
            for (int q = 0; q < 3; ++q) { float y0 = dd[r][2 * q] * rs * g2[q][0] + bt2[q][0], y1 = dd[r][2 * q + 1] * rs * g2[q][1] + bt2[q][1]; y0 *= fast_sigmoid(y0); y1 *= fast_sigmoid(y1);
                *(LAS unsigned*)(lds + TT + (8 * w + r) * TST + (128 * q + 2 * lane) * 2) = cvt_pk_bf16(y0, y1); } } }
      __syncthreads();
      for (int crep = 0; crep < 1 + ((CONV_REP >> 2) & 1); ++crep) { f32x4 acc[4][3];
#pragma unroll
        for (int a = 0; a < 4; ++a)
#pragma unroll
            for (int b = 0; b < 3; ++b) acc[a][b] = (f32x4){0.f, 0.f, 0.f, 0.f};
        const f32x4* pb4 = (const f32x4*)(in[13] + layer * DCV); f32x4 pbv[3];
#pragma unroll
        for (int nt = 0; nt < 3; ++nt) pbv[nt] = pb4[(3 * w + nt) * 4 + fq];
#pragma unroll
        for (int kb = 0; kb < 3; ++kb) { bf16x8 Bn[4][3];
            if (kb < 2) {
#pragma unroll
                for (int ks = 0; ks < 4; ++ks)
#pragma unroll
                    for (int nt = 0; nt < 3; ++nt) Bn[ks][nt] = *(const bf16x8*)(pw + (size_t)((3 * w + nt) * 16 + fr) * DCV + (4 * (kb + 1) + ks) * 32 + 8 * fq); }
#pragma unroll
            for (int ks = 0; ks < 4; ++ks) { bf16x8 A[4];
#pragma unroll
                for (int mt = 0; mt < 4; ++mt) A[mt] = *(const LAS bf16x8*)(lds + TT + (mt * 16 + fr) * TST + ((4 * kb + ks) * 32 + 8 * fq) * 2);
#pragma unroll
                for (int mt = 0; mt < 4; ++mt)
#pragma unroll
                    for (int nt = 0; nt < 3; ++nt) acc[mt][nt] = __builtin_amdgcn_mfma_f32_16x16x32_bf16(Bp[ks][nt], A[mt], acc[mt][nt], 0, 0, 0); }
            if (kb < 2) {
#pragma unroll
                for (int ks = 0; ks < 4; ++ks)
#pragma unroll
                    for (int nt = 0; nt < 3; ++nt) Bp[ks][nt] = Bn[ks][nt]; } }
#pragma unroll
        for (int mt = 0; mt < 4; ++mt)
#pragma unroll
            for (int nt = 0; nt < 3; ++nt) { const int t = r0 + mt * 16 + fr, n4 = (3 * w + nt) * 16 + 4 * fq; const f32x4 v = acc[mt][nt] + pbv[nt];
                u32x2 o; o.x = cvt_pk_bf16(v[0], v[1]); o.y = cvt_pk_bf16(v[2], v[3]); *(u32x2*)(Y + (size_t)t * D + 640 + n4) = o; } }
      __syncthreads(); }
}

__device__ __forceinline__ void router_phase(Frame& F) {
    LAS unsigned char* lds = F.lds; int lane = F.lane; asm volatile("" : "+v"(lane)); const int w = F.wave; unsigned char* ws = F.ws;
    const InTab in = in_tab(F); const bf16* XBr = (const bf16*)(ws + WS_XB); const float* g2 = in[15] + D; const float* R = in[19];
    unsigned* rowoff = (unsigned*)(ws + WS_ROWOFF); float* rs_e = (float*)(ws + WS_RS); float* gate_e = (float*)(ws + WS_GATE); int* sel = (int*)(ws + WS_SEL);
    unsigned* cnt = F.ctl + CW_CNT;
    LAS int* se0 = (LAS int*)lds; LAS int* se1 = se0 + 64; LAS float* sw0 = (LAS float*)(se1 + 64); LAS float* sw1 = sw0 + 64; LAS float* srs = sw1 + 64;
    float Rg[4][4][8];
#pragma unroll
    for (int j = 0; j < 4; ++j)
#pragma unroll
        for (int q = 0; q < 4; ++q) { const int k = 8 * lane + 512 * (j >> 1) + 4 * (j & 1) + q; const float gk = g2[k]; const f32x4 a = *(const f32x4*)(R + k * 8), b = *(const f32x4*)(R + k * 8 + 4);
            Rg[j][q][0] = a[0] * gk; Rg[j][q][1] = a[1] * gk; Rg[j][q][2] = a[2] * gk; Rg[j][q][3] = a[3] * gk; Rg[j][q][4] = b[0] * gk; Rg[j][q][5] = b[1] * gk; Rg[j][q][6] = b[2] * gk; Rg[j][q][7] = b[3] * gk; }
    for (int b = F.vcu; b < M / 64; b += F.G) {
        for (int i = 0; i < 8; ++i) { const int tl = 8 * w + i, t = 64 * b + tl; const u32x4* xr = (const u32x4*)(XBr + (size_t)t * D) + lane; float ss = 0.f, le[8];
#pragma unroll
            for (int e = 0; e < 8; ++e) le[e] = 0.f;
            const u32x4 xa = xr[0], xb2 = xr[64];
#pragma unroll
            for (int j = 0; j < 4; ++j) { const u32x4 xw = (j < 2) ? xa : xb2; const unsigned w0_ = (j & 1) ? xw.z : xw.x, w1_ = (j & 1) ? xw.w : xw.y; const f32x4 v = (f32x4){bf_lo(w0_), bf_hi(w0_), bf_lo(w1_), bf_hi(w1_)};
#pragma unroll
                for (int q = 0; q < 4; ++q) { ss += v[q] * v[q];
#pragma unroll
                    for (int e = 0; e < 8; ++e) le[e] += v[q] * Rg[j][q][e]; } }
            ss = wave_sum(ss);
#pragma unroll
            for (int e = 0; e < 8; ++e) le[e] = wave_sum(le[e]);
            const float rs = 1.0f / sqrtf(ss * (1.0f / D) + EPS);
            int i0 = 0; float l0 = le[0];
#pragma unroll
            for (int e = 1; e < 8; ++e) if (le[e] > l0) { l0 = le[e]; i0 = e; }
            int i1 = -1; float l1 = -3.0e38f;
#pragma unroll
            for (int e = 0; e < 8; ++e) if (e != i0 && le[e] > l1) { l1 = le[e]; i1 = e; }
            const float ex = expf((l1 - l0) * rs), w0 = 1.0f / (1.0f + ex), w1 = ex / (1.0f + ex);
            if (lane == 0) { se0[tl] = i0; se1[tl] = i1; sw0[tl] = w0; sw1[tl] = w1; srs[tl] = rs; } }
        __syncthreads();
        if (w == 0) { const int e0 = se0[lane], e1 = se1[lane]; int r0 = 0, r1 = 0; const unsigned long long lt = (1ull << lane) - 1ull;
#pragma unroll
            for (int e = 0; e < 8; ++e) { const unsigned long long m0 = __ballot(e0 == e), m1 = __ballot(e1 == e); const int n0 = __popcll(m0), n = n0 + __popcll(m1); unsigned base = 0u;
                if (lane == 0 && n > 0) base = __hip_atomic_fetch_add(cnt + 64 * e, (unsigned)n, RLX_AGENT);
                base = __shfl(base, 0);
                if (e0 == e) r0 = (int)base + __popcll(m0 & lt);
                if (e1 == e) r1 = (int)base + n0 + __popcll(m1 & lt); }
            const int t = 64 * b + lane; const float rs = srs[lane];
            rowoff[e0 * ECAP + r0] = (unsigned)t * (unsigned)(D * 2); rs_e[e0 * ECAP + r0] = rs; gate_e[e0 * ECAP + r0] = sw0[lane];
            rowoff[e1 * ECAP + r1] = (unsigned)t * (unsigned)(D * 2); rs_e[e1 * ECAP + r1] = rs; gate_e[e1 * ECAP + r1] = sw1[lane];
            *(int4*)(sel + 4 * t) = make_int4(e0, r0, e1, r1); }
        __syncthreads();
    }
}
__device__ __forceinline__ void moe_panels(Frame& F, int (&pb)[9]) {
    unsigned* cnt = F.ctl + CW_CNT; pb[0] = 0;
#pragma unroll
    for (int e = 0; e < 8; ++e) { const unsigned c = (unsigned)__builtin_amdgcn_readfirstlane(__hip_atomic_load(cnt + 64 * e, RLX_AGENT)); pb[e + 1] = pb[e] + (int)((c + 255u) >> 8); }
}
__device__ __forceinline__ void final_phase(Frame& F) {
    int pb[9]; moe_panels(F, pb);
    const int total = pb[8] * 4, nfull = (total / F.G) * F.G, NPf = nfull / 4, sp = pg8::moe_split(total - nfull, F.G); const bf16* slabs = (const bf16*)(F.ws + WS_SLAB);
    int lane = F.lane; asm volatile("" : "+v"(lane));
    const int gw = F.vcu * 8 + F.wave, NGW = F.G * 8; unsigned char* ws = F.ws;
    const bf16* YP = (const bf16*)(ws + WS_YP); const int* sel = (const int*)(ws + WS_SEL); const float* fg = in_tab(F)[23]; float* X = F.out; const bf16* XBf = (const bf16*)(ws + WS_XB2);
    f32x4 g4[4];
#pragma unroll
    for (int j = 0; j < 4; ++j) g4[j] = *((const f32x4*)fg + lane + 64 * j);
    for (int t = gw; t < M; t += NGW) { const int4 s = *(const int4*)(sel + 4 * t); int b0 = 0, b1 = 0;
#pragma unroll
        for (int e = 0; e < 8; ++e) { b0 = (s.x == e) ? pb[e] : b0; b1 = (s.z == e) ? pb[e] : b1; }
        const int pr[2] = {256 * b0 + s.y, 256 * b1 + s.w};
        const u32x2* xr = (const u32x2*)(XBf + (size_t)t * D) + lane;
        f32x4 v[4];
#pragma unroll
        for (int j = 0; j < 4; ++j) { const u32x2 a = xr[64 * j]; v[j] = (f32x4){bf_lo(a.x), bf_hi(a.x), bf_lo(a.y), bf_hi(a.y)}; }
#pragma unroll
        for (int k = 0; k < 2; ++k) { const int pm = pr[k] >> 8, lr = pr[k] & 255;
            if (sp > 1 && pm >= NPf) {
#pragma unroll
                for (int j = 0; j < 4; ++j) { const bf16* sb = slabs + (size_t)(((pm - NPf) * 4 + j) * sp) * 65536 + lr * 256 + 4 * lane; u32x2 a[14];
#pragma unroll
                    for (int ks = 0; ks < 14; ++ks) { a[ks] = (u32x2){0u, 0u}; if (ks < sp) a[ks] = *(const u32x2*)(sb + (size_t)ks * 65536); }
#pragma unroll
                    for (int ks = 0; ks < 14; ++ks) { v[j][0] += bf_lo(a[ks].x); v[j][1] += bf_hi(a[ks].x); v[j][2] += bf_lo(a[ks].y); v[j][3] += bf_hi(a[ks].y); } }
            } else { const u32x2* y = (const u32x2*)(YP + (size_t)pr[k] * D) + lane;
#pragma unroll
                for (int j = 0; j < 4; ++j) { const u32x2 a = y[64 * j]; v[j][0] += bf_lo(a.x); v[j][1] += bf_hi(a.x); v[j][2] += bf_lo(a.y); v[j][3] += bf_hi(a.y); } } }
        float ss = 0.f;
#pragma unroll
        for (int j = 0; j < 4; ++j) ss += (v[j][0] * v[j][0] + v[j][1] * v[j][1]) + (v[j][2] * v[j][2] + v[j][3] * v[j][3]);
        ss = wave_sum(ss); const float rs = 1.0f / sqrtf(ss * (1.0f / D) + EPS);
        f32x4* o = (f32x4*)(X + (size_t)t * D) + lane;
#pragma unroll
        for (int j = 0; j < 4; ++j) o[64 * j] = v[j] * rs * g4[j]; }
}

struct Args { const float* in[24]; float* out; unsigned char* ws; int ph_lo, ph_hi, li, pad; };
__global__ void __launch_bounds__(512, 2) fwd(Args args) {
    extern __shared__ __attribute__((aligned(16))) unsigned char lds_raw[];
    Frame F;
    F.lds = (LAS unsigned char*)lds_raw; F.MISC = (volatile LAS unsigned*)(F.lds + MISC_OFF);
    F.tid = threadIdx.x; F.lane = F.tid & 63; F.wave = __builtin_amdgcn_readfirstlane(F.tid >> 6);
    F.G = gridDim.x; { const int bx = blockIdx.x; F.vcu = (F.G % 8 == 0) ? (bx % 8) * (F.G / 8) + bx / 8 : bx; }
    F.in.t = (const LAS unsigned long long*)(F.lds + INTAB_OFF); F.out = args.out; F.ws = args.ws; F.ctl = (unsigned*)(args.ws + WS_CTL);
    for (int u = F.tid; u < 64; u += 512) ((LAS unsigned*)(F.lds + MISC_OFF))[u] = 0u;
    if (F.tid < 24) ((LAS unsigned long long*)(F.lds + INTAB_OFF))[F.tid] = (unsigned long long)args.in[F.tid];
    __syncthreads();
    XcdBarrier bar = xcd_barrier_post(F.ctl + CW_BAR + args.li * XCD_BAR_WORDS, F.MISC + 8);
    const int lo = args.ph_lo, hi = args.ph_hi;
#ifndef PH_MASK
#define PH_MASK 0xFFFF
#endif
#define PH_ON(k) (((PH_MASK) >> (k)) & 1)
#ifndef REP_MASK
#define REP_MASK 0
#endif
#define REPS(k) (1 + (((REP_MASK) >> (k)) & 1))
#ifndef PRO_PROBE
#define PRO_PROBE 0
#endif
#ifndef CVT_BEFORE
#define CVT_BEFORE 0
#endif
#ifndef EPI_PROBE
#define EPI_PROBE 0
#endif
#define IN(k) (lo <= (k) && (k) < hi)
#define SEAM(k) do { if (IN(k) && IN((k) + 1)) xcd_barrier(bar); } while (0)
    unsigned char* ws = args.ws; LAS unsigned* gtab = (LAS unsigned*)(F.lds + GTAB_OFF);
    bf16* XB = (bf16*)(ws + WS_XB); float* ssq = (float*)(ws + WS_SSQ);
    if (F.G != 256) return;

    if (PH_ON(0) && IN(0)) for (int rep = 0; rep < REPS(0); ++rep) { p0_prologue(F, rep == 0 ? 0 : PRO_PROBE); __syncthreads(); }
    SEAM(0);
#pragma unroll 1
    for (int layer = 0; layer < 2; ++layer) {
        const int pbase = 1 + layer * 5;
        if (PH_ON(1) && IN(pbase)) for (int rep = 0; rep < REPS(1); ++rep) { pg8::Gemm g{XB, (const bf16*)(ws + WS_WIN) + (size_t)layer * DIN * D, D, 0}; pg8::StaticOrder S; S.init(M, DIN, F.G, (int)blockIdx.x);
            pg8::EpiP E{(bf16*)(ws + WS_P), DIN, ssq}; pg8::gemm_phase<pg8::EpiP, pg8::StaticOrder, true, true>(F.lds, gtab, g, S, E);
            if (rep == 0) tail_convert(F, layer ? H6_BEG : H1_BEG, H1_N, (int)blockIdx.x - 192, 64); }
        SEAM(pbase);
        if (PH_ON(2) && IN(pbase + 1)) for (int rep = 0; rep < REPS(2); ++rep) { for (int u = F.vcu; u < M / 64; u += F.G) mixer_unit(F, u, layer); }
        SEAM(pbase + 1);
        if (PH_ON(3) && IN(pbase + 2)) for (int rep = 0; rep < (layer == 0 ? REPS(3) : 1); ++rep) { pg8::Gemm g{(const bf16*)(ws + WS_Y), (const bf16*)(ws + WS_WOUT) + (size_t)layer * D * D, D, 0}; pg8::StaticOrder S; S.init(M, D, F.G, (int)blockIdx.x);
            pg8::EpiResid E{layer == 0 ? in_tab(F)[0] : (const float*)nullptr, (float*)nullptr, XB, ssq}; pg8::gemm_phase<pg8::EpiResid, pg8::StaticOrder, false, true>(F.lds, gtab, g, S, E); }
        SEAM(pbase + 2);
        if (layer == 0) {
            if (PH_ON(4) && IN(4)) for (int rep = 0; rep < REPS(4); ++rep) { pg8::Gemm g{XB, (const bf16*)(ws + WS_WGU), D, 0}; pg8::StaticOrder S; S.init(M, NGU, F.G, (int)blockIdx.x);
                pg8::EpiSwiglu<false> E{(bf16*)(ws + WS_ACT), DFF, ssq, nullptr, nullptr, 0}; pg8::gemm_phase<pg8::EpiSwiglu<false>, pg8::StaticOrder, true, true>(F.lds, gtab, g, S, E);
                if (rep == 0) tail_convert(F, H4_BEG, H4_N, (int)blockIdx.x - 128, 128); }
            SEAM(4);
            if (PH_ON(5) && IN(5)) { pg8::Gemm g{(const bf16*)(ws + WS_ACT), (const bf16*)(ws + WS_WD), DFF, 0}; pg8::StaticOrder S; S.init(M, D, F.G, (int)blockIdx.x);
                pg8::EpiResid E{(const float*)nullptr, (float*)nullptr, XB, ssq}; pg8::gemm_phase<pg8::EpiResid, pg8::StaticOrder, false, true>(F.lds, gtab, g, S, E); }
            SEAM(5);
        }
    }
    if (PH_ON(9) && IN(9)) router_phase(F);
    SEAM(9);
    if (PH_ON(10) && IN(10)) for (int rep = 0; rep < REPS(10); ++rep) { pg8::MoeOrderGather S; moe_panels(F, S.pb); S.nN = NGUE / 256; S.nwg = S.pb[8] * S.nN; S.G = F.G; S.c = (int)blockIdx.x; S.rowoff = (const unsigned*)(ws + WS_ROWOFF);
        pg8::Gemm g{XB, (const bf16*)(ws + WS_MOE_WGU), D, (size_t)NGUE * D};
        pg8::EpiSwiglu<true> E{(bf16*)(ws + WS_ACTM), DFE, nullptr, (const float*)(ws + WS_RS), (const float*)(ws + WS_GATE), rep == 0 ? 0 : EPI_PROBE};
        pg8::gemm_phase<pg8::EpiSwiglu<true>, pg8::MoeOrderGather, true, true>(F.lds, gtab, g, S, E);
        if (rep == 0) tail_convert(F, H10_BEG, H10_N, ((int)blockIdx.x - (S.nwg % F.G) + F.G) % F.G, H10_WG); }
    SEAM(10);
    if (PH_ON(11) && IN(11)) for (int rep = 0; rep < REPS(11); ++rep) { pg8::MoeOrderDown S; moe_panels(F, S.pb); S.init(F.G, (int)blockIdx.x);
        pg8::Gemm g{(const bf16*)(ws + WS_ACTM), (const bf16*)(ws + WS_MOE_WD), DFE, (size_t)D * DFE};
        pg8::EpiBf16 E{(bf16*)(ws + WS_YP), D, (bf16*)(ws + WS_SLAB)};
        pg8::gemm_phase<pg8::EpiBf16, pg8::MoeOrderDown, true, true>(F.lds, gtab, g, S, E); }
    SEAM(11);
    if (PH_ON(12) && IN(12)) final_phase(F);
#undef IN
#undef SEAM
}
#ifndef MK_PER_PHASE
#define MK_PER_PHASE 0
#endif
extern "C" void kernel_launch(void* const* d_in, const int* in_sizes, int n_in, void* d_out, int out_size, void* d_ws, size_t ws_size, hipStream_t stream) {
    static int grid = 0;
    if (grid == 0) {
        if (n_in != 24 || out_size != M * D || ws_size < WS_END) { fprintf(stderr, "kernel_launch: unexpected shapes (n_in %d out %d ws %zu)\n", n_in, out_size, ws_size); grid = -1; return; }
        int dev = 0, cus = 0;
        if (hipGetDevice(&dev) != hipSuccess || hipDeviceGetAttribute(&cus, hipDeviceAttributeMultiprocessorCount, dev) != hipSuccess) { grid = -1; return; }
        if (hipFuncSetAttribute((const void*)fwd, hipFuncAttributeMaxDynamicSharedMemorySize, LDS_BYTES) != hipSuccess) { fprintf(stderr, "kernel_launch: hipFuncSetAttribute failed\n"); grid = -1; return; }
        int per_cu = 0;
        if (hipOccupancyMaxActiveBlocksPerMultiprocessor(&per_cu, (const void*)fwd, 512, LDS_BYTES) != hipSuccess || per_cu < 1) fprintf(stderr, "kernel_launch: occupancy query says %d\n", per_cu);
        (void)hipGetLastError();
        grid = cus;
        if (grid != 256) { fprintf(stderr, "kernel_launch: built for 256 CUs, found %d\n", grid); grid = -1; return; }
    }
    if (grid < 0) return;
    (void)hipMemsetAsync((char*)d_ws + WS_CTL, 0, CTL_ZERO_BYTES, stream);
    Args a{};
    for (int i = 0; i < 24; ++i) a.in[i] = (const float*)d_in[i];
    a.out = (float*)d_out; a.ws = (unsigned char*)d_ws; a.pad = 0;
#if MK_PER_PHASE
    for (int p = 0; p < NPHASE; ++p) { a.ph_lo = p; a.ph_hi = p + 1; a.li = p; hipLaunchKernelGGL(fwd, dim3(grid), dim3(512), LDS_BYTES, stream, a); }
#else
    a.ph_lo = 0; a.ph_hi = NPHASE; a.li = 0; hipLaunchKernelGGL(fwd, dim3(grid), dim3(512), LDS_BYTES, stream, a);
#endif
}
```

```cpp
#define MK_PER_PHASE 0
#define PG_WGM 4
#define NT_ACT 1
#define HID_PW 8
#define H10_SHARE 11264
#include <hip/hip_runtime.h>
#include <cstdio>
#include <cstdint>
constexpr int M = 16384, D = 1024, SEQ = 8192, DIN = 1792, DFF = 2816, DFE = 3584, NE = 8;
constexpr int DPOOL = 256, DGM = 384, DCV = 384;
constexpr int NGU = 2 * DFF, NGUE = 2 * DFE;
constexpr int ECAP = 16384;
constexpr int PMAX = 2 * M + NE * 256;
constexpr float EPS = 1e-6f;

#define LAS __attribute__((address_space(3)))
#define GAS __attribute__((address_space(1)))
typedef unsigned short bf16;
typedef short bf16x8 __attribute__((ext_vector_type(8)));
typedef short s16x4 __attribute__((ext_vector_type(4)));
typedef float f32x4 __attribute__((ext_vector_type(4)));
typedef float f32x2 __attribute__((ext_vector_type(2)));
typedef unsigned u32x4 __attribute__((ext_vector_type(4)));
typedef unsigned u32x2 __attribute__((ext_vector_type(2)));

__device__ __forceinline__ unsigned cvt_pk_bf16(float lo, float hi) { unsigned r; asm volatile("v_cvt_pk_bf16_f32 %0, %1, %2" : "=v"(r) : "v"(lo), "v"(hi)); return r; }
__device__ __forceinline__ float bf_lo(unsigned w) { return __uint_as_float(w << 16); }
__device__ __forceinline__ float bf_hi(unsigned w) { return __uint_as_float(w & 0xffff0000u); }
__device__ __forceinline__ float fast_sigmoid(float x) { return __builtin_amdgcn_rcpf(1.0f + __builtin_amdgcn_exp2f(-1.4426950408889634f * x)); }
template <int CTRL> __device__ __forceinline__ float dpp_f(float v) { return __int_as_float(__builtin_amdgcn_update_dpp(0, __float_as_int(v), CTRL, 0xF, 0xF, true)); }
__device__ __forceinline__ float wave_sum(float v) {
    v += dpp_f<0xB1>(v); v += dpp_f<0x4E>(v); v += dpp_f<0x141>(v); v += dpp_f<0x140>(v);
    const int iv = __float_as_int(v);
    return (__int_as_float(__builtin_amdgcn_readlane(iv, 0)) + __int_as_float(__builtin_amdgcn_readlane(iv, 16))) + (__int_as_float(__builtin_amdgcn_readlane(iv, 32)) + __int_as_float(__builtin_amdgcn_readlane(iv, 48)));
}

#ifndef NT_ACT2
#define NT_ACT2 0
#endif
#ifndef PG_WGM
#define PG_WGM 8
#endif
namespace pg8 {
constexpr int BM = 256, BK = 64, HALF = 128, HTB = HALF * BK * 2, STAGE_BYTES = 8 * HTB, NXCD = 8, WGM = PG_WGM;
__host__ __device__ __forceinline__ int lds_byte(int r, int c) { const int st = (r >> 4) * 2 + (c >> 5), rr = r & 15, cc = c & 31, ob = rr * 64 + cc * 2; return st * 1024 + (ob ^ (((ob >> 9) & 1) << 5)); }
__host__ __device__ __forceinline__ void stage_rc(int b, int& R, int& C) { const int st = b / 1024, sb = b % 1024, swz = sb ^ (((sb >> 9) & 1) << 5); R = (st >> 1) * 16 + swz / 64; C = (st & 1) * 32 + (swz % 64) / 2; }
__host__ __device__ __forceinline__ int perm32(int rho) { const int n = rho >> 4, i = rho & 15; return 8 * (i >> 2) + 4 * n + (i & 3); }

struct Unit { int pm, pn, e, tab, k0b, nt, slab, ui; };
struct Gemm { const bf16* A; const bf16* Bt; int K; size_t bstride_e; };

__device__ __forceinline__ void order_map(int wgid, int nM, int nN, int& pm, int& pn) {
    const int nwg = nM * nN; { const int q = nwg / NXCD, r = nwg % NXCD, xcd = wgid % NXCD, off = wgid / NXCD; wgid = (xcd < r ? xcd * (q + 1) : r * (q + 1) + (xcd - r) * q) + off; }
    const int nig = WGM * nN, gid = wgid / nig, fm = gid * WGM, gsz = (nM - fm) < WGM ? (nM - fm) : WGM;
    pm = fm + ((wgid % nig) % gsz); pn = (wgid % nig) / gsz;
}
struct StaticOrder {
    static constexpr bool GATHER = false;
    int nM, nN, nwg, G, c;
    __device__ void init(int Mrows, int N, int G_, int c_) { nM = Mrows / BM; nN = N / BM; nwg = nM * nN; G = G_; c = c_; }
    __device__ __forceinline__ bool next(int i, Unit& u) const { const long L = (long)i * G + c; if (L >= nwg) return false; order_map((int)L, nM, nN, u.pm, u.pn); u.e = 0; u.tab = i * 256; u.k0b = 0; u.nt = 0; u.slab = -1; return true; }
    __device__ __forceinline__ const unsigned* a_table(const Unit&) const { return nullptr; }
    __device__ __forceinline__ const float* rs_table(const Unit&) const { return nullptr; }
    __device__ __forceinline__ const float* gate_table(const Unit&) const { return nullptr; }
};
struct MoeOrder {
    int pb[9]; int nN, nwg, G, c; const unsigned* rowoff; const float* rs_e; const float* gate_e;
    __device__ __forceinline__ bool next(int i, Unit& u) const {
        const long L = (long)i * G + c; if (L >= nwg) return false; order_map((int)L, pb[8], nN, u.pm, u.pn); u.k0b = 0; u.nt = 0; u.slab = -1;
        int e = 0;
#pragma unroll
        for (int k = 1; k < 8; ++k) e += (u.pm >= pb[k]) ? 1 : 0;
        int pbe = pb[0];
#pragma unroll
        for (int k = 1; k < 8; ++k) pbe = (e == k) ? pb[k] : pbe;
        u.e = e; u.tab = e * ECAP + 256 * (u.pm - pbe); return true;
    }
    __device__ __forceinline__ const unsigned* a_table(const Unit& u) const { return rowoff + u.tab; }
    __device__ __forceinline__ const float* rs_table(const Unit& u) const { return rs_e + u.tab; }
    __device__ __forceinline__ const float* gate_table(const Unit& u) const { return gate_e + u.tab; }
};
struct MoeOrderGather : MoeOrder { static constexpr bool GATHER = true; };
#ifndef FORCE_SPLIT
#define FORCE_SPLIT 0
#endif
__host__ __device__ __forceinline__ int moe_split(int r, int G) { if (FORCE_SPLIT) return r == 0 ? 1 : FORCE_SPLIT;
    return r == 0 ? 1 : (r * 14 <= G ? 14 : (r * 7 <= G ? 7 : (r * 4 <= G ? 4 : (r * 2 <= G ? 2 : 1)))); }
struct MoeOrderDown {
    static constexpr bool GATHER = false;
    int pb[9]; int G, c, NPf, nfull, r, s;
    __device__ __forceinline__ void init(int G_, int c_) { G = G_; c = c_; const int total = pb[8] * 4; nfull = (total / G) * G; NPf = nfull / 4; r = total - nfull; s = moe_split(r, G); }
    __device__ __forceinline__ bool next(int i, Unit& u) const {
        const int L = i * G + c; u.tab = 0;
        if (L < nfull) { order_map(L, NPf, 4, u.pm, u.pn); u.k0b = 0; u.nt = 0; u.slab = -1; }
        else { const int j = L - nfull; if (j >= r * s) return false; const int lu = j / s, ks = j - lu * s; u.pm = NPf + (lu >> 2); u.pn = lu & 3; u.nt = (DFE / BK) / s; u.k0b = ks * u.nt * BK * 2; u.slab = s > 1 ? j : -1; }
        int e = 0;
#pragma unroll
        for (int k = 1; k < 8; ++k) e += (u.pm >= pb[k]) ? 1 : 0;
        u.e = e; return true;
    }
    __device__ __forceinline__ const unsigned* a_table(const Unit&) const { return nullptr; }
    __device__ __forceinline__ const float* rs_table(const Unit&) const { return nullptr; }
    __device__ __forceinline__ const float* gate_table(const Unit&) const { return nullptr; }
};

__device__ __forceinline__ float rstd_of(const float* ssq, int row) { const float s = (ssq[row] + ssq[M + row]) + (ssq[2 * M + row] + ssq[3 * M + row]); return 1.0f / sqrtf(s * (1.0f / D) + EPS); }

struct EpiP {
    static constexpr bool PERM = true, AFTER_DRAIN = false; static constexpr int NSTORE = 16;
    bf16* O; int ldc; const LAS float* rtab;
    __device__ __forceinline__ void operator()(const f32x4 (&acc)[2][2][4][2], const Unit& u, int wr, int wc, int fr, int fq) const {
        const int row0 = u.pm * BM + wr * 64 + fr, col0 = u.pn * BM + wc * 32 + 8 * fq;
#pragma unroll
        for (int ai = 0; ai < 2; ++ai)
#pragma unroll
            for (int m = 0; m < 4; ++m) { const int row = row0 + ai * HALF + m * 16; const float rs = rtab[u.tab + wr * 64 + fr + ai * HALF + m * 16]; bf16* rowp = O + (size_t)row * ldc + col0;
#pragma unroll
                for (int bj = 0; bj < 2; ++bj) { const f32x4 v0 = acc[ai][bj][m][0] * rs, v1 = acc[ai][bj][m][1] * rs;
                    u32x4 w; w.x = cvt_pk_bf16(v0[0], v0[1]); w.y = cvt_pk_bf16(v0[2], v0[3]); w.z = cvt_pk_bf16(v1[0], v1[1]); w.w = cvt_pk_bf16(v1[2], v1[3]);
                    if (NT_ACT2) __builtin_nontemporal_store(w, (u32x4*)(rowp + bj * HALF)); else *(u32x4*)(rowp + bj * HALF) = w; } }
    }
};
#ifndef NT_ACT
#define NT_ACT 0
#endif
#ifndef ACT_AUX
#define ACT_AUX -1
#endif
template <bool MOE> struct EpiSwiglu {
    static constexpr bool PERM = true, AFTER_DRAIN = false; static constexpr int NSTORE = 8;
    bf16* O; int ldc; const LAS float* rtab; int mode;
    __device__ __forceinline__ void operator()(const f32x4 (&acc)[2][2][4][2], const Unit& u, int wr, int wc, int fr, int fq) const {
        if (mode == 2) { asm volatile("" :: "v"(acc[0][0][0][0][0]), "v"(acc[1][1][3][1][3])); return; }
        const int lr0 = wr * 64 + fr, col0 = u.pn * HALF + wc * 32 + 8 * fq;
#pragma unroll
        for (int ai = 0; ai < 2; ++ai)
#pragma unroll
            for (int m = 0; m < 4; ++m) { const int lr = lr0 + ai * HALF + m * 16, row = u.pm * BM + lr; float rs, gw;
                if (MOE) { rs = rtab[(u.ui & 1) * 512 + lr]; gw = rtab[(u.ui & 1) * 512 + 256 + lr]; } else { rs = rtab[u.tab + lr]; gw = 1.0f; }
                float o[8]; const float c1 = rs * -1.4426950408889634f, c2 = rs * rs * gw;
#pragma unroll
                for (int n = 0; n < 2; ++n) { const f32x4 ga = acc[ai][0][m][n], gu = ga * acc[ai][1][m][n] * c2, ex = ga * c1;
#pragma unroll
                    for (int q = 0; q < 4; ++q) o[n * 4 + q] = gu[q] * __builtin_amdgcn_rcpf(1.0f + __builtin_amdgcn_exp2f(ex[q])); }
                u32x4 w; w.x = cvt_pk_bf16(o[0], o[1]); w.y = cvt_pk_bf16(o[2], o[3]); w.z = cvt_pk_bf16(o[4], o[5]); w.w = cvt_pk_bf16(o[6], o[7]);
                if (mode == 1) { asm volatile("" :: "v"(w.x), "v"(w.y), "v"(w.z), "v"(w.w)); } else if (ACT_AUX == 16) { bf16* ap = O + (size_t)row * ldc + col0; asm volatile("global_store_dwordx4 %0, %1, off sc1\n\ts_nop 1" :: "v"(ap), "v"(w) : "memory"); } else if (ACT_AUX == 18) { bf16* ap = O + (size_t)row * ldc + col0; asm volatile("global_store_dwordx4 %0, %1, off sc1 nt\n\ts_nop 1" :: "v"(ap), "v"(w) : "memory"); } else if (NT_ACT) __builtin_nontemporal_store(w, (u32x4*)(O + (size_t)row * ldc + col0)); else *(u32x4*)(O + (size_t)row * ldc + col0) = w; }
    }
};
struct EpiBf16 {
    static constexpr bool PERM = true, AFTER_DRAIN = false; static constexpr int NSTORE = 16;
    bf16* O; int ldc; bf16* slabs;
    __device__ __forceinline__ void operator()(const f32x4 (&acc)[2][2][4][2], const Unit& u, int wr, int wc, int fr, int fq) const {
        const bool sl = u.slab >= 0; bf16* base = sl ? slabs + (size_t)u.slab * (BM * BM) : O; const int ld = sl ? BM : ldc;
        const int row0 = (sl ? 0 : u.pm * BM) + wr * 64 + fr, col0 = (sl ? 0 : u.pn * BM) + wc * 32 + 8 * fq;
#pragma unroll
        for (int ai = 0; ai < 2; ++ai)
#pragma unroll
            for (int m = 0; m < 4; ++m) { bf16* rowp = base + (size_t)(row0 + ai * HALF + m * 16) * ld + col0;
#pragma unroll
                for (int bj = 0; bj < 2; ++bj) { const f32x4 v0 = acc[ai][bj][m][0], v1 = acc[ai][bj][m][1];
                    u32x4 w; w.x = cvt_pk_bf16(v0[0], v0[1]); w.y = cvt_pk_bf16(v0[2], v0[3]); w.z = cvt_pk_bf16(v1[0], v1[1]); w.w = cvt_pk_bf16(v1[2], v1[3]);
                    if (NT_ACT2) __builtin_nontemporal_store(w, (u32x4*)(rowp + bj * HALF)); else *(u32x4*)(rowp + bj * HALF) = w; } }
    }
};
struct EpiResid {
    static constexpr bool PERM = true, AFTER_DRAIN = true; static constexpr int NSTORE = 0;
    const float* xold32; bf16* XB; float* ssq;
    __device__ __forceinline__ void fused(f32x4 (&acc)[2][2][4][2], const Unit& u, int wr, int wc, int fr, int fq, LAS unsigned char* lds, int wid, int lane) const {
        LAS float* Pt = (LAS float*)lds;
        const int col0 = u.pn * BM + wc * 32 + 8 * fq;
#pragma unroll
        for (int ai = 0; ai < 2; ++ai)
#pragma unroll
            for (int m = 0; m < 4; ++m) { const int r = ai * HALF + wr * 64 + m * 16 + fr; const size_t off = (size_t)(u.pm * BM + r) * D + col0; float s = 0.f;
#pragma unroll
                for (int bj = 0; bj < 2; ++bj) { f32x4 b0, b1;
                    if (xold32) { b0 = *(const f32x4*)(xold32 + off + bj * HALF); b1 = *(const f32x4*)(xold32 + off + bj * HALF + 4); }
                    else { const u32x4 w = *(const u32x4*)(XB + off + bj * HALF); b0 = (f32x4){bf_lo(w.x), bf_hi(w.x), bf_lo(w.y), bf_hi(w.y)}; b1 = (f32x4){bf_lo(w.z), bf_hi(w.z), bf_lo(w.w), bf_hi(w.w)}; }
                    const f32x4 o0 = b0 + acc[ai][bj][m][0], o1 = b1 + acc[ai][bj][m][1];
                    u32x4 w; w.x = cvt_pk_bf16(o0[0], o0[1]); w.y = cvt_pk_bf16(o0[2], o0[3]); w.z = cvt_pk_bf16(o1[0], o1[1]); w.w = cvt_pk_bf16(o1[2], o1[3]); *(u32x4*)(XB + off + bj * HALF) = w;
                    s += ((o0[0] * o0[0] + o0[1] * o0[1]) + (o0[2] * o0[2] + o0[3] * o0[3])) + ((o1[0] * o1[0] + o1[1] * o1[1]) + (o1[2] * o1[2] + o1[3] * o1[3])); }
                s += __shfl_xor(s, 16); s += __shfl_xor(s, 32);
                if (fq == 0) Pt[r * 4 + wc] = s; }
        __syncthreads();
        const int t = wid * 64 + lane;
        if (t < 256) { const float s = (Pt[t * 4 + 0] + Pt[t * 4 + 1]) + (Pt[t * 4 + 2] + Pt[t * 4 + 3]); ssq[(size_t)u.pn * M + u.pm * BM + t] = s; }
        __syncthreads();
    }
};

template <class Epi, class Sched, bool ALIGN_EPI = false, bool SP2 = true>
__device__ __forceinline__ void gemm_phase(LAS unsigned char* lds, LAS unsigned* gtab, const Gemm g, const Sched& S, const Epi& E) {
    constexpr bool GATHER = Sched::GATHER;
    static_assert(!GATHER || SP2, "gather needs the SP2 loop (lgkmcnt(0) waits only)");
    int tid_ = threadIdx.x; asm volatile("" : "+v"(tid_));
    const int tid = tid_, wid = __builtin_amdgcn_readfirstlane(tid >> 6), lane = tid & 63, wr = wid >> 2, wc = wid & 3, fr = lane & 15, fq = lane >> 4;
    const int K = g.K; int nt = K / BK;
    unsigned voffA[2], voffB[2];
#pragma unroll
    for (int i = 0; i < 2; ++i) { int R, C; stage_rc(tid * 16 + i * 8192, R, C); const int Rb = Epi::PERM ? ((R & ~31) + perm32(R & 31)) : R;
        voffA[i] = (unsigned)(R * K + C) * 2u; voffB[i] = (unsigned)(Rb * K + C) * 2u; }
    const size_t kstep = (size_t)(BK * 2);
    const size_t hstep = (size_t)HALF * K * 2;
    const size_t tstep = 2 * hstep;
    const unsigned ldsw = (unsigned)wid * 1024u;
    const int aoff = lds_byte(wr * 64 + fr, fq * 8), boff = lds_byte(wc * 32 + fr, fq * 8);
#define PG8_SA(b, h) (((b) * 2 + (h)) * HTB)
#define PG8_SB(b, h) ((4 + (b) * 2 + (h)) * HTB)
#define PG8_STAGE(bufoff, gbase, voff) do { _Pragma("unroll") for (int _i = 0; _i < 2; ++_i) \
        __builtin_amdgcn_global_load_lds((const unsigned*)((const char*)(gbase) + (voff)[_i]), (LAS unsigned*)(lds + (bufoff) + ldsw + _i * 8192), 16, 0, 0); } while (0)
#define PG8_STAGE_A(bufoff, ubase, kb, h) do { if constexpr (GATHER) { PG8_STAGE(bufoff, (const char*)g.A + (kb), ga[h]); } else { PG8_STAGE(bufoff, (ubase) + (size_t)(h) * hstep + (kb), voffA); } } while (0)
#define PG8_LDA(dst, b, h) do { _Pragma("unroll") for (int m = 0; m < 4; ++m) _Pragma("unroll") for (int k = 0; k < 2; ++k) dst[m][k] = *(const LAS bf16x8*)(lds + PG8_SA(b, h) + aoff + m * 2048 + k * 1024); } while (0)
#define PG8_LDB(dst, b, h) do { _Pragma("unroll") for (int n = 0; n < 2; ++n) _Pragma("unroll") for (int k = 0; k < 2; ++k) dst[n][k] = *(const LAS bf16x8*)(lds + PG8_SB(b, h) + boff + n * 2048 + k * 1024); } while (0)
#define PG8_MMA(ai, bj, At, Bt) do { __builtin_amdgcn_s_setprio(1); _Pragma("unroll") for (int m = 0; m < 4; ++m) _Pragma("unroll") for (int n = 0; n < 2; ++n) _Pragma("unroll") for (int k = 0; k < 2; ++k) \
        acc[ai][bj][m][n] = __builtin_amdgcn_mfma_f32_16x16x32_bf16(Bt[n][k], At[m][k], acc[ai][bj][m][n], 0, 0, 0); __builtin_amdgcn_s_setprio(0); } while (0)
#define PG8_WAIT_V(n) asm volatile("s_waitcnt vmcnt(" #n ")" ::: "memory")
#define PG8_WAIT_L(n) asm volatile("s_waitcnt lgkmcnt(" #n ")" ::: "memory")
#ifndef SEAM_RELAX
#define SEAM_RELAX 1
#endif
#define PG8_WAIT_VS() do { const int _rl = __builtin_amdgcn_readfirstlane((t == 0 && ui > 0) ? 1 : 0); if constexpr (SEAM_RELAX && Epi::NSTORE == 8) asm volatile("s_waitcnt vmcnt(16)\n\ts_cmp_lg_u32 %0, 0\n\ts_cbranch_scc1 .Lrelax%=\n\ts_waitcnt vmcnt(8)\n.Lrelax%=:" :: "s"(_rl) : "memory", "scc"); \
        else if constexpr (SEAM_RELAX && Epi::NSTORE == 16) asm volatile("s_waitcnt vmcnt(24)\n\ts_cmp_lg_u32 %0, 0\n\ts_cbranch_scc1 .Lrelax%=\n\ts_waitcnt vmcnt(8)\n.Lrelax%=:" :: "s"(_rl) : "memory", "scc"); else PG8_WAIT_V(8); } while (0)
#define PG8_BAR __builtin_amdgcn_s_barrier()
#define PG8_SCHED __builtin_amdgcn_sched_barrier(0)
#define PG8_GTAB_DMA(un, slot) do { if (wid < 4) { __builtin_amdgcn_global_load_lds(S.a_table(un) + wid * 64 + lane, (LAS unsigned*)(gtab + (slot) * 256 + wid * 64), 4, 0, 0); \
            __builtin_amdgcn_global_load_lds((const unsigned*)S.gate_table(un) + wid * 64 + lane, (LAS unsigned*)(gtab + 512 + (slot) * 512 + 256 + wid * 64), 4, 0, 0); } \
        else __builtin_amdgcn_global_load_lds((const unsigned*)S.rs_table(un) + (wid - 4) * 64 + lane, (LAS unsigned*)(gtab + 512 + (slot) * 512 + (wid - 4) * 64), 4, 0, 0); } while (0)
#define PG8_GTAB_READ(dst, slot) do { _Pragma("unroll") for (int _i = 0; _i < 2; ++_i) { int _R, _C; stage_rc(tid * 16 + _i * 8192, _R, _C); _Pragma("unroll") for (int _h = 0; _h < 2; ++_h) dst[_h][_i] = gtab[(slot) * 256 + _h * HALF + _R] + (unsigned)_C * 2u; } } while (0)
    Unit cur, nxt; int ui = 0;
    if (!S.next(0, cur)) return;
    f32x4 acc[2][2][4][2];
#pragma unroll
    for (int a = 0; a < 2; ++a)
#pragma unroll
        for (int b = 0; b < 2; ++b)
#pragma unroll
            for (int m = 0; m < 4; ++m)
#pragma unroll
                for (int n = 0; n < 2; ++n) acc[a][b][m][n] = (f32x4){0.f, 0.f, 0.f, 0.f};
    bf16x8 At[4][2], B0[2][2], B1[2][2];
    unsigned ga[2][2];
    if (cur.nt) nt = cur.nt;
    const char* cA = (const char*)g.A + (GATHER ? (size_t)0 : (size_t)cur.pm * tstep + cur.k0b); const char* cB = (const char*)g.Bt + ((size_t)cur.e * g.bstride_e) * 2 + (size_t)cur.pn * tstep + cur.k0b;
    if constexpr (GATHER) { PG8_GTAB_DMA(cur, 0); PG8_WAIT_V(0); PG8_BAR; PG8_GTAB_READ(ga, 0); }
    if constexpr (SP2) {
        PG8_STAGE(PG8_SB(0, 0), cB, voffB); PG8_STAGE(PG8_SB(0, 1), cB + hstep, voffB); PG8_STAGE_A(PG8_SA(0, 0), cA, 0, 0); PG8_STAGE_A(PG8_SA(0, 1), cA, 0, 1);
        if (wr == 1) PG8_BAR;
        PG8_WAIT_V(2); PG8_BAR;
        PG8_STAGE(PG8_SB(1, 0), cB + kstep, voffB); PG8_STAGE_A(PG8_SA(1, 0), cA, kstep, 0); PG8_STAGE(PG8_SB(1, 1), cB + hstep + kstep, voffB);
        PG8_WAIT_V(6); PG8_BAR;
    } else {
        PG8_STAGE(PG8_SB(0, 0), cB, voffB); PG8_STAGE_A(PG8_SA(0, 0), cA, 0, 0); PG8_STAGE(PG8_SB(0, 1), cB + hstep, voffB); PG8_STAGE_A(PG8_SA(0, 1), cA, 0, 1);
        if (wr == 1) PG8_BAR;
        PG8_WAIT_V(4); PG8_BAR;
        PG8_STAGE(PG8_SB(1, 0), cB + kstep, voffB); PG8_STAGE_A(PG8_SA(1, 0), cA, kstep, 0); PG8_STAGE(PG8_SB(1, 1), cB + hstep + kstep, voffB);
        PG8_WAIT_V(6); PG8_BAR;
    }
    for (;;) {
        const bool has_next = S.next(ui + 1, nxt);
        const char* nA = (has_next && !GATHER) ? (const char*)g.A + (size_t)nxt.pm * tstep + nxt.k0b : cA;
        const char* nB = has_next ? (const char*)g.Bt + ((size_t)nxt.e * g.bstride_e) * 2 + (size_t)nxt.pn * tstep + nxt.k0b : cB;
        for (int t = 0; t < nt; t += 2) {
            const bool last = (t == nt - 2);
            const size_t k1 = (size_t)(t + 1) * kstep;
            const char* a2 = last ? nA : cA; const size_t k2 = last ? 0 : (size_t)(t + 2) * kstep;
            const char* b2 = last ? nB : cB + (size_t)(t + 2) * kstep; const char* b3 = b2 + kstep;
            const size_t k3 = k2 + kstep;
            if constexpr (GATHER) {
                if (t == nt - 4 && has_next) PG8_GTAB_DMA(nxt, (ui + 1) & 1);
            }
            if constexpr (SP2) {
            PG8_LDB(B0, 0, 0); PG8_LDB(B1, 0, 1); PG8_SCHED; PG8_LDA(At, 0, 0); PG8_STAGE_A(PG8_SA(1, 1), cA, k1, 1);
            if constexpr (GATHER) { if (last && has_next) PG8_GTAB_READ(ga, (ui + 1) & 1); }
            PG8_WAIT_VS(); PG8_WAIT_L(0); PG8_BAR; PG8_MMA(0, 0, At, B0); PG8_MMA(0, 1, At, B1); PG8_BAR; PG8_SCHED;
            PG8_LDA(At, 0, 1); PG8_STAGE(PG8_SB(0, 0), b2, voffB); PG8_STAGE(PG8_SB(0, 1), b2 + hstep, voffB); PG8_STAGE_A(PG8_SA(0, 0), a2, k2, 0);
            PG8_WAIT_VS(); PG8_WAIT_L(0); PG8_BAR; PG8_MMA(1, 0, At, B0); PG8_MMA(1, 1, At, B1); PG8_BAR; PG8_SCHED;
            PG8_LDB(B0, 1, 0); PG8_LDB(B1, 1, 1); PG8_SCHED; PG8_LDA(At, 1, 0); PG8_STAGE_A(PG8_SA(0, 1), a2, k2, 1);
            PG8_WAIT_V(8); PG8_WAIT_L(0); PG8_BAR; PG8_MMA(0, 0, At, B0); PG8_MMA(0, 1, At, B1); PG8_BAR; PG8_SCHED;
            PG8_LDA(At, 1, 1); PG8_STAGE(PG8_SB(1, 0), b3, voffB); PG8_STAGE(PG8_SB(1, 1), b3 + hstep, voffB); PG8_STAGE_A(PG8_SA(1, 0), a2, k3, 0);
            PG8_WAIT_V(8); PG8_WAIT_L(0); PG8_BAR; PG8_MMA(1, 0, At, B0); PG8_MMA(1, 1, At, B1); PG8_BAR; PG8_SCHED;
            } else {
            PG8_LDB(B0, 0, 0); PG8_SCHED; PG8_LDA(At, 0, 0); PG8_STAGE_A(PG8_SA(1, 1), cA, k1, 1);
            PG8_WAIT_L(8); PG8_BAR; PG8_WAIT_L(0); PG8_MMA(0, 0, At, B0); PG8_BAR; PG8_SCHED;
            PG8_LDB(B1, 0, 1); PG8_STAGE(PG8_SB(0, 0), b2, voffB);
            PG8_BAR; PG8_WAIT_L(0); PG8_MMA(0, 1, At, B1); PG8_BAR;
            PG8_LDA(At, 0, 1); PG8_STAGE_A(PG8_SA(0, 0), a2, k2, 0);
            PG8_BAR; PG8_WAIT_L(0); PG8_MMA(1, 0, At, B0); PG8_BAR; PG8_SCHED;
            PG8_STAGE(PG8_SB(0, 1), b2 + hstep, voffB);
            PG8_WAIT_V(6); PG8_BAR; PG8_MMA(1, 1, At, B1); PG8_BAR;
            PG8_LDB(B0, 1, 0); PG8_SCHED; PG8_LDA(At, 1, 0); PG8_STAGE_A(PG8_SA(0, 1), a2, k2, 1);
            PG8_WAIT_L(8); PG8_BAR; PG8_WAIT_L(0); PG8_MMA(0, 0, At, B0); PG8_BAR; PG8_SCHED;
            PG8_LDB(B1, 1, 1); PG8_STAGE(PG8_SB(1, 0), b3, voffB);
            PG8_BAR; PG8_WAIT_L(0); PG8_MMA(0, 1, At, B1); PG8_BAR;
            PG8_LDA(At, 1, 1); PG8_STAGE_A(PG8_SA(1, 0), a2, k3, 0);
            PG8_BAR; PG8_WAIT_L(0); PG8_MMA(1, 0, At, B0); PG8_BAR; PG8_SCHED;
            PG8_STAGE(PG8_SB(1, 1), b3 + hstep, voffB);
            PG8_WAIT_V(6); PG8_BAR; PG8_MMA(1, 1, At, B1); PG8_BAR;
            }
        }
        if constexpr (ALIGN_EPI) { if (wr == 0) PG8_BAR; }
        cur.ui = ui;
        if constexpr (!Epi::AFTER_DRAIN) { E(acc, cur, wr, wc, fr, fq); }
        if (!has_next) break;
#pragma unroll
        for (int a = 0; a < 2; ++a)
#pragma unroll
            for (int b = 0; b < 2; ++b)
#pragma unroll
                for (int m = 0; m < 4; ++m)
#pragma unroll
                    for (int n = 0; n < 2; ++n) acc[a][b][m][n] = (f32x4){0.f, 0.f, 0.f, 0.f};
        cur = nxt; cA = nA; cB = nB; ++ui; nt = cur.nt ? cur.nt : K / BK;
        if constexpr (ALIGN_EPI) { if (wr == 1) PG8_BAR; }
    }
    PG8_WAIT_V(0);
    if constexpr (!ALIGN_EPI) { if (wr == 0) PG8_BAR; }
    PG8_BAR;
    if constexpr (Epi::AFTER_DRAIN) { E.fused(acc, cur, wr, wc, fr, fq, lds, wid, lane); }
#undef PG8_SA
#undef PG8_SB
#undef PG8_STAGE
#undef PG8_STAGE_A
#undef PG8_LDA
#undef PG8_LDB
#undef PG8_MMA
#undef PG8_WAIT_V
#undef PG8_WAIT_VS
#undef PG8_WAIT_L
#undef PG8_BAR
#undef PG8_SCHED
#undef PG8_GTAB_DMA
#undef PG8_GTAB_READ
}
}
constexpr size_t MiB = 1u << 20;
constexpr size_t WS_CTL = 0, CTL_ZERO_BYTES = 256 * 1024;
constexpr size_t WS_ROWOFF = 1 * MiB;
constexpr size_t WS_RS = WS_ROWOFF + 512 * 1024;
constexpr size_t WS_GATE = WS_RS + 512 * 1024;
constexpr size_t WS_SEL = WS_GATE + 512 * 1024;
constexpr size_t WS_SSQ = WS_SEL + 256 * 1024;
constexpr size_t WS_SMALLW = 4 * MiB;
constexpr size_t WS_PWT = WS_SMALLW;
constexpr size_t WS_POOLWT = WS_PWT + 2 * 384 * 384 * 2;
constexpr size_t WS_GMWS = WS_POOLWT + 2 * 4 * 64 * 64 * 2;
constexpr size_t WS_XB = 6 * MiB;
constexpr size_t WS_SLAB = 162 * MiB;
constexpr size_t WS_XB2 = WS_XB;
constexpr size_t WS_MOE_WD = 38 * MiB;
constexpr size_t WS_MOE_WGU = 94 * MiB;
constexpr size_t WS_YP = 94 * MiB;
constexpr size_t WS_ACTM = 206 * MiB;
constexpr size_t WS_P = 206 * MiB;
constexpr size_t WS_Y = 262 * MiB;
constexpr size_t WS_ACT = 206 * MiB;
constexpr size_t WS_WIN = 294 * MiB;
constexpr size_t WS_WOUT = 301 * MiB;
constexpr size_t WS_WGU = 305 * MiB;
constexpr size_t WS_WD = 316 * MiB;
constexpr size_t WS_END = 444 * MiB;
static_assert(WS_SSQ + 4 * (size_t)M * 4 <= WS_SMALLW && WS_GMWS + 2 * 4 * 128 * 128 * 2 <= WS_XB && WS_XB + (size_t)M * D * 2 <= WS_MOE_WD, "ws map 1");
static_assert(WS_SLAB >= WS_YP + (size_t)PMAX * D * 2 && WS_SLAB + 256 * (size_t)65536 * 2 <= WS_ACTM, "slabs");
static_assert(WS_MOE_WD + (size_t)NE * D * DFE * 2 <= WS_MOE_WGU && WS_MOE_WGU + (size_t)NE * NGUE * D * 2 <= WS_ACTM && WS_YP + (size_t)PMAX * D * 2 <= WS_ACTM, "ws map 2");
static_assert(WS_ACTM + (size_t)PMAX * DFE * 2 <= WS_END && WS_P + (size_t)M * DIN * 2 <= WS_Y && WS_Y + (size_t)M * D * 2 <= WS_WIN && WS_ACT + (size_t)M * DFF * 2 <= WS_WIN, "ws map 3");
static_assert(WS_WIN + 2 * (size_t)DIN * D * 2 <= WS_WOUT && WS_WOUT + 2 * (size_t)D * D * 2 <= WS_WGU && WS_WGU + (size_t)NGU * D * 2 <= WS_WD && WS_WD + (size_t)D * DFF * 2 <= WS_END, "ws map 4");
constexpr int CW_BAR = 4096;
constexpr int CW_CNT = 49152;
constexpr int CW_CVT = 140000;
constexpr int NPHASE = 13;
static_assert(CW_BAR + NPHASE * 3456 <= CW_CNT && (size_t)(CW_CNT + 8 * 64) * 4 <= CTL_ZERO_BYTES, "control words inside the per-call memset");
constexpr int RING_BYTES = 131072;
constexpr int GTAB_OFF = RING_BYTES;
constexpr int MISC_OFF = GTAB_OFF + 8192;
constexpr int INTAB_OFF = MISC_OFF + 256;
constexpr int JOBS_OFF = INTAB_OFF + 256;
constexpr int LDS_BYTES = 147456;
static_assert(JOBS_OFF + 7 * 12 * 32 <= LDS_BYTES, "LDS map (jobs)");
static_assert(MISC_OFF + 256 <= LDS_BYTES, "LDS map");

typedef GAS unsigned gu32;
#define RLX_AGENT __ATOMIC_RELAXED, __HIP_MEMORY_SCOPE_AGENT
#define LDS_WAIT() asm volatile("s_waitcnt lgkmcnt(0)" ::: "memory")
#define VM_WAIT() asm volatile("s_waitcnt vmcnt(0)" ::: "memory")

#define XB_TMO      128
#define XB_XCNT(j)  (256  + 64 * (j))
#define XB_XSUB(j)  (1280 + 64 * (j))
#define XB_XGEN(j)  (2304 + 64 * (j))
#define XB_TOP      3328
#define XB_TOPGEN   3392
#define XCD_BAR_WORDS 3456
#define XB_SPIN_CAP (1u << 18)
__device__ __forceinline__ unsigned xb_ld(unsigned* p)              { return __hip_atomic_load(p, __ATOMIC_RELAXED, __HIP_MEMORY_SCOPE_AGENT); }
__device__ __forceinline__ unsigned xb_add(unsigned* p, unsigned v) { return __hip_atomic_fetch_add(p, v, __ATOMIC_RELAXED, __HIP_MEMORY_SCOPE_AGENT); }
__device__ __forceinline__ unsigned xb_xcc_id() { return (unsigned)__builtin_amdgcn_s_getreg((3 << 11) | 20) & 0xFu; }
#define XB_SPIN(cond, bar) do { unsigned _sp = 0; while (cond) { __builtin_amdgcn_s_sleep(1); \
    if ((++_sp & 255u) == 0u) { if (xb_ld(&(bar)[XB_TMO])) break; if (_sp > XB_SPIN_CAP) { atomicAdd(&(bar)[XB_TMO], 1u); break; } } } } while (0)
struct XcdBarrier { unsigned* bar; unsigned x; volatile LAS unsigned* st; };
__device__ __forceinline__ XcdBarrier xcd_barrier_post(unsigned* bar, volatile LAS unsigned* st) {
    XcdBarrier b; b.bar = bar; b.x = xb_xcc_id(); b.st = st;
    if (threadIdx.x == 0) (void)xb_add(&bar[XB_XCNT(b.x)], 1u);
    return b;
}
__device__ __forceinline__ void xcd_barrier_complete(unsigned* bar, unsigned x, unsigned& nloc, unsigned& nx) {
    const unsigned G = gridDim.x * gridDim.y * gridDim.z;
    unsigned sum, cnt, mine, sp = 0u;
    for (;;) {
        sum = 0u; cnt = 0u; mine = 0u;
#pragma unroll
        for (unsigned j = 0; j < 16; ++j) { const unsigned c = xb_ld(&bar[XB_XCNT(j)]); sum += c; cnt += (c > 0u) ? 1u : 0u; mine = (j == x) ? c : mine; }
        if (sum == G) break;
        __builtin_amdgcn_s_sleep(1);
        if ((++sp & 255u) == 0u) { if (xb_ld(&bar[XB_TMO])) break; if (sp > XB_SPIN_CAP) { atomicAdd(&bar[XB_TMO], 1u); break; } }
    }
    nloc = mine > 0u ? mine : 1u; nx = cnt > 0u ? cnt : 1u;
}
__device__ __forceinline__ void xcd_barrier(const XcdBarrier& b) {
    asm volatile("s_waitcnt vmcnt(0)" ::: "memory");
    __syncthreads();
    if (threadIdx.x == 0) {
        unsigned* bar = b.bar;
        __builtin_amdgcn_s_waitcnt(0);
        unsigned nloc = b.st[0], nx = b.st[1];
        if (nloc == 0u) { xcd_barrier_complete(bar, b.x, nloc, nx); b.st[0] = nloc; b.st[1] = nx; }
        const unsigned old = xb_add(&bar[XB_XSUB(b.x)], 1u);
        const unsigned gen = old / nloc;
        if (old + 1u == (gen + 1u) * nloc) {
            __builtin_amdgcn_fence(__ATOMIC_RELEASE, "agent");
            asm volatile("s_waitcnt vmcnt(0)" ::: "memory");
            const unsigned og = xb_add(&bar[XB_TOP], 1u);
            const unsigned tg = og / nx;
            if (og + 1u == (tg + 1u) * nx) xb_add(&bar[XB_TOPGEN], 1u);
            else XB_SPIN(xb_ld(&bar[XB_TOPGEN]) == tg, bar);
            __builtin_amdgcn_fence(__ATOMIC_ACQUIRE, "agent");
            xb_add(&bar[XB_XGEN(b.x)], 1u);
            asm volatile("s_waitcnt vmcnt(0)" ::: "memory");
        } else {
            XB_SPIN(xb_ld(&bar[XB_XGEN(b.x)]) == gen, bar);
            __builtin_amdgcn_fence(__ATOMIC_ACQUIRE, "agent");
            asm volatile("s_waitcnt vmcnt(0)" ::: "memory");
        }
    }
    __syncthreads();
}

struct InTab { const LAS unsigned long long* t;
    __device__ __forceinline__ const float* operator[](int k) const { const unsigned long long v = t[k]; const unsigned lo = __builtin_amdgcn_readfirstlane((unsigned)v), hi = __builtin_amdgcn_readfirstlane((unsigned)(v >> 32));
        return (const float*)(((unsigned long long)hi << 32) | lo); } };
struct Frame {
    LAS unsigned char* lds; volatile LAS unsigned* MISC; unsigned* ctl;
    int tid, lane, wave, vcu, G;
    InTab in; float* out; unsigned char* ws;
};

__device__ __forceinline__ InTab in_tab(Frame& F) { return F.in; }
struct TrJob { const float* src; bf16* dst; const float* gk; int K, N; };
__device__ __forceinline__ TrJob tr_mat(const float* W, int K, int N, bf16* WT, int mode, const float* gk, int r) {
    const int nblk = N / 32, kb = r / nblk, nb = r % nblk, n0 = 32 * nb, k0 = 64 * kb;
    const int drow = mode == 0 ? n0 : ((n0 >> 7) * 256 + (n0 & 127) + (mode == 2 ? 128 : 0));
    TrJob j; j.src = W + (size_t)k0 * N + n0; j.dst = WT + (size_t)drow * K + k0; j.gk = gk ? gk + k0 : nullptr; j.K = K; j.N = N; return j;
}
constexpr int TR_I_IN = (D / 64) * (DIN / 32), TR_I_OUT = (D / 64) * (D / 32), TR_I_G = (D / 64) * (DFF / 32), TR_I_D = (DFF / 64) * (D / 32), TR_I_MG = (D / 64) * (DFE / 32), TR_I_MD = (DFE / 64) * (D / 32), TR_I_PW = (DCV / 64) * (DCV / 32), TR_I_PL = 2;
constexpr int TR_E_END = TR_I_IN + 2 * TR_I_PW + 8 * TR_I_PL;
constexpr int TR_A_END = TR_E_END + TR_I_OUT + 2 * TR_I_G + TR_I_D;
constexpr int TR_B_END = TR_A_END + TR_I_IN + TR_I_OUT;
constexpr int TR_C_END = TR_B_END + 2 * NE * TR_I_MG;
constexpr int TR_D_END = TR_C_END + NE * TR_I_MD;
__device__ __forceinline__ TrJob tr_decode(const InTab in, unsigned char* ws, int r) {
    if (r < TR_I_IN) return tr_mat(in[2], D, DIN, (bf16*)(ws + WS_WIN), 0, in[1], r); r -= TR_I_IN;
    if (r < 2 * TR_I_PW) { const int l = r / TR_I_PW; return tr_mat(in[12] + (size_t)l * DCV * DCV, DCV, DCV, (bf16*)(ws + WS_PWT) + (size_t)l * DCV * DCV, 0, nullptr, r % TR_I_PW); } r -= 2 * TR_I_PW;
    if (r < 8 * TR_I_PL) { const int gi = r / TR_I_PL; return tr_mat(in[3] + (size_t)gi * 64 * 64, 64, 64, (bf16*)(ws + WS_POOLWT) + (size_t)gi * 64 * 64, 0, nullptr, r % TR_I_PL); } r -= 8 * TR_I_PL;
    if (r < TR_I_OUT) return tr_mat(in[14], D, D, (bf16*)(ws + WS_WOUT), 0, nullptr, r); r -= TR_I_OUT;
    if (r < TR_I_G) return tr_mat(in[16], D, DFF, (bf16*)(ws + WS_WGU), 1, in[15], r); r -= TR_I_G;
    if (r < TR_I_G) return tr_mat(in[17], D, DFF, (bf16*)(ws + WS_WGU), 2, in[15], r); r -= TR_I_G;
    if (r < TR_I_D) return tr_mat(in[18], DFF, D, (bf16*)(ws + WS_WD), 0, nullptr, r); r -= TR_I_D;
    if (r < TR_I_IN) return tr_mat(in[2] + (size_t)D * DIN, D, DIN, (bf16*)(ws + WS_WIN) + (size_t)DIN * D, 0, in[1] + D, r); r -= TR_I_IN;
    if (r < TR_I_OUT) return tr_mat(in[14] + (size_t)D * D, D, D, (bf16*)(ws + WS_WOUT) + (size_t)D * D, 0, nullptr, r); r -= TR_I_OUT;
    if (r < 2 * NE * TR_I_MG) { const int e = r / (2 * TR_I_MG), q = r % (2 * TR_I_MG), up = q / TR_I_MG;
        return tr_mat(in[20 + up] + (size_t)e * D * DFE, D, DFE, (bf16*)(ws + WS_MOE_WGU) + (size_t)e * NGUE * D, 1 + up, in[15] + D, q % TR_I_MG); } r -= 2 * NE * TR_I_MG;
    { const int e = r / TR_I_MD; return tr_mat(in[22] + (size_t)e * DFE * D, DFE, D, (bf16*)(ws + WS_MOE_WD) + (size_t)e * D * DFE, 0, nullptr, r % TR_I_MD); }
}
__device__ __forceinline__ void tr_load(const TrJob& j, f32x4 (&v)[8], int lane, int probe) {
    const int n4 = (lane & 7) * 4, k8 = (lane >> 3) * 8;
    if (probe == 2) {
#pragma unroll
        for (int i = 0; i < 8; ++i) v[i] = (f32x4){1.f, 2.f, 3.f, 4.f};
        return; }
#pragma unroll
    for (int i = 0; i < 8; ++i) v[i] = __builtin_nontemporal_load((const f32x4*)(j.src + (size_t)(k8 + i) * j.N + n4));
    if (j.gk) { const f32x4 g0 = *(const f32x4*)(j.gk + k8), g1 = *(const f32x4*)(j.gk + k8 + 4);
        v[0] = v[0] * g0[0]; v[1] = v[1] * g0[1]; v[2] = v[2] * g0[2]; v[3] = v[3] * g0[3]; v[4] = v[4] * g1[0]; v[5] = v[5] * g1[1]; v[6] = v[6] * g1[2]; v[7] = v[7] * g1[3]; }
}
__device__ __forceinline__ void tr_store(const TrJob& j, const f32x4 (&v)[8], LAS float* scr, int lane, int probe) {
    (void)scr; const int n4 = (lane & 7) * 4, k8 = (lane >> 3) * 8;
#pragma unroll
    for (int q = 0; q < 4; ++q) { u32x4 o; o.x = cvt_pk_bf16(v[0][q], v[1][q]); o.y = cvt_pk_bf16(v[2][q], v[3][q]); o.z = cvt_pk_bf16(v[4][q], v[5][q]); o.w = cvt_pk_bf16(v[6][q], v[7][q]);
        if (probe == 1 || probe == 2) { asm volatile("" :: "v"(o.x), "v"(o.y), "v"(o.z), "v"(o.w)); } else *(GAS u32x4*)(j.dst + (size_t)(n4 + q) * j.K + k8) = o; }
}
__device__ __forceinline__ void tr_run(Frame& F, int first, int count, int widx, int nw, int probe) {
    LAS float* scr = (LAS float*)(F.lds + F.wave * 16384); int lane = F.lane; asm volatile("" : "+v"(lane)); const InTab in = in_tab(F); unsigned char* ws = F.ws;
    const int end = first + count; f32x4 v[4][8]; TrJob j[4];
#pragma unroll
    for (int k = 0; k < 4; ++k) { const int it = first + widx + k * nw; if (it < end) { j[k] = tr_decode(in, ws, it); tr_load(j[k], v[k], lane, probe); } }
    for (int it = first + widx; it < end; it += 4 * nw) {
#pragma unroll
        for (int k = 0; k < 4; ++k) { const int ik = it + k * nw, nx = ik + 4 * nw;
            if (ik < end) tr_store(j[k], v[k], scr, lane, probe);
            if (nx < end) { j[k] = tr_decode(in, ws, nx); tr_load(j[k], v[k], lane, probe); } } }
}
#ifndef H10_SHARE
#define H10_SHARE 8192
#endif
#ifndef HID_PW
#define HID_PW 2
#endif
constexpr int HID_PER_WAVE = HID_PW, H1_N = 64 * 8 * HID_PER_WAVE, H4_N = 128 * 8 * HID_PER_WAVE, H6_N = 64 * 8 * HID_PER_WAVE, H10_N = H10_SHARE;
constexpr int H10_BEG = TR_D_END - H10_N;
#ifndef MIX_CVT
#define MIX_CVT 0
#endif
#ifndef R9_CVT
#define R9_CVT 0
#endif
#ifndef SB_CVT
#define SB_CVT 2
#endif
constexpr int MX_N = (M / 64) * 8 * MIX_CVT, R9_N = (M / 64) * 8 * R9_CVT, SB_N = 7 * 256 * SB_CVT;
constexpr int H1_BEG = TR_E_END, S0_BEG = H1_BEG + H1_N, S1_BEG = S0_BEG + SB_N, S2_BEG = S1_BEG + SB_N, S3_BEG = S2_BEG + SB_N, H4_BEG = S3_BEG + SB_N, S4_BEG = H4_BEG + H4_N, S5_BEG = S4_BEG + SB_N,
              H6_BEG = S5_BEG + SB_N, MX0_BEG = H6_BEG + H6_N, MX1_BEG = MX0_BEG + MX_N, R9_BEG = MX1_BEG + MX_N, PRO_BEG = R9_BEG + R9_N;
static_assert(PRO_BEG <= H10_BEG, "hidden conversion shares exceed the weight tiles");
static_assert(H1_BEG + TR_I_OUT <= S0_BEG, "w_out of layer 0 (phase 3): inside H1");
static_assert(TR_A_END - TR_I_D <= S1_BEG, "dense gate|up weights (phase 4): visible by phase 3 at the latest, i.e. inside H1 | S0");
static_assert(TR_A_END <= S2_BEG, "dense down weights (phase 5): inside H1 | S0 | S1");
static_assert(TR_A_END + TR_I_IN <= S3_BEG && TR_B_END <= S5_BEG, "layer-1 projections (phases 6, 8)");
static_assert(TR_C_END <= H10_BEG && MIX_CVT == 0 && R9_CVT == 0, "MoE gate|up weights before phase 10 (H6 is visible from phase 7); no hosting in mixers / router in this layout");
__device__ __forceinline__ void tail_convert(Frame& F, int first, int count, int rank, int nwg_idle) {
    if (rank >= 0 && rank < nwg_idle) tr_run(F, first, count, rank * 8 + F.wave, nwg_idle * 8, 0);
}

struct JobRec { unsigned long long src, dst, gk; int K, N; };
__device__ __forceinline__ TrJob job_read(const LAS JobRec* r) {
    const u32x4 a = *(const LAS u32x4*)r, c = *((const LAS u32x4*)r + 1); TrJob j;
    const unsigned s0 = __builtin_amdgcn_readfirstlane(a.x), s1 = __builtin_amdgcn_readfirstlane(a.y), d0 = __builtin_amdgcn_readfirstlane(a.z), d1 = __builtin_amdgcn_readfirstlane(a.w);
    const unsigned g0 = __builtin_amdgcn_readfirstlane(c.x), g1 = __builtin_amdgcn_readfirstlane(c.y);
    j.src = (const float*)(((unsigned long long)s1 << 32) | s0); j.dst = (bf16*)(((unsigned long long)d1 << 32) | d0); j.gk = (const float*)(((unsigned long long)g1 << 32) | g0);
    j.K = __builtin_amdgcn_readfirstlane(c.z); j.N = __builtin_amdgcn_readfirstlane(c.w); return j;
}
__device__ __forceinline__ void jobs_setup(Frame& F) {
    if (SB_CVT == 0 || F.wave == 0) return;
    const InTab in = in_tab(F); unsigned char* ws = F.ws; LAS JobRec* tab = (LAS JobRec*)(F.lds + JOBS_OFF) + (F.wave - 1) * 12;
#pragma unroll 1
    for (int q = 0; q < 6 * SB_CVT; ++q) { const int sI = q / SB_CVT, k = q - sI * SB_CVT; const int beg = sI < 4 ? S0_BEG + sI * SB_N : S4_BEG + (sI - 4) * SB_N;
        const TrJob j = tr_decode(in, ws, beg + (int)blockIdx.x * 7 + F.wave - 1 + k * 7 * 256);
        if (F.lane == 0) { const unsigned long long s = (unsigned long long)j.src, d = (unsigned long long)j.dst, g = (unsigned long long)j.gk; LAS u32x4* o = (LAS u32x4*)(tab + sI * 2 + k);
            u32x4 a, c; a.x = (unsigned)s; a.y = (unsigned)(s >> 32); a.z = (unsigned)d; a.w = (unsigned)(d >> 32); c.x = (unsigned)g; c.y = (unsigned)(g >> 32); c.z = (unsigned)j.K; c.w = (unsigned)j.N; o[0] = a; o[1] = c; } }
}
__device__ __forceinline__ void xcd_barrier_host(const XcdBarrier& b, Frame& F, int slot) {
    if (slot < 0 || SB_CVT == 0) { xcd_barrier(b); return; }
    asm volatile("s_waitcnt vmcnt(0)" ::: "memory");
    __syncthreads();
    int lane = F.lane; asm volatile("" : "+v"(lane));
    f32x4 va[8], vb[8]; TrJob ja, jb; const bool host = F.wave > 0; const LAS JobRec* jr = (const LAS JobRec*)(F.lds + JOBS_OFF) + (F.wave - 1) * 12 + slot * 2;
    if (host) { ja = job_read(jr); tr_load(ja, va, lane, 0); if (SB_CVT >= 2) { jb = job_read(jr + 1); tr_load(jb, vb, lane, 0); } }
    if (threadIdx.x == 0) {
        unsigned* bar = b.bar;
        __builtin_amdgcn_s_waitcnt(0);
        unsigned nloc = b.st[0], nx = b.st[1];
        if (nloc == 0u) { xcd_barrier_complete(bar, b.x, nloc, nx); b.st[0] = nloc; b.st[1] = nx; }
        const unsigned old = xb_add(&bar[XB_XSUB(b.x)], 1u);
        const unsigned gen = old / nloc;
        if (old + 1u == (gen + 1u) * nloc) {
            __builtin_amdgcn_fence(__ATOMIC_RELEASE, "agent");
            asm volatile("s_waitcnt vmcnt(0)" ::: "memory");
            const unsigned og = xb_add(&bar[XB_TOP], 1u);
            const unsigned tg = og / nx;
            if (og + 1u == (tg + 1u) * nx) xb_add(&bar[XB_TOPGEN], 1u);
            else XB_SPIN(xb_ld(&bar[XB_TOPGEN]) == tg, bar);
            __builtin_amdgcn_fence(__ATOMIC_ACQUIRE, "agent");
            xb_add(&bar[XB_XGEN(b.x)], 1u);
            asm volatile("s_waitcnt vmcnt(0)" ::: "memory");
        } else {
            XB_SPIN(xb_ld(&bar[XB_XGEN(b.x)]) == gen, bar);
            __builtin_amdgcn_fence(__ATOMIC_ACQUIRE, "agent");
            asm volatile("s_waitcnt vmcnt(0)" ::: "memory");
        }
    }
    __syncthreads();
    if (host) { tr_store(ja, va, nullptr, lane, 0); if (SB_CVT >= 2) tr_store(jb, vb, nullptr, lane, 0); }
}
__device__ __forceinline__ void p0_prologue(Frame& F, int probe) {
    LAS float* scr = (LAS float*)(F.lds + F.wave * 16384);
    int lane = F.lane; asm volatile("" : "+v"(lane));
    const int gw = F.vcu * 8 + F.wave, NGW = F.G * 8;
    const InTab in = in_tab(F); unsigned char* ws = F.ws;
    tr_run(F, 0, TR_E_END, gw, NGW, probe);
    tr_run(F, PRO_BEG, H10_BEG - PRO_BEG, gw, NGW, probe);
    { const float* src = in[6]; bf16* dst = (bf16*)(ws + WS_GMWS);
      for (int i = gw * 64 + lane; i < 2 * 4 * 128 * 128 / 8; i += NGW * 64) { const f32x4 a = *(const f32x4*)(src + (size_t)i * 8), b = *(const f32x4*)(src + (size_t)i * 8 + 4);
          u32x4 o; o.x = cvt_pk_bf16(a[0], a[1]); o.y = cvt_pk_bf16(a[2], a[3]); o.z = cvt_pk_bf16(b[0], b[1]); o.w = cvt_pk_bf16(b[2], b[3]); *(u32x4*)(dst + (size_t)i * 8) = o; } }
    { u32x4* t = (u32x4*)(ws + WS_ROWOFF); for (int i = gw * 64 + lane; i < NE * ECAP / 4; i += NGW * 64) t[i] = (u32x4){0u, 0u, 0u, 0u}; }
    { const float* x = in[0]; bf16* XB = (bf16*)(ws + WS_XB); float* ssq = (float*)(ws + WS_SSQ);
      for (int m = gw; m < M; m += NGW) { const f32x4* xr = (const f32x4*)(x + (size_t)m * D) + lane; f32x4 v[4]; float s = 0.f;
#pragma unroll
          for (int j = 0; j < 4; ++j) { v[j] = xr[64 * j]; s += (v[j][0] * v[j][0] + v[j][1] * v[j][1]) + (v[j][2] * v[j][2] + v[j][3] * v[j][3]); }
          s = wave_sum(s);
          u32x2* o = (u32x2*)(XB + (size_t)m * D) + lane;
#pragma unroll
          for (int j = 0; j < 4; ++j) { u32x2 w; w.x = cvt_pk_bf16(v[j][0], v[j][1]); w.y = cvt_pk_bf16(v[j][2], v[j][3]); o[64 * j] = w; }
          if (lane < 4) ssq[(size_t)lane * M + m] = lane == 0 ? s : 0.f; } }
}

__device__ __forceinline__ void unpack8(const u32x4 w, float (&f)[8]) { f[0] = bf_lo(w.x); f[1] = bf_hi(w.x); f[2] = bf_lo(w.y); f[3] = bf_hi(w.y); f[4] = bf_lo(w.z); f[5] = bf_hi(w.z); f[6] = bf_lo(w.w); f[7] = bf_hi(w.w); }
#define LDS_BARRIER() asm volatile("s_waitcnt lgkmcnt(0)\n\ts_barrier" ::: "memory")
__device__ __forceinline__ void mixer_unit(Frame& F, int u, int layer, int cvt0) {
    LAS unsigned char* lds = F.lds; int tid = F.tid; asm volatile("" : "+v"(tid)); int lane = tid & 63; const int w = F.wave;
    const InTab in = in_tab(F); unsigned char* ws = F.ws;
    const bf16* P = (const bf16*)(ws + WS_P); bf16* Y = (bf16*)(ws + WS_Y);
    const int r0 = 64 * u, s0 = r0 & (SEQ - 1), half = u & 1, blk0 = r0 & ~127;
#ifndef CONV_REP
#define CONV_REP 0
#endif
#ifndef MIX_MASK
#define MIX_MASK 7
#endif
#ifndef MIX_REP
#define MIX_REP 0
#endif
    f32x4 cva[8], cvb[8]; TrJob cja, cjb; const int cvi = cvt0 + u * 8 + w; constexpr int CVS = (M / 64) * 8;
    for (int mrep = 0; mrep < 1 + (MIX_REP & 1); ++mrep) if (MIX_MASK & 1) { constexpr int AIN = 0, YPL = 40448, YST = 528;
      const int g = w >> 1, th = w & 1, fr = lane & 15, fq = lane >> 4;
      u32x4 st[5];
#pragma unroll
      for (int i = 0; i < 5; ++i) { const int idx = tid + 512 * i, rr = idx >> 5, ch = idx & 31, pos = s0 - 15 + rr; st[i] = (u32x4){0u, 0u, 0u, 0u};
          if (idx < 79 * 32 && pos >= 0) st[i] = *(const u32x4*)(P + (size_t)(r0 - 15 + rr) * DIN + ch * 8); }
      const bf16* wt = (const bf16*)(ws + WS_POOLWT) + (size_t)(layer * 4 + g) * 64 * 64; const float* sc = in[4] + layer * DPOOL + g * 64;
      bf16x8 Bf[2][4]; f32x4 sc4[4];
#pragma unroll
      for (int ks = 0; ks < 2; ++ks)
#pragma unroll
          for (int nt = 0; nt < 4; ++nt) Bf[ks][nt] = *(const bf16x8*)(wt + (nt * 16 + fr) * 64 + ks * 32 + 8 * fq);
#pragma unroll
      for (int nt = 0; nt < 4; ++nt) sc4[nt] = *(const f32x4*)(sc + nt * 16 + 4 * fq);
      if (MIX_CVT >= 2 && mrep == 0) { asm volatile("" ::: "memory"); cja = tr_decode(in, ws, cvi); tr_load(cja, cva, lane, 0); cjb = tr_decode(in, ws, cvi + CVS); tr_load(cjb, cvb, lane, 0); asm volatile("" ::: "memory"); }
#pragma unroll
      for (int i = 0; i < 5; ++i) { const int idx = tid + 512 * i; if (idx < 79 * 32) *(LAS u32x4*)(lds + AIN + (idx >> 5) * 512 + (idx & 31) * 16) = st[i]; }
      LDS_BARRIER();
      { const int p = tid & 127, rq = tid >> 7, gp = p >> 5, win = 2 << gp; float S0 = 0.f, S1 = 0.f;
        for (int j = 1; j < win; ++j) { const unsigned a = *(const LAS unsigned*)(lds + AIN + (16 * rq + 15 - j) * 512 + p * 4); S0 += bf_lo(a); S1 += bf_hi(a); }
#pragma unroll 4
        for (int t = 0; t < 16; ++t) { const int lt = 16 * rq + t, rr = lt + 15; const unsigned a = *(const LAS unsigned*)(lds + AIN + rr * 512 + p * 4); const float a0 = bf_lo(a), a1 = bf_hi(a);
            S0 += a0; S1 += a1; const int pos1 = s0 + lt + 1; const float rn = __builtin_amdgcn_rcpf((float)(pos1 < win ? pos1 : win));
            *(LAS unsigned*)(lds + YPL + lt * YST + p * 4) = cvt_pk_bf16(S0 * rn - a0, S1 * rn - a1);
            const unsigned o = *(const LAS unsigned*)(lds + AIN + (rr - win + 1) * 512 + p * 4); S0 -= bf_lo(o); S1 -= bf_hi(o); } }
      LDS_BARRIER();
      for (int prep = 0; prep < 1 + ((CONV_REP >> 3) & 1); ++prep) { f32x4 acc[2][4];
#pragma unroll
        for (int a = 0; a < 2; ++a)
#pragma unroll
            for (int b = 0; b < 4; ++b) acc[a][b] = (f32x4){0.f, 0.f, 0.f, 0.f};
#pragma unroll
        for (int ks = 0; ks < 2; ++ks) { bf16x8 A[2];
#pragma unroll
            for (int mt = 0; mt < 2; ++mt) A[mt] = *(const LAS bf16x8*)(lds + YPL + ((2 * th + mt) * 16 + fr) * YST + (g * 64 + ks * 32 + 8 * fq) * 2);
#pragma unroll
            for (int mt = 0; mt < 2; ++mt)
#pragma unroll
                for (int nt = 0; nt < 4; ++nt) acc[mt][nt] = __builtin_amdgcn_mfma_f32_16x16x32_bf16(Bf[ks][nt], A[mt], acc[mt][nt], 0, 0, 0); }
#pragma unroll
        for (int mt = 0; mt < 2; ++mt)
#pragma unroll
            for (int nt = 0; nt < 4; ++nt) { const int t = r0 + (2 * th + mt) * 16 + fr, d = nt * 16 + 4 * fq; const f32x4 v = acc[mt][nt] * sc4[nt];
                u32x2 o; o.x = cvt_pk_bf16(v[0], v[1]); o.y = cvt_pk_bf16(v[2], v[3]); *(u32x2*)(Y + (size_t)t * D + g * 64 + d) = o; } }
      LDS_BARRIER(); }
    asm volatile("" : "+v"(tid)); lane = tid & 63;
    for (int mrep = 0; mrep < 1 + ((MIX_REP >> 1) & 1); ++mrep) if (MIX_MASK & 2) { constexpr int VN = 0, VST = 800; const int nj = half ? 128 : 64, nks = nj >> 5;
      const int h = w & 3, ih = w >> 2, fr = lane & 15, fq = lane >> 4, q4 = (lane & 15) >> 2, p4 = lane & 3;
      const bf16* wsb = (const bf16*)(ws + WS_GMWS) + (size_t)(layer * 4 + h) * 128 * 128;
      const float* gg = in[5] + layer * DGM; const float* bb = in[7] + (size_t)(layer * 4 + h) * 128;
      u32x4 raw[16]; const int nr = nj >> 3;
#pragma unroll
      for (int i = 0; i < 16; ++i) { raw[i] = (u32x4){0u, 0u, 0u, 0u}; if (i < nr && lane < 48) raw[i] = *(const u32x4*)(P + (size_t)(blk0 + i * 8 + w) * DIN + 640 + lane * 8); }
      bf16x8 Aw[4][2]; f32x4 g4[6]; float bi[2];
#pragma unroll
      for (int ks = 0; ks < 4; ++ks)
#pragma unroll
          for (int mt = 0; mt < 2; ++mt) { Aw[ks][mt] = (bf16x8){0, 0, 0, 0, 0, 0, 0, 0}; if (ks < nks) Aw[ks][mt] = *(const bf16x8*)(wsb + (size_t)(half * 64 + (2 * ih + mt) * 16 + fr) * 128 + ks * 32 + 8 * fq); }
#pragma unroll
      for (int ct = 0; ct < 6; ++ct) g4[ct] = *(const f32x4*)(gg + h * 96 + ct * 16 + 4 * fq);
#pragma unroll
      for (int mt = 0; mt < 2; ++mt) bi[mt] = bb[half * 64 + (2 * ih + mt) * 16 + fr];
#pragma unroll
      for (int i = 0; i < 16; ++i) { if (i < nr) { float f[8]; unpack8(raw[i], f); float s = 0.f;
#pragma unroll
              for (int q = 0; q < 8; ++q) s += f[q] * f[q];
              s = wave_sum(s); const float rs = 1.0f / sqrtf(s * (1.0f / DGM) + EPS);
              u32x4 o; o.x = cvt_pk_bf16(f[0] * rs, f[1] * rs); o.y = cvt_pk_bf16(f[2] * rs, f[3] * rs); o.z = cvt_pk_bf16(f[4] * rs, f[5] * rs); o.w = cvt_pk_bf16(f[6] * rs, f[7] * rs);
              if (lane < 48) *(LAS u32x4*)(lds + VN + (i * 8 + w) * VST + lane * 16) = o; } }
      u32x2 uu[2][6];
#pragma unroll
      for (int mt = 0; mt < 2; ++mt)
#pragma unroll
          for (int ct = 0; ct < 6; ++ct) uu[mt][ct] = *(const u32x2*)(P + (size_t)(r0 + (2 * ih + mt) * 16 + fr) * DIN + 256 + h * 96 + ct * 16 + 4 * fq);
      LDS_BARRIER();
      { f32x4 acc[2][6];
#pragma unroll
        for (int a = 0; a < 2; ++a)
#pragma unroll
            for (int b = 0; b < 6; ++b) acc[a][b] = (f32x4){0.f, 0.f, 0.f, 0.f};
#pragma unroll
        for (int ks = 0; ks < 4; ++ks) { if (ks < nks) {
#pragma unroll
            for (int ct = 0; ct < 6; ++ct) { const unsigned ad = VN + (32 * ks + 8 * fq + q4) * VST + (h * 96 + ct * 16 + 4 * p4) * 2;
                const s16x4 t0 = __builtin_amdgcn_ds_read_tr16_b64_v4i16((LAS s16x4*)(lds + ad)), t1 = __builtin_amdgcn_ds_read_tr16_b64_v4i16((LAS s16x4*)(lds + ad + 4 * VST));
                bf16x8 B; B[0] = t0[0]; B[1] = t0[1]; B[2] = t0[2]; B[3] = t0[3]; B[4] = t1[0]; B[5] = t1[1]; B[6] = t1[2]; B[7] = t1[3];
#pragma unroll
                for (int mt = 0; mt < 2; ++mt) acc[mt][ct] = __builtin_amdgcn_mfma_f32_16x16x32_bf16(B, Aw[ks][mt], acc[mt][ct], 0, 0, 0); } } }
#pragma unroll
        for (int mt = 0; mt < 2; ++mt) { const int t = r0 + (2 * ih + mt) * 16 + fr;
#pragma unroll
            for (int ct = 0; ct < 6; ++ct) { const int c4 = h * 96 + ct * 16 + 4 * fq; const f32x4 z = acc[mt][ct] * g4[ct] + bi[mt]; const u32x2 uv = uu[mt][ct];
                u32x2 o; o.x = cvt_pk_bf16(bf_lo(uv.x) * z[0], bf_hi(uv.x) * z[1]); o.y = cvt_pk_bf16(bf_lo(uv.y) * z[2], bf_hi(uv.y) * z[3]); *(u32x2*)(Y + (size_t)t * D + 256 + c4) = o; } } }
      LDS_BARRIER(); }
    if (MIX_CVT >= 2) { tr_store(cja, cva, nullptr, lane, 0); tr_store(cjb, cvb, nullptr, lane, 0); }
    asm volatile("" : "+v"(tid)); lane = tid & 63;
    for (int mrep = 0; mrep < 1 + ((MIX_REP >> 2) & 1); ++mrep) if (MIX_MASK & 4) { constexpr int HC = 0, TT = 72192, TST = 784;
      for (int crep = 0; crep < 1 + (CONV_REP & 1); ++crep) { u32x4 cvr[9], cgr[9];
#pragma unroll
        for (int i = 0; i < 9; ++i) { const int idx = tid + 512 * i, rr = idx / 48, ch = idx % 48, pos = s0 - 30 + rr; cvr[i] = (u32x4){0u, 0u, 0u, 0u}; cgr[i] = (u32x4){0u, 0u, 0u, 0u};
            if (idx < 94 * 48 && pos >= 0) { const bf16* pr = P + (size_t)(r0 - 30 + rr) * DIN; cvr[i] = *(const u32x4*)(pr + 1024 + ch * 8); cgr[i] = *(const u32x4*)(pr + 1408 + ch * 8); } }
        if (MIX_CVT >= 4 && mrep == 0 && crep == 0) { asm volatile("" ::: "memory"); cja = tr_decode(in, ws, cvi + 2 * CVS); tr_load(cja, cva, lane, 0); cjb = tr_decode(in, ws, cvi + 3 * CVS); tr_load(cjb, cvb, lane, 0); asm volatile("" ::: "memory"); }
#pragma unroll
        for (int i = 0; i < 9; ++i) { const int idx = tid + 512 * i, rr = idx / 48, ch = idx % 48; float a[8], b[8]; unpack8(cvr[i], a); unpack8(cgr[i], b);
#pragma unroll
            for (int q = 0; q < 8; ++q) a[q] *= fast_sigmoid(b[q]);
            u32x4 o; o.x = cvt_pk_bf16(a[0], a[1]); o.y = cvt_pk_bf16(a[2], a[3]); o.z = cvt_pk_bf16(a[4], a[5]); o.w = cvt_pk_bf16(a[6], a[7]);
            if (idx < 94 * 48) *(LAS u32x4*)(lds + HC + rr * 768 + ch * 16) = o; } }
      LDS_BARRIER();
      asm volatile("" : "+v"(tid)); lane = tid & 63;
      const int fr = lane & 15, fq = lane >> 4; const bf16* pw = (const bf16*)(ws + WS_PWT) + (size_t)layer * DCV * DCV;
      bf16x8 Bp[4][3];
      for (int crep = 0; crep < 1 + ((CONV_REP >> 1) & 1); ++crep) { const float* dww = in[8] + (size_t)layer * 31 * DCV; const float* dwb = in[9] + layer * DCV; const float* lg = in[10] + layer * DCV; const float* lb = in[11] + layer * DCV;
        f32x2 g2[3], bt2[3];
#pragma unroll
        for (int q = 0; q < 3; ++q) { g2[q] = *(const f32x2*)(lg + 128 * q + 2 * lane); bt2[q] = *(const f32x2*)(lb + 128 * q + 2 * lane); }
        float dd[8][6];
#pragma unroll
        for (int q = 0; q < 3; ++q) { const int c = 128 * q + 2 * lane; f32x2 wj[31];
#pragma unroll
            for (int j = 0; j < 31; ++j) wj[j] = *(const f32x2*)(dww + j * DCV + c);
            const f32x2 b2 = *(const f32x2*)(dwb + c); f32x2 a2[8];
#pragma unroll
            for (int r = 0; r < 8; ++r) a2[r] = b2;
#pragma unroll
            for (int s = 0; s < 38; ++s) { const unsigned hv = *(const LAS unsigned*)(lds + HC + (8 * w + s) * 768 + c * 2); const f32x2 h2 = (f32x2){bf_lo(hv), bf_hi(hv)};
#pragma unroll
                for (int r = 0; r < 8; ++r) { const int j = s - r; if (j >= 0 && j <= 30) a2[r] = __builtin_elementwise_fma(h2, wj[j], a2[r]); } }
#pragma unroll
            for (int r = 0; r < 8; ++r) { dd[r][2 * q] = a2[r][0]; dd[r][2 * q + 1] = a2[r][1]; asm volatile("" : "+v"(dd[r][2 * q]), "+v"(dd[r][2 * q + 1])); }
            asm volatile("" ::: "memory"); }
#pragma unroll
        for (int ks = 0; ks < 4; ++ks)
#pragma unroll
            for (int nt = 0; nt < 3; ++nt) Bp[ks][nt] = *(const bf16x8*)(pw + (size_t)((3 * w + nt) * 16 + fr) * DCV + ks * 32 + 8 * fq);
#pragma unroll
        for (int r = 0; r < 8; ++r) { float s = 0.f, v = 0.f;
#pragma unroll
            for (int q = 0; q < 6; ++q) { s += dd[r][q]; v += dd[r][q] * dd[r][q]; }
            const float mu = wave_sum(s) * (1.0f / DCV), ex2 = wave_sum(v) * (1.0f / DCV);
#pragma unroll
            for (int q = 0; q < 6; ++q) dd[r][q] -= mu;
            const float rs = 1.0f / sqrtf(fmaxf(ex2 - mu * mu, 0.f) + EPS);
#pragma unroll
            for (int q = 0; q < 3; ++q) { float y0 = dd[r][2 * q] * rs * g2[q][0] + bt2[q][0], y1 = dd[r][2 * q + 1] * rs * g2[q][1] + bt2[q][1]; y0 *= fast_sigmoid(y0); y1 *= fast_sigmoid(y1);
                *(LAS unsigned*)(lds + TT + (8 * w + r) * TST + (128 * q + 2 * lane) * 2) = cvt_pk_bf16(y0, y1); } } }
      LDS_BARRIER();
      for (int crep = 0; crep < 1 + ((CONV_REP >> 2) & 1); ++crep) { f32x4 acc[4][3];
        if (crep > 0) {
#pragma unroll
            for (int ks = 0; ks < 4; ++ks)
#pragma unroll
                for (int nt = 0; nt < 3; ++nt) Bp[ks][nt] = *(const bf16x8*)(pw + (size_t)((3 * w + nt) * 16 + fr) * DCV + ks * 32 + 8 * fq); }
#pragma unroll
        for (int a = 0; a < 4; ++a)
#pragma unroll
            for (int b = 0; b < 3; ++b) acc[a][b] = (f32x4){0.f, 0.f, 0.f, 0.f};
        const f32x4* pb4 = (const f32x4*)(in[13] + layer * DCV); f32x4 pbv[3];
#pragma unroll
        for (int nt = 0; nt < 3; ++nt) pbv[nt] = pb4[(3 * w + nt) * 4 + fq];
#pragma unroll
        for (int kb = 0; kb < 3; ++kb) { bf16x8 Bn[4][3];
            if (kb < 2) {
#pragma unroll
                for (int ks = 0; ks < 4; ++ks)
#pragma unroll
                    for (int nt = 0; nt < 3; ++nt) Bn[ks][nt] = *(const bf16x8*)(pw + (size_t)((3 * w + nt) * 16 + fr) * DCV + (4 * (kb + 1) + ks) * 32 + 8 * fq); }
#pragma unroll
            for (int ks = 0; ks < 4; ++ks) { bf16x8 A[4];
#pragma unroll
                for (int mt = 0; mt < 4; ++mt) A[mt] = *(const LAS bf16x8*)(lds + TT + (mt * 16 + fr) * TST + ((4 * kb + ks) * 32 + 8 * fq) * 2);
#pragma unroll
                for (int mt = 0; mt < 4; ++mt)
#pragma unroll
                    for (int nt = 0; nt < 3; ++nt) acc[mt][nt] = __builtin_amdgcn_mfma_f32_16x16x32_bf16(Bp[ks][nt], A[mt], acc[mt][nt], 0, 0, 0); }
            if (kb < 2) {
#pragma unroll
                for (int ks = 0; ks < 4; ++ks)
#pragma unroll
                    for (int nt = 0; nt < 3; ++nt) Bp[ks][nt] = Bn[ks][nt]; } }
#pragma unroll
        for (int mt = 0; mt < 4; ++mt)
#pragma unroll
            for (int nt = 0; nt < 3; ++nt) { const int t = r0 + mt * 16 + fr, n4 = (3 * w + nt) * 16 + 4 * fq; const f32x4 v = acc[mt][nt] + pbv[nt];
                u32x2 o; o.x = cvt_pk_bf16(v[0], v[1]); o.y = cvt_pk_bf16(v[2], v[3]); *(u32x2*)(Y + (size_t)t * D + 640 + n4) = o; } }
      LDS_BARRIER(); }
    if (MIX_CVT >= 4) { tr_store(cja, cva, nullptr, lane, 0); tr_store(cjb, cvb, nullptr, lane, 0); }
}

__device__ __forceinline__ void router_phase(Frame& F) {
    LAS unsigned char* lds = F.lds; int lane = F.lane; asm volatile("" : "+v"(lane)); const int w = F.wave; unsigned char* ws = F.ws;
    const InTab in = in_tab(F); const bf16* XBr = (const bf16*)(ws + WS_XB); const float* g2 = in[15] + D; const float* R = in[19];
    unsigned* rowoff = (unsigned*)(ws + WS_ROWOFF); float* rs_e = (float*)(ws + WS_RS); float* gate_e = (float*)(ws + WS_GATE); int* sel = (int*)(ws + WS_SEL);
    unsigned* cnt = F.ctl + CW_CNT;
    LAS int* se0 = (LAS int*)lds; LAS int* se1 = se0 + 64; LAS float* sw0 = (LAS float*)(se1 + 64); LAS float* sw1 = sw0 + 64; LAS float* srs = sw1 + 64;
    float Rg[4][4][8];
#pragma unroll
    for (int j = 0; j < 4; ++j)
#pragma unroll
        for (int q = 0; q < 4; ++q) { const int k = 8 * lane + 512 * (j >> 1) + 4 * (j & 1) + q; const float gk = g2[k]; const f32x4 a = *(const f32x4*)(R + k * 8), b = *(const f32x4*)(R + k * 8 + 4);
            Rg[j][q][0] = a[0] * gk; Rg[j][q][1] = a[1] * gk; Rg[j][q][2] = a[2] * gk; Rg[j][q][3] = a[3] * gk; Rg[j][q][4] = b[0] * gk; Rg[j][q][5] = b[1] * gk; Rg[j][q][6] = b[2] * gk; Rg[j][q][7] = b[3] * gk; }
    for (int b = F.vcu; b < M / 64; b += F.G) {
        f32x4 cva[8], cvb[8]; TrJob cja, cjb; const int cvi = R9_BEG + b * 8 + w;
        if (R9_CVT >= 2) { cja = tr_decode(in, ws, cvi); tr_load(cja, cva, lane, 0); cjb = tr_decode(in, ws, cvi + (M / 64) * 8); tr_load(cjb, cvb, lane, 0); }
        for (int i = 0; i < 8; ++i) { const int tl = 8 * w + i, t = 64 * b + tl; const u32x4* xr = (const u32x4*)(XBr + (size_t)t * D) + lane; float ss = 0.f, le[8];
#pragma unroll
            for (int e = 0; e < 8; ++e) le[e] = 0.f;
            const u32x4 xa = xr[0], xb2 = xr[64];
#pragma unroll
            for (int j = 0; j < 4; ++j) { const u32x4 xw = (j < 2) ? xa : xb2; const unsigned w0_ = (j & 1) ? xw.z : xw.x, w1_ = (j & 1) ? xw.w : xw.y; const f32x4 v = (f32x4){bf_lo(w0_), bf_hi(w0_), bf_lo(w1_), bf_hi(w1_)};
#pragma unroll
                for (int q = 0; q < 4; ++q) { ss += v[q] * v[q];
#pragma unroll
                    for (int e = 0; e < 8; ++e) le[e] += v[q] * Rg[j][q][e]; } }
            ss = wave_sum(ss);
#pragma unroll
            for (int e = 0; e < 8; ++e) le[e] = wave_sum(le[e]);
            const float rs = 1.0f / sqrtf(ss * (1.0f / D) + EPS);
            int i0 = 0; float l0 = le[0];
#pragma unroll
            for (int e = 1; e < 8; ++e) if (le[e] > l0) { l0 = le[e]; i0 = e; }
            int i1 = -1; float l1 = -3.0e38f;
#pragma unroll
            for (int e = 0; e < 8; ++e) if (e != i0 && le[e] > l1) { l1 = le[e]; i1 = e; }
            const float ex = expf((l1 - l0) * rs), w0 = 1.0f / (1.0f + ex), w1 = ex / (1.0f + ex);
            if (lane == 0) { se0[tl] = i0; se1[tl] = i1; sw0[tl] = w0; sw1[tl] = w1; srs[tl] = rs; } }
        __syncthreads();
        if (w == 0) { const int e0 = se0[lane], e1 = se1[lane]; int r0 = 0, r1 = 0; const unsigned long long lt = (1ull << lane) - 1ull;
            int l0 = 0, l1 = 0, nmine = 0;
#pragma unroll
            for (int e = 0; e < 8; ++e) { const unsigned long long m0 = __ballot(e0 == e), m1 = __ballot(e1 == e); const int n0 = __popcll(m0), n = n0 + __popcll(m1);
                if (e0 == e) l0 = __popcll(m0 & lt);
                if (e1 == e) l1 = n0 + __popcll(m1 & lt);
                nmine = (lane == e) ? n : nmine; }
            unsigned base = 0u;
            if (lane < 8 && nmine > 0) base = __hip_atomic_fetch_add(cnt + 64 * lane, (unsigned)nmine, RLX_AGENT);
            r0 = (int)__shfl(base, e0) + l0; r1 = (int)__shfl(base, e1) + l1;
            const int t = 64 * b + lane; const float rs = srs[lane];
            rowoff[e0 * ECAP + r0] = (unsigned)t * (unsigned)(D * 2); rs_e[e0 * ECAP + r0] = rs; gate_e[e0 * ECAP + r0] = sw0[lane];
            rowoff[e1 * ECAP + r1] = (unsigned)t * (unsigned)(D * 2); rs_e[e1 * ECAP + r1] = rs; gate_e[e1 * ECAP + r1] = sw1[lane];
            *(int4*)(sel + 4 * t) = make_int4(e0, r0, e1, r1); }
        if (R9_CVT >= 2) { tr_store(cja, cva, nullptr, lane, 0); tr_store(cjb, cvb, nullptr, lane, 0); }
        __syncthreads();
    }
}
__device__ __forceinline__ void moe_panels(Frame& F, int (&pb)[9]) {
    unsigned* cnt = F.ctl + CW_CNT; pb[0] = 0;
#pragma unroll
    for (int e = 0; e < 8; ++e) { const unsigned c = (unsigned)__builtin_amdgcn_readfirstlane(__hip_atomic_load(cnt + 64 * e, RLX_AGENT)); pb[e + 1] = pb[e] + (int)((c + 255u) >> 8); }
}
__device__ __forceinline__ void final_phase(Frame& F) {
    int pb[9]; moe_panels(F, pb);
    const int total = pb[8] * 4, nfull = (total / F.G) * F.G, NPf = nfull / 4, sp = pg8::moe_split(total - nfull, F.G); const bf16* slabs = (const bf16*)(F.ws + WS_SLAB);
    int lane = F.lane; asm volatile("" : "+v"(lane));
    const int gw = F.vcu * 8 + F.wave, NGW = F.G * 8; unsigned char* ws = F.ws;
    const bf16* YP = (const bf16*)(ws + WS_YP); const int* sel = (const int*)(ws + WS_SEL); const float* fg = in_tab(F)[23]; float* X = F.out; const bf16* XBf = (const bf16*)(ws + WS_XB2);
    f32x4 g4[4];
#pragma unroll
    for (int j = 0; j < 4; ++j) g4[j] = *((const f32x4*)fg + lane + 64 * j);
    for (int t = gw; t < M; t += NGW) { const int4 s = *(const int4*)(sel + 4 * t); int b0 = 0, b1 = 0;
#pragma unroll
        for (int e = 0; e < 8; ++e) { b0 = (s.x == e) ? pb[e] : b0; b1 = (s.z == e) ? pb[e] : b1; }
        const int pr[2] = {256 * b0 + s.y, 256 * b1 + s.w};
        const u32x2* xr = (const u32x2*)(XBf + (size_t)t * D) + lane;
        f32x4 v[4];
#pragma unroll
        for (int j = 0; j < 4; ++j) { const u32x2 a = xr[64 * j]; v[j] = (f32x4){bf_lo(a.x), bf_hi(a.x), bf_lo(a.y), bf_hi(a.y)}; }
#pragma unroll
        for (int k = 0; k < 2; ++k) { const int pm = pr[k] >> 8, lr = pr[k] & 255;
            if (sp > 1 && pm >= NPf) {
#pragma unroll
                for (int j = 0; j < 4; ++j) { const bf16* sb = slabs + (size_t)(((pm - NPf) * 4 + j) * sp) * 65536 + lr * 256 + 4 * lane; u32x2 a[14];
#pragma unroll
                    for (int ks = 0; ks < 14; ++ks) { a[ks] = (u32x2){0u, 0u}; if (ks < sp) a[ks] = *(const u32x2*)(sb + (size_t)ks * 65536); }
#pragma unroll
                    for (int ks = 0; ks < 14; ++ks) { v[j][0] += bf_lo(a[ks].x); v[j][1] += bf_hi(a[ks].x); v[j][2] += bf_lo(a[ks].y); v[j][3] += bf_hi(a[ks].y); } }
            } else { const u32x2* y = (const u32x2*)(YP + (size_t)pr[k] * D) + lane;
#pragma unroll
                for (int j = 0; j < 4; ++j) { const u32x2 a = __builtin_nontemporal_load(y + 64 * j); v[j][0] += bf_lo(a.x); v[j][1] += bf_hi(a.x); v[j][2] += bf_lo(a.y); v[j][3] += bf_hi(a.y); } } }
        float ss = 0.f;
#pragma unroll
        for (int j = 0; j < 4; ++j) ss += (v[j][0] * v[j][0] + v[j][1] * v[j][1]) + (v[j][2] * v[j][2] + v[j][3] * v[j][3]);
        ss = wave_sum(ss); const float rs = 1.0f / sqrtf(ss * (1.0f / D) + EPS);
        f32x4* o = (f32x4*)(X + (size_t)t * D) + lane;
#pragma unroll
        for (int j = 0; j < 4; ++j) __builtin_nontemporal_store(v[j] * rs * g4[j], o + 64 * j); }
}

template <class Sched> __device__ __forceinline__ void stage_rstd(Frame& F, const Sched& S, const float* ssq, LAS float* rtab) {
    pg8::Unit u; int tid = F.tid; asm volatile("" : "+v"(tid)); __syncthreads();
#pragma unroll 1
    for (int i = 0; i < 8 && S.next(i, u); ++i) if (tid < 256) rtab[i * 256 + tid] = pg8::rstd_of(ssq, u.pm * 256 + tid);
    __syncthreads();
}
struct Args { const float* in[24]; float* out; unsigned char* ws; int ph_lo, ph_hi, li, pad; };
__global__ void __launch_bounds__(512, 2) fwd(Args args) {
    extern __shared__ __attribute__((aligned(16))) unsigned char lds_raw[];
    Frame F;
    F.lds = (LAS unsigned char*)lds_raw; F.MISC = (volatile LAS unsigned*)(F.lds + MISC_OFF);
    F.tid = threadIdx.x; F.lane = F.tid & 63; F.wave = __builtin_amdgcn_readfirstlane(F.tid >> 6);
    F.G = gridDim.x; { const int bx = blockIdx.x; F.vcu = (F.G % 8 == 0) ? (bx % 8) * (F.G / 8) + bx / 8 : bx; }
    F.in.t = (const LAS unsigned long long*)(F.lds + INTAB_OFF); F.out = args.out; F.ws = args.ws; F.ctl = (unsigned*)(args.ws + WS_CTL);
    for (int u = F.tid; u < 64; u += 512) ((LAS unsigned*)(F.lds + MISC_OFF))[u] = 0u;
    if (F.tid < 24) ((LAS unsigned long long*)(F.lds + INTAB_OFF))[F.tid] = (unsigned long long)args.in[F.tid];
    __syncthreads();
    jobs_setup(F);
    XcdBarrier bar = xcd_barrier_post(F.ctl + CW_BAR + args.li * XCD_BAR_WORDS, F.MISC + 8);
    const int lo = args.ph_lo, hi = args.ph_hi;
#ifndef PH_MASK
#define PH_MASK 0xFFFF
#endif
#define PH_ON(k) (((PH_MASK) >> (k)) & 1)
#ifndef REP_MASK
#define REP_MASK 0
#endif
#define REPS(k) (1 + (((REP_MASK) >> (k)) & 1))
#ifndef PRO_PROBE
#define PRO_PROBE 0
#endif
#ifndef CVT_BEFORE
#define CVT_BEFORE 0
#endif
#ifndef EPI_PROBE
#define EPI_PROBE 0
#endif
#define IN(k) (lo <= (k) && (k) < hi)
#define SEAM(k) do { if (IN(k) && IN((k) + 1)) xcd_barrier(bar); } while (0)
#define SEAMH(k, first) do { if (IN(k) && IN((k) + 1)) xcd_barrier_host(bar, F, (first)); } while (0)
    unsigned char* ws = args.ws; LAS unsigned* gtab = (LAS unsigned*)(F.lds + GTAB_OFF);
    bf16* XB = (bf16*)(ws + WS_XB); float* ssq = (float*)(ws + WS_SSQ);
    if (F.G != 256) return;

    if (PH_ON(0) && IN(0)) for (int rep = 0; rep < REPS(0); ++rep) { p0_prologue(F, rep == 0 ? 0 : PRO_PROBE); __syncthreads(); }
    SEAMH(0, 0);
#pragma unroll 1
    for (int layer = 0; layer < 2; ++layer) {
        const int pbase = 1 + layer * 5;
        if (PH_ON(1) && IN(pbase)) for (int rep = 0; rep < REPS(1); ++rep) { pg8::Gemm g{XB, (const bf16*)(ws + WS_WIN) + (size_t)layer * DIN * D, D, 0}; pg8::StaticOrder S; S.init(M, DIN, F.G, (int)blockIdx.x);
            stage_rstd(F, S, ssq, (LAS float*)gtab); pg8::EpiP E{(bf16*)(ws + WS_P), DIN, (const LAS float*)gtab}; pg8::gemm_phase<pg8::EpiP, pg8::StaticOrder, true, true>(F.lds, gtab, g, S, E);
            if (rep == 0) tail_convert(F, layer ? H6_BEG : H1_BEG, H1_N, (int)blockIdx.x - 192, 64); }
        SEAMH(pbase, layer == 0 ? 1 : -1);
        if (PH_ON(2) && IN(pbase + 1)) for (int rep = 0; rep < REPS(2); ++rep) { for (int u = F.vcu; u < M / 64; u += F.G) mixer_unit(F, u, layer, layer ? MX1_BEG : MX0_BEG); }
        SEAMH(pbase + 1, layer == 0 ? 2 : -1);
        if (PH_ON(3) && IN(pbase + 2)) for (int rep = 0; rep < (layer == 0 ? REPS(3) : 1); ++rep) { pg8::Gemm g{(const bf16*)(ws + WS_Y), (const bf16*)(ws + WS_WOUT) + (size_t)layer * D * D, D, 0}; pg8::StaticOrder S; S.init(M, D, F.G, (int)blockIdx.x);
            pg8::EpiResid E{(const float*)nullptr, XB, ssq}; pg8::gemm_phase<pg8::EpiResid, pg8::StaticOrder, false, true>(F.lds, gtab, g, S, E); }
        SEAMH(pbase + 2, layer == 0 ? 3 : -1);
        if (layer == 0) {
            if (PH_ON(4) && IN(4)) for (int rep = 0; rep < REPS(4); ++rep) { pg8::Gemm g{XB, (const bf16*)(ws + WS_WGU), D, 0}; pg8::StaticOrder S; S.init(M, NGU, F.G, (int)blockIdx.x);
                stage_rstd(F, S, ssq, (LAS float*)gtab); pg8::EpiSwiglu<false> E{(bf16*)(ws + WS_ACT), DFF, (const LAS float*)gtab, 0}; pg8::gemm_phase<pg8::EpiSwiglu<false>, pg8::StaticOrder, true, true>(F.lds, gtab, g, S, E);
                if (rep == 0) tail_convert(F, H4_BEG, H4_N, (int)blockIdx.x - 128, 128); }
            SEAMH(4, 4);
            if (PH_ON(5) && IN(5)) { pg8::Gemm g{(const bf16*)(ws + WS_ACT), (const bf16*)(ws + WS_WD), DFF, 0}; pg8::StaticOrder S; S.init(M, D, F.G, (int)blockIdx.x);
                pg8::EpiResid E{(const float*)nullptr, XB, ssq}; pg8::gemm_phase<pg8::EpiResid, pg8::StaticOrder, false, true>(F.lds, gtab, g, S, E); }
            SEAMH(5, 5);
        }
    }
    if (PH_ON(9) && IN(9)) router_phase(F);
    SEAM(9);
#ifndef STAGGER_US
#define STAGGER_US 0
#endif
    if (PH_ON(10) && IN(10)) for (int rep = 0; rep < REPS(10); ++rep) {
        if (STAGGER_US > 0 && (blockIdx.x & 1)) { const unsigned long long t0 = __builtin_amdgcn_s_memrealtime(); while (__builtin_amdgcn_s_memrealtime() - t0 < (unsigned long long)(STAGGER_US * 100)) __builtin_amdgcn_s_sleep(8); __syncthreads(); }
        pg8::MoeOrderGather S; moe_panels(F, S.pb); S.nN = NGUE / 256; S.nwg = S.pb[8] * S.nN; S.G = F.G; S.c = (int)blockIdx.x; S.rowoff = (const unsigned*)(ws + WS_ROWOFF); S.rs_e = (const float*)(ws + WS_RS); S.gate_e = (const float*)(ws + WS_GATE);
        pg8::Gemm g{XB, (const bf16*)(ws + WS_MOE_WGU), D, (size_t)NGUE * D};
        pg8::EpiSwiglu<true> E{(bf16*)(ws + WS_ACTM), DFE, (const LAS float*)(gtab + 512), rep == 0 ? 0 : EPI_PROBE};
        pg8::gemm_phase<pg8::EpiSwiglu<true>, pg8::MoeOrderGather, true, true>(F.lds, gtab, g, S, E);
        if (rep == 0) { const int rem = S.nwg % F.G, idle = rem ? F.G - rem : 0, nconv = idle < 48 ? F.G : (idle > 192 ? 192 : idle);
            tail_convert(F, H10_BEG, H10_N, ((int)blockIdx.x - rem + F.G) % F.G, nconv); } }
    SEAM(10);
    if (PH_ON(11) && IN(11)) for (int rep = 0; rep < REPS(11); ++rep) { pg8::MoeOrderDown S; moe_panels(F, S.pb); S.init(F.G, (int)blockIdx.x);
        pg8::Gemm g{(const bf16*)(ws + WS_ACTM), (const bf16*)(ws + WS_MOE_WD), DFE, (size_t)D * DFE};
        pg8::EpiBf16 E{(bf16*)(ws + WS_YP), D, (bf16*)(ws + WS_SLAB)};
        pg8::gemm_phase<pg8::EpiBf16, pg8::MoeOrderDown, true, true>(F.lds, gtab, g, S, E); }
    SEAM(11);
    if (PH_ON(12) && IN(12)) final_phase(F);
#undef IN
#undef SEAM
}
#ifndef MK_PER_PHASE
#define MK_PER_PHASE 0
#endif
extern "C" void kernel_launch(void* const* d_in, const int* in_sizes, int n_in, void* d_out, int out_size, void* d_ws, size_t ws_size, hipStream_t stream) {
    static int grid = 0;
    if (grid == 0) {
        if (n_in != 24 || out_size != M * D || ws_size < WS_END) { fprintf(stderr, "kernel_launch: unexpected shapes (n_in %d out %d ws %zu)\n", n_in, out_size, ws_size); grid = -1; return; }
        int dev = 0, cus = 0;
        if (hipGetDevice(&dev) != hipSuccess || hipDeviceGetAttribute(&cus, hipDeviceAttributeMultiprocessorCount, dev) != hipSuccess) { grid = -1; return; }
        if (hipFuncSetAttribute((const void*)fwd, hipFuncAttributeMaxDynamicSharedMemorySize, LDS_BYTES) != hipSuccess) { fprintf(stderr, "kernel_launch: hipFuncSetAttribute failed\n"); grid = -1; return; }
        int per_cu = 0;
        if (hipOccupancyMaxActiveBlocksPerMultiprocessor(&per_cu, (const void*)fwd, 512, LDS_BYTES) != hipSuccess || per_cu < 1) fprintf(stderr, "kernel_launch: occupancy query says %d\n", per_cu);
        (void)hipGetLastError();
        grid = cus;
        if (grid != 256) { fprintf(stderr, "kernel_launch: built for 256 CUs, found %d\n", grid); grid = -1; return; }
    }
    if (grid < 0) return;
    (void)hipMemsetAsync((char*)d_ws + WS_CTL, 0, CTL_ZERO_BYTES, stream);
    Args a{};
    for (int i = 0; i < 24; ++i) a.in[i] = (const float*)d_in[i];
    a.out = (float*)d_out; a.ws = (unsigned char*)d_ws; a.pad = 0;
#if MK_PER_PHASE
    for (int p = 0; p < NPHASE; ++p) { a.ph_lo = p; a.ph_hi = p + 1; a.li = p; hipLaunchKernelGGL(fwd, dim3(grid), dim3(512), LDS_BYTES, stream, a); }
#else
    a.ph_lo = 0; a.ph_hi = NPHASE; a.li = 0; hipLaunchKernelGGL(fwd, dim3(grid), dim3(512), LDS_BYTES, stream, a);
#endif
}
```

```cpp
#define MK_PER_PHASE 0
#define PG_WGM 4
#define NT_ACT 1
#define HID_PW 8
#define H10_SHARE 11264
#define SEAM_RELAX 0
#include <hip/hip_runtime.h>
#include <cstdio>
#include <cstdint>
constexpr int M = 16384, D = 1024, SEQ = 8192, DIN = 1792, DFF = 2816, DFE = 3584, NE = 8;
constexpr int DPOOL = 256, DGM = 384, DCV = 384;
constexpr int NGU = 2 * DFF, NGUE = 2 * DFE;
constexpr int ECAP = 16384;
constexpr int PMAX = 2 * M + NE * 256;
constexpr float EPS = 1e-6f;

#define LAS __attribute__((address_space(3)))
#define GAS __attribute__((address_space(1)))
typedef unsigned short bf16;
typedef short bf16x8 __attribute__((ext_vector_type(8)));
typedef short s16x4 __attribute__((ext_vector_type(4)));
typedef float f32x4 __attribute__((ext_vector_type(4)));
typedef float f32x2 __attribute__((ext_vector_type(2)));
typedef unsigned u32x4 __attribute__((ext_vector_type(4)));
typedef unsigned u32x2 __attribute__((ext_vector_type(2)));

__device__ __forceinline__ unsigned cvt_pk_bf16(float lo, float hi) { unsigned r; asm volatile("v_cvt_pk_bf16_f32 %0, %1, %2" : "=v"(r) : "v"(lo), "v"(hi)); return r; }
#ifndef WT_MASK
#define WT_MASK 0
#endif
__device__ __forceinline__ void st16_wt(const void* base, unsigned off, u32x4 w) { asm volatile("s_nop 4\n\tglobal_store_dwordx4 %0, %1, %2 sc1\n\ts_nop 1" :: "v"(off), "v"(w), "s"(base) : "memory"); }
__device__ __forceinline__ void st16_wt_u(const void* base, unsigned off, u32x4 w) {
    const unsigned long long b = (unsigned long long)base; const unsigned lo = __builtin_amdgcn_readfirstlane((unsigned)b), hi = __builtin_amdgcn_readfirstlane((unsigned)(b >> 32));
    st16_wt((const void*)(((unsigned long long)hi << 32) | lo), off, w); }
__device__ __forceinline__ void st8_wt(const void* base, unsigned off, u32x2 w) { asm volatile("s_nop 4\n\tglobal_store_dwordx2 %0, %1, %2 sc1" :: "v"(off), "v"(w), "s"(base) : "memory"); }
__device__ __forceinline__ float bf_lo(unsigned w) { return __uint_as_float(w << 16); }
__device__ __forceinline__ float bf_hi(unsigned w) { return __uint_as_float(w & 0xffff0000u); }
__device__ __forceinline__ float fast_sigmoid(float x) { return __builtin_amdgcn_rcpf(1.0f + __builtin_amdgcn_exp2f(-1.4426950408889634f * x)); }
template <int CTRL> __device__ __forceinline__ float dpp_f(float v) { return __int_as_float(__builtin_amdgcn_update_dpp(0, __float_as_int(v), CTRL, 0xF, 0xF, true)); }
__device__ __forceinline__ float wave_sum(float v) {
    v += dpp_f<0xB1>(v); v += dpp_f<0x4E>(v); v += dpp_f<0x141>(v); v += dpp_f<0x140>(v);
    const int iv = __float_as_int(v);
    return (__int_as_float(__builtin_amdgcn_readlane(iv, 0)) + __int_as_float(__builtin_amdgcn_readlane(iv, 16))) + (__int_as_float(__builtin_amdgcn_readlane(iv, 32)) + __int_as_float(__builtin_amdgcn_readlane(iv, 48)));
}

#ifndef NT_ACT2
#define NT_ACT2 0
#endif
#ifndef PG_WGM
#define PG_WGM 8
#endif
namespace pg8 {
constexpr int BM = 256, BK = 64, HALF = 128, HTB = HALF * BK * 2, STAGE_BYTES = 8 * HTB, NXCD = 8, WGM = PG_WGM;
__host__ __device__ __forceinline__ int lds_byte(int r, int c) { const int st = (r >> 4) * 2 + (c >> 5), rr = r & 15, cc = c & 31, ob = rr * 64 + cc * 2; return st * 1024 + (ob ^ (((ob >> 9) & 1) << 5)); }
__host__ __device__ __forceinline__ void stage_rc(int b, int& R, int& C) { const int st = b / 1024, sb = b % 1024, swz = sb ^ (((sb >> 9) & 1) << 5); R = (st >> 1) * 16 + swz / 64; C = (st & 1) * 32 + (swz % 64) / 2; }
__host__ __device__ __forceinline__ int perm32(int rho) { const int n = rho >> 4, i = rho & 15; return 8 * (i >> 2) + 4 * n + (i & 3); }

struct Unit { int pm, pn, e, tab, k0b, nt, slab, ui; };
struct Gemm { const bf16* A; const bf16* Bt; int K; size_t bstride_e; };

__device__ __forceinline__ void order_map(int wgid, int nM, int nN, int& pm, int& pn) {
    const int nwg = nM * nN; { const int q = nwg / NXCD, r = nwg % NXCD, xcd = wgid % NXCD, off = wgid / NXCD; wgid = (xcd < r ? xcd * (q + 1) : r * (q + 1) + (xcd - r) * q) + off; }
    const int nig = WGM * nN, gid = wgid / nig, fm = gid * WGM, gsz = (nM - fm) < WGM ? (nM - fm) : WGM;
    pm = fm + ((wgid % nig) % gsz); pn = (wgid % nig) / gsz;
}
struct StaticOrder {
    static constexpr bool GATHER = false;
    int nM, nN, nwg, G, c;
    __device__ void init(int Mrows, int N, int G_, int c_) { nM = Mrows / BM; nN = N / BM; nwg = nM * nN; G = G_; c = c_; }
    __device__ __forceinline__ bool next(int i, Unit& u) const { const long L = (long)i * G + c; if (L >= nwg) return false; order_map((int)L, nM, nN, u.pm, u.pn); u.e = 0; u.tab = i * 256; u.k0b = 0; u.nt = 0; u.slab = -1; return true; }
    __device__ __forceinline__ const unsigned* a_table(const Unit&) const { return nullptr; }
    __device__ __forceinline__ const float* rs_table(const Unit&) const { return nullptr; }
    __device__ __forceinline__ const float* gate_table(const Unit&) const { return nullptr; }
};
struct MoeOrder {
    int pb[9]; int nN, nwg, G, c; const unsigned* rowoff; const float* rs_e; const float* gate_e;
    __device__ __forceinline__ bool next(int i, Unit& u) const {
        const long L = (long)i * G + c; if (L >= nwg) return false; order_map((int)L, pb[8], nN, u.pm, u.pn); u.k0b = 0; u.nt = 0; u.slab = -1;
        int e = 0;
#pragma unroll
        for (int k = 1; k < 8; ++k) e += (u.pm >= pb[k]) ? 1 : 0;
        int pbe = pb[0];
#pragma unroll
        for (int k = 1; k < 8; ++k) pbe = (e == k) ? pb[k] : pbe;
        u.e = e; u.tab = e * ECAP + 256 * (u.pm - pbe); return true;
    }
    __device__ __forceinline__ const unsigned* a_table(const Unit& u) const { return rowoff + u.tab; }
    __device__ __forceinline__ const float* rs_table(const Unit& u) const { return rs_e + u.tab; }
    __device__ __forceinline__ const float* gate_table(const Unit& u) const { return gate_e + u.tab; }
};
struct MoeOrderGather : MoeOrder { static constexpr bool GATHER = true; };
#ifndef FORCE_SPLIT
#define FORCE_SPLIT 0
#endif
__host__ __device__ __forceinline__ int moe_split(int r, int G) { if (FORCE_SPLIT) return r == 0 ? 1 : FORCE_SPLIT;
    return r == 0 ? 1 : (r * 14 <= G ? 14 : (r * 7 <= G ? 7 : (r * 4 <= G ? 4 : (r * 2 <= G ? 2 : 1)))); }
struct MoeOrderDown {
    static constexpr bool GATHER = false;
    int pb[9]; int G, c, NPf, nfull, r, s;
    __device__ __forceinline__ void init(int G_, int c_) { G = G_; c = c_; const int total = pb[8] * 4; nfull = (total / G) * G; NPf = nfull / 4; r = total - nfull; s = moe_split(r, G); }
    __device__ __forceinline__ bool next(int i, Unit& u) const {
        const int L = i * G + c; u.tab = 0;
        if (L < nfull) { order_map(L, NPf, 4, u.pm, u.pn); u.k0b = 0; u.nt = 0; u.slab = -1; }
        else { const int j = L - nfull; if (j >= r * s) return false; const int lu = j / s, ks = j - lu * s; u.pm = NPf + (lu >> 2); u.pn = lu & 3; u.nt = (DFE / BK) / s; u.k0b = ks * u.nt * BK * 2; u.slab = s > 1 ? j : -1; }
        int e = 0;
#pragma unroll
        for (int k = 1; k < 8; ++k) e += (u.pm >= pb[k]) ? 1 : 0;
        u.e = e; return true;
    }
    __device__ __forceinline__ const unsigned* a_table(const Unit&) const { return nullptr; }
    __device__ __forceinline__ const float* rs_table(const Unit&) const { return nullptr; }
    __device__ __forceinline__ const float* gate_table(const Unit&) const { return nullptr; }
};

__device__ __forceinline__ float rstd_of(const float* ssq, int row) { const float s = (ssq[row] + ssq[M + row]) + (ssq[2 * M + row] + ssq[3 * M + row]); return 1.0f / sqrtf(s * (1.0f / D) + EPS); }

struct EpiP {
    static constexpr bool PERM = true, AFTER_DRAIN = false; static constexpr int NSTORE = 16;
    bf16* O; int ldc; const LAS float* rtab;
    __device__ __forceinline__ void operator()(const f32x4 (&acc)[2][2][4][2], const Unit& u, int wr, int wc, int fr, int fq) const {
        const int row0 = u.pm * BM + wr * 64 + fr, col0 = u.pn * BM + wc * 32 + 8 * fq;
#pragma unroll
        for (int ai = 0; ai < 2; ++ai)
#pragma unroll
            for (int m = 0; m < 4; ++m) { const int row = row0 + ai * HALF + m * 16; const float rs = rtab[u.tab + wr * 64 + fr + ai * HALF + m * 16]; bf16* rowp = O + (size_t)row * ldc + col0;
#pragma unroll
                for (int bj = 0; bj < 2; ++bj) { const f32x4 v0 = acc[ai][bj][m][0] * rs, v1 = acc[ai][bj][m][1] * rs;
                    u32x4 w; w.x = cvt_pk_bf16(v0[0], v0[1]); w.y = cvt_pk_bf16(v0[2], v0[3]); w.z = cvt_pk_bf16(v1[0], v1[1]); w.w = cvt_pk_bf16(v1[2], v1[3]);
                    if (WT_MASK & 4) st16_wt(O, (unsigned)((row * ldc + col0 + bj * HALF) * 2), w); else if (NT_ACT2) __builtin_nontemporal_store(w, (u32x4*)(rowp + bj * HALF)); else *(u32x4*)(rowp + bj * HALF) = w; } }
    }
};
#ifndef NT_ACT
#define NT_ACT 0
#endif
#ifndef ACT_AUX
#define ACT_AUX -1
#endif
template <bool MOE> struct EpiSwiglu {
    static constexpr bool PERM = true, AFTER_DRAIN = false; static constexpr int NSTORE = 8;
    bf16* O; int ldc; const LAS float* rtab; int mode;
    __device__ __forceinline__ void operator()(const f32x4 (&acc)[2][2][4][2], const Unit& u, int wr, int wc, int fr, int fq) const {
        if (mode == 2) { asm volatile("" :: "v"(acc[0][0][0][0][0]), "v"(acc[1][1][3][1][3])); return; }
        const int lr0 = wr * 64 + fr, col0 = u.pn * HALF + wc * 32 + 8 * fq;
#pragma unroll
        for (int ai = 0; ai < 2; ++ai)
#pragma unroll
            for (int m = 0; m < 4; ++m) { const int lr = lr0 + ai * HALF + m * 16, row = u.pm * BM + lr; float rs, gw;
                if (MOE) { rs = rtab[(u.ui & 1) * 512 + lr]; gw = rtab[(u.ui & 1) * 512 + 256 + lr]; } else { rs = rtab[u.tab + lr]; gw = 1.0f; }
                float o[8]; const float c1 = rs * -1.4426950408889634f, c2 = rs * rs * gw;
#pragma unroll
                for (int n = 0; n < 2; ++n) { const f32x4 ga = acc[ai][0][m][n], gu = ga * acc[ai][1][m][n] * c2, ex = ga * c1;
#pragma unroll
                    for (int q = 0; q < 4; ++q) o[n * 4 + q] = gu[q] * __builtin_amdgcn_rcpf(1.0f + __builtin_amdgcn_exp2f(ex[q])); }
                u32x4 w; w.x = cvt_pk_bf16(o[0], o[1]); w.y = cvt_pk_bf16(o[2], o[3]); w.z = cvt_pk_bf16(o[4], o[5]); w.w = cvt_pk_bf16(o[6], o[7]);
                if (mode == 1) { asm volatile("" :: "v"(w.x), "v"(w.y), "v"(w.z), "v"(w.w)); } else if (ACT_AUX == 16) { bf16* ap = O + (size_t)row * ldc + col0; asm volatile("global_store_dwordx4 %0, %1, off sc1\n\ts_nop 1" :: "v"(ap), "v"(w) : "memory"); } else if (ACT_AUX == 18) { bf16* ap = O + (size_t)row * ldc + col0; asm volatile("global_store_dwordx4 %0, %1, off sc1 nt\n\ts_nop 1" :: "v"(ap), "v"(w) : "memory"); } else if (WT_MASK & 8) st16_wt(O, (unsigned)(row * ldc + col0) * 2u, w); else if (NT_ACT) __builtin_nontemporal_store(w, (u32x4*)(O + (size_t)row * ldc + col0)); else *(u32x4*)(O + (size_t)row * ldc + col0) = w; }
    }
};
struct EpiBf16 {
    static constexpr bool PERM = true, AFTER_DRAIN = false; static constexpr int NSTORE = 16;
    bf16* O; int ldc; bf16* slabs;
    __device__ __forceinline__ void operator()(const f32x4 (&acc)[2][2][4][2], const Unit& u, int wr, int wc, int fr, int fq) const {
        const bool sl = u.slab >= 0; bf16* base = sl ? slabs + (size_t)u.slab * (BM * BM) : O; const int ld = sl ? BM : ldc;
        const int row0 = (sl ? 0 : u.pm * BM) + wr * 64 + fr, col0 = (sl ? 0 : u.pn * BM) + wc * 32 + 8 * fq;
#pragma unroll
        for (int ai = 0; ai < 2; ++ai)
#pragma unroll
            for (int m = 0; m < 4; ++m) { bf16* rowp = base + (size_t)(row0 + ai * HALF + m * 16) * ld + col0;
#pragma unroll
                for (int bj = 0; bj < 2; ++bj) { const f32x4 v0 = acc[ai][bj][m][0], v1 = acc[ai][bj][m][1];
                    u32x4 w; w.x = cvt_pk_bf16(v0[0], v0[1]); w.y = cvt_pk_bf16(v0[2], v0[3]); w.z = cvt_pk_bf16(v1[0], v1[1]); w.w = cvt_pk_bf16(v1[2], v1[3]);
                    if (WT_MASK & 16) st16_wt(base, (unsigned)(((row0 + ai * HALF + m * 16) * ld + col0 + bj * HALF) * 2), w); else if (NT_ACT2) __builtin_nontemporal_store(w, (u32x4*)(rowp + bj * HALF)); else *(u32x4*)(rowp + bj * HALF) = w; } }
    }
};
struct EpiResid {
    static constexpr bool PERM = true, AFTER_DRAIN = true; static constexpr int NSTORE = 0;
    const float* xold32; bf16* XB; float* ssq;
    __device__ __forceinline__ void fused(f32x4 (&acc)[2][2][4][2], const Unit& u, int wr, int wc, int fr, int fq, LAS unsigned char* lds, int wid, int lane) const {
        LAS float* Pt = (LAS float*)lds;
        const int col0 = u.pn * BM + wc * 32 + 8 * fq;
#pragma unroll
        for (int ai = 0; ai < 2; ++ai)
#pragma unroll
            for (int m = 0; m < 4; ++m) { const int r = ai * HALF + wr * 64 + m * 16 + fr; const size_t off = (size_t)(u.pm * BM + r) * D + col0; float s = 0.f;
#pragma unroll
                for (int bj = 0; bj < 2; ++bj) { f32x4 b0, b1;
                    if (xold32) { b0 = *(const f32x4*)(xold32 + off + bj * HALF); b1 = *(const f32x4*)(xold32 + off + bj * HALF + 4); }
                    else { const u32x4 w = *(const u32x4*)(XB + off + bj * HALF); b0 = (f32x4){bf_lo(w.x), bf_hi(w.x), bf_lo(w.y), bf_hi(w.y)}; b1 = (f32x4){bf_lo(w.z), bf_hi(w.z), bf_lo(w.w), bf_hi(w.w)}; }
                    const f32x4 o0 = b0 + acc[ai][bj][m][0], o1 = b1 + acc[ai][bj][m][1];
                    u32x4 w; w.x = cvt_pk_bf16(o0[0], o0[1]); w.y = cvt_pk_bf16(o0[2], o0[3]); w.z = cvt_pk_bf16(o1[0], o1[1]); w.w = cvt_pk_bf16(o1[2], o1[3]); if (WT_MASK & 2) st16_wt(XB, (unsigned)(off + bj * HALF) * 2u, w); else *(u32x4*)(XB + off + bj * HALF) = w;
                    s += ((o0[0] * o0[0] + o0[1] * o0[1]) + (o0[2] * o0[2] + o0[3] * o0[3])) + ((o1[0] * o1[0] + o1[1] * o1[1]) + (o1[2] * o1[2] + o1[3] * o1[3])); }
                s += __shfl_xor(s, 16); s += __shfl_xor(s, 32);
                if (fq == 0) Pt[r * 4 + wc] = s; }
        __syncthreads();
        const int t = wid * 64 + lane;
        if (t < 256) { const float s = (Pt[t * 4 + 0] + Pt[t * 4 + 1]) + (Pt[t * 4 + 2] + Pt[t * 4 + 3]); ssq[(size_t)u.pn * M + u.pm * BM + t] = s; }
        __syncthreads();
    }
};

template <class Epi, class Sched, bool ALIGN_EPI = false, bool SP2 = true>
__device__ __forceinline__ void gemm_phase(LAS unsigned char* lds, LAS unsigned* gtab, const Gemm g, const Sched& S, const Epi& E) {
    constexpr bool GATHER = Sched::GATHER;
    static_assert(!GATHER || SP2, "gather needs the SP2 loop (lgkmcnt(0) waits only)");
    int tid_ = threadIdx.x; asm volatile("" : "+v"(tid_));
    const int tid = tid_, wid = __builtin_amdgcn_readfirstlane(tid >> 6), lane = tid & 63, wr = wid >> 2, wc = wid & 3, fr = lane & 15, fq = lane >> 4;
    const int K = g.K; int nt = K / BK;
    unsigned voffA[2], voffB[2];
#pragma unroll
    for (int i = 0; i < 2; ++i) { int R, C; stage_rc(tid * 16 + i * 8192, R, C); const int Rb = Epi::PERM ? ((R & ~31) + perm32(R & 31)) : R;
        voffA[i] = (unsigned)(R * K + C) * 2u; voffB[i] = (unsigned)(Rb * K + C) * 2u; }
    const size_t kstep = (size_t)(BK * 2);
    const size_t hstep = (size_t)HALF * K * 2;
    const size_t tstep = 2 * hstep;
    const unsigned ldsw = (unsigned)wid * 1024u;
    const int aoff = lds_byte(wr * 64 + fr, fq * 8), boff = lds_byte(wc * 32 + fr, fq * 8);
#define PG8_SA(b, h) (((b) * 2 + (h)) * HTB)
#define PG8_SB(b, h) ((4 + (b) * 2 + (h)) * HTB)
#define PG8_STAGE(bufoff, gbase, voff) do { _Pragma("unroll") for (int _i = 0; _i < 2; ++_i) \
        __builtin_amdgcn_global_load_lds((const unsigned*)((const char*)(gbase) + (voff)[_i]), (LAS unsigned*)(lds + (bufoff) + ldsw + _i * 8192), 16, 0, 0); } while (0)
#define PG8_STAGE_A(bufoff, ubase, kb, h) do { if constexpr (GATHER) { PG8_STAGE(bufoff, (const char*)g.A + (kb), ga[h]); } else { PG8_STAGE(bufoff, (ubase) + (size_t)(h) * hstep + (kb), voffA); } } while (0)
#define PG8_LDA(dst, b, h) do { _Pragma("unroll") for (int m = 0; m < 4; ++m) _Pragma("unroll") for (int k = 0; k < 2; ++k) dst[m][k] = *(const LAS bf16x8*)(lds + PG8_SA(b, h) + aoff + m * 2048 + k * 1024); } while (0)
#define PG8_LDB(dst, b, h) do { _Pragma("unroll") for (int n = 0; n < 2; ++n) _Pragma("unroll") for (int k = 0; k < 2; ++k) dst[n][k] = *(const LAS bf16x8*)(lds + PG8_SB(b, h) + boff + n * 2048 + k * 1024); } while (0)
#define PG8_MMA(ai, bj, At, Bt) do { __builtin_amdgcn_s_setprio(1); _Pragma("unroll") for (int m = 0; m < 4; ++m) _Pragma("unroll") for (int n = 0; n < 2; ++n) _Pragma("unroll") for (int k = 0; k < 2; ++k) \
        acc[ai][bj][m][n] = __builtin_amdgcn_mfma_f32_16x16x32_bf16(Bt[n][k], At[m][k], acc[ai][bj][m][n], 0, 0, 0); __builtin_amdgcn_s_setprio(0); } while (0)
#define PG8_WAIT_V(n) asm volatile("s_waitcnt vmcnt(" #n ")" ::: "memory")
#define PG8_WAIT_L(n) asm volatile("s_waitcnt lgkmcnt(" #n ")" ::: "memory")
#ifndef SEAM_RELAX
#define SEAM_RELAX 1
#endif
#define PG8_WAIT_VS() do { const int _rl = __builtin_amdgcn_readfirstlane((t == 0 && ui > 0) ? 1 : 0); if constexpr (SEAM_RELAX && Epi::NSTORE == 8) asm volatile("s_waitcnt vmcnt(16)\n\ts_cmp_lg_u32 %0, 0\n\ts_cbranch_scc1 .Lrelax%=\n\ts_waitcnt vmcnt(8)\n.Lrelax%=:" :: "s"(_rl) : "memory", "scc"); \
        else if constexpr (SEAM_RELAX && Epi::NSTORE == 16) asm volatile("s_waitcnt vmcnt(24)\n\ts_cmp_lg_u32 %0, 0\n\ts_cbranch_scc1 .Lrelax%=\n\ts_waitcnt vmcnt(8)\n.Lrelax%=:" :: "s"(_rl) : "memory", "scc"); else PG8_WAIT_V(8); } while (0)
#define PG8_BAR __builtin_amdgcn_s_barrier()
#define PG8_SCHED __builtin_amdgcn_sched_barrier(0)
#define PG8_GTAB_DMA(un, slot) do { if (wid < 4) { __builtin_amdgcn_global_load_lds(S.a_table(un) + wid * 64 + lane, (LAS unsigned*)(gtab + (slot) * 256 + wid * 64), 4, 0, 0); \
            __builtin_amdgcn_global_load_lds((const unsigned*)S.gate_table(un) + wid * 64 + lane, (LAS unsigned*)(gtab + 512 + (slot) * 512 + 256 + wid * 64), 4, 0, 0); } \
        else __builtin_amdgcn_global_load_lds((const unsigned*)S.rs_table(un) + (wid - 4) * 64 + lane, (LAS unsigned*)(gtab + 512 + (slot) * 512 + (wid - 4) * 64), 4, 0, 0); } while (0)
#define PG8_GTAB_READ(dst, slot) do { _Pragma("unroll") for (int _i = 0; _i < 2; ++_i) { int _R, _C; stage_rc(tid * 16 + _i * 8192, _R, _C); _Pragma("unroll") for (int _h = 0; _h < 2; ++_h) dst[_h][_i] = gtab[(slot) * 256 + _h * HALF + _R] + (unsigned)_C * 2u; } } while (0)
    Unit cur, nxt; int ui = 0;
    if (!S.next(0, cur)) return;
    f32x4 acc[2][2][4][2];
#pragma unroll
    for (int a = 0; a < 2; ++a)
#pragma unroll
        for (int b = 0; b < 2; ++b)
#pragma unroll
            for (int m = 0; m < 4; ++m)
#pragma unroll
                for (int n = 0; n < 2; ++n) acc[a][b][m][n] = (f32x4){0.f, 0.f, 0.f, 0.f};
    bf16x8 At[4][2], B0[2][2], B1[2][2];
    unsigned ga[2][2];
    if (cur.nt) nt = cur.nt;
    const char* cA = (const char*)g.A + (GATHER ? (size_t)0 : (size_t)cur.pm * tstep + cur.k0b); const char* cB = (const char*)g.Bt + ((size_t)cur.e * g.bstride_e) * 2 + (size_t)cur.pn * tstep + cur.k0b;
    if constexpr (GATHER) { PG8_GTAB_DMA(cur, 0); PG8_WAIT_V(0); PG8_BAR; PG8_GTAB_READ(ga, 0); }
    if constexpr (SP2) {
        PG8_STAGE(PG8_SB(0, 0), cB, voffB); PG8_STAGE(PG8_SB(0, 1), cB + hstep, voffB); PG8_STAGE_A(PG8_SA(0, 0), cA, 0, 0); PG8_STAGE_A(PG8_SA(0, 1), cA, 0, 1);
        if (wr == 1) PG8_BAR;
        PG8_WAIT_V(2); PG8_BAR;
        PG8_STAGE(PG8_SB(1, 0), cB + kstep, voffB); PG8_STAGE_A(PG8_SA(1, 0), cA, kstep, 0); PG8_STAGE(PG8_SB(1, 1), cB + hstep + kstep, voffB);
        PG8_WAIT_V(6); PG8_BAR;
    } else {
        PG8_STAGE(PG8_SB(0, 0), cB, voffB); PG8_STAGE_A(PG8_SA(0, 0), cA, 0, 0); PG8_STAGE(PG8_SB(0, 1), cB + hstep, voffB); PG8_STAGE_A(PG8_SA(0, 1), cA, 0, 1);
        if (wr == 1) PG8_BAR;
        PG8_WAIT_V(4); PG8_BAR;
        PG8_STAGE(PG8_SB(1, 0), cB + kstep, voffB); PG8_STAGE_A(PG8_SA(1, 0), cA, kstep, 0); PG8_STAGE(PG8_SB(1, 1), cB + hstep + kstep, voffB);
        PG8_WAIT_V(6); PG8_BAR;
    }
    for (;;) {
        const bool has_next = S.next(ui + 1, nxt);
        const char* nA = (has_next && !GATHER) ? (const char*)g.A + (size_t)nxt.pm * tstep + nxt.k0b : cA;
        const char* nB = has_next ? (const char*)g.Bt + ((size_t)nxt.e * g.bstride_e) * 2 + (size_t)nxt.pn * tstep + nxt.k0b : cB;
        for (int t = 0; t < nt; t += 2) {
            const bool last = (t == nt - 2);
            const size_t k1 = (size_t)(t + 1) * kstep;
            const char* a2 = last ? nA : cA; const size_t k2 = last ? 0 : (size_t)(t + 2) * kstep;
            const char* b2 = last ? nB : cB + (size_t)(t + 2) * kstep; const char* b3 = b2 + kstep;
            const size_t k3 = k2 + kstep;
            if constexpr (GATHER) {
                if (t == nt - 4 && has_next) PG8_GTAB_DMA(nxt, (ui + 1) & 1);
            }
            if constexpr (SP2) {
            PG8_LDB(B0, 0, 0); PG8_LDB(B1, 0, 1); PG8_SCHED; PG8_LDA(At, 0, 0); PG8_STAGE_A(PG8_SA(1, 1), cA, k1, 1);
            if constexpr (GATHER) { if (last && has_next) PG8_GTAB_READ(ga, (ui + 1) & 1); }
            PG8_WAIT_VS(); PG8_WAIT_L(0); PG8_BAR; PG8_MMA(0, 0, At, B0); PG8_MMA(0, 1, At, B1); PG8_BAR; PG8_SCHED;
            PG8_LDA(At, 0, 1); PG8_STAGE(PG8_SB(0, 0), b2, voffB); PG8_STAGE(PG8_SB(0, 1), b2 + hstep, voffB); PG8_STAGE_A(PG8_SA(0, 0), a2, k2, 0);
            PG8_WAIT_VS(); PG8_WAIT_L(0); PG8_BAR; PG8_MMA(1, 0, At, B0); PG8_MMA(1, 1, At, B1); PG8_BAR; PG8_SCHED;
            PG8_LDB(B0, 1, 0); PG8_LDB(B1, 1, 1); PG8_SCHED; PG8_LDA(At, 1, 0); PG8_STAGE_A(PG8_SA(0, 1), a2, k2, 1);
            PG8_WAIT_V(8); PG8_WAIT_L(0); PG8_BAR; PG8_MMA(0, 0, At, B0); PG8_MMA(0, 1, At, B1); PG8_BAR; PG8_SCHED;
            PG8_LDA(At, 1, 1); PG8_STAGE(PG8_SB(1, 0), b3, voffB); PG8_STAGE(PG8_SB(1, 1), b3 + hstep, voffB); PG8_STAGE_A(PG8_SA(1, 0), a2, k3, 0);
            PG8_WAIT_V(8); PG8_WAIT_L(0); PG8_BAR; PG8_MMA(1, 0, At, B0); PG8_MMA(1, 1, At, B1); PG8_BAR; PG8_SCHED;
            } else {
            PG8_LDB(B0, 0, 0); PG8_SCHED; PG8_LDA(At, 0, 0); PG8_STAGE_A(PG8_SA(1, 1), cA, k1, 1);
            PG8_WAIT_L(8); PG8_BAR; PG8_WAIT_L(0); PG8_MMA(0, 0, At, B0); PG8_BAR; PG8_SCHED;
            PG8_LDB(B1, 0, 1); PG8_STAGE(PG8_SB(0, 0), b2, voffB);
            PG8_BAR; PG8_WAIT_L(0); PG8_MMA(0, 1, At, B1); PG8_BAR;
            PG8_LDA(At, 0, 1); PG8_STAGE_A(PG8_SA(0, 0), a2, k2, 0);
            PG8_BAR; PG8_WAIT_L(0); PG8_MMA(1, 0, At, B0); PG8_BAR; PG8_SCHED;
            PG8_STAGE(PG8_SB(0, 1), b2 + hstep, voffB);
            PG8_WAIT_V(6); PG8_BAR; PG8_MMA(1, 1, At, B1); PG8_BAR;
            PG8_LDB(B0, 1, 0); PG8_SCHED; PG8_LDA(At, 1, 0); PG8_STAGE_A(PG8_SA(0, 1), a2, k2, 1);
            PG8_WAIT_L(8); PG8_BAR; PG8_WAIT_L(0); PG8_MMA(0, 0, At, B0); PG8_BAR; PG8_SCHED;
            PG8_LDB(B1, 1, 1); PG8_STAGE(PG8_SB(1, 0), b3, voffB);
            PG8_BAR; PG8_WAIT_L(0); PG8_MMA(0, 1, At, B1); PG8_BAR;
            PG8_LDA(At, 1, 1); PG8_STAGE_A(PG8_SA(1, 0), a2, k3, 0);
            PG8_BAR; PG8_WAIT_L(0); PG8_MMA(1, 0, At, B0); PG8_BAR; PG8_SCHED;
            PG8_STAGE(PG8_SB(1, 1), b3 + hstep, voffB);
            PG8_WAIT_V(6); PG8_BAR; PG8_MMA(1, 1, At, B1); PG8_BAR;
            }
        }
        if constexpr (ALIGN_EPI) { if (wr == 0) PG8_BAR; }
        cur.ui = ui;
        if constexpr (!Epi::AFTER_DRAIN) { E(acc, cur, wr, wc, fr, fq); }
        if (!has_next) break;
#pragma unroll
        for (int a = 0; a < 2; ++a)
#pragma unroll
            for (int b = 0; b < 2; ++b)
#pragma unroll
                for (int m = 0; m < 4; ++m)
#pragma unroll
                    for (int n = 0; n < 2; ++n) acc[a][b][m][n] = (f32x4){0.f, 0.f, 0.f, 0.f};
        cur = nxt; cA = nA; cB = nB; ++ui; nt = cur.nt ? cur.nt : K / BK;
        if constexpr (ALIGN_EPI) { if (wr == 1) PG8_BAR; }
    }
    PG8_WAIT_V(0);
    if constexpr (!ALIGN_EPI) { if (wr == 0) PG8_BAR; }
    PG8_BAR;
    if constexpr (Epi::AFTER_DRAIN) { E.fused(acc, cur, wr, wc, fr, fq, lds, wid, lane); }
#undef PG8_SA
#undef PG8_SB
#undef PG8_STAGE
#undef PG8_STAGE_A
#undef PG8_LDA
#undef PG8_LDB
#undef PG8_MMA
#undef PG8_WAIT_V
#undef PG8_WAIT_VS
#undef PG8_WAIT_L
#undef PG8_BAR
#undef PG8_SCHED
#undef PG8_GTAB_DMA
#undef PG8_GTAB_READ
}
}
constexpr size_t MiB = 1u << 20;
constexpr size_t WS_CTL = 0, CTL_ZERO_BYTES = 256 * 1024;
constexpr size_t WS_ROWOFF = 1 * MiB;
constexpr size_t WS_RS = WS_ROWOFF + 512 * 1024;
constexpr size_t WS_GATE = WS_RS + 512 * 1024;
constexpr size_t WS_SEL = WS_GATE + 512 * 1024;
constexpr size_t WS_SSQ = WS_SEL + 256 * 1024;
constexpr size_t WS_SMALLW = 4 * MiB;
constexpr size_t WS_PWT = WS_SMALLW;
constexpr size_t WS_POOLWT = WS_PWT + 2 * 384 * 384 * 2;
constexpr size_t WS_GMWS = WS_POOLWT + 2 * 4 * 64 * 64 * 2;
constexpr size_t WS_XB = 6 * MiB;
constexpr size_t WS_SLAB = 162 * MiB;
constexpr size_t WS_XB2 = WS_XB;
constexpr size_t WS_MOE_WD = 38 * MiB;
constexpr size_t WS_MOE_WGU = 94 * MiB;
constexpr size_t WS_YP = 94 * MiB;
constexpr size_t WS_ACTM = 206 * MiB;
constexpr size_t WS_P = 206 * MiB;
constexpr size_t WS_Y = 262 * MiB;
constexpr size_t WS_ACT = 206 * MiB;
constexpr size_t WS_WIN = 294 * MiB;
constexpr size_t WS_WOUT = 301 * MiB;
constexpr size_t WS_WGU = 305 * MiB;
constexpr size_t WS_WD = 316 * MiB;
constexpr size_t WS_END = 444 * MiB;
static_assert(WS_SSQ + 4 * (size_t)M * 4 <= WS_SMALLW && WS_GMWS + 2 * 4 * 128 * 128 * 2 <= WS_XB && WS_XB + (size_t)M * D * 2 <= WS_MOE_WD, "ws map 1");
static_assert(WS_SLAB >= WS_YP + (size_t)PMAX * D * 2 && WS_SLAB + 256 * (size_t)65536 * 2 <= WS_ACTM, "slabs");
static_assert(WS_MOE_WD + (size_t)NE * D * DFE * 2 <= WS_MOE_WGU && WS_MOE_WGU + (size_t)NE * NGUE * D * 2 <= WS_ACTM && WS_YP + (size_t)PMAX * D * 2 <= WS_ACTM, "ws map 2");
static_assert(WS_ACTM + (size_t)PMAX * DFE * 2 <= WS_END && WS_P + (size_t)M * DIN * 2 <= WS_Y && WS_Y + (size_t)M * D * 2 <= WS_WIN && WS_ACT + (size_t)M * DFF * 2 <= WS_WIN, "ws map 3");
static_assert(WS_WIN + 2 * (size_t)DIN * D * 2 <= WS_WOUT && WS_WOUT + 2 * (size_t)D * D * 2 <= WS_WGU && WS_WGU + (size_t)NGU * D * 2 <= WS_WD && WS_WD + (size_t)D * DFF * 2 <= WS_END, "ws map 4");
constexpr int CW_BAR = 4096;
constexpr int CW_CNT = 49152;
constexpr int CW_CVT = 140000;
constexpr int NPHASE = 13;
static_assert(CW_BAR + NPHASE * 3456 <= CW_CNT && (size_t)(CW_CNT + 8 * 64) * 4 <= CTL_ZERO_BYTES, "control words inside the per-call memset");
constexpr int RING_BYTES = 131072;
constexpr int GTAB_OFF = RING_BYTES;
constexpr int MISC_OFF = GTAB_OFF + 8192;
constexpr int INTAB_OFF = MISC_OFF + 256;
constexpr int JOBS_OFF = INTAB_OFF + 256;
constexpr int LDS_BYTES = 147456;
static_assert(JOBS_OFF + 7 * 12 * 32 <= LDS_BYTES, "LDS map (jobs)");
static_assert(MISC_OFF + 256 <= LDS_BYTES, "LDS map");

typedef GAS unsigned gu32;
#define RLX_AGENT __ATOMIC_RELAXED, __HIP_MEMORY_SCOPE_AGENT
#define LDS_WAIT() asm volatile("s_waitcnt lgkmcnt(0)" ::: "memory")
#define VM_WAIT() asm volatile("s_waitcnt vmcnt(0)" ::: "memory")

#define XB_TMO      128
#define XB_XCNT(j)  (256  + 64 * (j))
#define XB_XSUB(j)  (1280 + 64 * (j))
#define XB_XGEN(j)  (2304 + 64 * (j))
#define XB_TOP      3328
#define XB_TOPGEN   3392
#define XCD_BAR_WORDS 3456
#define XB_SPIN_CAP (1u << 18)
__device__ __forceinline__ unsigned xb_ld(unsigned* p)              { return __hip_atomic_load(p, __ATOMIC_RELAXED, __HIP_MEMORY_SCOPE_AGENT); }
__device__ __forceinline__ unsigned xb_add(unsigned* p, unsigned v) { return __hip_atomic_fetch_add(p, v, __ATOMIC_RELAXED, __HIP_MEMORY_SCOPE_AGENT); }
__device__ __forceinline__ unsigned xb_xcc_id() { return (unsigned)__builtin_amdgcn_s_getreg((3 << 11) | 20) & 0xFu; }
#define XB_SPIN(cond, bar) do { unsigned _sp = 0; while (cond) { __builtin_amdgcn_s_sleep(1); \
    if ((++_sp & 255u) == 0u) { if (xb_ld(&(bar)[XB_TMO])) break; if (_sp > XB_SPIN_CAP) { atomicAdd(&(bar)[XB_TMO], 1u); break; } } } } while (0)
struct XcdBarrier { unsigned* bar; unsigned x; volatile LAS unsigned* st; };
__device__ __forceinline__ XcdBarrier xcd_barrier_post(unsigned* bar, volatile LAS unsigned* st) {
    XcdBarrier b; b.bar = bar; b.x = xb_xcc_id(); b.st = st;
    if (threadIdx.x == 0) (void)xb_add(&bar[XB_XCNT(b.x)], 1u);
    return b;
}
__device__ __forceinline__ void xcd_barrier_complete(unsigned* bar, unsigned x, unsigned& nloc, unsigned& nx) {
    const unsigned G = gridDim.x * gridDim.y * gridDim.z;
    unsigned sum, cnt, mine, sp = 0u;
    for (;;) {
        sum = 0u; cnt = 0u; mine = 0u;
#pragma unroll
        for (unsigned j = 0; j < 16; ++j) { const unsigned c = xb_ld(&bar[XB_XCNT(j)]); sum += c; cnt += (c > 0u) ? 1u : 0u; mine = (j == x) ? c : mine; }
        if (sum == G) break;
        __builtin_amdgcn_s_sleep(1);
        if ((++sp & 255u) == 0u) { if (xb_ld(&bar[XB_TMO])) break; if (sp > XB_SPIN_CAP) { atomicAdd(&bar[XB_TMO], 1u); break; } }
    }
    nloc = mine > 0u ? mine : 1u; nx = cnt > 0u ? cnt : 1u;
}
__device__ __forceinline__ void xcd_barrier(const XcdBarrier& b) {
    asm volatile("s_waitcnt vmcnt(0)" ::: "memory");
    __syncthreads();
    if (threadIdx.x == 0) {
        unsigned* bar = b.bar;
        __builtin_amdgcn_s_waitcnt(0);
        unsigned nloc = b.st[0], nx = b.st[1];
        if (nloc == 0u) { xcd_barrier_complete(bar, b.x, nloc, nx); b.st[0] = nloc; b.st[1] = nx; }
        const unsigned old = xb_add(&bar[XB_XSUB(b.x)], 1u);
        const unsigned gen = old / nloc;
        if (old + 1u == (gen + 1u) * nloc) {
            __builtin_amdgcn_fence(__ATOMIC_RELEASE, "agent");
            asm volatile("s_waitcnt vmcnt(0)" ::: "memory");
            const unsigned og = xb_add(&bar[XB_TOP], 1u);
            const unsigned tg = og / nx;
            if (og + 1u == (tg + 1u) * nx) xb_add(&bar[XB_TOPGEN], 1u);
            else XB_SPIN(xb_ld(&bar[XB_TOPGEN]) == tg, bar);
            __builtin_amdgcn_fence(__ATOMIC_ACQUIRE, "agent");
            xb_add(&bar[XB_XGEN(b.x)], 1u);
            asm volatile("s_waitcnt vmcnt(0)" ::: "memory");
        } else {
            XB_SPIN(xb_ld(&bar[XB_XGEN(b.x)]) == gen, bar);
            __builtin_amdgcn_fence(__ATOMIC_ACQUIRE, "agent");
            asm volatile("s_waitcnt vmcnt(0)" ::: "memory");
        }
    }
    __syncthreads();
}

struct InTab { const LAS unsigned long long* t;
    __device__ __forceinline__ const float* operator[](int k) const { const unsigned long long v = t[k]; const unsigned lo = __builtin_amdgcn_readfirstlane((unsigned)v), hi = __builtin_amdgcn_readfirstlane((unsigned)(v >> 32));
        return (const float*)(((unsigned long long)hi << 32) | lo); } };
struct Frame {
    LAS unsigned char* lds; volatile LAS unsigned* MISC; unsigned* ctl;
    int tid, lane, wave, vcu, G;
    InTab in; float* out; unsigned char* ws;
};

__device__ __forceinline__ InTab in_tab(Frame& F) { return F.in; }
struct TrJob { const float* src; bf16* dst; const float* gk; int K, N; };
__device__ __forceinline__ TrJob tr_mat(const float* W, int K, int N, bf16* WT, int mode, const float* gk, int r) {
    const int nblk = N / 32, kb = r / nblk, nb = r % nblk, n0 = 32 * nb, k0 = 64 * kb;
    const int drow = mode == 0 ? n0 : ((n0 >> 7) * 256 + (n0 & 127) + (mode == 2 ? 128 : 0));
    TrJob j; j.src = W + (size_t)k0 * N + n0; j.dst = WT + (size_t)drow * K + k0; j.gk = gk ? gk + k0 : nullptr; j.K = K; j.N = N; return j;
}
constexpr int TR_I_IN = (D / 64) * (DIN / 32), TR_I_OUT = (D / 64) * (D / 32), TR_I_G = (D / 64) * (DFF / 32), TR_I_D = (DFF / 64) * (D / 32), TR_I_MG = (D / 64) * (DFE / 32), TR_I_MD = (DFE / 64) * (D / 32), TR_I_PW = (DCV / 64) * (DCV / 32), TR_I_PL = 2;
constexpr int TR_E_END = TR_I_IN + 2 * TR_I_PW + 8 * TR_I_PL;
constexpr int TR_A_END = TR_E_END + TR_I_OUT + 2 * TR_I_G + TR_I_D;
constexpr int TR_B_END = TR_A_END + TR_I_IN + TR_I_OUT;
constexpr int TR_C_END = TR_B_END + 2 * NE * TR_I_MG;
constexpr int TR_D_END = TR_C_END + NE * TR_I_MD;
__device__ __forceinline__ TrJob tr_decode(const InTab in, unsigned char* ws, int r) {
    if (r < TR_I_IN) return tr_mat(in[2], D, DIN, (bf16*)(ws + WS_WIN), 0, in[1], r); r -= TR_I_IN;
    if (r < 2 * TR_I_PW) { const int l = r / TR_I_PW; return tr_mat(in[12] + (size_t)l * DCV * DCV, DCV, DCV, (bf16*)(ws + WS_PWT) + (size_t)l * DCV * DCV, 0, nullptr, r % TR_I_PW); } r -= 2 * TR_I_PW;
    if (r < 8 * TR_I_PL) { const int gi = r / TR_I_PL; return tr_mat(in[3] + (size_t)gi * 64 * 64, 64, 64, (bf16*)(ws + WS_POOLWT) + (size_t)gi * 64 * 64, 0, nullptr, r % TR_I_PL); } r -= 8 * TR_I_PL;
    if (r < TR_I_OUT) return tr_mat(in[14], D, D, (bf16*)(ws + WS_WOUT), 0, nullptr, r); r -= TR_I_OUT;
    if (r < TR_I_G) return tr_mat(in[16], D, DFF, (bf16*)(ws + WS_WGU), 1, in[15], r); r -= TR_I_G;
    if (r < TR_I_G) return tr_mat(in[17], D, DFF, (bf16*)(ws + WS_WGU), 2, in[15], r); r -= TR_I_G;
    if (r < TR_I_D) return tr_mat(in[18], DFF, D, (bf16*)(ws + WS_WD), 0, nullptr, r); r -= TR_I_D;
    if (r < TR_I_IN) return tr_mat(in[2] + (size_t)D * DIN, D, DIN, (bf16*)(ws + WS_WIN) + (size_t)DIN * D, 0, in[1] + D, r); r -= TR_I_IN;
    if (r < TR_I_OUT) return tr_mat(in[14] + (size_t)D * D, D, D, (bf16*)(ws + WS_WOUT) + (size_t)D * D, 0, nullptr, r); r -= TR_I_OUT;
    if (r < 2 * NE * TR_I_MG) { const int e = r / (2 * TR_I_MG), q = r % (2 * TR_I_MG), up = q / TR_I_MG;
        return tr_mat(in[20 + up] + (size_t)e * D * DFE, D, DFE, (bf16*)(ws + WS_MOE_WGU) + (size_t)e * NGUE * D, 1 + up, in[15] + D, q % TR_I_MG); } r -= 2 * NE * TR_I_MG;
    { const int e = r / TR_I_MD; return tr_mat(in[22] + (size_t)e * DFE * D, DFE, D, (bf16*)(ws + WS_MOE_WD) + (size_t)e * D * DFE, 0, nullptr, r % TR_I_MD); }
}
__device__ __forceinline__ void tr_load(const TrJob& j, f32x4 (&v)[8], int lane, int probe) {
    const int n4 = (lane & 7) * 4, k8 = (lane >> 3) * 8;
    if (probe == 2) {
#pragma unroll
        for (int i = 0; i < 8; ++i) v[i] = (f32x4){1.f, 2.f, 3.f, 4.f};
        return; }
#pragma unroll
    for (int i = 0; i < 8; ++i) v[i] = __builtin_nontemporal_load((const f32x4*)(j.src + (size_t)(k8 + i) * j.N + n4));
    if (j.gk) { const f32x4 g0 = *(const f32x4*)(j.gk + k8), g1 = *(const f32x4*)(j.gk + k8 + 4);
        v[0] = v[0] * g0[0]; v[1] = v[1] * g0[1]; v[2] = v[2] * g0[2]; v[3] = v[3] * g0[3]; v[4] = v[4] * g1[0]; v[5] = v[5] * g1[1]; v[6] = v[6] * g1[2]; v[7] = v[7] * g1[3]; }
}
__device__ __forceinline__ void tr_store(const TrJob& j, const f32x4 (&v)[8], LAS float* scr, int lane, int probe) {
    (void)scr; const int n4 = (lane & 7) * 4, k8 = (lane >> 3) * 8;
#pragma unroll
    for (int q = 0; q < 4; ++q) { u32x4 o; o.x = cvt_pk_bf16(v[0][q], v[1][q]); o.y = cvt_pk_bf16(v[2][q], v[3][q]); o.z = cvt_pk_bf16(v[4][q], v[5][q]); o.w = cvt_pk_bf16(v[6][q], v[7][q]);
        if (probe == 1 || probe == 2) { asm volatile("" :: "v"(o.x), "v"(o.y), "v"(o.z), "v"(o.w)); } else if (WT_MASK & 1) st16_wt_u(j.dst, (unsigned)(((n4 + q) * j.K + k8) * 2), o); else *(GAS u32x4*)(j.dst + (size_t)(n4 + q) * j.K + k8) = o; }
}
__device__ __forceinline__ void tr_run(Frame& F, int first, int count, int widx, int nw, int probe) {
    LAS float* scr = (LAS float*)(F.lds + F.wave * 16384); int lane = F.lane; asm volatile("" : "+v"(lane)); const InTab in = in_tab(F); unsigned char* ws = F.ws;
    const int end = first + count; f32x4 v[4][8]; TrJob j[4];
#pragma unroll
    for (int k = 0; k < 4; ++k) { const int it = first + widx + k * nw; if (it < end) { j[k] = tr_decode(in, ws, it); tr_load(j[k], v[k], lane, probe); } }
    for (int it = first + widx; it < end; it += 4 * nw) {
#pragma unroll
        for (int k = 0; k < 4; ++k) { const int ik = it + k * nw, nx = ik + 4 * nw;
            if (ik < end) tr_store(j[k], v[k], scr, lane, probe);
            if (nx < end) { j[k] = tr_decode(in, ws, nx); tr_load(j[k], v[k], lane, probe); } } }
}
#ifndef H10_SHARE
#define H10_SHARE 8192
#endif
#ifndef HID_PW
#define HID_PW 2
#endif
constexpr int HID_PER_WAVE = HID_PW, H1_N = 64 * 8 * HID_PER_WAVE, H4_N = 128 * 8 * HID_PER_WAVE, H6_N = 64 * 8 * HID_PER_WAVE, H10_N = H10_SHARE;
constexpr int H10_BEG = TR_D_END - H10_N;
#ifndef MIX_CVT
#define MIX_CVT 0
#endif
#ifndef R9_CVT
#define R9_CVT 0
#endif
#ifndef SB_CVT
#define SB_CVT 2
#endif
constexpr int MX_N = (M / 64) * 8 * MIX_CVT, R9_N = (M / 64) * 8 * R9_CVT, SB_N = 7 * 256 * SB_CVT;
constexpr int H1_BEG = TR_E_END, S0_BEG = H1_BEG + H1_N, S1_BEG = S0_BEG + SB_N, S2_BEG = S1_BEG + SB_N, S3_BEG = S2_BEG + SB_N, H4_BEG = S3_BEG + SB_N, S4_BEG = H4_BEG + H4_N, S5_BEG = S4_BEG + SB_N,
              H6_BEG = S5_BEG + SB_N, MX0_BEG = H6_BEG + H6_N, MX1_BEG = MX0_BEG + MX_N, R9_BEG = MX1_BEG + MX_N, PRO_BEG = R9_BEG + R9_N;
static_assert(PRO_BEG <= H10_BEG, "hidden conversion shares exceed the weight tiles");
static_assert(H1_BEG + TR_I_OUT <= S0_BEG, "w_out of layer 0 (phase 3): inside H1");
static_assert(TR_A_END - TR_I_D <= S1_BEG, "dense gate|up weights (phase 4): visible by phase 3 at the latest, i.e. inside H1 | S0");
static_assert(TR_A_END <= S2_BEG, "dense down weights (phase 5): inside H1 | S0 | S1");
static_assert(TR_A_END + TR_I_IN <= S3_BEG && TR_B_END <= S5_BEG, "layer-1 projections (phases 6, 8)");
static_assert(TR_C_END <= H10_BEG && MIX_CVT == 0 && R9_CVT == 0, "MoE gate|up weights before phase 10 (H6 is visible from phase 7); no hosting in mixers / router in this layout");
__device__ __forceinline__ void tail_convert(Frame& F, int first, int count, int rank, int nwg_idle) {
    if (rank >= 0 && rank < nwg_idle) tr_run(F, first, count, rank * 8 + F.wave, nwg_idle * 8, 0);
}

struct JobRec { unsigned long long src, dst, gk; int K, N; };
__device__ __forceinline__ TrJob job_read(const LAS JobRec* r) {
    const u32x4 a = *(const LAS u32x4*)r, c = *((const LAS u32x4*)r + 1); TrJob j;
    const unsigned s0 = __builtin_amdgcn_readfirstlane(a.x), s1 = __builtin_amdgcn_readfirstlane(a.y), d0 = __builtin_amdgcn_readfirstlane(a.z), d1 = __builtin_amdgcn_readfirstlane(a.w);
    const unsigned g0 = __builtin_amdgcn_readfirstlane(c.x), g1 = __builtin_amdgcn_readfirstlane(c.y);
    j.src = (const float*)(((unsigned long long)s1 << 32) | s0); j.dst = (bf16*)(((unsigned long long)d1 << 32) | d0); j.gk = (const float*)(((unsigned long long)g1 << 32) | g0);
    j.K = __builtin_amdgcn_readfirstlane(c.z); j.N = __builtin_amdgcn_readfirstlane(c.w); return j;
}
__device__ __forceinline__ void jobs_setup(Frame& F) {
    if (SB_CVT == 0 || F.wave == 0) return;
    const InTab in = in_tab(F); unsigned char* ws = F.ws; LAS JobRec* tab = (LAS JobRec*)(F.lds + JOBS_OFF) + (F.wave - 1) * 12;
#pragma unroll 1
    for (int q = 0; q < 6 * SB_CVT; ++q) { const int sI = q / SB_CVT, k = q - sI * SB_CVT; const int beg = sI < 4 ? S0_BEG + sI * SB_N : S4_BEG + (sI - 4) * SB_N;
        const TrJob j = tr_decode(in, ws, beg + (int)blockIdx.x * 7 + F.wave - 1 + k * 7 * 256);
        if (F.lane == 0) { const unsigned long long s = (unsigned long long)j.src, d = (unsigned long long)j.dst, g = (unsigned long long)j.gk; LAS u32x4* o = (LAS u32x4*)(tab + sI * 2 + k);
            u32x4 a, c; a.x = (unsigned)s; a.y = (unsigned)(s >> 32); a.z = (unsigned)d; a.w = (unsigned)(d >> 32); c.x = (unsigned)g; c.y = (unsigned)(g >> 32); c.z = (unsigned)j.K; c.w = (unsigned)j.N; o[0] = a; o[1] = c; } }
}
__device__ __forceinline__ void xcd_barrier_host(const XcdBarrier& b, Frame& F, int slot) {
    if (slot < 0 || SB_CVT == 0) { xcd_barrier(b); return; }
    asm volatile("s_waitcnt vmcnt(0)" ::: "memory");
    __syncthreads();
    int lane = F.lane; asm volatile("" : "+v"(lane));
    f32x4 va[8], vb[8]; TrJob ja, jb; const bool host = F.wave > 0; const LAS JobRec* jr = (const LAS JobRec*)(F.lds + JOBS_OFF) + (F.wave - 1) * 12 + slot * 2;
    if (host) { ja = job_read(jr); tr_load(ja, va, lane, 0); if (SB_CVT >= 2) { jb = job_read(jr + 1); tr_load(jb, vb, lane, 0); } }
    if (threadIdx.x == 0) {
        unsigned* bar = b.bar;
        __builtin_amdgcn_s_waitcnt(0);
        unsigned nloc = b.st[0], nx = b.st[1];
        if (nloc == 0u) { xcd_barrier_complete(bar, b.x, nloc, nx); b.st[0] = nloc; b.st[1] = nx; }
        const unsigned old = xb_add(&bar[XB_XSUB(b.x)], 1u);
        const unsigned gen = old / nloc;
        if (old + 1u == (gen + 1u) * nloc) {
            __builtin_amdgcn_fence(__ATOMIC_RELEASE, "agent");
            asm volatile("s_waitcnt vmcnt(0)" ::: "memory");
            const unsigned og = xb_add(&bar[XB_TOP], 1u);
            const unsigned tg = og / nx;
            if (og + 1u == (tg + 1u) * nx) xb_add(&bar[XB_TOPGEN], 1u);
            else XB_SPIN(xb_ld(&bar[XB_TOPGEN]) == tg, bar);
            __builtin_amdgcn_fence(__ATOMIC_ACQUIRE, "agent");
            xb_add(&bar[XB_XGEN(b.x)], 1u);
            asm volatile("s_waitcnt vmcnt(0)" ::: "memory");
        } else {
            XB_SPIN(xb_ld(&bar[XB_XGEN(b.x)]) == gen, bar);
            __builtin_amdgcn_fence(__ATOMIC_ACQUIRE, "agent");
            asm volatile("s_waitcnt vmcnt(0)" ::: "memory");
        }
    }
    __syncthreads();
    if (host) { tr_store(ja, va, nullptr, lane, 0); if (SB_CVT >= 2) tr_store(jb, vb, nullptr, lane, 0); }
}
__device__ __forceinline__ void p0_prologue(Frame& F, int probe) {
    LAS float* scr = (LAS float*)(F.lds + F.wave * 16384);
    int lane = F.lane; asm volatile("" : "+v"(lane));
    const int gw = F.vcu * 8 + F.wave, NGW = F.G * 8;
    const InTab in = in_tab(F); unsigned char* ws = F.ws;
    tr_run(F, 0, TR_E_END, gw, NGW, probe);
    tr_run(F, PRO_BEG, H10_BEG - PRO_BEG, gw, NGW, probe);
    { const float* src = in[6]; bf16* dst = (bf16*)(ws + WS_GMWS);
      for (int i = gw * 64 + lane; i < 2 * 4 * 128 * 128 / 8; i += NGW * 64) { const f32x4 a = *(const f32x4*)(src + (size_t)i * 8), b = *(const f32x4*)(src + (size_t)i * 8 + 4);
          u32x4 o; o.x = cvt_pk_bf16(a[0], a[1]); o.y = cvt_pk_bf16(a[2], a[3]); o.z = cvt_pk_bf16(b[0], b[1]); o.w = cvt_pk_bf16(b[2], b[3]); *(u32x4*)(dst + (size_t)i * 8) = o; } }
    { u32x4* t = (u32x4*)(ws + WS_ROWOFF); for (int i = gw * 64 + lane; i < NE * ECAP / 4; i += NGW * 64) t[i] = (u32x4){0u, 0u, 0u, 0u}; }
    { const float* x = in[0]; bf16* XB = (bf16*)(ws + WS_XB); float* ssq = (float*)(ws + WS_SSQ);
      for (int m = gw; m < M; m += NGW) { const f32x4* xr = (const f32x4*)(x + (size_t)m * D) + lane; f32x4 v[4]; float s = 0.f;
#pragma unroll
          for (int j = 0; j < 4; ++j) { v[j] = xr[64 * j]; s += (v[j][0] * v[j][0] + v[j][1] * v[j][1]) + (v[j][2] * v[j][2] + v[j][3] * v[j][3]); }
          s = wave_sum(s);
          u32x2* o = (u32x2*)(XB + (size_t)m * D) + lane;
#pragma unroll
          for (int j = 0; j < 4; ++j) { u32x2 w; w.x = cvt_pk_bf16(v[j][0], v[j][1]); w.y = cvt_pk_bf16(v[j][2], v[j][3]); if (WT_MASK & 1) st8_wt(XB, (unsigned)((m * D + (lane + 64 * j) * 4) * 2), w); else o[64 * j] = w; }
          if (lane < 4) ssq[(size_t)lane * M + m] = lane == 0 ? s : 0.f; } }
}

__device__ __forceinline__ void unpack8(const u32x4 w, float (&f)[8]) { f[0] = bf_lo(w.x); f[1] = bf_hi(w.x); f[2] = bf_lo(w.y); f[3] = bf_hi(w.y); f[4] = bf_lo(w.z); f[5] = bf_hi(w.z); f[6] = bf_lo(w.w); f[7] = bf_hi(w.w); }
#define LDS_BARRIER() asm volatile("s_waitcnt lgkmcnt(0)\n\ts_barrier" ::: "memory")
__device__ __forceinline__ void mixer_unit(Frame& F, int u, int layer, int cvt0) {
    LAS unsigned char* lds = F.lds; int tid = F.tid; asm volatile("" : "+v"(tid)); int lane = tid & 63; const int w = F.wave;
    const InTab in = in_tab(F); unsigned char* ws = F.ws;
    const bf16* P = (const bf16*)(ws + WS_P); bf16* Y = (bf16*)(ws + WS_Y);
    const int r0 = 64 * u, s0 = r0 & (SEQ - 1), half = u & 1, blk0 = r0 & ~127;
#ifndef CONV_REP
#define CONV_REP 0
#endif
#ifndef MIX_MASK
#define MIX_MASK 7
#endif
#ifndef MIX_REP
#define MIX_REP 0
#endif
    f32x4 cva[8], cvb[8]; TrJob cja, cjb; const int cvi = cvt0 + u * 8 + w; constexpr int CVS = (M / 64) * 8;
    for (int mrep = 0; mrep < 1 + (MIX_REP & 1); ++mrep) if (MIX_MASK & 1) { constexpr int AIN = 0, YPL = 40448, YST = 528;
      const int g = w >> 1, th = w & 1, fr = lane & 15, fq = lane >> 4;
      u32x4 st[5];
#pragma unroll
      for (int i = 0; i < 5; ++i) { const int idx = tid + 512 * i, rr = idx >> 5, ch = idx & 31, pos = s0 - 15 + rr; st[i] = (u32x4){0u, 0u, 0u, 0u};
          if (idx < 79 * 32 && pos >= 0) st[i] = *(const u32x4*)(P + (size_t)(r0 - 15 + rr) * DIN + ch * 8); }
      const bf16* wt = (const bf16*)(ws + WS_POOLWT) + (size_t)(layer * 4 + g) * 64 * 64; const float* sc = in[4] + layer * DPOOL + g * 64;
      bf16x8 Bf[2][4]; f32x4 sc4[4];
#pragma unroll
      for (int ks = 0; ks < 2; ++ks)
#pragma unroll
          for (int nt = 0; nt < 4; ++nt) Bf[ks][nt] = *(const bf16x8*)(wt + (nt * 16 + fr) * 64 + ks * 32 + 8 * fq);
#pragma unroll
      for (int nt = 0; nt < 4; ++nt) sc4[nt] = *(const f32x4*)(sc + nt * 16 + 4 * fq);
      if (MIX_CVT >= 2 && mrep == 0) { asm volatile("" ::: "memory"); cja = tr_decode(in, ws, cvi); tr_load(cja, cva, lane, 0); cjb = tr_decode(in, ws, cvi + CVS); tr_load(cjb, cvb, lane, 0); asm volatile("" ::: "memory"); }
#pragma unroll
      for (int i = 0; i < 5; ++i) { const int idx = tid + 512 * i; if (idx < 79 * 32) *(LAS u32x4*)(lds + AIN + (idx >> 5) * 512 + (idx & 31) * 16) = st[i]; }
      LDS_BARRIER();
      { const int p = tid & 127, rq = tid >> 7, gp = p >> 5, win = 2 << gp; float S0 = 0.f, S1 = 0.f;
        for (int j = 1; j < win; ++j) { const unsigned a = *(const LAS unsigned*)(lds + AIN + (16 * rq + 15 - j) * 512 + p * 4); S0 += bf_lo(a); S1 += bf_hi(a); }
#pragma unroll 4
        for (int t = 0; t < 16; ++t) { const int lt = 16 * rq + t, rr = lt + 15; const unsigned a = *(const LAS unsigned*)(lds + AIN + rr * 512 + p * 4); const float a0 = bf_lo(a), a1 = bf_hi(a);
            S0 += a0; S1 += a1; const int pos1 = s0 + lt + 1; const float rn = __builtin_amdgcn_rcpf((float)(pos1 < win ? pos1 : win));
            *(LAS unsigned*)(lds + YPL + lt * YST + p * 4) = cvt_pk_bf16(S0 * rn - a0, S1 * rn - a1);
            const unsigned o = *(const LAS unsigned*)(lds + AIN + (rr - win + 1) * 512 + p * 4); S0 -= bf_lo(o); S1 -= bf_hi(o); } }
      LDS_BARRIER();
      for (int prep = 0; prep < 1 + ((CONV_REP >> 3) & 1); ++prep) { f32x4 acc[2][4];
#pragma unroll
        for (int a = 0; a < 2; ++a)
#pragma unroll
            for (int b = 0; b < 4; ++b) acc[a][b] = (f32x4){0.f, 0.f, 0.f, 0.f};
#pragma unroll
        for (int ks = 0; ks < 2; ++ks) { bf16x8 A[2];
#pragma unroll
            for (int mt = 0; mt < 2; ++mt) A[mt] = *(const LAS bf16x8*)(lds + YPL + ((2 * th + mt) * 16 + fr) * YST + (g * 64 + ks * 32 + 8 * fq) * 2);
#pragma unroll
            for (int mt = 0; mt < 2; ++mt)
#pragma unroll
                for (int nt = 0; nt < 4; ++nt) acc[mt][nt] = __builtin_amdgcn_mfma_f32_16x16x32_bf16(Bf[ks][nt], A[mt], acc[mt][nt], 0, 0, 0); }
#pragma unroll
        for (int mt = 0; mt < 2; ++mt)
#pragma unroll
            for (int nt = 0; nt < 4; ++nt) { const int t = r0 + (2 * th + mt) * 16 + fr, d = nt * 16 + 4 * fq; const f32x4 v = acc[mt][nt] * sc4[nt];
                u32x2 o; o.x = cvt_pk_bf16(v[0], v[1]); o.y = cvt_pk_bf16(v[2], v[3]); if (WT_MASK & 1) st8_wt(Y, (unsigned)((t * D + g * 64 + d) * 2), o); else *(u32x2*)(Y + (size_t)t * D + g * 64 + d) = o; } }
      LDS_BARRIER(); }
    asm volatile("" : "+v"(tid)); lane = tid & 63;
    for (int mrep = 0; mrep < 1 + ((MIX_REP >> 1) & 1); ++mrep) if (MIX_MASK & 2) { constexpr int VN = 0, VST = 800; const int nj = half ? 128 : 64, nks = nj >> 5;
      const int h = w & 3, ih = w >> 2, fr = lane & 15, fq = lane >> 4, q4 = (lane & 15) >> 2, p4 = lane & 3;
      const bf16* wsb = (const bf16*)(ws + WS_GMWS) + (size_t)(layer * 4 + h) * 128 * 128;
      const float* gg = in[5] + layer * DGM; const float* bb = in[7] + (size_t)(layer * 4 + h) * 128;
      u32x4 raw[16]; const int nr = nj >> 3;
#pragma unroll
      for (int i = 0; i < 16; ++i) { raw[i] = (u32x4){0u, 0u, 0u, 0u}; if (i < nr && lane < 48) raw[i] = *(const u32x4*)(P + (size_t)(blk0 + i * 8 + w) * DIN + 640 + lane * 8); }
      bf16x8 Aw[4][2]; f32x4 g4[6]; float bi[2];
#pragma unroll
      for (int ks = 0; ks < 4; ++ks)
#pragma unroll
          for (int mt = 0; mt < 2; ++mt) { Aw[ks][mt] = (bf16x8){0, 0, 0, 0, 0, 0, 0, 0}; if (ks < nks) Aw[ks][mt] = *(const bf16x8*)(wsb + (size_t)(half * 64 + (2 * ih + mt) * 16 + fr) * 128 + ks * 32 + 8 * fq); }
#pragma unroll
      for (int ct = 0; ct < 6; ++ct) g4[ct] = *(const f32x4*)(gg + h * 96 + ct * 16 + 4 * fq);
#pragma unroll
      for (int mt = 0; mt < 2; ++mt) bi[mt] = bb[half * 64 + (2 * ih + mt) * 16 + fr];
#pragma unroll
      for (int i = 0; i < 16; ++i) { if (i < nr) { float f[8]; unpack8(raw[i], f); float s = 0.f;
#pragma unroll
              for (int q = 0; q < 8; ++q) s += f[q] * f[q];
              s = wave_sum(s); const float rs = 1.0f / sqrtf(s * (1.0f / DGM) + EPS);
              u32x4 o; o.x = cvt_pk_bf16(f[0] * rs, f[1] * rs); o.y = cvt_pk_bf16(f[2] * rs, f[3] * rs); o.z = cvt_pk_bf16(f[4] * rs, f[5] * rs); o.w = cvt_pk_bf16(f[6] * rs, f[7] * rs);
              if (lane < 48) *(LAS u32x4*)(lds + VN + (i * 8 + w) * VST + lane * 16) = o; } }
      u32x2 uu[2][6];
#pragma unroll
      for (int mt = 0; mt < 2; ++mt)
#pragma unroll
          for (int ct = 0; ct < 6; ++ct) uu[mt][ct] = *(const u32x2*)(P + (size_t)(r0 + (2 * ih + mt) * 16 + fr) * DIN + 256 + h * 96 + ct * 16 + 4 * fq);
      LDS_BARRIER();
      { f32x4 acc[2][6];
#pragma unroll
        for (int a = 0; a < 2; ++a)
#pragma unroll
            for (int b = 0; b < 6; ++b) acc[a][b] = (f32x4){0.f, 0.f, 0.f, 0.f};
#pragma unroll
        for (int ks = 0; ks < 4; ++ks) { if (ks < nks) {
#pragma unroll
            for (int ct = 0; ct < 6; ++ct) { const unsigned ad = VN + (32 * ks + 8 * fq + q4) * VST + (h * 96 + ct * 16 + 4 * p4) * 2;
                const s16x4 t0 = __builtin_amdgcn_ds_read_tr16_b64_v4i16((LAS s16x4*)(lds + ad)), t1 = __builtin_amdgcn_ds_read_tr16_b64_v4i16((LAS s16x4*)(lds + ad + 4 * VST));
                bf16x8 B; B[0] = t0[0]; B[1] = t0[1]; B[2] = t0[2]; B[3] = t0[3]; B[4] = t1[0]; B[5] = t1[1]; B[6] = t1[2]; B[7] = t1[3];
#pragma unroll
                for (int mt = 0; mt < 2; ++mt) acc[mt][ct] = __builtin_amdgcn_mfma_f32_16x16x32_bf16(B, Aw[ks][mt], acc[mt][ct], 0, 0, 0); } } }
#pragma unroll
        for (int mt = 0; mt < 2; ++mt) { const int t = r0 + (2 * ih + mt) * 16 + fr;
#pragma unroll
            for (int ct = 0; ct < 6; ++ct) { const int c4 = h * 96 + ct * 16 + 4 * fq; const f32x4 z = acc[mt][ct] * g4[ct] + bi[mt]; const u32x2 uv = uu[mt][ct];
                u32x2 o; o.x = cvt_pk_bf16(bf_lo(uv.x) * z[0], bf_hi(uv.x) * z[1]); o.y = cvt_pk_bf16(bf_lo(uv.y) * z[2], bf_hi(uv.y) * z[3]); if (WT_MASK & 1) st8_wt(Y, (unsigned)((t * D + 256 + c4) * 2), o); else *(u32x2*)(Y + (size_t)t * D + 256 + c4) = o; } } }
      LDS_BARRIER(); }
    if (MIX_CVT >= 2) { tr_store(cja, cva, nullptr, lane, 0); tr_store(cjb, cvb, nullptr, lane, 0); }
    asm volatile("" : "+v"(tid)); lane = tid & 63;
    for (int mrep = 0; mrep < 1 + ((MIX_REP >> 2) & 1); ++mrep) if (MIX_MASK & 4) { constexpr int HC = 0, TT = 72192, TST = 784;
      { const char* dwsrc = (const char*)(in[8] + (size_t)layer * 31 * DCV);
#pragma unroll
        for (int i = 0; i < 6; ++i) { const int c = i * 8 + w; if (c * 1024 + lane * 16 < 31 * DCV * 4) __builtin_amdgcn_global_load_lds((const unsigned*)(dwsrc + c * 1024 + lane * 16), (LAS unsigned*)(lds + TT + c * 1024), 16, 0, 0); } }
      for (int crep = 0; crep < 1 + (CONV_REP & 1); ++crep) { u32x4 cvr[9], cgr[9];
#pragma unroll
        for (int i = 0; i < 9; ++i) { const int idx = tid + 512 * i, rr = idx / 48, ch = idx % 48, pos = s0 - 30 + rr; cvr[i] = (u32x4){0u, 0u, 0u, 0u}; cgr[i] = (u32x4){0u, 0u, 0u, 0u};
            if (idx < 94 * 48 && pos >= 0) { const bf16* pr = P + (size_t)(r0 - 30 + rr) * DIN; cvr[i] = *(const u32x4*)(pr + 1024 + ch * 8); cgr[i] = *(const u32x4*)(pr + 1408 + ch * 8); } }
        if (MIX_CVT >= 4 && mrep == 0 && crep == 0) { asm volatile("" ::: "memory"); cja = tr_decode(in, ws, cvi + 2 * CVS); tr_load(cja, cva, lane, 0); cjb = tr_decode(in, ws, cvi + 3 * CVS); tr_load(cjb, cvb, lane, 0); asm volatile("" ::: "memory"); }
#pragma unroll
        for (int i = 0; i < 9; ++i) { const int idx = tid + 512 * i, rr = idx / 48, ch = idx % 48; float a[8], b[8]; unpack8(cvr[i], a); unpack8(cgr[i], b);
#pragma unroll
            for (int q = 0; q < 8; ++q) a[q] *= fast_sigmoid(b[q]);
            u32x4 o; o.x = cvt_pk_bf16(a[0], a[1]); o.y = cvt_pk_bf16(a[2], a[3]); o.z = cvt_pk_bf16(a[4], a[5]); o.w = cvt_pk_bf16(a[6], a[7]);
            if (idx < 94 * 48) *(LAS u32x4*)(lds + HC + rr * 768 + ch * 16) = o; } }
      asm volatile("s_waitcnt vmcnt(0)" ::: "memory");
      LDS_BARRIER();
      asm volatile("" : "+v"(tid)); lane = tid & 63;
      const int fr = lane & 15, fq = lane >> 4; const bf16* pw = (const bf16*)(ws + WS_PWT) + (size_t)layer * DCV * DCV;
      bf16x8 Bp[4][3], Bq[8][3];
      for (int crep = 0; crep < 1 + ((CONV_REP >> 1) & 1); ++crep) { const float* dwb = in[9] + layer * DCV; const float* lg = in[10] + layer * DCV; const float* lb = in[11] + layer * DCV;
        f32x2 g2[3], bt2[3];
#pragma unroll
        for (int q = 0; q < 3; ++q) { g2[q] = *(const f32x2*)(lg + 128 * q + 2 * lane); bt2[q] = *(const f32x2*)(lb + 128 * q + 2 * lane); }
        float dd[8][6];
#pragma unroll
        for (int q = 0; q < 3; ++q) { const int c = 128 * q + 2 * lane; f32x2 wj[31];
#pragma unroll
            for (int j = 0; j < 31; ++j) wj[j] = *(const LAS f32x2*)(lds + TT + (j * DCV + c) * 4);
            const f32x2 b2 = *(const f32x2*)(dwb + c); f32x2 a2[8];
#pragma unroll
            for (int r = 0; r < 8; ++r) a2[r] = b2;
#pragma unroll
            for (int s = 0; s < 38; ++s) { const unsigned hv = *(const LAS unsigned*)(lds + HC + (8 * w + s) * 768 + c * 2); const f32x2 h2 = (f32x2){bf_lo(hv), bf_hi(hv)};
#pragma unroll
                for (int r = 0; r < 8; ++r) { const int j = s - r; if (j >= 0 && j <= 30) a2[r] = __builtin_elementwise_fma(h2, wj[j], a2[r]); } }
#pragma unroll
            for (int r = 0; r < 8; ++r) { dd[r][2 * q] = a2[r][0]; dd[r][2 * q + 1] = a2[r][1]; asm volatile("" : "+v"(dd[r][2 * q]), "+v"(dd[r][2 * q + 1])); }
            asm volatile("" ::: "memory"); }
#pragma unroll
        for (int ks = 0; ks < 4; ++ks)
#pragma unroll
            for (int nt = 0; nt < 3; ++nt) Bp[ks][nt] = *(const bf16x8*)(pw + (size_t)((3 * w + nt) * 16 + fr) * DCV + ks * 32 + 8 * fq);
#pragma unroll
        for (int ks = 0; ks < 8; ++ks)
#pragma unroll
            for (int nt = 0; nt < 3; ++nt) Bq[ks][nt] = *(const bf16x8*)(pw + (size_t)((3 * w + nt) * 16 + fr) * DCV + (4 + ks) * 32 + 8 * fq);
        LDS_BARRIER();
#pragma unroll
        for (int r = 0; r < 8; ++r) { float s = 0.f, v = 0.f;
#pragma unroll
            for (int q = 0; q < 6; ++q) { s += dd[r][q]; v += dd[r][q] * dd[r][q]; }
            const float mu = wave_sum(s) * (1.0f / DCV), ex2 = wave_sum(v) * (1.0f / DCV);
#pragma unroll
            for (int q = 0; q < 6; ++q) dd[r][q] -= mu;
            const float rs = 1.0f / sqrtf(fmaxf(ex2 - mu * mu, 0.f) + EPS);
#pragma unroll
            for (int q = 0; q < 3; ++q) { float y0 = dd[r][2 * q] * rs * g2[q][0] + bt2[q][0], y1 = dd[r][2 * q + 1] * rs * g2[q][1] + bt2[q][1]; y0 *= fast_sigmoid(y0); y1 *= fast_sigmoid(y1);
                *(LAS unsigned*)(lds + TT + (8 * w + r) * TST + (128 * q + 2 * lane) * 2) = cvt_pk_bf16(y0, y1); } } }
      LDS_BARRIER();
      for (int crep = 0; crep < 1 + ((CONV_REP >> 2) & 1); ++crep) { f32x4 acc[4][3];
#pragma unroll
        for (int a = 0; a < 4; ++a)
#pragma unroll
            for (int b = 0; b < 3; ++b) acc[a][b] = (f32x4){0.f, 0.f, 0.f, 0.f};
        const f32x4* pb4 = (const f32x4*)(in[13] + layer * DCV); f32x4 pbv[3];
#pragma unroll
        for (int nt = 0; nt < 3; ++nt) pbv[nt] = pb4[(3 * w + nt) * 4 + fq];
#pragma unroll
        for (int ks = 0; ks < 12; ++ks) { bf16x8 A[4];
#pragma unroll
            for (int mt = 0; mt < 4; ++mt) A[mt] = *(const LAS bf16x8*)(lds + TT + (mt * 16 + fr) * TST + (ks * 32 + 8 * fq) * 2);
#pragma unroll
            for (int mt = 0; mt < 4; ++mt)
#pragma unroll
                for (int nt = 0; nt < 3; ++nt) acc[mt][nt] = __builtin_amdgcn_mfma_f32_16x16x32_bf16(ks < 4 ? Bp[ks & 3][nt] : Bq[(ks - 4) & 7][nt], A[mt], acc[mt][nt], 0, 0, 0); }
#pragma unroll
        for (int mt = 0; mt < 4; ++mt)
#pragma unroll
            for (int nt = 0; nt < 3; ++nt) { const int t = r0 + mt * 16 + fr, n4 = (3 * w + nt) * 16 + 4 * fq; const f32x4 v = acc[mt][nt] + pbv[nt];
                u32x2 o; o.x = cvt_pk_bf16(v[0], v[1]); o.y = cvt_pk_bf16(v[2], v[3]); if (WT_MASK & 1) st8_wt(Y, (unsigned)((t * D + 640 + n4) * 2), o); else *(u32x2*)(Y + (size_t)t * D + 640 + n4) = o; } }
      LDS_BARRIER(); }
    if (MIX_CVT >= 4) { tr_store(cja, cva, nullptr, lane, 0); tr_store(cjb, cvb, nullptr, lane, 0); }
}

__device__ __forceinline__ void router_phase(Frame& F) {
    LAS unsigned char* lds = F.lds; int lane = F.lane; asm volatile("" : "+v"(lane)); const int w = F.wave; unsigned char* ws = F.ws;
    const InTab in = in_tab(F); const bf16* XBr = (const bf16*)(ws + WS_XB); const float* g2 = in[15] + D; const float* R = in[19];
    unsigned* rowoff = (unsigned*)(ws + WS_ROWOFF); float* rs_e = (float*)(ws + WS_RS); float* gate_e = (float*)(ws + WS_GATE); int* sel = (int*)(ws + WS_SEL);
    unsigned* cnt = F.ctl + CW_CNT;
    LAS int* se0 = (LAS int*)lds; LAS int* se1 = se0 + 64; LAS float* sw0 = (LAS float*)(se1 + 64); LAS float* sw1 = sw0 + 64; LAS float* srs = sw1 + 64;
    float Rg[4][4][8];
#pragma unroll
    for (int j = 0; j < 4; ++j)
#pragma unroll
        for (int q = 0; q < 4; ++q) { const int k = 8 * lane + 512 * (j >> 1) + 4 * (j & 1) + q; const float gk = g2[k]; const f32x4 a = *(const f32x4*)(R + k * 8), b = *(const f32x4*)(R + k * 8 + 4);
            Rg[j][q][0] = a[0] * gk; Rg[j][q][1] = a[1] * gk; Rg[j][q][2] = a[2] * gk; Rg[j][q][3] = a[3] * gk; Rg[j][q][4] = b[0] * gk; Rg[j][q][5] = b[1] * gk; Rg[j][q][6] = b[2] * gk; Rg[j][q][7] = b[3] * gk; }
    for (int b = F.vcu; b < M / 64; b += F.G) {
        f32x4 cva[8], cvb[8]; TrJob cja, cjb; const int cvi = R9_BEG + b * 8 + w;
        if (R9_CVT >= 2) { cja = tr_decode(in, ws, cvi); tr_load(cja, cva, lane, 0); cjb = tr_decode(in, ws, cvi + (M / 64) * 8); tr_load(cjb, cvb, lane, 0); }
        for (int i = 0; i < 8; ++i) { const int tl = 8 * w + i, t = 64 * b + tl; const u32x4* xr = (const u32x4*)(XBr + (size_t)t * D) + lane; float ss = 0.f, le[8];
#pragma unroll
            for (int e = 0; e < 8; ++e) le[e] = 0.f;
            const u32x4 xa = xr[0], xb2 = xr[64];
#pragma unroll
            for (int j = 0; j < 4; ++j) { const u32x4 xw = (j < 2) ? xa : xb2; const unsigned w0_ = (j & 1) ? xw.z : xw.x, w1_ = (j & 1) ? xw.w : xw.y; const f32x4 v = (f32x4){bf_lo(w0_), bf_hi(w0_), bf_lo(w1_), bf_hi(w1_)};
#pragma unroll
                for (int q = 0; q < 4; ++q) { ss += v[q] * v[q];
#pragma unroll
                    for (int e = 0; e < 8; ++e) le[e] += v[q] * Rg[j][q][e]; } }
            ss = wave_sum(ss);
#pragma unroll
            for (int e = 0; e < 8; ++e) le[e] = wave_sum(le[e]);
            const float rs = 1.0f / sqrtf(ss * (1.0f / D) + EPS);
            int i0 = 0; float l0 = le[0];
#pragma unroll
            for (int e = 1; e < 8; ++e) if (le[e] > l0) { l0 = le[e]; i0 = e; }
            int i1 = -1; float l1 = -3.0e38f;
#pragma unroll
            for (int e = 0; e < 8; ++e) if (e != i0 && le[e] > l1) { l1 = le[e]; i1 = e; }
            const float ex = expf((l1 - l0) * rs), w0 = 1.0f / (1.0f + ex), w1 = ex / (1.0f + ex);
            if (lane == 0) { se0[tl] = i0; se1[tl] = i1; sw0[tl] = w0; sw1[tl] = w1; srs[tl] = rs; } }
        __syncthreads();
        if (w == 0) { const int e0 = se0[lane], e1 = se1[lane]; int r0 = 0, r1 = 0; const unsigned long long lt = (1ull << lane) - 1ull;
            int l0 = 0, l1 = 0, nmine = 0;
#pragma unroll
            for (int e = 0; e < 8; ++e) { const unsigned long long m0 = __ballot(e0 == e), m1 = __ballot(e1 == e); const int n0 = __popcll(m0), n = n0 + __popcll(m1);
                if (e0 == e) l0 = __popcll(m0 & lt);
                if (e1 == e) l1 = n0 + __popcll(m1 & lt);
                nmine = (lane == e) ? n : nmine; }
            unsigned base = 0u;
            if (lane < 8 && nmine > 0) base = __hip_atomic_fetch_add(cnt + 64 * lane, (unsigned)nmine, RLX_AGENT);
            r0 = (int)__shfl(base, e0) + l0; r1 = (int)__shfl(base, e1) + l1;
            const int t = 64 * b + lane; const float rs = srs[lane];
            rowoff[e0 * ECAP + r0] = (unsigned)t * (unsigned)(D * 2); rs_e[e0 * ECAP + r0] = rs; gate_e[e0 * ECAP + r0] = sw0[lane];
            rowoff[e1 * ECAP + r1] = (unsigned)t * (unsigned)(D * 2); rs_e[e1 * ECAP + r1] = rs; gate_e[e1 * ECAP + r1] = sw1[lane];
            *(int4*)(sel + 4 * t) = make_int4(e0, r0, e1, r1); }
        if (R9_CVT >= 2) { tr_store(cja, cva, nullptr, lane, 0); tr_store(cjb, cvb, nullptr, lane, 0); }
        __syncthreads();
    }
}
__device__ __forceinline__ void moe_panels(Frame& F, int (&pb)[9]) {
    unsigned* cnt = F.ctl + CW_CNT; pb[0] = 0;
#pragma unroll
    for (int e = 0; e < 8; ++e) { const unsigned c = (unsigned)__builtin_amdgcn_readfirstlane(__hip_atomic_load(cnt + 64 * e, RLX_AGENT)); pb[e + 1] = pb[e] + (int)((c + 255u) >> 8); }
}
__device__ __forceinline__ void final_phase(Frame& F) {
    int pb[9]; moe_panels(F, pb);
    const int total = pb[8] * 4, nfull = (total / F.G) * F.G, NPf = nfull / 4, sp = pg8::moe_split(total - nfull, F.G); const bf16* slabs = (const bf16*)(F.ws + WS_SLAB);
    int lane = F.lane; asm volatile("" : "+v"(lane));
    const int gw = F.vcu * 8 + F.wave, NGW = F.G * 8; unsigned char* ws = F.ws;
    const bf16* YP = (const bf16*)(ws + WS_YP); const int* sel = (const int*)(ws + WS_SEL); const float* fg = in_tab(F)[23]; float* X = F.out; const bf16* XBf = (const bf16*)(ws + WS_XB2);
    f32x4 g4[4];
#pragma unroll
    for (int j = 0; j < 4; ++j) g4[j] = *((const f32x4*)fg + lane + 64 * j);
    for (int t = gw; t < M; t += NGW) { const int4 s = *(const int4*)(sel + 4 * t); int b0 = 0, b1 = 0;
#pragma unroll
        for (int e = 0; e < 8; ++e) { b0 = (s.x == e) ? pb[e] : b0; b1 = (s.z == e) ? pb[e] : b1; }
        const int pr[2] = {256 * b0 + s.y, 256 * b1 + s.w};
        const u32x2* xr = (const u32x2*)(XBf + (size_t)t * D) + lane;
        f32x4 v[4];
#pragma unroll
        for (int j = 0; j < 4; ++j) { const u32x2 a = xr[64 * j]; v[j] = (f32x4){bf_lo(a.x), bf_hi(a.x), bf_lo(a.y), bf_hi(a.y)}; }
#pragma unroll
        for (int k = 0; k < 2; ++k) { const int pm = pr[k] >> 8, lr = pr[k] & 255;
            if (sp > 1 && pm >= NPf) {
#pragma unroll
                for (int j = 0; j < 4; ++j) { const bf16* sb = slabs + (size_t)(((pm - NPf) * 4 + j) * sp) * 65536 + lr * 256 + 4 * lane; u32x2 a[14];
#pragma unroll
                    for (int ks = 0; ks < 14; ++ks) { a[ks] = (u32x2){0u, 0u}; if (ks < sp) a[ks] = *(const u32x2*)(sb + (size_t)ks * 65536); }
#pragma unroll
                    for (int ks = 0; ks < 14; ++ks) { v[j][0] += bf_lo(a[ks].x); v[j][1] += bf_hi(a[ks].x); v[j][2] += bf_lo(a[ks].y); v[j][3] += bf_hi(a[ks].y); } }
            } else { const u32x2* y = (const u32x2*)(YP + (size_t)pr[k] * D) + lane;
#pragma unroll
                for (int j = 0; j < 4; ++j) { const u32x2 a = __builtin_nontemporal_load(y + 64 * j); v[j][0] += bf_lo(a.x); v[j][1] += bf_hi(a.x); v[j][2] += bf_lo(a.y); v[j][3] += bf_hi(a.y); } } }
        float ss = 0.f;
#pragma unroll
        for (int j = 0; j < 4; ++j) ss += (v[j][0] * v[j][0] + v[j][1] * v[j][1]) + (v[j][2] * v[j][2] + v[j][3] * v[j][3]);
        ss = wave_sum(ss); const float rs = 1.0f / sqrtf(ss * (1.0f / D) + EPS);
        f32x4* o = (f32x4*)(X + (size_t)t * D) + lane;
#pragma unroll
        for (int j = 0; j < 4; ++j) __builtin_nontemporal_store(v[j] * rs * g4[j], o + 64 * j); }
}

template <class Sched> __device__ __forceinline__ void stage_rstd(Frame& F, const Sched& S, const float* ssq, LAS float* rtab) {
    pg8::Unit u; int tid = F.tid; asm volatile("" : "+v"(tid)); __syncthreads();
#pragma unroll 1
    for (int i = 0; i < 8 && S.next(i, u); ++i) if (tid < 256) rtab[i * 256 + tid] = pg8::rstd_of(ssq, u.pm * 256 + tid);
    __syncthreads();
}
struct Args { const float* in[24]; float* out; unsigned char* ws; int ph_lo, ph_hi, li, pad; };
__global__ void __launch_bounds__(512, 2) fwd(Args args) {
    extern __shared__ __attribute__((aligned(16))) unsigned char lds_raw[];
    Frame F;
    F.lds = (LAS unsigned char*)lds_raw; F.MISC = (volatile LAS unsigned*)(F.lds + MISC_OFF);
    F.tid = threadIdx.x; F.lane = F.tid & 63; F.wave = __builtin_amdgcn_readfirstlane(F.tid >> 6);
    F.G = gridDim.x; { const int bx = blockIdx.x; F.vcu = (F.G % 8 == 0) ? (bx % 8) * (F.G / 8) + bx / 8 : bx; }
    F.in.t = (const LAS unsigned long long*)(F.lds + INTAB_OFF); F.out = args.out; F.ws = args.ws; F.ctl = (unsigned*)(args.ws + WS_CTL);
    for (int u = F.tid; u < 64; u += 512) ((LAS unsigned*)(F.lds + MISC_OFF))[u] = 0u;
    if (F.tid < 24) ((LAS unsigned long long*)(F.lds + INTAB_OFF))[F.tid] = (unsigned long long)args.in[F.tid];
    __syncthreads();
    jobs_setup(F);
    XcdBarrier bar = xcd_barrier_post(F.ctl + CW_BAR + args.li * XCD_BAR_WORDS, F.MISC + 8);
    const int lo = args.ph_lo, hi = args.ph_hi;
#ifndef PH_MASK
#define PH_MASK 0xFFFF
#endif
#define PH_ON(k) (((PH_MASK) >> (k)) & 1)
#ifndef REP_MASK
#define REP_MASK 0
#endif
#define REPS(k) (1 + (((REP_MASK) >> (k)) & 1))
#ifndef PRO_PROBE
#define PRO_PROBE 0
#endif
#ifndef CVT_BEFORE
#define CVT_BEFORE 0
#endif
#ifndef EPI_PROBE
#define EPI_PROBE 0
#endif
#define IN(k) (lo <= (k) && (k) < hi)
#define SEAM(k) do { if (IN(k) && IN((k) + 1)) xcd_barrier(bar); } while (0)
#define SEAMH(k, first) do { if (IN(k) && IN((k) + 1)) xcd_barrier_host(bar, F, (first)); } while (0)
    unsigned char* ws = args.ws; LAS unsigned* gtab = (LAS unsigned*)(F.lds + GTAB_OFF);
    bf16* XB = (bf16*)(ws + WS_XB); float* ssq = (float*)(ws + WS_SSQ);
    if (F.G != 256) return;

    if (PH_ON(0) && IN(0)) for (int rep = 0; rep < REPS(0); ++rep) { p0_prologue(F, rep == 0 ? 0 : PRO_PROBE); __syncthreads(); }
    SEAMH(0, 0);
#pragma unroll 1
    for (int layer = 0; layer < 2; ++layer) {
        const int pbase = 1 + layer * 5;
        if (PH_ON(1) && IN(pbase)) for (int rep = 0; rep < REPS(1); ++rep) { pg8::Gemm g{XB, (const bf16*)(ws + WS_WIN) + (size_t)layer * DIN * D, D, 0}; pg8::StaticOrder S; S.init(M, DIN, F.G, (int)blockIdx.x);
            stage_rstd(F, S, ssq, (LAS float*)gtab); pg8::EpiP E{(bf16*)(ws + WS_P), DIN, (const LAS float*)gtab}; pg8::gemm_phase<pg8::EpiP, pg8::StaticOrder, true, true>(F.lds, gtab, g, S, E);
            if (rep == 0) tail_convert(F, layer ? H6_BEG : H1_BEG, H1_N, (int)blockIdx.x - 192, 64); }
        SEAMH(pbase, layer == 0 ? 1 : -1);
        if (PH_ON(2) && IN(pbase + 1)) for (int rep = 0; rep < REPS(2); ++rep) { for (int u = F.vcu; u < M / 64; u += F.G) mixer_unit(F, u, layer, layer ? MX1_BEG : MX0_BEG); }
        SEAMH(pbase + 1, layer == 0 ? 2 : -1);
        if (PH_ON(3) && IN(pbase + 2)) for (int rep = 0; rep < (layer == 0 ? REPS(3) : 1); ++rep) { pg8::Gemm g{(const bf16*)(ws + WS_Y), (const bf16*)(ws + WS_WOUT) + (size_t)layer * D * D, D, 0}; pg8::StaticOrder S; S.init(M, D, F.G, (int)blockIdx.x);
            pg8::EpiResid E{(const float*)nullptr, XB, ssq}; pg8::gemm_phase<pg8::EpiResid, pg8::StaticOrder, false, true>(F.lds, gtab, g, S, E); }
        SEAMH(pbase + 2, layer == 0 ? 3 : -1);
        if (layer == 0) {
            if (PH_ON(4) && IN(4)) for (int rep = 0; rep < REPS(4); ++rep) { pg8::Gemm g{XB, (const bf16*)(ws + WS_WGU), D, 0}; pg8::StaticOrder S; S.init(M, NGU, F.G, (int)blockIdx.x);
                stage_rstd(F, S, ssq, (LAS float*)gtab); pg8::EpiSwiglu<false> E{(bf16*)(ws + WS_ACT), DFF, (const LAS float*)gtab, 0}; pg8::gemm_phase<pg8::EpiSwiglu<false>, pg8::StaticOrder, true, true>(F.lds, gtab, g, S, E);
                if (rep == 0) tail_convert(F, H4_BEG, H4_N, (int)blockIdx.x - 128, 128); }
            SEAMH(4, 4);
            if (PH_ON(5) && IN(5)) { pg8::Gemm g{(const bf16*)(ws + WS_ACT), (const bf16*)(ws + WS_WD), DFF, 0}; pg8::StaticOrder S; S.init(M, D, F.G, (int)blockIdx.x);
                pg8::EpiResid E{(const float*)nullptr, XB, ssq}; pg8::gemm_phase<pg8::EpiResid, pg8::StaticOrder, false, true>(F.lds, gtab, g, S, E); }
            SEAMH(5, 5);
        }
    }
    if (PH_ON(9) && IN(9)) router_phase(F);
    SEAM(9);
#ifndef STAGGER_US
#define STAGGER_US 0
#endif
    if (PH_ON(10) && IN(10)) for (int rep = 0; rep < REPS(10); ++rep) {
        if (STAGGER_US > 0 && (blockIdx.x & 1)) { const unsigned long long t0 = __builtin_amdgcn_s_memrealtime(); while (__builtin_amdgcn_s_memrealtime() - t0 < (unsigned long long)(STAGGER_US * 100)) __builtin_amdgcn_s_sleep(8); __syncthreads(); }
        pg8::MoeOrderGather S; moe_panels(F, S.pb); S.nN = NGUE / 256; S.nwg = S.pb[8] * S.nN; S.G = F.G; S.c = (int)blockIdx.x; S.rowoff = (const unsigned*)(ws + WS_ROWOFF); S.rs_e = (const float*)(ws + WS_RS); S.gate_e = (const float*)(ws + WS_GATE);
        pg8::Gemm g{XB, (const bf16*)(ws + WS_MOE_WGU), D, (size_t)NGUE * D};
        pg8::EpiSwiglu<true> E{(bf16*)(ws + WS_ACTM), DFE, (const LAS float*)(gtab + 512), rep == 0 ? 0 : EPI_PROBE};
        pg8::gemm_phase<pg8::EpiSwiglu<true>, pg8::MoeOrderGather, true, true>(F.lds, gtab, g, S, E);
        if (rep == 0) { const int rem = S.nwg % F.G, idle = rem ? F.G - rem : 0, nconv = idle < 48 ? F.G : (idle > 192 ? 192 : idle);
            tail_convert(F, H10_BEG, H10_N, ((int)blockIdx.x - rem + F.G) % F.G, nconv); } }
    SEAM(10);
    if (PH_ON(11) && IN(11)) for (int rep = 0; rep < REPS(11); ++rep) { pg8::MoeOrderDown S; moe_panels(F, S.pb); S.init(F.G, (int)blockIdx.x);
        pg8::Gemm g{(const bf16*)(ws + WS_ACTM), (const bf16*)(ws + WS_MOE_WD), DFE, (size_t)D * DFE};
        pg8::EpiBf16 E{(bf16*)(ws + WS_YP), D, (bf16*)(ws + WS_SLAB)};
        pg8::gemm_phase<pg8::EpiBf16, pg8::MoeOrderDown, true, true>(F.lds, gtab, g, S, E); }
    SEAM(11);
    if (PH_ON(12) && IN(12)) final_phase(F);
#undef IN
#undef SEAM
}
#ifndef MK_PER_PHASE
#define MK_PER_PHASE 0
#endif
extern "C" void kernel_launch(void* const* d_in, const int* in_sizes, int n_in, void* d_out, int out_size, void* d_ws, size_t ws_size, hipStream_t stream) {
    static int grid = 0;
    if (grid == 0) {
        if (n_in != 24 || out_size != M * D || ws_size < WS_END) { fprintf(stderr, "kernel_launch: unexpected shapes (n_in %d out %d ws %zu)\n", n_in, out_size, ws_size); grid = -1; return; }
        int dev = 0, cus = 0;
        if (hipGetDevice(&dev) != hipSuccess || hipDeviceGetAttribute(&cus, hipDeviceAttributeMultiprocessorCount, dev) != hipSuccess) { grid = -1; return; }
        if (hipFuncSetAttribute((const void*)fwd, hipFuncAttributeMaxDynamicSharedMemorySize, LDS_BYTES) != hipSuccess) { fprintf(stderr, "kernel_launch: hipFuncSetAttribute failed\n"); grid = -1; return; }
        int per_cu = 0;
        if (hipOccupancyMaxActiveBlocksPerMultiprocessor(&per_cu, (const void*)fwd, 512, LDS_BYTES) != hipSuccess || per_cu < 1) fprintf(stderr, "kernel_launch: occupancy query says %d\n", per_cu);
        (void)hipGetLastError();
        grid = cus;
        if (grid != 256) { fprintf(stderr, "kernel_launch: built for 256 CUs, found %d\n", grid); grid = -1; return; }
    }
    if (grid < 0) return;
    (void)hipMemsetAsync((char*)d_ws + WS_CTL, 0, CTL_ZERO_BYTES, stream);
    Args a{};
    for (int i = 0; i < 24; ++i) a.in[i] = (const float*)d_in[i];
    a.out = (float*)d_out; a.ws = (unsigned char*)d_ws; a.pad = 0;
#if MK_PER_PHASE
    for (int p = 0; p < NPHASE; ++p) { a.ph_lo = p; a.ph_hi = p + 1; a.li = p; hipLaunchKernelGGL(fwd, dim3(grid), dim3(512), LDS_BYTES, stream, a); }
#else
    a.ph_lo = 0; a.ph_hi = NPHASE; a.li = 0; hipLaunchKernelGGL(fwd, dim3(grid), dim3(512), LDS_BYTES, stream, a);
#endif
}
```

```cpp
#define MK_PER_PHASE 0
#define PG_WGM 4
#define NT_ACT 1
#define HID_PW 8
#define H10_SHARE 11264
#define SEAM_RELAX 0
#include <hip/hip_runtime.h>
#include <cstdio>
#include <cstdint>
constexpr int M = 16384, D = 1024, SEQ = 8192, DIN = 1792, DFF = 2816, DFE = 3584, NE = 8;
constexpr int DPOOL = 256, DGM = 384, DCV = 384;
constexpr int NGU = 2 * DFF, NGUE = 2 * DFE;
constexpr int ECAP = 16384;
constexpr int PMAX = 2 * M + NE * 256;
constexpr float EPS = 1e-6f;

#define LAS __attribute__((address_space(3)))
#define GAS __attribute__((address_space(1)))
typedef unsigned short bf16;
typedef short bf16x8 __attribute__((ext_vector_type(8)));
typedef short s16x4 __attribute__((ext_vector_type(4)));
typedef float f32x4 __attribute__((ext_vector_type(4)));
typedef float f32x2 __attribute__((ext_vector_type(2)));
typedef unsigned u32x4 __attribute__((ext_vector_type(4)));
typedef unsigned u32x2 __attribute__((ext_vector_type(2)));

__device__ __forceinline__ unsigned cvt_pk_bf16(float lo, float hi) { unsigned r; asm volatile("v_cvt_pk_bf16_f32 %0, %1, %2" : "=v"(r) : "v"(lo), "v"(hi)); return r; }
typedef int i32x4 __attribute__((ext_vector_type(4)));
typedef int i32x8 __attribute__((ext_vector_type(8)));
__device__ __forceinline__ unsigned cvt4_fp8(float a, float b, float c, float d) { int r = 0; r = __builtin_amdgcn_cvt_pk_fp8_f32(a, b, r, false); r = __builtin_amdgcn_cvt_pk_fp8_f32(c, d, r, true); return (unsigned)r; }
__device__ __forceinline__ i32x8 cat8(const bf16x8 a, const bf16x8 b) { const i32x4 x = __builtin_bit_cast(i32x4, a), y = __builtin_bit_cast(i32x4, b); return __builtin_shufflevector(x, y, 0, 1, 2, 3, 4, 5, 6, 7); }
#ifndef WT_MASK
#define WT_MASK 0
#endif
__device__ __forceinline__ void st16_wt(const void* base, unsigned off, u32x4 w) { asm volatile("s_nop 4\n\tglobal_store_dwordx4 %0, %1, %2 sc1\n\ts_nop 1" :: "v"(off), "v"(w), "s"(base) : "memory"); }
__device__ __forceinline__ void st16_wt_u(const void* base, unsigned off, u32x4 w) {
    const unsigned long long b = (unsigned long long)base; const unsigned lo = __builtin_amdgcn_readfirstlane((unsigned)b), hi = __builtin_amdgcn_readfirstlane((unsigned)(b >> 32));
    st16_wt((const void*)(((unsigned long long)hi << 32) | lo), off, w); }
__device__ __forceinline__ void st8_wt(const void* base, unsigned off, u32x2 w) { asm volatile("s_nop 4\n\tglobal_store_dwordx2 %0, %1, %2 sc1" :: "v"(off), "v"(w), "s"(base) : "memory"); }
__device__ __forceinline__ float bf_lo(unsigned w) { return __uint_as_float(w << 16); }
__device__ __forceinline__ float bf_hi(unsigned w) { return __uint_as_float(w & 0xffff0000u); }
__device__ __forceinline__ float fast_sigmoid(float x) { return __builtin_amdgcn_rcpf(1.0f + __builtin_amdgcn_exp2f(-1.4426950408889634f * x)); }
template <int CTRL> __device__ __forceinline__ float dpp_f(float v) { return __int_as_float(__builtin_amdgcn_update_dpp(0, __float_as_int(v), CTRL, 0xF, 0xF, true)); }
__device__ __forceinline__ float wave_sum(float v) {
    v += dpp_f<0xB1>(v); v += dpp_f<0x4E>(v); v += dpp_f<0x141>(v); v += dpp_f<0x140>(v);
    const int iv = __float_as_int(v);
    return (__int_as_float(__builtin_amdgcn_readlane(iv, 0)) + __int_as_float(__builtin_amdgcn_readlane(iv, 16))) + (__int_as_float(__builtin_amdgcn_readlane(iv, 32)) + __int_as_float(__builtin_amdgcn_readlane(iv, 48)));
}

#ifndef NT_ACT2
#define NT_ACT2 0
#endif
#ifndef PG_WGM
#define PG_WGM 8
#endif
namespace pg8 {
constexpr int BM = 256, BK = 64, HALF = 128, HTB = HALF * BK * 2, STAGE_BYTES = 8 * HTB, NXCD = 8, WGM = PG_WGM;
__host__ __device__ __forceinline__ int lds_byte(int r, int c) { const int st = (r >> 4) * 2 + (c >> 5), rr = r & 15, cc = c & 31, ob = rr * 64 + cc * 2; return st * 1024 + (ob ^ (((ob >> 9) & 1) << 5)); }
__host__ __device__ __forceinline__ void stage_rc(int b, int& R, int& C) { const int st = b / 1024, sb = b % 1024, swz = sb ^ (((sb >> 9) & 1) << 5); R = (st >> 1) * 16 + swz / 64; C = (st & 1) * 32 + (swz % 64) / 2; }
__host__ __device__ __forceinline__ int perm32(int rho) { const int n = rho >> 4, i = rho & 15; return 8 * (i >> 2) + 4 * n + (i & 3); }

struct Unit { int pm, pn, e, tab, k0b, nt, slab, ui; };
struct Gemm { const bf16* A; const bf16* Bt; int K; size_t bstride_e; };

__device__ __forceinline__ void order_map(int wgid, int nM, int nN, int& pm, int& pn) {
    const int nwg = nM * nN; { const int q = nwg / NXCD, r = nwg % NXCD, xcd = wgid % NXCD, off = wgid / NXCD; wgid = (xcd < r ? xcd * (q + 1) : r * (q + 1) + (xcd - r) * q) + off; }
    const int nig = WGM * nN, gid = wgid / nig, fm = gid * WGM, gsz = (nM - fm) < WGM ? (nM - fm) : WGM;
    pm = fm + ((wgid % nig) % gsz); pn = (wgid % nig) / gsz;
}
struct StaticOrder {
    static constexpr bool GATHER = false;
    int nM, nN, nwg, G, c;
    __device__ void init(int Mrows, int N, int G_, int c_) { nM = Mrows / BM; nN = N / BM; nwg = nM * nN; G = G_; c = c_; }
    __device__ __forceinline__ bool next(int i, Unit& u) const { const long L = (long)i * G + c; if (L >= nwg) return false; order_map((int)L, nM, nN, u.pm, u.pn); u.e = 0; u.tab = i * 256; u.k0b = 0; u.nt = 0; u.slab = -1; return true; }
    __device__ __forceinline__ const unsigned* a_table(const Unit&) const { return nullptr; }
    __device__ __forceinline__ const float* rs_table(const Unit&) const { return nullptr; }
    __device__ __forceinline__ const float* gate_table(const Unit&) const { return nullptr; }
};
struct MoeOrder {
    int pb[9]; int nN, nwg, G, c; const unsigned* rowoff; const float* rs_e; const float* gate_e;
    __device__ __forceinline__ bool next(int i, Unit& u) const {
        const long L = (long)i * G + c; if (L >= nwg) return false; order_map((int)L, pb[8], nN, u.pm, u.pn); u.k0b = 0; u.nt = 0; u.slab = -1;
        int e = 0;
#pragma unroll
        for (int k = 1; k < 8; ++k) e += (u.pm >= pb[k]) ? 1 : 0;
        int pbe = pb[0];
#pragma unroll
        for (int k = 1; k < 8; ++k) pbe = (e == k) ? pb[k] : pbe;
        u.e = e; u.tab = e * ECAP + 256 * (u.pm - pbe); return true;
    }
    __device__ __forceinline__ const unsigned* a_table(const Unit& u) const { return rowoff + u.tab; }
    __device__ __forceinline__ const float* rs_table(const Unit& u) const { return rs_e + u.tab; }
    __device__ __forceinline__ const float* gate_table(const Unit& u) const { return gate_e + u.tab; }
};
struct MoeOrderGather : MoeOrder { static constexpr bool GATHER = true; };
#ifndef FORCE_SPLIT
#define FORCE_SPLIT 0
#endif
__host__ __device__ __forceinline__ int moe_split(int r, int G) { if (FORCE_SPLIT) return r == 0 ? 1 : FORCE_SPLIT;
    return r == 0 ? 1 : (r * 14 <= G ? 14 : (r * 7 <= G ? 7 : (r * 4 <= G ? 4 : (r * 2 <= G ? 2 : 1)))); }
struct MoeOrderDown {
    static constexpr bool GATHER = false;
    int pb[9]; int G, c, NPf, nfull, r, s;
    __device__ __forceinline__ void init(int G_, int c_) { G = G_; c = c_; const int total = pb[8] * 4; nfull = (total / G) * G; NPf = nfull / 4; r = total - nfull; s = moe_split(r, G); }
    __device__ __forceinline__ bool next(int i, Unit& u) const {
        const int L = i * G + c; u.tab = 0;
        if (L < nfull) { order_map(L, NPf, 4, u.pm, u.pn); u.k0b = 0; u.nt = 0; u.slab = -1; }
        else { const int j = L - nfull; if (j >= r * s) return false; const int lu = j / s, ks = j - lu * s; u.pm = NPf + (lu >> 2); u.pn = lu & 3; u.nt = (DFE / BK) / s; u.k0b = ks * u.nt * BK * 2; u.slab = s > 1 ? j : -1; }
        int e = 0;
#pragma unroll
        for (int k = 1; k < 8; ++k) e += (u.pm >= pb[k]) ? 1 : 0;
        u.e = e; return true;
    }
    __device__ __forceinline__ const unsigned* a_table(const Unit&) const { return nullptr; }
    __device__ __forceinline__ const float* rs_table(const Unit&) const { return nullptr; }
    __device__ __forceinline__ const float* gate_table(const Unit&) const { return nullptr; }
};

__device__ __forceinline__ float rstd_of(const float* ssq, int row) { const float s = (ssq[row] + ssq[M + row]) + (ssq[2 * M + row] + ssq[3 * M + row]); return 1.0f / sqrtf(s * (1.0f / D) + EPS); }

struct EpiP {
    static constexpr bool PERM = true, AFTER_DRAIN = false; static constexpr int NSTORE = 16;
    bf16* O; int ldc; const LAS float* rtab;
    __device__ __forceinline__ void operator()(const f32x4 (&acc)[2][2][4][2], const Unit& u, int wr, int wc, int fr, int fq) const {
        const int row0 = u.pm * BM + wr * 64 + fr, col0 = u.pn * BM + wc * 32 + 8 * fq;
#pragma unroll
        for (int ai = 0; ai < 2; ++ai)
#pragma unroll
            for (int m = 0; m < 4; ++m) { const int row = row0 + ai * HALF + m * 16; const float rs = rtab[u.tab + wr * 64 + fr + ai * HALF + m * 16]; bf16* rowp = O + (size_t)row * ldc + col0;
#pragma unroll
                for (int bj = 0; bj < 2; ++bj) { const f32x4 v0 = acc[ai][bj][m][0] * rs, v1 = acc[ai][bj][m][1] * rs;
                    u32x4 w; w.x = cvt_pk_bf16(v0[0], v0[1]); w.y = cvt_pk_bf16(v0[2], v0[3]); w.z = cvt_pk_bf16(v1[0], v1[1]); w.w = cvt_pk_bf16(v1[2], v1[3]);
                    if (WT_MASK & 4) st16_wt(O, (unsigned)((row * ldc + col0 + bj * HALF) * 2), w); else if (NT_ACT2) __builtin_nontemporal_store(w, (u32x4*)(rowp + bj * HALF)); else *(u32x4*)(rowp + bj * HALF) = w; } }
    }
};
#ifndef NT_ACT
#define NT_ACT 0
#endif
#ifndef ACT_AUX
#define ACT_AUX -1
#endif
template <bool MOE> struct EpiSwiglu {
    static constexpr bool PERM = true, AFTER_DRAIN = false; static constexpr int NSTORE = 8;
    bf16* O; int ldc; const LAS float* rtab; int mode; float inv;
    __device__ __forceinline__ void operator()(const f32x4 (&acc)[2][2][4][2], const Unit& u, int wr, int wc, int fr, int fq) const {
        if (mode == 2) { asm volatile("" :: "v"(acc[0][0][0][0][0]), "v"(acc[1][1][3][1][3])); return; }
        const int lr0 = wr * 64 + fr, col0 = u.pn * HALF + wc * 32 + 8 * fq;
#pragma unroll
        for (int ai = 0; ai < 2; ++ai)
#pragma unroll
            for (int m = 0; m < 4; ++m) { const int lr = lr0 + ai * HALF + m * 16, row = u.pm * BM + lr; float rs, gw;
                if (MOE) { rs = rtab[(u.ui & 1) * 512 + lr]; gw = rtab[(u.ui & 1) * 512 + 256 + lr]; } else { rs = rtab[u.tab + lr]; gw = 1.0f; }
                float o[8]; const float rsi = rs * inv, c1 = rsi * -1.4426950408889634f, c2 = rsi * rsi * gw;
#pragma unroll
                for (int n = 0; n < 2; ++n) { const f32x4 ga = acc[ai][0][m][n], gu = ga * acc[ai][1][m][n] * c2, ex = ga * c1;
#pragma unroll
                    for (int q = 0; q < 4; ++q) o[n * 4 + q] = gu[q] * __builtin_amdgcn_rcpf(1.0f + __builtin_amdgcn_exp2f(ex[q])); }
                u32x4 w; w.x = cvt_pk_bf16(o[0], o[1]); w.y = cvt_pk_bf16(o[2], o[3]); w.z = cvt_pk_bf16(o[4], o[5]); w.w = cvt_pk_bf16(o[6], o[7]);
                if (mode == 1) { asm volatile("" :: "v"(w.x), "v"(w.y), "v"(w.z), "v"(w.w)); } else if (ACT_AUX == 16) { bf16* ap = O + (size_t)row * ldc + col0; asm volatile("global_store_dwordx4 %0, %1, off sc1\n\ts_nop 1" :: "v"(ap), "v"(w) : "memory"); } else if (ACT_AUX == 18) { bf16* ap = O + (size_t)row * ldc + col0; asm volatile("global_store_dwordx4 %0, %1, off sc1 nt\n\ts_nop 1" :: "v"(ap), "v"(w) : "memory"); } else if (WT_MASK & 8) st16_wt(O, (unsigned)(row * ldc + col0) * 2u, w); else if (NT_ACT) __builtin_nontemporal_store(w, (u32x4*)(O + (size_t)row * ldc + col0)); else *(u32x4*)(O + (size_t)row * ldc + col0) = w; }
    }
};
struct EpiBf16 {
    static constexpr bool PERM = true, AFTER_DRAIN = false; static constexpr int NSTORE = 16;
    bf16* O; int ldc; bf16* slabs;
    __device__ __forceinline__ void operator()(const f32x4 (&acc)[2][2][4][2], const Unit& u, int wr, int wc, int fr, int fq) const {
        const bool sl = u.slab >= 0; bf16* base = sl ? slabs + (size_t)u.slab * (BM * BM) : O; const int ld = sl ? BM : ldc;
        const int row0 = (sl ? 0 : u.pm * BM) + wr * 64 + fr, col0 = (sl ? 0 : u.pn * BM) + wc * 32 + 8 * fq;
#pragma unroll
        for (int ai = 0; ai < 2; ++ai)
#pragma unroll
            for (int m = 0; m < 4; ++m) { bf16* rowp = base + (size_t)(row0 + ai * HALF + m * 16) * ld + col0;
#pragma unroll
                for (int bj = 0; bj < 2; ++bj) { const f32x4 v0 = acc[ai][bj][m][0], v1 = acc[ai][bj][m][1];
                    u32x4 w; w.x = cvt_pk_bf16(v0[0], v0[1]); w.y = cvt_pk_bf16(v0[2], v0[3]); w.z = cvt_pk_bf16(v1[0], v1[1]); w.w = cvt_pk_bf16(v1[2], v1[3]);
                    if (WT_MASK & 16) st16_wt(base, (unsigned)(((row0 + ai * HALF + m * 16) * ld + col0 + bj * HALF) * 2), w); else if (NT_ACT2) __builtin_nontemporal_store(w, (u32x4*)(rowp + bj * HALF)); else *(u32x4*)(rowp + bj * HALF) = w; } }
    }
};
struct EpiResid {
    static constexpr bool PERM = true, AFTER_DRAIN = true; static constexpr int NSTORE = 0;
    const float* xold32; bf16* XB; float* ssq;
    __device__ __forceinline__ void fused(f32x4 (&acc)[2][2][4][2], const Unit& u, int wr, int wc, int fr, int fq, LAS unsigned char* lds, int wid, int lane) const {
        LAS float* Pt = (LAS float*)lds;
        const int col0 = u.pn * BM + wc * 32 + 8 * fq;
#pragma unroll
        for (int ai = 0; ai < 2; ++ai)
#pragma unroll
            for (int m = 0; m < 4; ++m) { const int r = ai * HALF + wr * 64 + m * 16 + fr; const size_t off = (size_t)(u.pm * BM + r) * D + col0; float s = 0.f;
#pragma unroll
                for (int bj = 0; bj < 2; ++bj) { f32x4 b0, b1;
                    if (xold32) { b0 = *(const f32x4*)(xold32 + off + bj * HALF); b1 = *(const f32x4*)(xold32 + off + bj * HALF + 4); }
                    else { const u32x4 w = *(const u32x4*)(XB + off + bj * HALF); b0 = (f32x4){bf_lo(w.x), bf_hi(w.x), bf_lo(w.y), bf_hi(w.y)}; b1 = (f32x4){bf_lo(w.z), bf_hi(w.z), bf_lo(w.w), bf_hi(w.w)}; }
                    const f32x4 o0 = b0 + acc[ai][bj][m][0], o1 = b1 + acc[ai][bj][m][1];
                    u32x4 w; w.x = cvt_pk_bf16(o0[0], o0[1]); w.y = cvt_pk_bf16(o0[2], o0[3]); w.z = cvt_pk_bf16(o1[0], o1[1]); w.w = cvt_pk_bf16(o1[2], o1[3]); if (WT_MASK & 2) st16_wt(XB, (unsigned)(off + bj * HALF) * 2u, w); else *(u32x4*)(XB + off + bj * HALF) = w;
                    s += ((o0[0] * o0[0] + o0[1] * o0[1]) + (o0[2] * o0[2] + o0[3] * o0[3])) + ((o1[0] * o1[0] + o1[1] * o1[1]) + (o1[2] * o1[2] + o1[3] * o1[3])); }
                s += __shfl_xor(s, 16); s += __shfl_xor(s, 32);
                if (fq == 0) Pt[r * 4 + wc] = s; }
        __syncthreads();
        const int t = wid * 64 + lane;
        if (t < 256) { const float s = (Pt[t * 4 + 0] + Pt[t * 4 + 1]) + (Pt[t * 4 + 2] + Pt[t * 4 + 3]); ssq[(size_t)u.pn * M + u.pm * BM + t] = s; }
        __syncthreads();
    }
};

template <class Epi, class Sched, bool ALIGN_EPI = false, bool SP2 = true, bool F8 = false>
__device__ __forceinline__ void gemm_phase(LAS unsigned char* lds, LAS unsigned* gtab, const Gemm g, const Sched& S, const Epi& E) {
    constexpr bool GATHER = Sched::GATHER;
    static_assert(!GATHER || SP2, "gather needs the SP2 loop (lgkmcnt(0) waits only)");
    int tid_ = threadIdx.x; asm volatile("" : "+v"(tid_));
    const int tid = tid_, wid = __builtin_amdgcn_readfirstlane(tid >> 6), lane = tid & 63, wr = wid >> 2, wc = wid & 3, fr = lane & 15, fq = lane >> 4;
    const int K = g.K; int nt = K / BK;
    unsigned voffA[2], voffB[2];
#pragma unroll
    for (int i = 0; i < 2; ++i) { int R, C; stage_rc(tid * 16 + i * 8192, R, C); const int Rb = Epi::PERM ? ((R & ~31) + perm32(R & 31)) : R;
        voffA[i] = (unsigned)(R * K + C) * 2u; voffB[i] = (unsigned)(Rb * K + C) * 2u; }
    const size_t kstep = (size_t)(BK * 2);
    const size_t hstep = (size_t)HALF * K * 2;
    const size_t tstep = 2 * hstep;
    const unsigned ldsw = (unsigned)wid * 1024u;
    const int aoff = lds_byte(wr * 64 + fr, fq * 8), boff = lds_byte(wc * 32 + fr, fq * 8);
#define PG8_SA(b, h) (((b) * 2 + (h)) * HTB)
#define PG8_SB(b, h) ((4 + (b) * 2 + (h)) * HTB)
#define PG8_STAGE(bufoff, gbase, voff) do { _Pragma("unroll") for (int _i = 0; _i < 2; ++_i) \
        __builtin_amdgcn_global_load_lds((const unsigned*)((const char*)(gbase) + (voff)[_i]), (LAS unsigned*)(lds + (bufoff) + ldsw + _i * 8192), 16, 0, 0); } while (0)
#define PG8_STAGE_A(bufoff, ubase, kb, h) do { if constexpr (GATHER) { PG8_STAGE(bufoff, (const char*)g.A + (kb), ga[h]); } else { PG8_STAGE(bufoff, (ubase) + (size_t)(h) * hstep + (kb), voffA); } } while (0)
#define PG8_LDA(dst, b, h) do { _Pragma("unroll") for (int m = 0; m < 4; ++m) _Pragma("unroll") for (int k = 0; k < 2; ++k) dst[m][k] = *(const LAS bf16x8*)(lds + PG8_SA(b, h) + aoff + m * 2048 + k * 1024); } while (0)
#define PG8_LDB(dst, b, h) do { _Pragma("unroll") for (int n = 0; n < 2; ++n) _Pragma("unroll") for (int k = 0; k < 2; ++k) dst[n][k] = *(const LAS bf16x8*)(lds + PG8_SB(b, h) + boff + n * 2048 + k * 1024); } while (0)
#define PG8_MMA(ai, bj, At, Bt) do { __builtin_amdgcn_s_setprio(1); _Pragma("unroll") for (int m = 0; m < 4; ++m) _Pragma("unroll") for (int n = 0; n < 2; ++n) { \
        if constexpr (F8) acc[ai][bj][m][n] = __builtin_amdgcn_mfma_scale_f32_16x16x128_f8f6f4(cat8(Bt[n][0], Bt[n][1]), cat8(At[m][0], At[m][1]), acc[ai][bj][m][n], 0, 0, 0, 0, 0, 0); \
        else { _Pragma("unroll") for (int k = 0; k < 2; ++k) acc[ai][bj][m][n] = __builtin_amdgcn_mfma_f32_16x16x32_bf16(Bt[n][k], At[m][k], acc[ai][bj][m][n], 0, 0, 0); } } __builtin_amdgcn_s_setprio(0); } while (0)
#define PG8_WAIT_V(n) asm volatile("s_waitcnt vmcnt(" #n ")" ::: "memory")
#define PG8_WAIT_L(n) asm volatile("s_waitcnt lgkmcnt(" #n ")" ::: "memory")
#ifndef SEAM_RELAX
#define SEAM_RELAX 1
#endif
#define PG8_WAIT_VS() do { const int _rl = __builtin_amdgcn_readfirstlane((t == 0 && ui > 0) ? 1 : 0); if constexpr (SEAM_RELAX && Epi::NSTORE == 8) asm volatile("s_waitcnt vmcnt(16)\n\ts_cmp_lg_u32 %0, 0\n\ts_cbranch_scc1 .Lrelax%=\n\ts_waitcnt vmcnt(8)\n.Lrelax%=:" :: "s"(_rl) : "memory", "scc"); \
        else if constexpr (SEAM_RELAX && Epi::NSTORE == 16) asm volatile("s_waitcnt vmcnt(24)\n\ts_cmp_lg_u32 %0, 0\n\ts_cbranch_scc1 .Lrelax%=\n\ts_waitcnt vmcnt(8)\n.Lrelax%=:" :: "s"(_rl) : "memory", "scc"); else PG8_WAIT_V(8); } while (0)
#define PG8_BAR __builtin_amdgcn_s_barrier()
#define PG8_SCHED __builtin_amdgcn_sched_barrier(0)
#define PG8_GTAB_DMA(un, slot) do { if (wid < 4) { __builtin_amdgcn_global_load_lds(S.a_table(un) + wid * 64 + lane, (LAS unsigned*)(gtab + (slot) * 256 + wid * 64), 4, 0, 0); \
            __builtin_amdgcn_global_load_lds((const unsigned*)S.gate_table(un) + wid * 64 + lane, (LAS unsigned*)(gtab + 512 + (slot) * 512 + 256 + wid * 64), 4, 0, 0); } \
        else __builtin_amdgcn_global_load_lds((const unsigned*)S.rs_table(un) + (wid - 4) * 64 + lane, (LAS unsigned*)(gtab + 512 + (slot) * 512 + (wid - 4) * 64), 4, 0, 0); } while (0)
#define PG8_GTAB_READ(dst, slot) do { _Pragma("unroll") for (int _i = 0; _i < 2; ++_i) { int _R, _C; stage_rc(tid * 16 + _i * 8192, _R, _C); _Pragma("unroll") for (int _h = 0; _h < 2; ++_h) dst[_h][_i] = gtab[(slot) * 256 + _h * HALF + _R] + (unsigned)_C * 2u; } } while (0)
    Unit cur, nxt; int ui = 0;
    if (!S.next(0, cur)) return;
    f32x4 acc[2][2][4][2];
#pragma unroll
    for (int a = 0; a < 2; ++a)
#pragma unroll
        for (int b = 0; b < 2; ++b)
#pragma unroll
            for (int m = 0; m < 4; ++m)
#pragma unroll
                for (int n = 0; n < 2; ++n) acc[a][b][m][n] = (f32x4){0.f, 0.f, 0.f, 0.f};
    bf16x8 At[4][2], B0[2][2], B1[2][2];
    unsigned ga[2][2];
    if (cur.nt) nt = cur.nt;
    const char* cA = (const char*)g.A + (GATHER ? (size_t)0 : (size_t)cur.pm * tstep + cur.k0b); const char* cB = (const char*)g.Bt + ((size_t)cur.e * g.bstride_e) * 2 + (size_t)cur.pn * tstep + cur.k0b;
    if constexpr (GATHER) { PG8_GTAB_DMA(cur, 0); PG8_WAIT_V(0); PG8_BAR; PG8_GTAB_READ(ga, 0); }
    if constexpr (SP2) {
        PG8_STAGE(PG8_SB(0, 0), cB, voffB); PG8_STAGE(PG8_SB(0, 1), cB + hstep, voffB); PG8_STAGE_A(PG8_SA(0, 0), cA, 0, 0); PG8_STAGE_A(PG8_SA(0, 1), cA, 0, 1);
        if (wr == 1) PG8_BAR;
        PG8_WAIT_V(2); PG8_BAR;
        PG8_STAGE(PG8_SB(1, 0), cB + kstep, voffB); PG8_STAGE_A(PG8_SA(1, 0), cA, kstep, 0); PG8_STAGE(PG8_SB(1, 1), cB + hstep + kstep, voffB);
        PG8_WAIT_V(6); PG8_BAR;
    } else {
        PG8_STAGE(PG8_SB(0, 0), cB, voffB); PG8_STAGE_A(PG8_SA(0, 0), cA, 0, 0); PG8_STAGE(PG8_SB(0, 1), cB + hstep, voffB); PG8_STAGE_A(PG8_SA(0, 1), cA, 0, 1);
        if (wr == 1) PG8_BAR;
        PG8_WAIT_V(4); PG8_BAR;
        PG8_STAGE(PG8_SB(1, 0), cB + kstep, voffB); PG8_STAGE_A(PG8_SA(1, 0), cA, kstep, 0); PG8_STAGE(PG8_SB(1, 1), cB + hstep + kstep, voffB);
        PG8_WAIT_V(6); PG8_BAR;
    }
    for (;;) {
        const bool has_next = S.next(ui + 1, nxt);
        const char* nA = (has_next && !GATHER) ? (const char*)g.A + (size_t)nxt.pm * tstep + nxt.k0b : cA;
        const char* nB = has_next ? (const char*)g.Bt + ((size_t)nxt.e * g.bstride_e) * 2 + (size_t)nxt.pn * tstep + nxt.k0b : cB;
        for (int t = 0; t < nt; t += 2) {
            const bool last = (t == nt - 2);
            const size_t k1 = (size_t)(t + 1) * kstep;
            const char* a2 = last ? nA : cA; const size_t k2 = last ? 0 : (size_t)(t + 2) * kstep;
            const char* b2 = last ? nB : cB + (size_t)(t + 2) * kstep; const char* b3 = b2 + kstep;
            const size_t k3 = k2 + kstep;
            if constexpr (GATHER) {
                if (t == nt - 4 && has_next) PG8_GTAB_DMA(nxt, (ui + 1) & 1);
            }
            if constexpr (SP2) {
            PG8_LDB(B0, 0, 0); PG8_LDB(B1, 0, 1); PG8_SCHED; PG8_LDA(At, 0, 0); PG8_STAGE_A(PG8_SA(1, 1), cA, k1, 1);
            if constexpr (GATHER) { if (last && has_next) PG8_GTAB_READ(ga, (ui + 1) & 1); }
            PG8_WAIT_VS(); PG8_WAIT_L(0); PG8_BAR; PG8_MMA(0, 0, At, B0); PG8_MMA(0, 1, At, B1); PG8_BAR; PG8_SCHED;
            PG8_LDA(At, 0, 1); PG8_STAGE(PG8_SB(0, 0), b2, voffB); PG8_STAGE(PG8_SB(0, 1), b2 + hstep, voffB); PG8_STAGE_A(PG8_SA(0, 0), a2, k2, 0);
            PG8_WAIT_VS(); PG8_WAIT_L(0); PG8_BAR; PG8_MMA(1, 0, At, B0); PG8_MMA(1, 1, At, B1); PG8_BAR; PG8_SCHED;
            PG8_LDB(B0, 1, 0); PG8_LDB(B1, 1, 1); PG8_SCHED; PG8_LDA(At, 1, 0); PG8_STAGE_A(PG8_SA(0, 1), a2, k2, 1);
            PG8_WAIT_V(8); PG8_WAIT_L(0); PG8_BAR; PG8_MMA(0, 0, At, B0); PG8_MMA(0, 1, At, B1); PG8_BAR; PG8_SCHED;
            PG8_LDA(At, 1, 1); PG8_STAGE(PG8_SB(1, 0), b3, voffB); PG8_STAGE(PG8_SB(1, 1), b3 + hstep, voffB); PG8_STAGE_A(PG8_SA(1, 0), a2, k3, 0);
            PG8_WAIT_V(8); PG8_WAIT_L(0); PG8_BAR; PG8_MMA(1, 0, At, B0); PG8_MMA(1, 1, At, B1); PG8_BAR; PG8_SCHED;
            } else {
            PG8_LDB(B0, 0, 0); PG8_SCHED; PG8_LDA(At, 0, 0); PG8_STAGE_A(PG8_SA(1, 1), cA, k1, 1);
            PG8_WAIT_L(8); PG8_BAR; PG8_WAIT_L(0); PG8_MMA(0, 0, At, B0); PG8_BAR; PG8_SCHED;
            PG8_LDB(B1, 0, 1); PG8_STAGE(PG8_SB(0, 0), b2, voffB);
            PG8_BAR; PG8_WAIT_L(0); PG8_MMA(0, 1, At, B1); PG8_BAR;
            PG8_LDA(At, 0, 1); PG8_STAGE_A(PG8_SA(0, 0), a2, k2, 0);
            PG8_BAR; PG8_WAIT_L(0); PG8_MMA(1, 0, At, B0); PG8_BAR; PG8_SCHED;
            PG8_STAGE(PG8_SB(0, 1), b2 + hstep, voffB);
            PG8_WAIT_V(6); PG8_BAR; PG8_MMA(1, 1, At, B1); PG8_BAR;
            PG8_LDB(B0, 1, 0); PG8_SCHED; PG8_LDA(At, 1, 0); PG8_STAGE_A(PG8_SA(0, 1), a2, k2, 1);
            PG8_WAIT_L(8); PG8_BAR; PG8_WAIT_L(0); PG8_MMA(0, 0, At, B0); PG8_BAR; PG8_SCHED;
            PG8_LDB(B1, 1, 1); PG8_STAGE(PG8_SB(1, 0), b3, voffB);
            PG8_BAR; PG8_WAIT_L(0); PG8_MMA(0, 1, At, B1); PG8_BAR;
            PG8_LDA(At, 1, 1); PG8_STAGE_A(PG8_SA(1, 0), a2, k3, 0);
            PG8_BAR; PG8_WAIT_L(0); PG8_MMA(1, 0, At, B0); PG8_BAR; PG8_SCHED;
            PG8_STAGE(PG8_SB(1, 1), b3 + hstep, voffB);
            PG8_WAIT_V(6); PG8_BAR; PG8_MMA(1, 1, At, B1); PG8_BAR;
            }
        }
        if constexpr (ALIGN_EPI) { if (wr == 0) PG8_BAR; }
        cur.ui = ui;
        if constexpr (!Epi::AFTER_DRAIN) { E(acc, cur, wr, wc, fr, fq); }
        if (!has_next) break;
#pragma unroll
        for (int a = 0; a < 2; ++a)
#pragma unroll
            for (int b = 0; b < 2; ++b)
#pragma unroll
                for (int m = 0; m < 4; ++m)
#pragma unroll
                    for (int n = 0; n < 2; ++n) acc[a][b][m][n] = (f32x4){0.f, 0.f, 0.f, 0.f};
        cur = nxt; cA = nA; cB = nB; ++ui; nt = cur.nt ? cur.nt : K / BK;
        if constexpr (ALIGN_EPI) { if (wr == 1) PG8_BAR; }
    }
    PG8_WAIT_V(0);
    if constexpr (!ALIGN_EPI) { if (wr == 0) PG8_BAR; }
    PG8_BAR;
    if constexpr (Epi::AFTER_DRAIN) { E.fused(acc, cur, wr, wc, fr, fq, lds, wid, lane); }
#undef PG8_SA
#undef PG8_SB
#undef PG8_STAGE
#undef PG8_STAGE_A
#undef PG8_LDA
#undef PG8_LDB
#undef PG8_MMA
#undef PG8_WAIT_V
#undef PG8_WAIT_VS
#undef PG8_WAIT_L
#undef PG8_BAR
#undef PG8_SCHED
#undef PG8_GTAB_DMA
#undef PG8_GTAB_READ
}
}
constexpr size_t MiB = 1u << 20;
constexpr size_t WS_CTL = 0, CTL_ZERO_BYTES = 256 * 1024;
constexpr size_t WS_ROWOFF = 1 * MiB;
constexpr size_t WS_RS = WS_ROWOFF + 512 * 1024;
constexpr size_t WS_GATE = WS_RS + 512 * 1024;
constexpr size_t WS_SEL = WS_GATE + 512 * 1024;
constexpr size_t WS_SSQ = WS_SEL + 256 * 1024;
constexpr size_t WS_SMALLW = 4 * MiB;
constexpr size_t WS_PWT = WS_SMALLW;
constexpr size_t WS_POOLWT = WS_PWT + 2 * 384 * 384 * 2;
constexpr size_t WS_GMWS = WS_POOLWT + 2 * 4 * 64 * 64 * 2;
constexpr size_t WS_XB = 6 * MiB;
constexpr size_t WS_SLAB = 162 * MiB;
constexpr size_t WS_XB2 = WS_XB;
constexpr size_t WS_MOE_WD = 38 * MiB;
constexpr size_t WS_MOE_WGU = 94 * MiB;
constexpr size_t WS_XQ = 150 * MiB;
constexpr size_t WS_YP = 94 * MiB;
constexpr size_t WS_ACTM = 206 * MiB;
constexpr size_t WS_P = 206 * MiB;
constexpr size_t WS_Y = 262 * MiB;
constexpr size_t WS_ACT = 206 * MiB;
constexpr size_t WS_WIN = 294 * MiB;
constexpr size_t WS_WOUT = 301 * MiB;
constexpr size_t WS_WGU = 305 * MiB;
constexpr size_t WS_WD = 316 * MiB;
constexpr size_t WS_END = 444 * MiB;
static_assert(WS_SSQ + 4 * (size_t)M * 4 <= WS_SMALLW && WS_GMWS + 2 * 4 * 128 * 128 * 2 <= WS_XB && WS_XB + (size_t)M * D * 2 <= WS_MOE_WD, "ws map 1");
static_assert(WS_MOE_WGU + (size_t)NE * NGUE * D <= WS_XQ && WS_XQ + (size_t)M * D <= WS_ACTM, "fp8 MoE gate|up weights, XQ");
static_assert(WS_SLAB >= WS_YP + (size_t)PMAX * D * 2 && WS_SLAB + 256 * (size_t)65536 * 2 <= WS_ACTM, "slabs");
static_assert(WS_MOE_WD + (size_t)NE * D * DFE * 2 <= WS_MOE_WGU && WS_MOE_WGU + (size_t)NE * NGUE * D * 2 <= WS_ACTM && WS_YP + (size_t)PMAX * D * 2 <= WS_ACTM, "ws map 2");
static_assert(WS_ACTM + (size_t)PMAX * DFE * 2 <= WS_END && WS_P + (size_t)M * DIN * 2 <= WS_Y && WS_Y + (size_t)M * D * 2 <= WS_WIN && WS_ACT + (size_t)M * DFF * 2 <= WS_WIN, "ws map 3");
static_assert(WS_WIN + 2 * (size_t)DIN * D * 2 <= WS_WOUT && WS_WOUT + 2 * (size_t)D * D * 2 <= WS_WGU && WS_WGU + (size_t)NGU * D * 2 <= WS_WD && WS_WD + (size_t)D * DFF * 2 <= WS_END, "ws map 4");
constexpr int CW_BAR = 4096;
constexpr int CW_CNT = 49152;
constexpr int CW_CVT = 140000;
constexpr int NPHASE = 13;
static_assert(CW_BAR + NPHASE * 3456 <= CW_CNT && (size_t)(CW_CNT + 8 * 64) * 4 <= CTL_ZERO_BYTES, "control words inside the per-call memset");
constexpr int RING_BYTES = 131072;
constexpr int GTAB_OFF = RING_BYTES;
constexpr int MISC_OFF = GTAB_OFF + 8192;
constexpr int INTAB_OFF = MISC_OFF + 256;
constexpr int JOBS_OFF = INTAB_OFF + 256;
constexpr int LDS_BYTES = 147456;
static_assert(JOBS_OFF + 7 * 12 * 32 <= LDS_BYTES, "LDS map (jobs)");
static_assert(MISC_OFF + 256 <= LDS_BYTES, "LDS map");

typedef GAS unsigned gu32;
#define RLX_AGENT __ATOMIC_RELAXED, __HIP_MEMORY_SCOPE_AGENT
#define LDS_WAIT() asm volatile("s_waitcnt lgkmcnt(0)" ::: "memory")
#define VM_WAIT() asm volatile("s_waitcnt vmcnt(0)" ::: "memory")

#define XB_TMO      128
#define XB_XCNT(j)  (256  + 64 * (j))
#define XB_XSUB(j)  (1280 + 64 * (j))
#define XB_XGEN(j)  (2304 + 64 * (j))
#define XB_TOP      3328
#define XB_TOPGEN   3392
#define XCD_BAR_WORDS 3456
#define XB_SPIN_CAP (1u << 18)
__device__ __forceinline__ unsigned xb_ld(unsigned* p)              { return __hip_atomic_load(p, __ATOMIC_RELAXED, __HIP_MEMORY_SCOPE_AGENT); }
__device__ __forceinline__ unsigned xb_add(unsigned* p, unsigned v) { return __hip_atomic_fetch_add(p, v, __ATOMIC_RELAXED, __HIP_MEMORY_SCOPE_AGENT); }
__device__ __forceinline__ unsigned xb_xcc_id() { return (unsigned)__builtin_amdgcn_s_getreg((3 << 11) | 20) & 0xFu; }
#define XB_SPIN(cond, bar) do { unsigned _sp = 0; while (cond) { __builtin_amdgcn_s_sleep(1); \
    if ((++_sp & 255u) == 0u) { if (xb_ld(&(bar)[XB_TMO])) break; if (_sp > XB_SPIN_CAP) { atomicAdd(&(bar)[XB_TMO], 1u); break; } } } } while (0)
struct XcdBarrier { unsigned* bar; unsigned x; volatile LAS unsigned* st; };
__device__ __forceinline__ XcdBarrier xcd_barrier_post(unsigned* bar, volatile LAS unsigned* st) {
    XcdBarrier b; b.bar = bar; b.x = xb_xcc_id(); b.st = st;
    if (threadIdx.x == 0) (void)xb_add(&bar[XB_XCNT(b.x)], 1u);
    return b;
}
__device__ __forceinline__ void xcd_barrier_complete(unsigned* bar, unsigned x, unsigned& nloc, unsigned& nx) {
    const unsigned G = gridDim.x * gridDim.y * gridDim.z;
    unsigned sum, cnt, mine, sp = 0u;
    for (;;) {
        sum = 0u; cnt = 0u; mine = 0u;
#pragma unroll
        for (unsigned j = 0; j < 16; ++j) { const unsigned c = xb_ld(&bar[XB_XCNT(j)]); sum += c; cnt += (c > 0u) ? 1u : 0u; mine = (j == x) ? c : mine; }
        if (sum == G) break;
        __builtin_amdgcn_s_sleep(1);
        if ((++sp & 255u) == 0u) { if (xb_ld(&bar[XB_TMO])) break; if (sp > XB_SPIN_CAP) { atomicAdd(&bar[XB_TMO], 1u); break; } }
    }
    nloc = mine > 0u ? mine : 1u; nx = cnt > 0u ? cnt : 1u;
}
__device__ __forceinline__ void xcd_barrier(const XcdBarrier& b) {
    asm volatile("s_waitcnt vmcnt(0)" ::: "memory");
    __syncthreads();
    if (threadIdx.x == 0) {
        unsigned* bar = b.bar;
        __builtin_amdgcn_s_waitcnt(0);
        unsigned nloc = b.st[0], nx = b.st[1];
        if (nloc == 0u) { xcd_barrier_complete(bar, b.x, nloc, nx); b.st[0] = nloc; b.st[1] = nx; }
        const unsigned old = xb_add(&bar[XB_XSUB(b.x)], 1u);
        const unsigned gen = old / nloc;
        if (old + 1u == (gen + 1u) * nloc) {
            __builtin_amdgcn_fence(__ATOMIC_RELEASE, "agent");
            asm volatile("s_waitcnt vmcnt(0)" ::: "memory");
            const unsigned og = xb_add(&bar[XB_TOP], 1u);
            const unsigned tg = og / nx;
            if (og + 1u == (tg + 1u) * nx) xb_add(&bar[XB_TOPGEN], 1u);
            else XB_SPIN(xb_ld(&bar[XB_TOPGEN]) == tg, bar);
            __builtin_amdgcn_fence(__ATOMIC_ACQUIRE, "agent");
            xb_add(&bar[XB_XGEN(b.x)], 1u);
            asm volatile("s_waitcnt vmcnt(0)" ::: "memory");
        } else {
            XB_SPIN(xb_ld(&bar[XB_XGEN(b.x)]) == gen, bar);
            __builtin_amdgcn_fence(__ATOMIC_ACQUIRE, "agent");
            asm volatile("s_waitcnt vmcnt(0)" ::: "memory");
        }
    }
    __syncthreads();
}

struct InTab { const LAS unsigned long long* t;
    __device__ __forceinline__ const float* operator[](int k) const { const unsigned long long v = t[k]; const unsigned lo = __builtin_amdgcn_readfirstlane((unsigned)v), hi = __builtin_amdgcn_readfirstlane((unsigned)(v >> 32));
        return (const float*)(((unsigned long long)hi << 32) | lo); } };
struct Frame {
    LAS unsigned char* lds; volatile LAS unsigned* MISC; unsigned* ctl;
    int tid, lane, wave, vcu, G;
    InTab in; float* out; unsigned char* ws;
};

__device__ __forceinline__ InTab in_tab(Frame& F) { return F.in; }
constexpr float W8_GU = 64.0f;
struct TrJob { const float* src; bf16* dst; const float* gk; int K, N, f8; };
__device__ __forceinline__ TrJob tr_mat(const float* W, int K, int N, bf16* WT, int mode, const float* gk, int r, int f8 = 0) {
    const int nblk = N / 32, kb = r / nblk, nb = r % nblk, n0 = 32 * nb, k0 = 64 * kb;
    const int drow = mode == 0 ? n0 : ((n0 >> 7) * 256 + (n0 & 127) + (mode == 2 ? 128 : 0));
    TrJob j; j.src = W + (size_t)k0 * N + n0; j.dst = f8 ? (bf16*)((unsigned char*)WT + (size_t)drow * K + k0) : WT + (size_t)drow * K + k0; j.gk = gk ? gk + k0 : nullptr; j.K = K; j.N = N; j.f8 = f8; return j;
}
constexpr int TR_I_IN = (D / 64) * (DIN / 32), TR_I_OUT = (D / 64) * (D / 32), TR_I_G = (D / 64) * (DFF / 32), TR_I_D = (DFF / 64) * (D / 32), TR_I_MG = (D / 64) * (DFE / 32), TR_I_MD = (DFE / 64) * (D / 32), TR_I_PW = (DCV / 64) * (DCV / 32), TR_I_PL = 2;
constexpr int TR_E_END = TR_I_IN + 2 * TR_I_PW + 8 * TR_I_PL;
constexpr int TR_A_END = TR_E_END + TR_I_OUT + 2 * TR_I_G + TR_I_D;
constexpr int TR_B_END = TR_A_END + TR_I_IN + TR_I_OUT;
constexpr int TR_C_END = TR_B_END + 2 * NE * TR_I_MG;
constexpr int TR_D_END = TR_C_END + NE * TR_I_MD;
__device__ __forceinline__ TrJob tr_decode(const InTab in, unsigned char* ws, int r) {
    if (r < TR_I_IN) return tr_mat(in[2], D, DIN, (bf16*)(ws + WS_WIN), 0, in[1], r); r -= TR_I_IN;
    if (r < 2 * TR_I_PW) { const int l = r / TR_I_PW; return tr_mat(in[12] + (size_t)l * DCV * DCV, DCV, DCV, (bf16*)(ws + WS_PWT) + (size_t)l * DCV * DCV, 0, nullptr, r % TR_I_PW); } r -= 2 * TR_I_PW;
    if (r < 8 * TR_I_PL) { const int gi = r / TR_I_PL; return tr_mat(in[3] + (size_t)gi * 64 * 64, 64, 64, (bf16*)(ws + WS_POOLWT) + (size_t)gi * 64 * 64, 0, nullptr, r % TR_I_PL); } r -= 8 * TR_I_PL;
    if (r < TR_I_OUT) return tr_mat(in[14], D, D, (bf16*)(ws + WS_WOUT), 0, nullptr, r); r -= TR_I_OUT;
    if (r < TR_I_G) return tr_mat(in[16], D, DFF, (bf16*)(ws + WS_WGU), 1, in[15], r); r -= TR_I_G;
    if (r < TR_I_G) return tr_mat(in[17], D, DFF, (bf16*)(ws + WS_WGU), 2, in[15], r); r -= TR_I_G;
    if (r < TR_I_D) return tr_mat(in[18], DFF, D, (bf16*)(ws + WS_WD), 0, nullptr, r); r -= TR_I_D;
    if (r < TR_I_IN) return tr_mat(in[2] + (size_t)D * DIN, D, DIN, (bf16*)(ws + WS_WIN) + (size_t)DIN * D, 0, in[1] + D, r); r -= TR_I_IN;
    if (r < TR_I_OUT) return tr_mat(in[14] + (size_t)D * D, D, D, (bf16*)(ws + WS_WOUT) + (size_t)D * D, 0, nullptr, r); r -= TR_I_OUT;
    if (r < 2 * NE * TR_I_MG) { const int e = r / (2 * TR_I_MG), q = r % (2 * TR_I_MG), up = q / TR_I_MG;
        return tr_mat(in[20 + up] + (size_t)e * D * DFE, D, DFE, (bf16*)(ws + WS_MOE_WGU + (size_t)e * NGUE * D), 1 + up, in[15] + D, q % TR_I_MG, 1); } r -= 2 * NE * TR_I_MG;
    { const int e = r / TR_I_MD; return tr_mat(in[22] + (size_t)e * DFE * D, DFE, D, (bf16*)(ws + WS_MOE_WD) + (size_t)e * D * DFE, 0, nullptr, r % TR_I_MD); }
}
__device__ __forceinline__ void tr_load(const TrJob& j, f32x4 (&v)[8], int lane, int probe) {
    const int n4 = (lane & 7) * 4, k8 = (lane >> 3) * 8;
    if (probe == 2) {
#pragma unroll
        for (int i = 0; i < 8; ++i) v[i] = (f32x4){1.f, 2.f, 3.f, 4.f};
        return; }
#pragma unroll
    for (int i = 0; i < 8; ++i) v[i] = __builtin_nontemporal_load((const f32x4*)(j.src + (size_t)(k8 + i) * j.N + n4));
    if (j.gk) { f32x4 g0 = *(const f32x4*)(j.gk + k8), g1 = *(const f32x4*)(j.gk + k8 + 4); if (j.f8) { g0 = g0 * W8_GU; g1 = g1 * W8_GU; }
        v[0] = v[0] * g0[0]; v[1] = v[1] * g0[1]; v[2] = v[2] * g0[2]; v[3] = v[3] * g0[3]; v[4] = v[4] * g1[0]; v[5] = v[5] * g1[1]; v[6] = v[6] * g1[2]; v[7] = v[7] * g1[3]; }
}
__device__ __forceinline__ void tr_store(const TrJob& j, const f32x4 (&v)[8], LAS float* scr, int lane, int probe) {
    (void)scr; const int n4 = (lane & 7) * 4, k8 = (lane >> 3) * 8;
    if (j.f8) {
#pragma unroll
        for (int q = 0; q < 4; ++q) { u32x2 o; o.x = cvt4_fp8(v[0][q], v[1][q], v[2][q], v[3][q]); o.y = cvt4_fp8(v[4][q], v[5][q], v[6][q], v[7][q]);
            *(GAS u32x2*)((GAS unsigned char*)j.dst + (size_t)(n4 + q) * j.K + k8) = o; }
        return; }
#pragma unroll
    for (int q = 0; q < 4; ++q) { u32x4 o; o.x = cvt_pk_bf16(v[0][q], v[1][q]); o.y = cvt_pk_bf16(v[2][q], v[3][q]); o.z = cvt_pk_bf16(v[4][q], v[5][q]); o.w = cvt_pk_bf16(v[6][q], v[7][q]);
        if (probe == 1 || probe == 2) { asm volatile("" :: "v"(o.x), "v"(o.y), "v"(o.z), "v"(o.w)); } else if (WT_MASK & 1) st16_wt_u(j.dst, (unsigned)(((n4 + q) * j.K + k8) * 2), o); else *(GAS u32x4*)(j.dst + (size_t)(n4 + q) * j.K + k8) = o; }
}
__device__ __forceinline__ void tr_run(Frame& F, int first, int count, int widx, int nw, int probe) {
    LAS float* scr = (LAS float*)(F.lds + F.wave * 16384); int lane = F.lane; asm volatile("" : "+v"(lane)); const InTab in = in_tab(F); unsigned char* ws = F.ws;
    const int end = first + count; f32x4 v[4][8]; TrJob j[4];
#pragma unroll
    for (int k = 0; k < 4; ++k) { const int it = first + widx + k * nw; if (it < end) { j[k] = tr_decode(in, ws, it); tr_load(j[k], v[k], lane, probe); } }
    for (int it = first + widx; it < end; it += 4 * nw) {
#pragma unroll
        for (int k = 0; k < 4; ++k) { const int ik = it + k * nw, nx = ik + 4 * nw;
            if (ik < end) tr_store(j[k], v[k], scr, lane, probe);
            if (nx < end) { j[k] = tr_decode(in, ws, nx); tr_load(j[k], v[k], lane, probe); } } }
}
#ifndef H10_SHARE
#define H10_SHARE 8192
#endif
#ifndef HID_PW
#define HID_PW 2
#endif
constexpr int HID_PER_WAVE = HID_PW, H1_N = 64 * 8 * HID_PER_WAVE, H4_N = 128 * 8 * HID_PER_WAVE, H6_N = 64 * 8 * HID_PER_WAVE, H10_N = H10_SHARE;
constexpr int H10_BEG = TR_D_END - H10_N;
#ifndef MIX_CVT
#define MIX_CVT 0
#endif
#ifndef R9_CVT
#define R9_CVT 0
#endif
#ifndef SB_CVT
#define SB_CVT 2
#endif
constexpr int MX_N = (M / 64) * 8 * MIX_CVT, R9_N = (M / 64) * 8 * R9_CVT, SB_N = 7 * 256 * SB_CVT;
constexpr int H1_BEG = TR_E_END, S0_BEG = H1_BEG + H1_N, S1_BEG = S0_BEG + SB_N, S2_BEG = S1_BEG + SB_N, S3_BEG = S2_BEG + SB_N, H4_BEG = S3_BEG + SB_N, S4_BEG = H4_BEG + H4_N, S5_BEG = S4_BEG + SB_N,
              H6_BEG = S5_BEG + SB_N, MX0_BEG = H6_BEG + H6_N, MX1_BEG = MX0_BEG + MX_N, R9_BEG = MX1_BEG + MX_N, PRO_BEG = R9_BEG + R9_N;
static_assert(PRO_BEG <= H10_BEG, "hidden conversion shares exceed the weight tiles");
static_assert(H1_BEG + TR_I_OUT <= S0_BEG, "w_out of layer 0 (phase 3): inside H1");
static_assert(TR_A_END - TR_I_D <= S1_BEG, "dense gate|up weights (phase 4): visible by phase 3 at the latest, i.e. inside H1 | S0");
static_assert(TR_A_END <= S2_BEG, "dense down weights (phase 5): inside H1 | S0 | S1");
static_assert(TR_A_END + TR_I_IN <= S3_BEG && TR_B_END <= S5_BEG, "layer-1 projections (phases 6, 8)");
static_assert(TR_C_END <= H10_BEG && MIX_CVT == 0 && R9_CVT == 0, "MoE gate|up weights before phase 10 (H6 is visible from phase 7); no hosting in mixers / router in this layout");
__device__ __forceinline__ void tail_convert(Frame& F, int first, int count, int rank, int nwg_idle) {
    if (rank >= 0 && rank < nwg_idle) tr_run(F, first, count, rank * 8 + F.wave, nwg_idle * 8, 0);
}

struct JobRec { unsigned long long src, dst, gk; int K, N; };
__device__ __forceinline__ TrJob job_read(const LAS JobRec* r) {
    const u32x4 a = *(const LAS u32x4*)r, c = *((const LAS u32x4*)r + 1); TrJob j;
    const unsigned s0 = __builtin_amdgcn_readfirstlane(a.x), s1 = __builtin_amdgcn_readfirstlane(a.y), d0 = __builtin_amdgcn_readfirstlane(a.z), d1 = __builtin_amdgcn_readfirstlane(a.w);
    const unsigned g0 = __builtin_amdgcn_readfirstlane(c.x), g1 = __builtin_amdgcn_readfirstlane(c.y);
    j.src = (const float*)(((unsigned long long)s1 << 32) | s0); j.dst = (bf16*)(((unsigned long long)d1 << 32) | d0); j.gk = (const float*)(((unsigned long long)g1 << 32) | g0);
    j.K = __builtin_amdgcn_readfirstlane(c.z); const int nf = __builtin_amdgcn_readfirstlane(c.w); j.N = nf & 0xFFFFF; j.f8 = nf >> 30; return j;
}
__device__ __forceinline__ void jobs_setup(Frame& F) {
    if (SB_CVT == 0 || F.wave == 0) return;
    const InTab in = in_tab(F); unsigned char* ws = F.ws; LAS JobRec* tab = (LAS JobRec*)(F.lds + JOBS_OFF) + (F.wave - 1) * 12;
#pragma unroll 1
    for (int q = 0; q < 6 * SB_CVT; ++q) { const int sI = q / SB_CVT, k = q - sI * SB_CVT; const int beg = sI < 4 ? S0_BEG + sI * SB_N : S4_BEG + (sI - 4) * SB_N;
        const TrJob j = tr_decode(in, ws, beg + (int)blockIdx.x * 7 + F.wave - 1 + k * 7 * 256);
        if (F.lane == 0) { const unsigned long long s = (unsigned long long)j.src, d = (unsigned long long)j.dst, g = (unsigned long long)j.gk; LAS u32x4* o = (LAS u32x4*)(tab + sI * 2 + k);
            u32x4 a, c; a.x = (unsigned)s; a.y = (unsigned)(s >> 32); a.z = (unsigned)d; a.w = (unsigned)(d >> 32); c.x = (unsigned)g; c.y = (unsigned)(g >> 32); c.z = (unsigned)j.K; c.w = (unsigned)j.N | ((unsigned)j.f8 << 30); o[0] = a; o[1] = c; } }
}
__device__ __forceinline__ void xcd_barrier_host(const XcdBarrier& b, Frame& F, int slot) {
    if (slot < 0 || SB_CVT == 0) { xcd_barrier(b); return; }
    asm volatile("s_waitcnt vmcnt(0)" ::: "memory");
    __syncthreads();
    int lane = F.lane; asm volatile("" : "+v"(lane));
    f32x4 va[8], vb[8]; TrJob ja, jb; const bool host = F.wave > 0; const LAS JobRec* jr = (const LAS JobRec*)(F.lds + JOBS_OFF) + (F.wave - 1) * 12 + slot * 2;
    if (host) { ja = job_read(jr); tr_load(ja, va, lane, 0); if (SB_CVT >= 2) { jb = job_read(jr + 1); tr_load(jb, vb, lane, 0); } }
    if (threadIdx.x == 0) {
        unsigned* bar = b.bar;
        __builtin_amdgcn_s_waitcnt(0);
        unsigned nloc = b.st[0], nx = b.st[1];
        if (nloc == 0u) { xcd_barrier_complete(bar, b.x, nloc, nx); b.st[0] = nloc; b.st[1] = nx; }
        const unsigned old = xb_add(&bar[XB_XSUB(b.x)], 1u);
        const unsigned gen = old / nloc;
        if (old + 1u == (gen + 1u) * nloc) {
            __builtin_amdgcn_fence(__ATOMIC_RELEASE, "agent");
            asm volatile("s_waitcnt vmcnt(0)" ::: "memory");
            const unsigned og = xb_add(&bar[XB_TOP], 1u);
            const unsigned tg = og / nx;
            if (og + 1u == (tg + 1u) * nx) xb_add(&bar[XB_TOPGEN], 1u);
            else XB_SPIN(xb_ld(&bar[XB_TOPGEN]) == tg, bar);
            __builtin_amdgcn_fence(__ATOMIC_ACQUIRE, "agent");
            xb_add(&bar[XB_XGEN(b.x)], 1u);
            asm volatile("s_waitcnt vmcnt(0)" ::: "memory");
        } else {
            XB_SPIN(xb_ld(&bar[XB_XGEN(b.x)]) == gen, bar);
            __builtin_amdgcn_fence(__ATOMIC_ACQUIRE, "agent");
            asm volatile("s_waitcnt vmcnt(0)" ::: "memory");
        }
    }
    __syncthreads();
    if (host) { tr_store(ja, va, nullptr, lane, 0); if (SB_CVT >= 2) tr_store(jb, vb, nullptr, lane, 0); }
}
__device__ __forceinline__ void p0_prologue(Frame& F, int probe) {
    LAS float* scr = (LAS float*)(F.lds + F.wave * 16384);
    int lane = F.lane; asm volatile("" : "+v"(lane));
    const int gw = F.vcu * 8 + F.wave, NGW = F.G * 8;
    const InTab in = in_tab(F); unsigned char* ws = F.ws;
    tr_run(F, 0, TR_E_END, gw, NGW, probe);
    tr_run(F, PRO_BEG, H10_BEG - PRO_BEG, gw, NGW, probe);
    { const float* src = in[6]; bf16* dst = (bf16*)(ws + WS_GMWS);
      for (int i = gw * 64 + lane; i < 2 * 4 * 128 * 128 / 8; i += NGW * 64) { const f32x4 a = *(const f32x4*)(src + (size_t)i * 8), b = *(const f32x4*)(src + (size_t)i * 8 + 4);
          u32x4 o; o.x = cvt_pk_bf16(a[0], a[1]); o.y = cvt_pk_bf16(a[2], a[3]); o.z = cvt_pk_bf16(b[0], b[1]); o.w = cvt_pk_bf16(b[2], b[3]); *(u32x4*)(dst + (size_t)i * 8) = o; } }
    { u32x4* t = (u32x4*)(ws + WS_ROWOFF); for (int i = gw * 64 + lane; i < NE * ECAP / 4; i += NGW * 64) t[i] = (u32x4){0u, 0u, 0u, 0u}; }
    { const float* x = in[0]; bf16* XB = (bf16*)(ws + WS_XB); float* ssq = (float*)(ws + WS_SSQ);
      for (int m = gw; m < M; m += NGW) { const f32x4* xr = (const f32x4*)(x + (size_t)m * D) + lane; f32x4 v[4]; float s = 0.f;
#pragma unroll
          for (int j = 0; j < 4; ++j) { v[j] = xr[64 * j]; s += (v[j][0] * v[j][0] + v[j][1] * v[j][1]) + (v[j][2] * v[j][2] + v[j][3] * v[j][3]); }
          s = wave_sum(s);
          u32x2* o = (u32x2*)(XB + (size_t)m * D) + lane;
#pragma unroll
          for (int j = 0; j < 4; ++j) { u32x2 w; w.x = cvt_pk_bf16(v[j][0], v[j][1]); w.y = cvt_pk_bf16(v[j][2], v[j][3]); if (WT_MASK & 1) st8_wt(XB, (unsigned)((m * D + (lane + 64 * j) * 4) * 2), w); else o[64 * j] = w; }
          if (lane < 4) ssq[(size_t)lane * M + m] = lane == 0 ? s : 0.f; } }
}

__device__ __forceinline__ void unpack8(const u32x4 w, float (&f)[8]) { f[0] = bf_lo(w.x); f[1] = bf_hi(w.x); f[2] = bf_lo(w.y); f[3] = bf_hi(w.y); f[4] = bf_lo(w.z); f[5] = bf_hi(w.z); f[6] = bf_lo(w.w); f[7] = bf_hi(w.w); }
#define LDS_BARRIER() asm volatile("s_waitcnt lgkmcnt(0)\n\ts_barrier" ::: "memory")
__device__ __forceinline__ void mixer_unit(Frame& F, int u, int layer, int cvt0) {
    LAS unsigned char* lds = F.lds; int tid = F.tid; asm volatile("" : "+v"(tid)); int lane = tid & 63; const int w = F.wave;
    const InTab in = in_tab(F); unsigned char* ws = F.ws;
    const bf16* P = (const bf16*)(ws + WS_P); bf16* Y = (bf16*)(ws + WS_Y);
    const int r0 = 64 * u, s0 = r0 & (SEQ - 1), half = u & 1, blk0 = r0 & ~127;
#ifndef CONV_REP
#define CONV_REP 0
#endif
#ifndef MIX_MASK
#define MIX_MASK 7
#endif
#ifndef MIX_REP
#define MIX_REP 0
#endif
    f32x4 cva[8], cvb[8]; TrJob cja, cjb; const int cvi = cvt0 + u * 8 + w; constexpr int CVS = (M / 64) * 8;
    for (int mrep = 0; mrep < 1 + (MIX_REP & 1); ++mrep) if (MIX_MASK & 1) { constexpr int AIN = 0, YPL = 40448, YST = 528;
      const int g = w >> 1, th = w & 1, fr = lane & 15, fq = lane >> 4;
      u32x4 st[5];
#pragma unroll
      for (int i = 0; i < 5; ++i) { const int idx = tid + 512 * i, rr = idx >> 5, ch = idx & 31, pos = s0 - 15 + rr; st[i] = (u32x4){0u, 0u, 0u, 0u};
          if (idx < 79 * 32 && pos >= 0) st[i] = *(const u32x4*)(P + (size_t)(r0 - 15 + rr) * DIN + ch * 8); }
      const bf16* wt = (const bf16*)(ws + WS_POOLWT) + (size_t)(layer * 4 + g) * 64 * 64; const float* sc = in[4] + layer * DPOOL + g * 64;
      bf16x8 Bf[2][4]; f32x4 sc4[4];
#pragma unroll
      for (int ks = 0; ks < 2; ++ks)
#pragma unroll
          for (int nt = 0; nt < 4; ++nt) Bf[ks][nt] = *(const bf16x8*)(wt + (nt * 16 + fr) * 64 + ks * 32 + 8 * fq);
#pragma unroll
      for (int nt = 0; nt < 4; ++nt) sc4[nt] = *(const f32x4*)(sc + nt * 16 + 4 * fq);
      if (MIX_CVT >= 2 && mrep == 0) { asm volatile("" ::: "memory"); cja = tr_decode(in, ws, cvi); tr_load(cja, cva, lane, 0); cjb = tr_decode(in, ws, cvi + CVS); tr_load(cjb, cvb, lane, 0); asm volatile("" ::: "memory"); }
#pragma unroll
      for (int i = 0; i < 5; ++i) { const int idx = tid + 512 * i; if (idx < 79 * 32) *(LAS u32x4*)(lds + AIN + (idx >> 5) * 512 + (idx & 31) * 16) = st[i]; }
      LDS_BARRIER();
      { const int p = tid & 127, rq = tid >> 7, gp = p >> 5, win = 2 << gp; float S0 = 0.f, S1 = 0.f;
        for (int j = 1; j < win; ++j) { const unsigned a = *(const LAS unsigned*)(lds + AIN + (16 * rq + 15 - j) * 512 + p * 4); S0 += bf_lo(a); S1 += bf_hi(a); }
#pragma unroll 4
        for (int t = 0; t < 16; ++t) { const int lt = 16 * rq + t, rr = lt + 15; const unsigned a = *(const LAS unsigned*)(lds + AIN + rr * 512 + p * 4); const float a0 = bf_lo(a), a1 = bf_hi(a);
            S0 += a0; S1 += a1; const int pos1 = s0 + lt + 1; const float rn = __builtin_amdgcn_rcpf((float)(pos1 < win ? pos1 : win));
            *(LAS unsigned*)(lds + YPL + lt * YST + p * 4) = cvt_pk_bf16(S0 * rn - a0, S1 * rn - a1);
            const unsigned o = *(const LAS unsigned*)(lds + AIN + (rr - win + 1) * 512 + p * 4); S0 -= bf_lo(o); S1 -= bf_hi(o); } }
      LDS_BARRIER();
      for (int prep = 0; prep < 1 + ((CONV_REP >> 3) & 1); ++prep) { f32x4 acc[2][4];
#pragma unroll
        for (int a = 0; a < 2; ++a)
#pragma unroll
            for (int b = 0; b < 4; ++b) acc[a][b] = (f32x4){0.f, 0.f, 0.f, 0.f};
#pragma unroll
        for (int ks = 0; ks < 2; ++ks) { bf16x8 A[2];
#pragma unroll
            for (int mt = 0; mt < 2; ++mt) A[mt] = *(const LAS bf16x8*)(lds + YPL + ((2 * th + mt) * 16 + fr) * YST + (g * 64 + ks * 32 + 8 * fq) * 2);
#pragma unroll
            for (int mt = 0; mt < 2; ++mt)
#pragma unroll
                for (int nt = 0; nt < 4; ++nt) acc[mt][nt] = __builtin_amdgcn_mfma_f32_16x16x32_bf16(Bf[ks][nt], A[mt], acc[mt][nt], 0, 0, 0); }
#pragma unroll
        for (int mt = 0; mt < 2; ++mt)
#pragma unroll
            for (int nt = 0; nt < 4; ++nt) { const int t = r0 + (2 * th + mt) * 16 + fr, d = nt * 16 + 4 * fq; const f32x4 v = acc[mt][nt] * sc4[nt];
                u32x2 o; o.x = cvt_pk_bf16(v[0], v[1]); o.y = cvt_pk_bf16(v[2], v[3]); if (WT_MASK & 1) st8_wt(Y, (unsigned)((t * D + g * 64 + d) * 2), o); else *(u32x2*)(Y + (size_t)t * D + g * 64 + d) = o; } }
      LDS_BARRIER(); }
    asm volatile("" : "+v"(tid)); lane = tid & 63;
    for (int mrep = 0; mrep < 1 + ((MIX_REP >> 1) & 1); ++mrep) if (MIX_MASK & 2) { constexpr int VN = 0, VST = 800; const int nj = half ? 128 : 64, nks = nj >> 5;
      const int h = w & 3, ih = w >> 2, fr = lane & 15, fq = lane >> 4, q4 = (lane & 15) >> 2, p4 = lane & 3;
      const bf16* wsb = (const bf16*)(ws + WS_GMWS) + (size_t)(layer * 4 + h) * 128 * 128;
      const float* gg = in[5] + layer * DGM; const float* bb = in[7] + (size_t)(layer * 4 + h) * 128;
      u32x4 raw[16]; const int nr = nj >> 3;
#pragma unroll
      for (int i = 0; i < 16; ++i) { raw[i] = (u32x4){0u, 0u, 0u, 0u}; if (i < nr && lane < 48) raw[i] = *(const u32x4*)(P + (size_t)(blk0 + i * 8 + w) * DIN + 640 + lane * 8); }
      bf16x8 Aw[4][2]; f32x4 g4[6]; float bi[2];
#pragma unroll
      for (int ks = 0; ks < 4; ++ks)
#pragma unroll
          for (int mt = 0; mt < 2; ++mt) { Aw[ks][mt] = (bf16x8){0, 0, 0, 0, 0, 0, 0, 0}; if (ks < nks) Aw[ks][mt] = *(const bf16x8*)(wsb + (size_t)(half * 64 + (2 * ih + mt) * 16 + fr) * 128 + ks * 32 + 8 * fq); }
#pragma unroll
      for (int ct = 0; ct < 6; ++ct) g4[ct] = *(const f32x4*)(gg + h * 96 + ct * 16 + 4 * fq);
#pragma unroll
      for (int mt = 0; mt < 2; ++mt) bi[mt] = bb[half * 64 + (2 * ih + mt) * 16 + fr];
#pragma unroll
      for (int i = 0; i < 16; ++i) { if (i < nr) { float f[8]; unpack8(raw[i], f); float s = 0.f;
#pragma unroll
              for (int q = 0; q < 8; ++q) s += f[q] * f[q];
              s = wave_sum(s); const float rs = 1.0f / sqrtf(s * (1.0f / DGM) + EPS);
              u32x4 o; o.x = cvt_pk_bf16(f[0] * rs, f[1] * rs); o.y = cvt_pk_bf16(f[2] * rs, f[3] * rs); o.z = cvt_pk_bf16(f[4] * rs, f[5] * rs); o.w = cvt_pk_bf16(f[6] * rs, f[7] * rs);
              if (lane < 48) *(LAS u32x4*)(lds + VN + (i * 8 + w) * VST + lane * 16) = o; } }
      u32x2 uu[2][6];
#pragma unroll
      for (int mt = 0; mt < 2; ++mt)
#pragma unroll
          for (int ct = 0; ct < 6; ++ct) uu[mt][ct] = *(const u32x2*)(P + (size_t)(r0 + (2 * ih + mt) * 16 + fr) * DIN + 256 + h * 96 + ct * 16 + 4 * fq);
      LDS_BARRIER();
      { f32x4 acc[2][6];
#pragma unroll
        for (int a = 0; a < 2; ++a)
#pragma unroll
            for (int b = 0; b < 6; ++b) acc[a][b] = (f32x4){0.f, 0.f, 0.f, 0.f};
#pragma unroll
        for (int ks = 0; ks < 4; ++ks) { if (ks < nks) {
#pragma unroll
            for (int ct = 0; ct < 6; ++ct) { const unsigned ad = VN + (32 * ks + 8 * fq + q4) * VST + (h * 96 + ct * 16 + 4 * p4) * 2;
                const s16x4 t0 = __builtin_amdgcn_ds_read_tr16_b64_v4i16((LAS s16x4*)(lds + ad)), t1 = __builtin_amdgcn_ds_read_tr16_b64_v4i16((LAS s16x4*)(lds + ad + 4 * VST));
                bf16x8 B; B[0] = t0[0]; B[1] = t0[1]; B[2] = t0[2]; B[3] = t0[3]; B[4] = t1[0]; B[5] = t1[1]; B[6] = t1[2]; B[7] = t1[3];
#pragma unroll
                for (int mt = 0; mt < 2; ++mt) acc[mt][ct] = __builtin_amdgcn_mfma_f32_16x16x32_bf16(B, Aw[ks][mt], acc[mt][ct], 0, 0, 0); } } }
#pragma unroll
        for (int mt = 0; mt < 2; ++mt) { const int t = r0 + (2 * ih + mt) * 16 + fr;
#pragma unroll
            for (int ct = 0; ct < 6; ++ct) { const int c4 = h * 96 + ct * 16 + 4 * fq; const f32x4 z = acc[mt][ct] * g4[ct] + bi[mt]; const u32x2 uv = uu[mt][ct];
                u32x2 o; o.x = cvt_pk_bf16(bf_lo(uv.x) * z[0], bf_hi(uv.x) * z[1]); o.y = cvt_pk_bf16(bf_lo(uv.y) * z[2], bf_hi(uv.y) * z[3]); if (WT_MASK & 1) st8_wt(Y, (unsigned)((t * D + 256 + c4) * 2), o); else *(u32x2*)(Y + (size_t)t * D + 256 + c4) = o; } } }
      LDS_BARRIER(); }
    if (MIX_CVT >= 2) { tr_store(cja, cva, nullptr, lane, 0); tr_store(cjb, cvb, nullptr, lane, 0); }
    asm volatile("" : "+v"(tid)); lane = tid & 63;
    for (int mrep = 0; mrep < 1 + ((MIX_REP >> 2) & 1); ++mrep) if (MIX_MASK & 4) { constexpr int HC = 0, TT = 72192, TST = 784;
      { const char* dwsrc = (const char*)(in[8] + (size_t)layer * 31 * DCV);
#pragma unroll
        for (int i = 0; i < 6; ++i) { const int c = i * 8 + w; if (c * 1024 + lane * 16 < 31 * DCV * 4) __builtin_amdgcn_global_load_lds((const unsigned*)(dwsrc + c * 1024 + lane * 16), (LAS unsigned*)(lds + TT + c * 1024), 16, 0, 0); } }
      for (int crep = 0; crep < 1 + (CONV_REP & 1); ++crep) { u32x4 cvr[9], cgr[9];
#pragma unroll
        for (int i = 0; i < 9; ++i) { const int idx = tid + 512 * i, rr = idx / 48, ch = idx % 48, pos = s0 - 30 + rr; cvr[i] = (u32x4){0u, 0u, 0u, 0u}; cgr[i] = (u32x4){0u, 0u, 0u, 0u};
            if (idx < 94 * 48 && pos >= 0) { const bf16* pr = P + (size_t)(r0 - 30 + rr) * DIN; cvr[i] = *(const u32x4*)(pr + 1024 + ch * 8); cgr[i] = *(const u32x4*)(pr + 1408 + ch * 8); } }
        if (MIX_CVT >= 4 && mrep == 0 && crep == 0) { asm volatile("" ::: "memory"); cja = tr_decode(in, ws, cvi + 2 * CVS); tr_load(cja, cva, lane, 0); cjb = tr_decode(in, ws, cvi + 3 * CVS); tr_load(cjb, cvb, lane, 0); asm volatile("" ::: "memory"); }
#pragma unroll
        for (int i = 0; i < 9; ++i) { const int idx = tid + 512 * i, rr = idx / 48, ch = idx % 48; float a[8], b[8]; unpack8(cvr[i], a); unpack8(cgr[i], b);
#pragma unroll
            for (int q = 0; q < 8; ++q) a[q] *= fast_sigmoid(b[q]);
            u32x4 o; o.x = cvt_pk_bf16(a[0], a[1]); o.y = cvt_pk_bf16(a[2], a[3]); o.z = cvt_pk_bf16(a[4], a[5]); o.w = cvt_pk_bf16(a[6], a[7]);
            if (idx < 94 * 48) *(LAS u32x4*)(lds + HC + rr * 768 + ch * 16) = o; } }
      asm volatile("s_waitcnt vmcnt(0)" ::: "memory");
      LDS_BARRIER();
      asm volatile("" : "+v"(tid)); lane = tid & 63;
      const int fr = lane & 15, fq = lane >> 4; const bf16* pw = (const bf16*)(ws + WS_PWT) + (size_t)layer * DCV * DCV;
      bf16x8 Bp[4][3], Bq[8][3];
      for (int crep = 0; crep < 1 + ((CONV_REP >> 1) & 1); ++crep) { const float* dwb = in[9] + layer * DCV; const float* lg = in[10] + layer * DCV; const float* lb = in[11] + layer * DCV;
        f32x2 g2[3], bt2[3];
#pragma unroll
        for (int q = 0; q < 3; ++q) { g2[q] = *(const f32x2*)(lg + 128 * q + 2 * lane); bt2[q] = *(const f32x2*)(lb + 128 * q + 2 * lane); }
        float dd[8][6];
#pragma unroll
        for (int q = 0; q < 3; ++q) { const int c = 128 * q + 2 * lane; f32x2 wj[31];
#pragma unroll
            for (int j = 0; j < 31; ++j) wj[j] = *(const LAS f32x2*)(lds + TT + (j * DCV + c) * 4);
            const f32x2 b2 = *(const f32x2*)(dwb + c); f32x2 a2[8];
#pragma unroll
            for (int r = 0; r < 8; ++r) a2[r] = b2;
#pragma unroll
            for (int s = 0; s < 38; ++s) { const unsigned hv = *(const LAS unsigned*)(lds + HC + (8 * w + s) * 768 + c * 2); const f32x2 h2 = (f32x2){bf_lo(hv), bf_hi(hv)};
#pragma unroll
                for (int r = 0; r < 8; ++r) { const int j = s - r; if (j >= 0 && j <= 30) a2[r] = __builtin_elementwise_fma(h2, wj[j], a2[r]); } }
#pragma unroll
            for (int r = 0; r < 8; ++r) { dd[r][2 * q] = a2[r][0]; dd[r][2 * q + 1] = a2[r][1]; asm volatile("" : "+v"(dd[r][2 * q]), "+v"(dd[r][2 * q + 1])); }
            asm volatile("" ::: "memory"); }
#pragma unroll
        for (int ks = 0; ks < 4; ++ks)
#pragma unroll
            for (int nt = 0; nt < 3; ++nt) Bp[ks][nt] = *(const bf16x8*)(pw + (size_t)((3 * w + nt) * 16 + fr) * DCV + ks * 32 + 8 * fq);
#pragma unroll
        for (int ks = 0; ks < 8; ++ks)
#pragma unroll
            for (int nt = 0; nt < 3; ++nt) Bq[ks][nt] = *(const bf16x8*)(pw + (size_t)((3 * w + nt) * 16 + fr) * DCV + (4 + ks) * 32 + 8 * fq);
        LDS_BARRIER();
#pragma unroll
        for (int r = 0; r < 8; ++r) { float s = 0.f, v = 0.f;
#pragma unroll
            for (int q = 0; q < 6; ++q) { s += dd[r][q]; v += dd[r][q] * dd[r][q]; }
            const float mu = wave_sum(s) * (1.0f / DCV), ex2 = wave_sum(v) * (1.0f / DCV);
#pragma unroll
            for (int q = 0; q < 6; ++q) dd[r][q] -= mu;
            const float rs = 1.0f / sqrtf(fmaxf(ex2 - mu * mu, 0.f) + EPS);
#pragma unroll
            for (int q = 0; q < 3; ++q) { float y0 = dd[r][2 * q] * rs * g2[q][0] + bt2[q][0], y1 = dd[r][2 * q + 1] * rs * g2[q][1] + bt2[q][1]; y0 *= fast_sigmoid(y0); y1 *= fast_sigmoid(y1);
                *(LAS unsigned*)(lds + TT + (8 * w + r) * TST + (128 * q + 2 * lane) * 2) = cvt_pk_bf16(y0, y1); } } }
      LDS_BARRIER();
      for (int crep = 0; crep < 1 + ((CONV_REP >> 2) & 1); ++crep) { f32x4 acc[4][3];
#pragma unroll
        for (int a = 0; a < 4; ++a)
#pragma unroll
            for (int b = 0; b < 3; ++b) acc[a][b] = (f32x4){0.f, 0.f, 0.f, 0.f};
        const f32x4* pb4 = (const f32x4*)(in[13] + layer * DCV); f32x4 pbv[3];
#pragma unroll
        for (int nt = 0; nt < 3; ++nt) pbv[nt] = pb4[(3 * w + nt) * 4 + fq];
#pragma unroll
        for (int ks = 0; ks < 12; ++ks) { bf16x8 A[4];
#pragma unroll
            for (int mt = 0; mt < 4; ++mt) A[mt] = *(const LAS bf16x8*)(lds + TT + (mt * 16 + fr) * TST + (ks * 32 + 8 * fq) * 2);
#pragma unroll
            for (int mt = 0; mt < 4; ++mt)
#pragma unroll
                for (int nt = 0; nt < 3; ++nt) acc[mt][nt] = __builtin_amdgcn_mfma_f32_16x16x32_bf16(ks < 4 ? Bp[ks & 3][nt] : Bq[(ks - 4) & 7][nt], A[mt], acc[mt][nt], 0, 0, 0); }
#pragma unroll
        for (int mt = 0; mt < 4; ++mt)
#pragma unroll
            for (int nt = 0; nt < 3; ++nt) { const int t = r0 + mt * 16 + fr, n4 = (3 * w + nt) * 16 + 4 * fq; const f32x4 v = acc[mt][nt] + pbv[nt];
                u32x2 o; o.x = cvt_pk_bf16(v[0], v[1]); o.y = cvt_pk_bf16(v[2], v[3]); if (WT_MASK & 1) st8_wt(Y, (unsigned)((t * D + 640 + n4) * 2), o); else *(u32x2*)(Y + (size_t)t * D + 640 + n4) = o; } }
      LDS_BARRIER(); }
    if (MIX_CVT >= 4) { tr_store(cja, cva, nullptr, lane, 0); tr_store(cjb, cvb, nullptr, lane, 0); }
}

__device__ __forceinline__ void router_phase(Frame& F) {
    LAS unsigned char* lds = F.lds; int lane = F.lane; asm volatile("" : "+v"(lane)); const int w = F.wave; unsigned char* ws = F.ws;
    const InTab in = in_tab(F); const bf16* XBr = (const bf16*)(ws + WS_XB); const float* g2 = in[15] + D; const float* R = in[19];
    unsigned* rowoff = (unsigned*)(ws + WS_ROWOFF); float* rs_e = (float*)(ws + WS_RS); float* gate_e = (float*)(ws + WS_GATE); int* sel = (int*)(ws + WS_SEL);
    unsigned* cnt = F.ctl + CW_CNT;
    LAS int* se0 = (LAS int*)lds; LAS int* se1 = se0 + 64; LAS float* sw0 = (LAS float*)(se1 + 64); LAS float* sw1 = sw0 + 64; LAS float* srs = sw1 + 64;
    float Rg[4][4][8];
#pragma unroll
    for (int j = 0; j < 4; ++j)
#pragma unroll
        for (int q = 0; q < 4; ++q) { const int k = 8 * lane + 512 * (j >> 1) + 4 * (j & 1) + q; const float gk = g2[k]; const f32x4 a = *(const f32x4*)(R + k * 8), b = *(const f32x4*)(R + k * 8 + 4);
            Rg[j][q][0] = a[0] * gk; Rg[j][q][1] = a[1] * gk; Rg[j][q][2] = a[2] * gk; Rg[j][q][3] = a[3] * gk; Rg[j][q][4] = b[0] * gk; Rg[j][q][5] = b[1] * gk; Rg[j][q][6] = b[2] * gk; Rg[j][q][7] = b[3] * gk; }
    for (int b = F.vcu; b < M / 64; b += F.G) {
        f32x4 cva[8], cvb[8]; TrJob cja, cjb; const int cvi = R9_BEG + b * 8 + w;
        if (R9_CVT >= 2) { cja = tr_decode(in, ws, cvi); tr_load(cja, cva, lane, 0); cjb = tr_decode(in, ws, cvi + (M / 64) * 8); tr_load(cjb, cvb, lane, 0); }
        for (int i = 0; i < 8; ++i) { const int tl = 8 * w + i, t = 64 * b + tl; const u32x4* xr = (const u32x4*)(XBr + (size_t)t * D) + lane; float ss = 0.f, le[8];
#pragma unroll
            for (int e = 0; e < 8; ++e) le[e] = 0.f;
            const u32x4 xa = xr[0], xb2 = xr[64]; u32x2 qa, qb;
#pragma unroll
            for (int j = 0; j < 4; ++j) { const u32x4 xw = (j < 2) ? xa : xb2; const unsigned w0_ = (j & 1) ? xw.z : xw.x, w1_ = (j & 1) ? xw.w : xw.y; const f32x4 v = (f32x4){bf_lo(w0_), bf_hi(w0_), bf_lo(w1_), bf_hi(w1_)};
#pragma unroll
                for (int q = 0; q < 4; ++q) { ss += v[q] * v[q];
#pragma unroll
                    for (int e = 0; e < 8; ++e) le[e] += v[q] * Rg[j][q][e]; }
                const unsigned p8 = cvt4_fp8(v[0], v[1], v[2], v[3]); if (j == 0) qa.x = p8; else if (j == 1) qa.y = p8; else if (j == 2) qb.x = p8; else qb.y = p8; }
            { u32x2* xq = (u32x2*)(ws + WS_XQ + (size_t)t * D) + lane; xq[0] = qa; xq[64] = qb; }
            ss = wave_sum(ss);
#pragma unroll
            for (int e = 0; e < 8; ++e) le[e] = wave_sum(le[e]);
            const float rs = 1.0f / sqrtf(ss * (1.0f / D) + EPS);
            int i0 = 0; float l0 = le[0];
#pragma unroll
            for (int e = 1; e < 8; ++e) if (le[e] > l0) { l0 = le[e]; i0 = e; }
            int i1 = -1; float l1 = -3.0e38f;
#pragma unroll
            for (int e = 0; e < 8; ++e) if (e != i0 && le[e] > l1) { l1 = le[e]; i1 = e; }
            const float ex = expf((l1 - l0) * rs), w0 = 1.0f / (1.0f + ex), w1 = ex / (1.0f + ex);
            if (lane == 0) { se0[tl] = i0; se1[tl] = i1; sw0[tl] = w0; sw1[tl] = w1; srs[tl] = rs; } }
        __syncthreads();
        if (w == 0) { const int e0 = se0[lane], e1 = se1[lane]; int r0 = 0, r1 = 0; const unsigned long long lt = (1ull << lane) - 1ull;
            int l0 = 0, l1 = 0, nmine = 0;
#pragma unroll
            for (int e = 0; e < 8; ++e) { const unsigned long long m0 = __ballot(e0 == e), m1 = __ballot(e1 == e); const int n0 = __popcll(m0), n = n0 + __popcll(m1);
                if (e0 == e) l0 = __popcll(m0 & lt);
                if (e1 == e) l1 = n0 + __popcll(m1 & lt);
                nmine = (lane == e) ? n : nmine; }
            unsigned base = 0u;
            if (lane < 8 && nmine > 0) base = __hip_atomic_fetch_add(cnt + 64 * lane, (unsigned)nmine, RLX_AGENT);
            r0 = (int)__shfl(base, e0) + l0; r1 = (int)__shfl(base, e1) + l1;
            const int t = 64 * b + lane; const float rs = srs[lane];
            rowoff[e0 * ECAP + r0] = (unsigned)t * (unsigned)D; rs_e[e0 * ECAP + r0] = rs; gate_e[e0 * ECAP + r0] = sw0[lane];
            rowoff[e1 * ECAP + r1] = (unsigned)t * (unsigned)D; rs_e[e1 * ECAP + r1] = rs; gate_e[e1 * ECAP + r1] = sw1[lane];
            *(int4*)(sel + 4 * t) = make_int4(e0, r0, e1, r1); }
        if (R9_CVT >= 2) { tr_store(cja, cva, nullptr, lane, 0); tr_store(cjb, cvb, nullptr, lane, 0); }
        __syncthreads();
    }
}
__device__ __forceinline__ void moe_panels(Frame& F, int (&pb)[9]) {
    unsigned* cnt = F.ctl + CW_CNT; pb[0] = 0;
#pragma unroll
    for (int e = 0; e < 8; ++e) { const unsigned c = (unsigned)__builtin_amdgcn_readfirstlane(__hip_atomic_load(cnt + 64 * e, RLX_AGENT)); pb[e + 1] = pb[e] + (int)((c + 255u) >> 8); }
}
__device__ __forceinline__ void final_phase(Frame& F) {
    int pb[9]; moe_panels(F, pb);
    const int total = pb[8] * 4, nfull = (total / F.G) * F.G, NPf = nfull / 4, sp = pg8::moe_split(total - nfull, F.G); const bf16* slabs = (const bf16*)(F.ws + WS_SLAB);
    int lane = F.lane; asm volatile("" : "+v"(lane));
    const int gw = F.vcu * 8 + F.wave, NGW = F.G * 8; unsigned char* ws = F.ws;
    const bf16* YP = (const bf16*)(ws + WS_YP); const int* sel = (const int*)(ws + WS_SEL); const float* fg = in_tab(F)[23]; float* X = F.out; const bf16* XBf = (const bf16*)(ws + WS_XB2);
    f32x4 g4[4];
#pragma unroll
    for (int j = 0; j < 4; ++j) g4[j] = *((const f32x4*)fg + lane + 64 * j);
    for (int t = gw; t < M; t += NGW) { const int4 s = *(const int4*)(sel + 4 * t); int b0 = 0, b1 = 0;
#pragma unroll
        for (int e = 0; e < 8; ++e) { b0 = (s.x == e) ? pb[e] : b0; b1 = (s.z == e) ? pb[e] : b1; }
        const int pr[2] = {256 * b0 + s.y, 256 * b1 + s.w};
        const u32x2* xr = (const u32x2*)(XBf + (size_t)t * D) + lane;
        f32x4 v[4];
#pragma unroll
        for (int j = 0; j < 4; ++j) { const u32x2 a = xr[64 * j]; v[j] = (f32x4){bf_lo(a.x), bf_hi(a.x), bf_lo(a.y), bf_hi(a.y)}; }
#pragma unroll
        for (int k = 0; k < 2; ++k) { const int pm = pr[k] >> 8, lr = pr[k] & 255;
            if (sp > 1 && pm >= NPf) {
#pragma unroll
                for (int j = 0; j < 4; ++j) { const bf16* sb = slabs + (size_t)(((pm - NPf) * 4 + j) * sp) * 65536 + lr * 256 + 4 * lane; u32x2 a[14];
#pragma unroll
                    for (int ks = 0; ks < 14; ++ks) { a[ks] = (u32x2){0u, 0u}; if (ks < sp) a[ks] = *(const u32x2*)(sb + (size_t)ks * 65536); }
#pragma unroll
                    for (int ks = 0; ks < 14; ++ks) { v[j][0] += bf_lo(a[ks].x); v[j][1] += bf_hi(a[ks].x); v[j][2] += bf_lo(a[ks].y); v[j][3] += bf_hi(a[ks].y); } }
            } else { const u32x2* y = (const u32x2*)(YP + (size_t)pr[k] * D) + lane;
#pragma unroll
                for (int j = 0; j < 4; ++j) { const u32x2 a = __builtin_nontemporal_load(y + 64 * j); v[j][0] += bf_lo(a.x); v[j][1] += bf_hi(a.x); v[j][2] += bf_lo(a.y); v[j][3] += bf_hi(a.y); } } }
        float ss = 0.f;
#pragma unroll
        for (int j = 0; j < 4; ++j) ss += (v[j][0] * v[j][0] + v[j][1] * v[j][1]) + (v[j][2] * v[j][2] + v[j][3] * v[j][3]);
        ss = wave_sum(ss); const float rs = 1.0f / sqrtf(ss * (1.0f / D) + EPS);
        f32x4* o = (f32x4*)(X + (size_t)t * D) + lane;
#pragma unroll
        for (int j = 0; j < 4; ++j) __builtin_nontemporal_store(v[j] * rs * g4[j], o + 64 * j); }
}

template <class Sched> __device__ __forceinline__ void stage_rstd(Frame& F, const Sched& S, const float* ssq, LAS float* rtab) {
    pg8::Unit u; int tid = F.tid; asm volatile("" : "+v"(tid)); __syncthreads();
#pragma unroll 1
    for (int i = 0; i < 8 && S.next(i, u); ++i) if (tid < 256) rtab[i * 256 + tid] = pg8::rstd_of(ssq, u.pm * 256 + tid);
    __syncthreads();
}
struct Args { const float* in[24]; float* out; unsigned char* ws; int ph_lo, ph_hi, li, pad; };
__global__ void __launch_bounds__(512, 2) fwd(Args args) {
    extern __shared__ __attribute__((aligned(16))) unsigned char lds_raw[];
    Frame F;
    F.lds = (LAS unsigned char*)lds_raw; F.MISC = (volatile LAS unsigned*)(F.lds + MISC_OFF);
    F.tid = threadIdx.x; F.lane = F.tid & 63; F.wave = __builtin_amdgcn_readfirstlane(F.tid >> 6);
    F.G = gridDim.x; { const int bx = blockIdx.x; F.vcu = (F.G % 8 == 0) ? (bx % 8) * (F.G / 8) + bx / 8 : bx; }
    F.in.t = (const LAS unsigned long long*)(F.lds + INTAB_OFF); F.out = args.out; F.ws = args.ws; F.ctl = (unsigned*)(args.ws + WS_CTL);
    for (int u = F.tid; u < 64; u += 512) ((LAS unsigned*)(F.lds + MISC_OFF))[u] = 0u;
    if (F.tid < 24) ((LAS unsigned long long*)(F.lds + INTAB_OFF))[F.tid] = (unsigned long long)args.in[F.tid];
    __syncthreads();
    jobs_setup(F);
    XcdBarrier bar = xcd_barrier_post(F.ctl + CW_BAR + args.li * XCD_BAR_WORDS, F.MISC + 8);
    const int lo = args.ph_lo, hi = args.ph_hi;
#ifndef PH_MASK
#define PH_MASK 0xFFFF
#endif
#define PH_ON(k) (((PH_MASK) >> (k)) & 1)
#ifndef REP_MASK
#define REP_MASK 0
#endif
#define REPS(k) (1 + (((REP_MASK) >> (k)) & 1))
#ifndef PRO_PROBE
#define PRO_PROBE 0
#endif
#ifndef CVT_BEFORE
#define CVT_BEFORE 0
#endif
#ifndef EPI_PROBE
#define EPI_PROBE 0
#endif
#define IN(k) (lo <= (k) && (k) < hi)
#define SEAM(k) do { if (IN(k) && IN((k) + 1)) xcd_barrier(bar); } while (0)
#define SEAMH(k, first) do { if (IN(k) && IN((k) + 1)) xcd_barrier_host(bar, F, (first)); } while (0)
    unsigned char* ws = args.ws; LAS unsigned* gtab = (LAS unsigned*)(F.lds + GTAB_OFF);
    bf16* XB = (bf16*)(ws + WS_XB); float* ssq = (float*)(ws + WS_SSQ);
    if (F.G != 256) return;

    if (PH_ON(0) && IN(0)) for (int rep = 0; rep < REPS(0); ++rep) { p0_prologue(F, rep == 0 ? 0 : PRO_PROBE); __syncthreads(); }
    SEAMH(0, 0);
#pragma unroll 1
    for (int layer = 0; layer < 2; ++layer) {
        const int pbase = 1 + layer * 5;
        if (PH_ON(1) && IN(pbase)) for (int rep = 0; rep < REPS(1); ++rep) { pg8::Gemm g{XB, (const bf16*)(ws + WS_WIN) + (size_t)layer * DIN * D, D, 0}; pg8::StaticOrder S; S.init(M, DIN, F.G, (int)blockIdx.x);
            stage_rstd(F, S, ssq, (LAS float*)gtab); pg8::EpiP E{(bf16*)(ws + WS_P), DIN, (const LAS float*)gtab}; pg8::gemm_phase<pg8::EpiP, pg8::StaticOrder, true, true>(F.lds, gtab, g, S, E);
            if (rep == 0) tail_convert(F, layer ? H6_BEG : H1_BEG, H1_N, (int)blockIdx.x - 192, 64); }
        SEAMH(pbase, layer == 0 ? 1 : -1);
        if (PH_ON(2) && IN(pbase + 1)) for (int rep = 0; rep < REPS(2); ++rep) { for (int u = F.vcu; u < M / 64; u += F.G) mixer_unit(F, u, layer, layer ? MX1_BEG : MX0_BEG); }
        SEAMH(pbase + 1, layer == 0 ? 2 : -1);
        if (PH_ON(3) && IN(pbase + 2)) for (int rep = 0; rep < (layer == 0 ? REPS(3) : 1); ++rep) { pg8::Gemm g{(const bf16*)(ws + WS_Y), (const bf16*)(ws + WS_WOUT) + (size_t)layer * D * D, D, 0}; pg8::StaticOrder S; S.init(M, D, F.G, (int)blockIdx.x);
            pg8::EpiResid E{(const float*)nullptr, XB, ssq}; pg8::gemm_phase<pg8::EpiResid, pg8::StaticOrder, false, true>(F.lds, gtab, g, S, E); }
        SEAMH(pbase + 2, layer == 0 ? 3 : -1);
        if (layer == 0) {
            if (PH_ON(4) && IN(4)) for (int rep = 0; rep < REPS(4); ++rep) { pg8::Gemm g{XB, (const bf16*)(ws + WS_WGU), D, 0}; pg8::StaticOrder S; S.init(M, NGU, F.G, (int)blockIdx.x);
                stage_rstd(F, S, ssq, (LAS float*)gtab); pg8::EpiSwiglu<false> E{(bf16*)(ws + WS_ACT), DFF, (const LAS float*)gtab, 0, 1.0f}; pg8::gemm_phase<pg8::EpiSwiglu<false>, pg8::StaticOrder, true, true>(F.lds, gtab, g, S, E);
                if (rep == 0) tail_convert(F, H4_BEG, H4_N, (int)blockIdx.x - 128, 128); }
            SEAMH(4, 4);
            if (PH_ON(5) && IN(5)) { pg8::Gemm g{(const bf16*)(ws + WS_ACT), (const bf16*)(ws + WS_WD), DFF, 0}; pg8::StaticOrder S; S.init(M, D, F.G, (int)blockIdx.x);
                pg8::EpiResid E{(const float*)nullptr, XB, ssq}; pg8::gemm_phase<pg8::EpiResid, pg8::StaticOrder, false, true>(F.lds, gtab, g, S, E); }
            SEAMH(5, 5);
        }
    }
    if (PH_ON(9) && IN(9)) router_phase(F);
    SEAM(9);
#ifndef STAGGER_US
#define STAGGER_US 0
#endif
    if (PH_ON(10) && IN(10)) for (int rep = 0; rep < REPS(10); ++rep) {
        if (STAGGER_US > 0 && (blockIdx.x & 1)) { const unsigned long long t0 = __builtin_amdgcn_s_memrealtime(); while (__builtin_amdgcn_s_memrealtime() - t0 < (unsigned long long)(STAGGER_US * 100)) __builtin_amdgcn_s_sleep(8); __syncthreads(); }
        pg8::MoeOrderGather S; moe_panels(F, S.pb); S.nN = NGUE / 256; S.nwg = S.pb[8] * S.nN; S.G = F.G; S.c = (int)blockIdx.x; S.rowoff = (const unsigned*)(ws + WS_ROWOFF); S.rs_e = (const float*)(ws + WS_RS); S.gate_e = (const float*)(ws + WS_GATE);
        pg8::Gemm g{(const bf16*)(ws + WS_XQ), (const bf16*)(ws + WS_MOE_WGU), D / 2, (size_t)NGUE * D / 2};
        pg8::EpiSwiglu<true> E{(bf16*)(ws + WS_ACTM), DFE, (const LAS float*)(gtab + 512), rep == 0 ? 0 : EPI_PROBE, 1.0f / W8_GU};
        pg8::gemm_phase<pg8::EpiSwiglu<true>, pg8::MoeOrderGather, true, true, true>(F.lds, gtab, g, S, E);
        if (rep == 0) { const int rem = S.nwg % F.G, idle = rem ? F.G - rem : 0, nconv = idle < 48 ? F.G : (idle > 192 ? 192 : idle);
            tail_convert(F, H10_BEG, H10_N, ((int)blockIdx.x - rem + F.G) % F.G, nconv); } }
    SEAM(10);
    if (PH_ON(11) && IN(11)) for (int rep = 0; rep < REPS(11); ++rep) { pg8::MoeOrderDown S; moe_panels(F, S.pb); S.init(F.G, (int)blockIdx.x);
        pg8::Gemm g{(const bf16*)(ws + WS_ACTM), (const bf16*)(ws + WS_MOE_WD), DFE, (size_t)D * DFE};
        pg8::EpiBf16 E{(bf16*)(ws + WS_YP), D, (bf16*)(ws + WS_SLAB)};
        pg8::gemm_phase<pg8::EpiBf16, pg8::MoeOrderDown, true, true>(F.lds, gtab, g, S, E); }
    SEAM(11);
    if (PH_ON(12) && IN(12)) final_phase(F);
#undef IN
#undef SEAM
}
#ifndef MK_PER_PHASE
#define MK_PER_PHASE 0
#endif
extern "C" void kernel_launch(void* const* d_in, const int* in_sizes, int n_in, void* d_out, int out_size, void* d_ws, size_t ws_size, hipStream_t stream) {
    static int grid = 0;
    if (grid == 0) {
        if (n_in != 24 || out_size != M * D || ws_size < WS_END) { fprintf(stderr, "kernel_launch: unexpected shapes (n_in %d out %d ws %zu)\n", n_in, out_size, ws_size); grid = -1; return; }
        int dev = 0, cus = 0;
        if (hipGetDevice(&dev) != hipSuccess || hipDeviceGetAttribute(&cus, hipDeviceAttributeMultiprocessorCount, dev) != hipSuccess) { grid = -1; return; }
        if (hipFuncSetAttribute((const void*)fwd, hipFuncAttributeMaxDynamicSharedMemorySize, LDS_BYTES) != hipSuccess) { fprintf(stderr, "kernel_launch: hipFuncSetAttribute failed\n"); grid = -1; return; }
        int per_cu = 0;
        if (hipOccupancyMaxActiveBlocksPerMultiprocessor(&per_cu, (const void*)fwd, 512, LDS_BYTES) != hipSuccess || per_cu < 1) fprintf(stderr, "kernel_launch: occupancy query says %d\n", per_cu);
        (void)hipGetLastError();
        grid = cus;
        if (grid != 256) { fprintf(stderr, "kernel_launch: built for 256 CUs, found %d\n", grid); grid = -1; return; }
    }
    if (grid < 0) return;
    (void)hipMemsetAsync((char*)d_ws + WS_CTL, 0, CTL_ZERO_BYTES, stream);
    Args a{};
    for (int i = 0; i < 24; ++i) a.in[i] = (const float*)d_in[i];
    a.out = (float*)d_out; a.ws = (unsigned char*)d_ws; a.pad = 0;
#if MK_PER_PHASE
    for (int p = 0; p < NPHASE; ++p) { a.ph_lo = p; a.ph_hi = p + 1; a.li = p; hipLaunchKernelGGL(fwd, dim3(grid), dim3(512), LDS_BYTES, stream, a); }
#else
    a.ph_lo = 0; a.ph_hi = NPHASE; a.li = 0; hipLaunchKernelGGL(fwd, dim3(grid), dim3(512), LDS_BYTES, stream, a);
#endif
}
```

```cpp
#define MK_PER_PHASE 0
#define PG_WGM 4
#define NT_ACT 1
#define HID_PW 8
#define H10_SHARE 11264
#define SEAM_RELAX 0
#include <hip/hip_runtime.h>
#include <cstdio>
#include <cstdint>
constexpr int M = 16384, D = 1024, SEQ = 8192, DIN = 1792, DFF = 2816, DFE = 3584, NE = 8;
constexpr int DPOOL = 256, DGM = 384, DCV = 384;
constexpr int NGU = 2 * DFF, NGUE = 2 * DFE;
constexpr int ECAP = 16384;
constexpr int PMAX = 2 * M + NE * 256;
constexpr float EPS = 1e-6f;

#define LAS __attribute__((address_space(3)))
#define GAS __attribute__((address_space(1)))
typedef unsigned short bf16;
typedef short bf16x8 __attribute__((ext_vector_type(8)));
typedef short s16x4 __attribute__((ext_vector_type(4)));
typedef float f32x4 __attribute__((ext_vector_type(4)));
typedef float f32x2 __attribute__((ext_vector_type(2)));
typedef unsigned u32x4 __attribute__((ext_vector_type(4)));
typedef unsigned u32x2 __attribute__((ext_vector_type(2)));

__device__ __forceinline__ unsigned cvt_pk_bf16(float lo, float hi) { unsigned r; asm volatile("v_cvt_pk_bf16_f32 %0, %1, %2" : "=v"(r) : "v"(lo), "v"(hi)); return r; }
typedef int i32x4 __attribute__((ext_vector_type(4)));
typedef int i32x8 __attribute__((ext_vector_type(8)));
__device__ __forceinline__ unsigned cvt4_fp8(float a, float b, float c, float d) { int r = 0; r = __builtin_amdgcn_cvt_pk_fp8_f32(a, b, r, false); r = __builtin_amdgcn_cvt_pk_fp8_f32(c, d, r, true); return (unsigned)r; }
__device__ __forceinline__ i32x8 cat8(const bf16x8 a, const bf16x8 b) { const i32x4 x = __builtin_bit_cast(i32x4, a), y = __builtin_bit_cast(i32x4, b); return __builtin_shufflevector(x, y, 0, 1, 2, 3, 4, 5, 6, 7); }
#ifndef WT_MASK
#define WT_MASK 0
#endif
__device__ __forceinline__ void st16_wt(const void* base, unsigned off, u32x4 w) { asm volatile("s_nop 4\n\tglobal_store_dwordx4 %0, %1, %2 sc1\n\ts_nop 1" :: "v"(off), "v"(w), "s"(base) : "memory"); }
__device__ __forceinline__ void st16_wt_u(const void* base, unsigned off, u32x4 w) {
    const unsigned long long b = (unsigned long long)base; const unsigned lo = __builtin_amdgcn_readfirstlane((unsigned)b), hi = __builtin_amdgcn_readfirstlane((unsigned)(b >> 32));
    st16_wt((const void*)(((unsigned long long)hi << 32) | lo), off, w); }
__device__ __forceinline__ void st8_wt(const void* base, unsigned off, u32x2 w) { asm volatile("s_nop 4\n\tglobal_store_dwordx2 %0, %1, %2 sc1" :: "v"(off), "v"(w), "s"(base) : "memory"); }
__device__ __forceinline__ float bf_lo(unsigned w) { return __uint_as_float(w << 16); }
__device__ __forceinline__ float bf_hi(unsigned w) { return __uint_as_float(w & 0xffff0000u); }
__device__ __forceinline__ float fast_sigmoid(float x) { return __builtin_amdgcn_rcpf(1.0f + __builtin_amdgcn_exp2f(-1.4426950408889634f * x)); }
template <int CTRL> __device__ __forceinline__ float dpp_f(float v) { return __int_as_float(__builtin_amdgcn_update_dpp(0, __float_as_int(v), CTRL, 0xF, 0xF, true)); }
__device__ __forceinline__ float wave_sum(float v) {
    v += dpp_f<0xB1>(v); v += dpp_f<0x4E>(v); v += dpp_f<0x141>(v); v += dpp_f<0x140>(v);
    const int iv = __float_as_int(v);
    return (__int_as_float(__builtin_amdgcn_readlane(iv, 0)) + __int_as_float(__builtin_amdgcn_readlane(iv, 16))) + (__int_as_float(__builtin_amdgcn_readlane(iv, 32)) + __int_as_float(__builtin_amdgcn_readlane(iv, 48)));
}

#ifndef NT_ACT2
#define NT_ACT2 0
#endif
#ifndef PG_WGM
#define PG_WGM 8
#endif
namespace pg8 {
constexpr int BM = 256, BK = 64, HALF = 128, HTB = HALF * BK * 2, STAGE_BYTES = 8 * HTB, NXCD = 8, WGM = PG_WGM;
__host__ __device__ __forceinline__ int lds_byte(int r, int c) { const int st = (r >> 4) * 2 + (c >> 5), rr = r & 15, cc = c & 31, ob = rr * 64 + cc * 2; return st * 1024 + (ob ^ (((ob >> 9) & 1) << 5)); }
__host__ __device__ __forceinline__ void stage_rc(int b, int& R, int& C) { const int st = b / 1024, sb = b % 1024, swz = sb ^ (((sb >> 9) & 1) << 5); R = (st >> 1) * 16 + swz / 64; C = (st & 1) * 32 + (swz % 64) / 2; }
__host__ __device__ __forceinline__ int perm32(int rho) { const int n = rho >> 4, i = rho & 15; return 8 * (i >> 2) + 4 * n + (i & 3); }

struct Unit { int pm, pn, e, tab, k0b, nt, slab, ui; };
struct Gemm { const bf16* A; const bf16* Bt; int K; size_t bstride_e; };

__device__ __forceinline__ void order_map(int wgid, int nM, int nN, int& pm, int& pn) {
    const int nwg = nM * nN; { const int q = nwg / NXCD, r = nwg % NXCD, xcd = wgid % NXCD, off = wgid / NXCD; wgid = (xcd < r ? xcd * (q + 1) : r * (q + 1) + (xcd - r) * q) + off; }
    const int nig = WGM * nN, gid = wgid / nig, fm = gid * WGM, gsz = (nM - fm) < WGM ? (nM - fm) : WGM;
    pm = fm + ((wgid % nig) % gsz); pn = (wgid % nig) / gsz;
}
struct StaticOrder {
    static constexpr bool GATHER = false;
    int nM, nN, nwg, G, c;
    __device__ void init(int Mrows, int N, int G_, int c_) { nM = Mrows / BM; nN = N / BM; nwg = nM * nN; G = G_; c = c_; }
    __device__ __forceinline__ bool next(int i, Unit& u) const { const long L = (long)i * G + c; if (L >= nwg) return false; order_map((int)L, nM, nN, u.pm, u.pn); u.e = 0; u.tab = i * 256; u.k0b = 0; u.nt = 0; u.slab = -1; return true; }
    __device__ __forceinline__ const unsigned* a_table(const Unit&) const { return nullptr; }
    __device__ __forceinline__ const float* rs_table(const Unit&) const { return nullptr; }
    __device__ __forceinline__ const float* gate_table(const Unit&) const { return nullptr; }
};
struct MoeOrder {
    int pb[9]; int nN, nwg, G, c; const unsigned* rowoff; const float* rs_e; const float* gate_e;
    __device__ __forceinline__ bool next(int i, Unit& u) const {
        const long L = (long)i * G + c; if (L >= nwg) return false; order_map((int)L, pb[8], nN, u.pm, u.pn); u.k0b = 0; u.nt = 0; u.slab = -1;
        int e = 0;
#pragma unroll
        for (int k = 1; k < 8; ++k) e += (int)((unsigned)(pb[k] - u.pm - 1) >> 31);
        int pbe = pb[0];
#pragma unroll
        for (int k = 1; k < 8; ++k) pbe = (e == k) ? pb[k] : pbe;
        u.e = e; u.tab = e * ECAP + 256 * (u.pm - pbe); return true;
    }
    __device__ __forceinline__ const unsigned* a_table(const Unit& u) const { return rowoff + u.tab; }
    __device__ __forceinline__ const float* rs_table(const Unit& u) const { return rs_e + u.tab; }
    __device__ __forceinline__ const float* gate_table(const Unit& u) const { return gate_e + u.tab; }
};
struct MoeOrderGather : MoeOrder { static constexpr bool GATHER = true; };
#ifndef FORCE_SPLIT
#define FORCE_SPLIT 0
#endif
constexpr int MOE_DOWN_KT = DFE / 128;
static_assert(MOE_DOWN_KT == 28, "moe_split assumes 28 K-tiles");
__host__ __device__ __forceinline__ int moe_split(int r, int G) { if (FORCE_SPLIT) return r == 0 ? 1 : FORCE_SPLIT;
    return r == 0 ? 1 : (r * 7 <= G ? 7 : (r * 2 <= G ? 2 : 1)); }
struct MoeOrderDown {
    static constexpr bool GATHER = false;
    int pb[9]; int G, c, NPf, nfull, r, s;
    __device__ __forceinline__ void init(int G_, int c_) { G = G_; c = c_; const int total = pb[8] * 4; nfull = (total / G) * G; NPf = nfull / 4; r = total - nfull; s = moe_split(r, G); }
    __device__ __forceinline__ bool next(int i, Unit& u) const {
        const int L = i * G + c; u.tab = 0;
        if (L < nfull) { order_map(L, NPf, 4, u.pm, u.pn); u.k0b = 0; u.nt = 0; u.slab = -1; }
        else { const int j = L - nfull; if (j >= r * s) return false; const int lu = j / s, ks = j - lu * s; u.pm = NPf + (lu >> 2); u.pn = lu & 3; u.nt = MOE_DOWN_KT / s; u.k0b = ks * u.nt * BK * 2; u.slab = s > 1 ? j : -1; }
        int e = 0;
#pragma unroll
        for (int k = 1; k < 8; ++k) e += (int)((unsigned)(pb[k] - u.pm - 1) >> 31);
        u.e = e; return true;
    }
    __device__ __forceinline__ const unsigned* a_table(const Unit&) const { return nullptr; }
    __device__ __forceinline__ const float* rs_table(const Unit&) const { return nullptr; }
    __device__ __forceinline__ const float* gate_table(const Unit&) const { return nullptr; }
};

__device__ __forceinline__ float rstd_of(const float* ssq, int row) { const float s = (ssq[row] + ssq[M + row]) + (ssq[2 * M + row] + ssq[3 * M + row]); return 1.0f / sqrtf(s * (1.0f / D) + EPS); }

struct EpiP {
    static constexpr bool PERM = true, AFTER_DRAIN = false; static constexpr int NSTORE = 16;
    bf16* O; int ldc; const LAS float* rtab;
    __device__ __forceinline__ void operator()(const f32x4 (&acc)[2][2][4][2], const Unit& u, int wr, int wc, int fr, int fq) const {
        const int row0 = u.pm * BM + wr * 64 + fr, col0 = u.pn * BM + wc * 32 + 8 * fq;
#pragma unroll
        for (int ai = 0; ai < 2; ++ai)
#pragma unroll
            for (int m = 0; m < 4; ++m) { const int row = row0 + ai * HALF + m * 16; const float rs = rtab[u.tab + wr * 64 + fr + ai * HALF + m * 16]; bf16* rowp = O + (size_t)row * ldc + col0;
#pragma unroll
                for (int bj = 0; bj < 2; ++bj) { const f32x4 v0 = acc[ai][bj][m][0] * rs, v1 = acc[ai][bj][m][1] * rs;
                    u32x4 w; w.x = cvt_pk_bf16(v0[0], v0[1]); w.y = cvt_pk_bf16(v0[2], v0[3]); w.z = cvt_pk_bf16(v1[0], v1[1]); w.w = cvt_pk_bf16(v1[2], v1[3]);
                    if (WT_MASK & 4) st16_wt(O, (unsigned)((row * ldc + col0 + bj * HALF) * 2), w); else if (NT_ACT2) __builtin_nontemporal_store(w, (u32x4*)(rowp + bj * HALF)); else *(u32x4*)(rowp + bj * HALF) = w; } }
    }
};
#ifndef NT_ACT
#define NT_ACT 0
#endif
#ifndef ACT_AUX
#define ACT_AUX -1
#endif
template <bool MOE> struct EpiSwiglu {
    static constexpr bool PERM = true, AFTER_DRAIN = false; static constexpr int NSTORE = 8;
    bf16* O; int ldc; const LAS float* rtab; int mode; float inv;
    __device__ __forceinline__ void operator()(const f32x4 (&acc)[2][2][4][2], const Unit& u, int wr, int wc, int fr, int fq) const {
        if (mode == 2) { asm volatile("" :: "v"(acc[0][0][0][0][0]), "v"(acc[1][1][3][1][3])); return; }
        const int lr0 = wr * 64 + fr, col0 = u.pn * HALF + wc * 32 + 8 * fq;
#pragma unroll
        for (int ai = 0; ai < 2; ++ai)
#pragma unroll
            for (int m = 0; m < 4; ++m) { const int lr = lr0 + ai * HALF + m * 16, row = u.pm * BM + lr; float rs, gw;
                if (MOE) { rs = rtab[(u.ui & 1) * 512 + lr]; gw = rtab[(u.ui & 1) * 512 + 256 + lr]; } else { rs = rtab[u.tab + lr]; gw = 1.0f; }
                float o[8]; const float rsi = rs * inv, c1 = rsi * -1.4426950408889634f, c2 = rsi * rsi * gw;
#pragma unroll
                for (int n = 0; n < 2; ++n) { const f32x4 ga = acc[ai][0][m][n], gu = ga * acc[ai][1][m][n] * c2, ex = ga * c1;
#pragma unroll
                    for (int q = 0; q < 4; ++q) o[n * 4 + q] = gu[q] * __builtin_amdgcn_rcpf(1.0f + __builtin_amdgcn_exp2f(ex[q])); }
                if constexpr (MOE) { u32x2 w8; w8.x = cvt4_fp8(o[0], o[1], o[2], o[3]); w8.y = cvt4_fp8(o[4], o[5], o[6], o[7]);
                    if (mode == 1) { asm volatile("" :: "v"(w8.x), "v"(w8.y)); } else __builtin_nontemporal_store(w8, (u32x2*)((unsigned char*)O + (size_t)row * ldc + col0)); }
                else { u32x4 w; w.x = cvt_pk_bf16(o[0], o[1]); w.y = cvt_pk_bf16(o[2], o[3]); w.z = cvt_pk_bf16(o[4], o[5]); w.w = cvt_pk_bf16(o[6], o[7]);
                    if (mode == 1) { asm volatile("" :: "v"(w.x), "v"(w.y), "v"(w.z), "v"(w.w)); } else if (WT_MASK & 8) st16_wt(O, (unsigned)(row * ldc + col0) * 2u, w); else if (NT_ACT) __builtin_nontemporal_store(w, (u32x4*)(O + (size_t)row * ldc + col0)); else *(u32x4*)(O + (size_t)row * ldc + col0) = w; } }
    }
};
struct EpiBf16 {
    static constexpr bool PERM = true, AFTER_DRAIN = false; static constexpr int NSTORE = 16;
    bf16* O; int ldc; bf16* slabs; float inv;
    __device__ __forceinline__ void operator()(const f32x4 (&acc)[2][2][4][2], const Unit& u, int wr, int wc, int fr, int fq) const {
        const bool sl = u.slab >= 0; bf16* base = sl ? slabs + (size_t)u.slab * (BM * BM) : O; const int ld = sl ? BM : ldc;
        const int row0 = (sl ? 0 : u.pm * BM) + wr * 64 + fr, col0 = (sl ? 0 : u.pn * BM) + wc * 32 + 8 * fq;
#pragma unroll
        for (int ai = 0; ai < 2; ++ai)
#pragma unroll
            for (int m = 0; m < 4; ++m) { bf16* rowp = base + (size_t)(row0 + ai * HALF + m * 16) * ld + col0;
#pragma unroll
                for (int bj = 0; bj < 2; ++bj) { const f32x4 v0 = acc[ai][bj][m][0] * inv, v1 = acc[ai][bj][m][1] * inv;
                    u32x4 w; w.x = cvt_pk_bf16(v0[0], v0[1]); w.y = cvt_pk_bf16(v0[2], v0[3]); w.z = cvt_pk_bf16(v1[0], v1[1]); w.w = cvt_pk_bf16(v1[2], v1[3]);
                    if (WT_MASK & 16) st16_wt(base, (unsigned)(((row0 + ai * HALF + m * 16) * ld + col0 + bj * HALF) * 2), w); else if (NT_ACT2) __builtin_nontemporal_store(w, (u32x4*)(rowp + bj * HALF)); else *(u32x4*)(rowp + bj * HALF) = w; } }
    }
};
struct EpiResid {
    static constexpr bool PERM = true, AFTER_DRAIN = true; static constexpr int NSTORE = 0;
    const float* xold32; bf16* XB; float* ssq;
    __device__ __forceinline__ void fused(f32x4 (&acc)[2][2][4][2], const Unit& u, int wr, int wc, int fr, int fq, LAS unsigned char* lds, int wid, int lane) const {
        LAS float* Pt = (LAS float*)lds;
        const int col0 = u.pn * BM + wc * 32 + 8 * fq;
#pragma unroll
        for (int ai = 0; ai < 2; ++ai)
#pragma unroll
            for (int m = 0; m < 4; ++m) { const int r = ai * HALF + wr * 64 + m * 16 + fr; const size_t off = (size_t)(u.pm * BM + r) * D + col0; float s = 0.f;
#pragma unroll
                for (int bj = 0; bj < 2; ++bj) { f32x4 b0, b1;
                    if (xold32) { b0 = *(const f32x4*)(xold32 + off + bj * HALF); b1 = *(const f32x4*)(xold32 + off + bj * HALF + 4); }
                    else { const u32x4 w = *(const u32x4*)(XB + off + bj * HALF); b0 = (f32x4){bf_lo(w.x), bf_hi(w.x), bf_lo(w.y), bf_hi(w.y)}; b1 = (f32x4){bf_lo(w.z), bf_hi(w.z), bf_lo(w.w), bf_hi(w.w)}; }
                    const f32x4 o0 = b0 + acc[ai][bj][m][0], o1 = b1 + acc[ai][bj][m][1];
                    u32x4 w; w.x = cvt_pk_bf16(o0[0], o0[1]); w.y = cvt_pk_bf16(o0[2], o0[3]); w.z = cvt_pk_bf16(o1[0], o1[1]); w.w = cvt_pk_bf16(o1[2], o1[3]); if (WT_MASK & 2) st16_wt(XB, (unsigned)(off + bj * HALF) * 2u, w); else *(u32x4*)(XB + off + bj * HALF) = w;
                    s += ((o0[0] * o0[0] + o0[1] * o0[1]) + (o0[2] * o0[2] + o0[3] * o0[3])) + ((o1[0] * o1[0] + o1[1] * o1[1]) + (o1[2] * o1[2] + o1[3] * o1[3])); }
                s += __shfl_xor(s, 16); s += __shfl_xor(s, 32);
                if (fq == 0) Pt[r * 4 + wc] = s; }
        __syncthreads();
        const int t = wid * 64 + lane;
        if (t < 256) { const float s = (Pt[t * 4 + 0] + Pt[t * 4 + 1]) + (Pt[t * 4 + 2] + Pt[t * 4 + 3]); ssq[(size_t)u.pn * M + u.pm * BM + t] = s; }
        __syncthreads();
    }
};

template <class Epi, class Sched, bool ALIGN_EPI = false, bool SP2 = true, bool F8 = false>
__device__ __forceinline__ void gemm_phase(LAS unsigned char* lds, LAS unsigned* gtab, const Gemm g, const Sched& S, const Epi& E) {
    constexpr bool GATHER = Sched::GATHER;
    static_assert(!GATHER || SP2, "gather needs the SP2 loop (lgkmcnt(0) waits only)");
    int tid_ = threadIdx.x; asm volatile("" : "+v"(tid_));
    const int tid = tid_, wid = __builtin_amdgcn_readfirstlane(tid >> 6), lane = tid & 63, wr = wid >> 2, wc = wid & 3, fr = lane & 15, fq = lane >> 4;
    const int K = g.K; int nt = K / BK;
    unsigned voffA[2], voffB[2];
#pragma unroll
    for (int i = 0; i < 2; ++i) { int R, C; stage_rc(tid * 16 + i * 8192, R, C); const int Rb = Epi::PERM ? ((R & ~31) + perm32(R & 31)) : R;
        voffA[i] = (unsigned)(R * K + C) * 2u; voffB[i] = (unsigned)(Rb * K + C) * 2u; }
    const size_t kstep = (size_t)(BK * 2);
    const size_t hstep = (size_t)HALF * K * 2;
    const size_t tstep = 2 * hstep;
    const unsigned ldsw = (unsigned)wid * 1024u;
    const int aoff = lds_byte(wr * 64 + fr, fq * 8), boff = lds_byte(wc * 32 + fr, fq * 8);
#define PG8_SA(b, h) (((b) * 2 + (h)) * HTB)
#define PG8_SB(b, h) ((4 + (b) * 2 + (h)) * HTB)
#define PG8_STAGE(bufoff, gbase, voff) do { _Pragma("unroll") for (int _i = 0; _i < 2; ++_i) { unsigned _vo = (voff)[_i]; asm volatile("" : "+v"(_vo)); \
        __builtin_amdgcn_global_load_lds((const unsigned*)((const char*)(gbase) + _vo), (LAS unsigned*)(lds + (bufoff) + ldsw + _i * 8192), 16, 0, 0); } } while (0)
#define PG8_STAGE_A(bufoff, ubase, kb, h) do { if constexpr (GATHER) { PG8_STAGE(bufoff, (const char*)g.A + (kb), ga[h]); } else { PG8_STAGE(bufoff, (ubase) + (size_t)(h) * hstep + (kb), voffA); } } while (0)
#define PG8_LDA(dst, b, h) do { _Pragma("unroll") for (int m = 0; m < 4; ++m) _Pragma("unroll") for (int k = 0; k < 2; ++k) dst[m][k] = *(const LAS bf16x8*)(lds + PG8_SA(b, h) + aoff + m * 2048 + k * 1024); } while (0)
#define PG8_LDB(dst, b, h) do { _Pragma("unroll") for (int n = 0; n < 2; ++n) _Pragma("unroll") for (int k = 0; k < 2; ++k) dst[n][k] = *(const LAS bf16x8*)(lds + PG8_SB(b, h) + boff + n * 2048 + k * 1024); } while (0)
#define PG8_MMA(ai, bj, At, Bt) do { __builtin_amdgcn_s_setprio(1); _Pragma("unroll") for (int m = 0; m < 4; ++m) _Pragma("unroll") for (int n = 0; n < 2; ++n) { \
        if constexpr (F8) acc[ai][bj][m][n] = __builtin_amdgcn_mfma_scale_f32_16x16x128_f8f6f4(cat8(Bt[n][0], Bt[n][1]), cat8(At[m][0], At[m][1]), acc[ai][bj][m][n], 0, 0, 0, 0, 0, 0); \
        else { _Pragma("unroll") for (int k = 0; k < 2; ++k) acc[ai][bj][m][n] = __builtin_amdgcn_mfma_f32_16x16x32_bf16(Bt[n][k], At[m][k], acc[ai][bj][m][n], 0, 0, 0); } } __builtin_amdgcn_s_setprio(0); } while (0)
#define PG8_WAIT_V(n) asm volatile("s_waitcnt vmcnt(" #n ")" ::: "memory")
#define PG8_WAIT_L(n) asm volatile("s_waitcnt lgkmcnt(" #n ")" ::: "memory")
#ifndef SEAM_RELAX
#define SEAM_RELAX 1
#endif
#define PG8_WAIT_VS() do { const int _rl = __builtin_amdgcn_readfirstlane((t == 0 && ui > 0) ? 1 : 0); if constexpr (SEAM_RELAX && Epi::NSTORE == 8) asm volatile("s_waitcnt vmcnt(16)\n\ts_cmp_lg_u32 %0, 0\n\ts_cbranch_scc1 .Lrelax%=\n\ts_waitcnt vmcnt(8)\n.Lrelax%=:" :: "s"(_rl) : "memory", "scc"); \
        else if constexpr (SEAM_RELAX && Epi::NSTORE == 16) asm volatile("s_waitcnt vmcnt(24)\n\ts_cmp_lg_u32 %0, 0\n\ts_cbranch_scc1 .Lrelax%=\n\ts_waitcnt vmcnt(8)\n.Lrelax%=:" :: "s"(_rl) : "memory", "scc"); else PG8_WAIT_V(8); } while (0)
#define PG8_BAR __builtin_amdgcn_s_barrier()
#define PG8_SCHED __builtin_amdgcn_sched_barrier(0)
#define PG8_GTAB_DMA(un, slot) do { if (wid < 4) { __builtin_amdgcn_global_load_lds(S.a_table(un) + wid * 64 + lane, (LAS unsigned*)(gtab + (slot) * 256 + wid * 64), 4, 0, 0); \
            __builtin_amdgcn_global_load_lds((const unsigned*)S.gate_table(un) + wid * 64 + lane, (LAS unsigned*)(gtab + 512 + (slot) * 512 + 256 + wid * 64), 4, 0, 0); } \
        else __builtin_amdgcn_global_load_lds((const unsigned*)S.rs_table(un) + (wid - 4) * 64 + lane, (LAS unsigned*)(gtab + 512 + (slot) * 512 + (wid - 4) * 64), 4, 0, 0); } while (0)
#define PG8_GTAB_READ(dst, slot) do { _Pragma("unroll") for (int _i = 0; _i < 2; ++_i) { int _R, _C; stage_rc(tid * 16 + _i * 8192, _R, _C); _Pragma("unroll") for (int _h = 0; _h < 2; ++_h) dst[_h][_i] = gtab[(slot) * 256 + _h * HALF + _R] + (unsigned)_C * 2u; } } while (0)
    Unit cur, nxt; int ui = 0;
    if (!S.next(0, cur)) return;
    f32x4 acc[2][2][4][2];
#pragma unroll
    for (int a = 0; a < 2; ++a)
#pragma unroll
        for (int b = 0; b < 2; ++b)
#pragma unroll
            for (int m = 0; m < 4; ++m)
#pragma unroll
                for (int n = 0; n < 2; ++n) acc[a][b][m][n] = (f32x4){0.f, 0.f, 0.f, 0.f};
    bf16x8 At[4][2], B0[2][2], B1[2][2];
    unsigned ga[2][2];
    if (cur.nt) nt = cur.nt;
    const char* cA = (const char*)g.A + (GATHER ? (size_t)0 : (size_t)cur.pm * tstep + cur.k0b); const char* cB = (const char*)g.Bt + ((size_t)cur.e * g.bstride_e) * 2 + (size_t)cur.pn * tstep + cur.k0b;
    if constexpr (GATHER) { PG8_GTAB_DMA(cur, 0); PG8_WAIT_V(0); PG8_BAR; PG8_GTAB_READ(ga, 0); }
    if constexpr (SP2) {
        PG8_STAGE(PG8_SB(0, 0), cB, voffB); PG8_STAGE(PG8_SB(0, 1), cB + hstep, voffB); PG8_STAGE_A(PG8_SA(0, 0), cA, 0, 0); PG8_STAGE_A(PG8_SA(0, 1), cA, 0, 1);
        if (wr == 1) PG8_BAR;
        PG8_WAIT_V(2); PG8_BAR;
        PG8_STAGE(PG8_SB(1, 0), cB + kstep, voffB); PG8_STAGE_A(PG8_SA(1, 0), cA, kstep, 0); PG8_STAGE(PG8_SB(1, 1), cB + hstep + kstep, voffB);
        PG8_WAIT_V(6); PG8_BAR;
    } else {
        PG8_STAGE(PG8_SB(0, 0), cB, voffB); PG8_STAGE_A(PG8_SA(0, 0), cA, 0, 0); PG8_STAGE(PG8_SB(0, 1), cB + hstep, voffB); PG8_STAGE_A(PG8_SA(0, 1), cA, 0, 1);
        if (wr == 1) PG8_BAR;
        PG8_WAIT_V(4); PG8_BAR;
        PG8_STAGE(PG8_SB(1, 0), cB + kstep, voffB); PG8_STAGE_A(PG8_SA(1, 0), cA, kstep, 0); PG8_STAGE(PG8_SB(1, 1), cB + hstep + kstep, voffB);
        PG8_WAIT_V(6); PG8_BAR;
    }
    for (;;) {
        const bool has_next = S.next(ui + 1, nxt);
        const char* nA = (has_next && !GATHER) ? (const char*)g.A + (size_t)nxt.pm * tstep + nxt.k0b : cA;
        const char* nB = has_next ? (const char*)g.Bt + ((size_t)nxt.e * g.bstride_e) * 2 + (size_t)nxt.pn * tstep + nxt.k0b : cB;
        for (int t = 0; t < nt; t += 2) {
            const bool last = (t == nt - 2);
            const size_t k1 = (size_t)(t + 1) * kstep;
            const char* a2 = last ? nA : cA; const size_t k2 = last ? 0 : (size_t)(t + 2) * kstep;
            const char* b2 = last ? nB : cB + (size_t)(t + 2) * kstep; const char* b3 = b2 + kstep;
            const size_t k3 = k2 + kstep;
            if constexpr (GATHER) {
                if (t == nt - 4 && has_next) PG8_GTAB_DMA(nxt, (ui + 1) & 1);
            }
            if constexpr (SP2) {
            PG8_LDB(B0, 0, 0); PG8_LDB(B1, 0, 1); PG8_SCHED; PG8_LDA(At, 0, 0); PG8_STAGE_A(PG8_SA(1, 1), cA, k1, 1);
            if constexpr (GATHER) { if (last && has_next) PG8_GTAB_READ(ga, (ui + 1) & 1); }
            PG8_WAIT_VS(); PG8_WAIT_L(0); PG8_BAR; PG8_MMA(0, 0, At, B0); PG8_MMA(0, 1, At, B1); PG8_BAR; PG8_SCHED;
            PG8_LDA(At, 0, 1); PG8_STAGE(PG8_SB(0, 0), b2, voffB); PG8_STAGE(PG8_SB(0, 1), b2 + hstep, voffB); PG8_STAGE_A(PG8_SA(0, 0), a2, k2, 0);
            PG8_WAIT_VS(); PG8_WAIT_L(0); PG8_BAR; PG8_MMA(1, 0, At, B0); PG8_MMA(1, 1, At, B1); PG8_BAR; PG8_SCHED;
            PG8_LDB(B0, 1, 0); PG8_LDB(B1, 1, 1); PG8_SCHED; PG8_LDA(At, 1, 0); PG8_STAGE_A(PG8_SA(0, 1), a2, k2, 1);
            PG8_WAIT_V(8); PG8_WAIT_L(0); PG8_BAR; PG8_MMA(0, 0, At, B0); PG8_MMA(0, 1, At, B1); PG8_BAR; PG8_SCHED;
            PG8_LDA(At, 1, 1); PG8_STAGE(PG8_SB(1, 0), b3, voffB); PG8_STAGE(PG8_SB(1, 1), b3 + hstep, voffB); PG8_STAGE_A(PG8_SA(1, 0), a2, k3, 0);
            PG8_WAIT_V(8); PG8_WAIT_L(0); PG8_BAR; PG8_MMA(1, 0, At, B0); PG8_MMA(1, 1, At, B1); PG8_BAR; PG8_SCHED;
            } else {
            PG8_LDB(B0, 0, 0); PG8_SCHED; PG8_LDA(At, 0, 0); PG8_STAGE_A(PG8_SA(1, 1), cA, k1, 1);
            PG8_WAIT_L(8); PG8_BAR; PG8_WAIT_L(0); PG8_MMA(0, 0, At, B0); PG8_BAR; PG8_SCHED;
            PG8_LDB(B1, 0, 1); PG8_STAGE(PG8_SB(0, 0), b2, voffB);
            PG8_BAR; PG8_WAIT_L(0); PG8_MMA(0, 1, At, B1); PG8_BAR;
            PG8_LDA(At, 0, 1); PG8_STAGE_A(PG8_SA(0, 0), a2, k2, 0);
            PG8_BAR; PG8_WAIT_L(0); PG8_MMA(1, 0, At, B0); PG8_BAR; PG8_SCHED;
            PG8_STAGE(PG8_SB(0, 1), b2 + hstep, voffB);
            PG8_WAIT_V(6); PG8_BAR; PG8_MMA(1, 1, At, B1); PG8_BAR;
            PG8_LDB(B0, 1, 0); PG8_SCHED; PG8_LDA(At, 1, 0); PG8_STAGE_A(PG8_SA(0, 1), a2, k2, 1);
            PG8_WAIT_L(8); PG8_BAR; PG8_WAIT_L(0); PG8_MMA(0, 0, At, B0); PG8_BAR; PG8_SCHED;
            PG8_LDB(B1, 1, 1); PG8_STAGE(PG8_SB(1, 0), b3, voffB);
            PG8_BAR; PG8_WAIT_L(0); PG8_MMA(0, 1, At, B1); PG8_BAR;
            PG8_LDA(At, 1, 1); PG8_STAGE_A(PG8_SA(1, 0), a2, k3, 0);
            PG8_BAR; PG8_WAIT_L(0); PG8_MMA(1, 0, At, B0); PG8_BAR; PG8_SCHED;
            PG8_STAGE(PG8_SB(1, 1), b3 + hstep, voffB);
            PG8_WAIT_V(6); PG8_BAR; PG8_MMA(1, 1, At, B1); PG8_BAR;
            }
        }
        if constexpr (ALIGN_EPI) { if (wr == 0) PG8_BAR; }
        cur.ui = ui;
        if constexpr (!Epi::AFTER_DRAIN) { int le; asm volatile("v_mbcnt_lo_u32_b32 %0, -1, 0\n\tv_mbcnt_hi_u32_b32 %0, -1, %0" : "=v"(le)); E(acc, cur, wr, wc, le & 15, le >> 4); }
        if (!has_next) break;
#pragma unroll
        for (int a = 0; a < 2; ++a)
#pragma unroll
            for (int b = 0; b < 2; ++b)
#pragma unroll
                for (int m = 0; m < 4; ++m)
#pragma unroll
                    for (int n = 0; n < 2; ++n) acc[a][b][m][n] = (f32x4){0.f, 0.f, 0.f, 0.f};
        cur = nxt; cA = nA; cB = nB; ++ui; nt = cur.nt ? cur.nt : K / BK;
        if constexpr (ALIGN_EPI) { if (wr == 1) PG8_BAR; }
    }
    PG8_WAIT_V(0);
    if constexpr (!ALIGN_EPI) { if (wr == 0) PG8_BAR; }
    PG8_BAR;
    if constexpr (Epi::AFTER_DRAIN) { E.fused(acc, cur, wr, wc, fr, fq, lds, wid, lane); }
#undef PG8_SA
#undef PG8_SB
#undef PG8_STAGE
#undef PG8_STAGE_A
#undef PG8_LDA
#undef PG8_LDB
#undef PG8_MMA
#undef PG8_WAIT_V
#undef PG8_WAIT_VS
#undef PG8_WAIT_L
#undef PG8_BAR
#undef PG8_SCHED
#undef PG8_GTAB_DMA
#undef PG8_GTAB_READ
}
}
constexpr size_t MiB = 1u << 20;
constexpr size_t WS_CTL = 0, CTL_ZERO_BYTES = 256 * 1024;
constexpr size_t WS_ROWOFF = 1 * MiB;
constexpr size_t WS_RS = WS_ROWOFF + 512 * 1024;
constexpr size_t WS_GATE = WS_RS + 512 * 1024;
constexpr size_t WS_SEL = WS_GATE + 512 * 1024;
constexpr size_t WS_SSQ = WS_SEL + 256 * 1024;
constexpr size_t WS_SMALLW = 4 * MiB;
constexpr size_t WS_PWT = WS_SMALLW;
constexpr size_t WS_POOLWT = WS_PWT + 2 * 384 * 384 * 2;
constexpr size_t WS_GMWS = WS_POOLWT + 2 * 4 * 64 * 64 * 2;
constexpr size_t WS_XB = 6 * MiB;
constexpr size_t WS_SLAB = 162 * MiB;
constexpr size_t WS_XB2 = WS_XB;
constexpr size_t WS_MOE_WD = 38 * MiB;
constexpr size_t WS_MOE_WGU = 94 * MiB;
constexpr size_t WS_XQ = 150 * MiB;
constexpr size_t WS_YP = 94 * MiB;
constexpr size_t WS_ACTM = 206 * MiB;
constexpr size_t WS_P = 206 * MiB;
constexpr size_t WS_Y = 262 * MiB;
constexpr size_t WS_ACT = 206 * MiB;
constexpr size_t WS_WIN = 294 * MiB;
constexpr size_t WS_WOUT = 301 * MiB;
constexpr size_t WS_WGU = 305 * MiB;
constexpr size_t WS_WD = 316 * MiB;
constexpr size_t WS_END = 444 * MiB;
static_assert(WS_SSQ + 4 * (size_t)M * 4 <= WS_SMALLW && WS_GMWS + 2 * 4 * 128 * 128 * 2 <= WS_XB && WS_XB + (size_t)M * D * 2 <= WS_MOE_WD, "ws map 1");
static_assert(WS_MOE_WGU + (size_t)NE * NGUE * D <= WS_XQ && WS_XQ + (size_t)M * D <= WS_ACTM, "fp8 MoE gate|up weights, XQ");
static_assert(WS_SLAB >= WS_YP + (size_t)PMAX * D * 2 && WS_SLAB + 256 * (size_t)65536 * 2 <= WS_ACTM, "slabs");
static_assert(WS_MOE_WD + (size_t)NE * D * DFE * 2 <= WS_MOE_WGU && WS_MOE_WGU + (size_t)NE * NGUE * D * 2 <= WS_ACTM && WS_YP + (size_t)PMAX * D * 2 <= WS_ACTM, "ws map 2");
static_assert(WS_ACTM + (size_t)PMAX * DFE * 2 <= WS_END && WS_P + (size_t)M * DIN * 2 <= WS_Y && WS_Y + (size_t)M * D * 2 <= WS_WIN && WS_ACT + (size_t)M * DFF * 2 <= WS_WIN, "ws map 3");
static_assert(WS_WIN + 2 * (size_t)DIN * D * 2 <= WS_WOUT && WS_WOUT + 2 * (size_t)D * D * 2 <= WS_WGU && WS_WGU + (size_t)NGU * D * 2 <= WS_WD && WS_WD + (size_t)D * DFF * 2 <= WS_END, "ws map 4");
constexpr int CW_BAR = 4096;
constexpr int CW_CNT = 49152;
constexpr int CW_CVT = 140000;
constexpr int NPHASE = 13;
static_assert(CW_BAR + NPHASE * 3456 <= CW_CNT && (size_t)(CW_CNT + 8 * 64) * 4 <= CTL_ZERO_BYTES, "control words inside the per-call memset");
constexpr int RING_BYTES = 131072;
constexpr int GTAB_OFF = RING_BYTES;
constexpr int MISC_OFF = GTAB_OFF + 8192;
constexpr int INTAB_OFF = MISC_OFF + 256;
constexpr int JOBS_OFF = INTAB_OFF + 256;
constexpr int LDS_BYTES = 147456;
static_assert(JOBS_OFF + 7 * 12 * 32 <= LDS_BYTES, "LDS map (jobs)");
static_assert(MISC_OFF + 256 <= LDS_BYTES, "LDS map");

typedef GAS unsigned gu32;
#define RLX_AGENT __ATOMIC_RELAXED, __HIP_MEMORY_SCOPE_AGENT
#define LDS_WAIT() asm volatile("s_waitcnt lgkmcnt(0)" ::: "memory")
#define VM_WAIT() asm volatile("s_waitcnt vmcnt(0)" ::: "memory")

#define XB_TMO      128
#define XB_XCNT(j)  (256  + 64 * (j))
#define XB_XSUB(j)  (1280 + 64 * (j))
#define XB_XGEN(j)  (2304 + 64 * (j))
#define XB_TOP      3328
#define XB_TOPGEN   3392
#define XCD_BAR_WORDS 3456
#define XB_SPIN_CAP (1u << 18)
__device__ __forceinline__ unsigned xb_ld(unsigned* p)              { return __hip_atomic_load(p, __ATOMIC_RELAXED, __HIP_MEMORY_SCOPE_AGENT); }
__device__ __forceinline__ unsigned xb_add(unsigned* p, unsigned v) { return __hip_atomic_fetch_add(p, v, __ATOMIC_RELAXED, __HIP_MEMORY_SCOPE_AGENT); }
__device__ __forceinline__ unsigned xb_xcc_id() { return (unsigned)__builtin_amdgcn_s_getreg((3 << 11) | 20) & 0xFu; }
#define XB_SPIN(cond, bar) do { unsigned _sp = 0; while (cond) { __builtin_amdgcn_s_sleep(1); \
    if ((++_sp & 255u) == 0u) { if (xb_ld(&(bar)[XB_TMO])) break; if (_sp > XB_SPIN_CAP) { atomicAdd(&(bar)[XB_TMO], 1u); break; } } } } while (0)
struct XcdBarrier { unsigned* bar; unsigned x; volatile LAS unsigned* st; };
__device__ __forceinline__ XcdBarrier xcd_barrier_post(unsigned* bar, volatile LAS unsigned* st) {
    XcdBarrier b; b.bar = bar; b.x = xb_xcc_id(); b.st = st;
    if (threadIdx.x == 0) (void)xb_add(&bar[XB_XCNT(b.x)], 1u);
    return b;
}
__device__ __forceinline__ void xcd_barrier_complete(unsigned* bar, unsigned x, unsigned& nloc, unsigned& nx) {
    const unsigned G = gridDim.x * gridDim.y * gridDim.z;
    unsigned sum, cnt, mine, sp = 0u;
    for (;;) {
        sum = 0u; cnt = 0u; mine = 0u;
#pragma unroll
        for (unsigned j = 0; j < 16; ++j) { const unsigned c = xb_ld(&bar[XB_XCNT(j)]); sum += c; cnt += (c > 0u) ? 1u : 0u; mine = (j == x) ? c : mine; }
        if (sum == G) break;
        __builtin_amdgcn_s_sleep(1);
        if ((++sp & 255u) == 0u) { if (xb_ld(&bar[XB_TMO])) break; if (sp > XB_SPIN_CAP) { atomicAdd(&bar[XB_TMO], 1u); break; } }
    }
    nloc = mine > 0u ? mine : 1u; nx = cnt > 0u ? cnt : 1u;
}
__device__ __forceinline__ void xcd_barrier(const XcdBarrier& b) {
    asm volatile("s_waitcnt vmcnt(0)" ::: "memory");
    __syncthreads();
    if (threadIdx.x == 0) {
        unsigned* bar = b.bar;
        __builtin_amdgcn_s_waitcnt(0);
        unsigned nloc = b.st[0], nx = b.st[1];
        if (nloc == 0u) { xcd_barrier_complete(bar, b.x, nloc, nx); b.st[0] = nloc; b.st[1] = nx; }
        const unsigned old = xb_add(&bar[XB_XSUB(b.x)], 1u);
        const unsigned gen = old / nloc;
        if (old + 1u == (gen + 1u) * nloc) {
            __builtin_amdgcn_fence(__ATOMIC_RELEASE, "agent");
            asm volatile("s_waitcnt vmcnt(0)" ::: "memory");
            const unsigned og = xb_add(&bar[XB_TOP], 1u);
            const unsigned tg = og / nx;
            if (og + 1u == (tg + 1u) * nx) xb_add(&bar[XB_TOPGEN], 1u);
            else XB_SPIN(xb_ld(&bar[XB_TOPGEN]) == tg, bar);
            __builtin_amdgcn_fence(__ATOMIC_ACQUIRE, "agent");
            xb_add(&bar[XB_XGEN(b.x)], 1u);
            asm volatile("s_waitcnt vmcnt(0)" ::: "memory");
        } else {
            XB_SPIN(xb_ld(&bar[XB_XGEN(b.x)]) == gen, bar);
            __builtin_amdgcn_fence(__ATOMIC_ACQUIRE, "agent");
            asm volatile("s_waitcnt vmcnt(0)" ::: "memory");
        }
    }
    __syncthreads();
}

struct InTab { const LAS unsigned long long* t;
    __device__ __forceinline__ const float* operator[](int k) const { const unsigned long long v = t[k]; const unsigned lo = __builtin_amdgcn_readfirstlane((unsigned)v), hi = __builtin_amdgcn_readfirstlane((unsigned)(v >> 32));
        return (const float*)(((unsigned long long)hi << 32) | lo); } };
struct Frame {
    LAS unsigned char* lds; volatile LAS unsigned* MISC; unsigned* ctl;
    int tid, lane, wave, vcu, G;
    InTab in; float* out; unsigned char* ws;
};

__device__ __forceinline__ InTab in_tab(Frame& F) { return F.in; }
constexpr float W8_D = 128.0f;
constexpr float W8_GU = 64.0f;
struct TrJob { const float* src; bf16* dst; const float* gk; int K, N, f8; };
__device__ __forceinline__ TrJob tr_mat(const float* W, int K, int N, bf16* WT, int mode, const float* gk, int r, int f8 = 0) {
    const int nblk = N / 32, kb = r / nblk, nb = r % nblk, n0 = 32 * nb, k0 = 64 * kb;
    const int drow = mode == 0 ? n0 : ((n0 >> 7) * 256 + (n0 & 127) + (mode == 2 ? 128 : 0));
    TrJob j; j.src = W + (size_t)k0 * N + n0; j.dst = f8 ? (bf16*)((unsigned char*)WT + (size_t)drow * K + k0) : WT + (size_t)drow * K + k0; j.gk = gk ? gk + k0 : nullptr; j.K = K; j.N = N; j.f8 = f8; return j;
}
constexpr int TR_I_IN = (D / 64) * (DIN / 32), TR_I_OUT = (D / 64) * (D / 32), TR_I_G = (D / 64) * (DFF / 32), TR_I_D = (DFF / 64) * (D / 32), TR_I_MG = (D / 64) * (DFE / 32), TR_I_MD = (DFE / 64) * (D / 32), TR_I_PW = (DCV / 64) * (DCV / 32), TR_I_PL = 2;
constexpr int TR_E_END = TR_I_IN + 2 * TR_I_PW + 8 * TR_I_PL;
constexpr int TR_A_END = TR_E_END + TR_I_OUT + 2 * TR_I_G + TR_I_D;
constexpr int TR_B_END = TR_A_END + TR_I_IN + TR_I_OUT;
constexpr int TR_C_END = TR_B_END + 2 * NE * TR_I_MG;
constexpr int TR_D_END = TR_C_END + NE * TR_I_MD;
__device__ __forceinline__ TrJob tr_decode(const InTab in, unsigned char* ws, int r) {
    if (r < TR_I_IN) return tr_mat(in[2], D, DIN, (bf16*)(ws + WS_WIN), 0, in[1], r); r -= TR_I_IN;
    if (r < 2 * TR_I_PW) { const int l = r / TR_I_PW; return tr_mat(in[12] + (size_t)l * DCV * DCV, DCV, DCV, (bf16*)(ws + WS_PWT) + (size_t)l * DCV * DCV, 0, nullptr, r % TR_I_PW); } r -= 2 * TR_I_PW;
    if (r < 8 * TR_I_PL) { const int gi = r / TR_I_PL; return tr_mat(in[3] + (size_t)gi * 64 * 64, 64, 64, (bf16*)(ws + WS_POOLWT) + (size_t)gi * 64 * 64, 0, nullptr, r % TR_I_PL); } r -= 8 * TR_I_PL;
    if (r < TR_I_OUT) return tr_mat(in[14], D, D, (bf16*)(ws + WS_WOUT), 0, nullptr, r); r -= TR_I_OUT;
    if (r < TR_I_G) return tr_mat(in[16], D, DFF, (bf16*)(ws + WS_WGU), 1, in[15], r); r -= TR_I_G;
    if (r < TR_I_G) return tr_mat(in[17], D, DFF, (bf16*)(ws + WS_WGU), 2, in[15], r); r -= TR_I_G;
    if (r < TR_I_D) return tr_mat(in[18], DFF, D, (bf16*)(ws + WS_WD), 0, nullptr, r); r -= TR_I_D;
    if (r < TR_I_IN) return tr_mat(in[2] + (size_t)D * DIN, D, DIN, (bf16*)(ws + WS_WIN) + (size_t)DIN * D, 0, in[1] + D, r); r -= TR_I_IN;
    if (r < TR_I_OUT) return tr_mat(in[14] + (size_t)D * D, D, D, (bf16*)(ws + WS_WOUT) + (size_t)D * D, 0, nullptr, r); r -= TR_I_OUT;
    if (r < 2 * NE * TR_I_MG) { const int e = r / (2 * TR_I_MG), q = r % (2 * TR_I_MG), up = q / TR_I_MG;
        return tr_mat(in[20 + up] + (size_t)e * D * DFE, D, DFE, (bf16*)(ws + WS_MOE_WGU + (size_t)e * NGUE * D), 1 + up, in[15] + D, q % TR_I_MG, 1); } r -= 2 * NE * TR_I_MG;
    { const int e = r / TR_I_MD; return tr_mat(in[22] + (size_t)e * DFE * D, DFE, D, (bf16*)(ws + WS_MOE_WD + (size_t)e * D * DFE), 0, nullptr, r % TR_I_MD, 2); }
}
__device__ __forceinline__ void tr_load(const TrJob& j, f32x4 (&v)[8], int lane, int probe) {
    const int n4 = (lane & 7) * 4, k8 = (lane >> 3) * 8;
    if (probe == 2) {
#pragma unroll
        for (int i = 0; i < 8; ++i) v[i] = (f32x4){1.f, 2.f, 3.f, 4.f};
        return; }
#pragma unroll
    for (int i = 0; i < 8; ++i) v[i] = __builtin_nontemporal_load((const f32x4*)(j.src + (size_t)(k8 + i) * j.N + n4));
    if (j.gk) { f32x4 g0 = *(const f32x4*)(j.gk + k8), g1 = *(const f32x4*)(j.gk + k8 + 4);
        v[0] = v[0] * g0[0]; v[1] = v[1] * g0[1]; v[2] = v[2] * g0[2]; v[3] = v[3] * g0[3]; v[4] = v[4] * g1[0]; v[5] = v[5] * g1[1]; v[6] = v[6] * g1[2]; v[7] = v[7] * g1[3]; }
    if (j.f8) { const float sc = j.f8 == 1 ? W8_GU : W8_D;
#pragma unroll
        for (int i = 0; i < 8; ++i) v[i] = v[i] * sc; }
}
__device__ __forceinline__ void tr_store(const TrJob& j, const f32x4 (&v)[8], LAS float* scr, int lane, int probe) {
    (void)scr; const int n4 = (lane & 7) * 4, k8 = (lane >> 3) * 8;
    if (j.f8) {
#pragma unroll
        for (int q = 0; q < 4; ++q) { u32x2 o; o.x = cvt4_fp8(v[0][q], v[1][q], v[2][q], v[3][q]); o.y = cvt4_fp8(v[4][q], v[5][q], v[6][q], v[7][q]);
            *(GAS u32x2*)((GAS unsigned char*)j.dst + (size_t)(n4 + q) * j.K + k8) = o; }
        return; }
#pragma unroll
    for (int q = 0; q < 4; ++q) { u32x4 o; o.x = cvt_pk_bf16(v[0][q], v[1][q]); o.y = cvt_pk_bf16(v[2][q], v[3][q]); o.z = cvt_pk_bf16(v[4][q], v[5][q]); o.w = cvt_pk_bf16(v[6][q], v[7][q]);
        if (probe == 1 || probe == 2) { asm volatile("" :: "v"(o.x), "v"(o.y), "v"(o.z), "v"(o.w)); } else if (WT_MASK & 1) st16_wt_u(j.dst, (unsigned)(((n4 + q) * j.K + k8) * 2), o); else *(GAS u32x4*)(j.dst + (size_t)(n4 + q) * j.K + k8) = o; }
}
__device__ __forceinline__ void tr_run(Frame& F, int first, int count, int widx, int nw, int probe) {
    LAS float* scr = (LAS float*)(F.lds + F.wave * 16384); int lane = F.lane; asm volatile("" : "+v"(lane)); const InTab in = in_tab(F); unsigned char* ws = F.ws;
    const int end = first + count; f32x4 v[4][8]; TrJob j[4];
#pragma unroll
    for (int k = 0; k < 4; ++k) { const int it = first + widx + k * nw; if (it < end) { j[k] = tr_decode(in, ws, it); tr_load(j[k], v[k], lane, probe); } }
    for (int it = first + widx; it < end; it += 4 * nw) {
#pragma unroll
        for (int k = 0; k < 4; ++k) { const int ik = it + k * nw, nx = ik + 4 * nw;
            if (ik < end) tr_store(j[k], v[k], scr, lane, probe);
            if (nx < end) { j[k] = tr_decode(in, ws, nx); tr_load(j[k], v[k], lane, probe); } } }
}
#ifndef H10_SHARE
#define H10_SHARE 8192
#endif
#ifndef HID_PW
#define HID_PW 2
#endif
constexpr int HID_PER_WAVE = HID_PW, H1_N = 64 * 8 * HID_PER_WAVE, H4_N = 128 * 8 * HID_PER_WAVE, H6_N = 64 * 8 * HID_PER_WAVE, H10_N = H10_SHARE;
constexpr int H10_BEG = TR_D_END - H10_N;
#ifndef MIX_CVT
#define MIX_CVT 0
#endif
#ifndef R9_CVT
#define R9_CVT 0
#endif
#ifndef SB_CVT
#define SB_CVT 2
#endif
constexpr int MX_N = (M / 64) * 8 * MIX_CVT, R9_N = (M / 64) * 8 * R9_CVT, SB_N = 7 * 256 * SB_CVT;
constexpr int H1_BEG = TR_E_END, S0_BEG = H1_BEG + H1_N, S1_BEG = S0_BEG + SB_N, S2_BEG = S1_BEG + SB_N, S3_BEG = S2_BEG + SB_N, H4_BEG = S3_BEG + SB_N, S4_BEG = H4_BEG + H4_N, S5_BEG = S4_BEG + SB_N,
              H6_BEG = S5_BEG + SB_N, MX0_BEG = H6_BEG + H6_N, MX1_BEG = MX0_BEG + MX_N, R9_BEG = MX1_BEG + MX_N, PRO_BEG = R9_BEG + R9_N;
static_assert(PRO_BEG <= H10_BEG, "hidden conversion shares exceed the weight tiles");
static_assert(H1_BEG + TR_I_OUT <= S0_BEG, "w_out of layer 0 (phase 3): inside H1");
static_assert(TR_A_END - TR_I_D <= S1_BEG, "dense gate|up weights (phase 4): visible by phase 3 at the latest, i.e. inside H1 | S0");
static_assert(TR_A_END <= S2_BEG, "dense down weights (phase 5): inside H1 | S0 | S1");
static_assert(TR_A_END + TR_I_IN <= S3_BEG && TR_B_END <= S5_BEG, "layer-1 projections (phases 6, 8)");
static_assert(TR_C_END <= H10_BEG && MIX_CVT == 0 && R9_CVT == 0, "MoE gate|up weights before phase 10 (H6 is visible from phase 7); no hosting in mixers / router in this layout");
__device__ __forceinline__ void tail_convert(Frame& F, int first, int count, int rank, int nwg_idle) {
    if (rank >= 0 && rank < nwg_idle) tr_run(F, first, count, rank * 8 + F.wave, nwg_idle * 8, 0);
}

struct JobRec { unsigned long long src, dst, gk; int K, N; };
__device__ __forceinline__ TrJob job_read(const LAS JobRec* r) {
    const u32x4 a = *(const LAS u32x4*)r, c = *((const LAS u32x4*)r + 1); TrJob j;
    const unsigned s0 = __builtin_amdgcn_readfirstlane(a.x), s1 = __builtin_amdgcn_readfirstlane(a.y), d0 = __builtin_amdgcn_readfirstlane(a.z), d1 = __builtin_amdgcn_readfirstlane(a.w);
    const unsigned g0 = __builtin_amdgcn_readfirstlane(c.x), g1 = __builtin_amdgcn_readfirstlane(c.y);
    j.src = (const float*)(((unsigned long long)s1 << 32) | s0); j.dst = (bf16*)(((unsigned long long)d1 << 32) | d0); j.gk = (const float*)(((unsigned long long)g1 << 32) | g0);
    j.K = __builtin_amdgcn_readfirstlane(c.z); const int nf = __builtin_amdgcn_readfirstlane(c.w); j.N = nf & 0xFFFFF; j.f8 = (int)((unsigned)nf >> 30); return j;
}
__device__ __forceinline__ void jobs_setup(Frame& F) {
    if (SB_CVT == 0 || F.wave == 0) return;
    const InTab in = in_tab(F); unsigned char* ws = F.ws; LAS JobRec* tab = (LAS JobRec*)(F.lds + JOBS_OFF) + (F.wave - 1) * 12;
#pragma unroll 1
    for (int q = 0; q < 6 * SB_CVT; ++q) { const int sI = q / SB_CVT, k = q - sI * SB_CVT; const int beg = sI < 4 ? S0_BEG + sI * SB_N : S4_BEG + (sI - 4) * SB_N;
        const TrJob j = tr_decode(in, ws, beg + (int)blockIdx.x * 7 + F.wave - 1 + k * 7 * 256);
        if (F.lane == 0) { const unsigned long long s = (unsigned long long)j.src, d = (unsigned long long)j.dst, g = (unsigned long long)j.gk; LAS u32x4* o = (LAS u32x4*)(tab + sI * 2 + k);
            u32x4 a, c; a.x = (unsigned)s; a.y = (unsigned)(s >> 32); a.z = (unsigned)d; a.w = (unsigned)(d >> 32); c.x = (unsigned)g; c.y = (unsigned)(g >> 32); c.z = (unsigned)j.K; c.w = (unsigned)j.N | ((unsigned)j.f8 << 30); o[0] = a; o[1] = c; } }
}
__device__ __forceinline__ void xcd_barrier_host(const XcdBarrier& b, Frame& F, int slot) {
    if (slot < 0 || SB_CVT == 0) { xcd_barrier(b); return; }
    asm volatile("s_waitcnt vmcnt(0)" ::: "memory");
    __syncthreads();
    int lane = F.lane; asm volatile("" : "+v"(lane));
    f32x4 va[8], vb[8]; TrJob ja, jb; const bool host = F.wave > 0; const LAS JobRec* jr = (const LAS JobRec*)(F.lds + JOBS_OFF) + (F.wave - 1) * 12 + slot * 2;
    if (host) { ja = job_read(jr); tr_load(ja, va, lane, 0); if (SB_CVT >= 2) { jb = job_read(jr + 1); tr_load(jb, vb, lane, 0); } }
    if (threadIdx.x == 0) {
        unsigned* bar = b.bar;
        __builtin_amdgcn_s_waitcnt(0);
        unsigned nloc = b.st[0], nx = b.st[1];
        if (nloc == 0u) { xcd_barrier_complete(bar, b.x, nloc, nx); b.st[0] = nloc; b.st[1] = nx; }
        const unsigned old = xb_add(&bar[XB_XSUB(b.x)], 1u);
        const unsigned gen = old / nloc;
        if (old + 1u == (gen + 1u) * nloc) {
            __builtin_amdgcn_fence(__ATOMIC_RELEASE, "agent");
            asm volatile("s_waitcnt vmcnt(0)" ::: "memory");
            const unsigned og = xb_add(&bar[XB_TOP], 1u);
            const unsigned tg = og / nx;
            if (og + 1u == (tg + 1u) * nx) xb_add(&bar[XB_TOPGEN], 1u);
            else XB_SPIN(xb_ld(&bar[XB_TOPGEN]) == tg, bar);
            __builtin_amdgcn_fence(__ATOMIC_ACQUIRE, "agent");
            xb_add(&bar[XB_XGEN(b.x)], 1u);
            asm volatile("s_waitcnt vmcnt(0)" ::: "memory");
        } else {
            XB_SPIN(xb_ld(&bar[XB_XGEN(b.x)]) == gen, bar);
            __builtin_amdgcn_fence(__ATOMIC_ACQUIRE, "agent");
            asm volatile("s_waitcnt vmcnt(0)" ::: "memory");
        }
    }
    __syncthreads();
    if (host) { tr_store(ja, va, nullptr, lane, 0); if (SB_CVT >= 2) tr_store(jb, vb, nullptr, lane, 0); }
}
__device__ __forceinline__ void p0_prologue(Frame& F, int probe) {
    LAS float* scr = (LAS float*)(F.lds + F.wave * 16384);
    int lane = F.lane; asm volatile("" : "+v"(lane));
    const int gw = F.vcu * 8 + F.wave, NGW = F.G * 8;
    const InTab in = in_tab(F); unsigned char* ws = F.ws;
    tr_run(F, 0, TR_E_END, gw, NGW, probe);
    tr_run(F, PRO_BEG, H10_BEG - PRO_BEG, gw, NGW, probe);
    { const float* src = in[6]; bf16* dst = (bf16*)(ws + WS_GMWS);
      for (int i = gw * 64 + lane; i < 2 * 4 * 128 * 128 / 8; i += NGW * 64) { const f32x4 a = *(const f32x4*)(src + (size_t)i * 8), b = *(const f32x4*)(src + (size_t)i * 8 + 4);
          u32x4 o; o.x = cvt_pk_bf16(a[0], a[1]); o.y = cvt_pk_bf16(a[2], a[3]); o.z = cvt_pk_bf16(b[0], b[1]); o.w = cvt_pk_bf16(b[2], b[3]); *(u32x4*)(dst + (size_t)i * 8) = o; } }
    { u32x4* t = (u32x4*)(ws + WS_ROWOFF); for (int i = gw * 64 + lane; i < NE * ECAP / 4; i += NGW * 64) t[i] = (u32x4){0u, 0u, 0u, 0u}; }
    { const float* x = in[0]; bf16* XB = (bf16*)(ws + WS_XB); float* ssq = (float*)(ws + WS_SSQ);
      for (int m = gw; m < M; m += NGW) { const f32x4* xr = (const f32x4*)(x + (size_t)m * D) + lane; f32x4 v[4]; float s = 0.f;
#pragma unroll
          for (int j = 0; j < 4; ++j) { v[j] = xr[64 * j]; s += (v[j][0] * v[j][0] + v[j][1] * v[j][1]) + (v[j][2] * v[j][2] + v[j][3] * v[j][3]); }
          s = wave_sum(s);
          u32x2* o = (u32x2*)(XB + (size_t)m * D) + lane;
#pragma unroll
          for (int j = 0; j < 4; ++j) { u32x2 w; w.x = cvt_pk_bf16(v[j][0], v[j][1]); w.y = cvt_pk_bf16(v[j][2], v[j][3]); if (WT_MASK & 1) st8_wt(XB, (unsigned)((m * D + (lane + 64 * j) * 4) * 2), w); else o[64 * j] = w; }
          if (lane < 4) ssq[(size_t)lane * M + m] = lane == 0 ? s : 0.f; } }
}

__device__ __forceinline__ void unpack8(const u32x4 w, float (&f)[8]) { f[0] = bf_lo(w.x); f[1] = bf_hi(w.x); f[2] = bf_lo(w.y); f[3] = bf_hi(w.y); f[4] = bf_lo(w.z); f[5] = bf_hi(w.z); f[6] = bf_lo(w.w); f[7] = bf_hi(w.w); }
#define LDS_BARRIER() asm volatile("s_waitcnt lgkmcnt(0)\n\ts_barrier" ::: "memory")
__device__ __forceinline__ void mixer_unit(Frame& F, int u, int layer, int cvt0) {
    LAS unsigned char* lds = F.lds; int tid = F.tid; asm volatile("" : "+v"(tid)); int lane = tid & 63; const int w = F.wave;
    const InTab in = in_tab(F); unsigned char* ws = F.ws;
    const bf16* P = (const bf16*)(ws + WS_P); bf16* Y = (bf16*)(ws + WS_Y);
    const int r0 = 64 * u, s0 = r0 & (SEQ - 1), half = u & 1, blk0 = r0 & ~127;
#ifndef CONV_REP
#define CONV_REP 0
#endif
#ifndef MIX_MASK
#define MIX_MASK 7
#endif
#ifndef MIX_REP
#define MIX_REP 0
#endif
    f32x4 cva[8], cvb[8]; TrJob cja, cjb; const int cvi = cvt0 + u * 8 + w; constexpr int CVS = (M / 64) * 8;
    for (int mrep = 0; mrep < 1 + (MIX_REP & 1); ++mrep) if (MIX_MASK & 1) { constexpr int AIN = 0, YPL = 40448, YST = 528;
      const int g = w >> 1, th = w & 1, fr = lane & 15, fq = lane >> 4;
      u32x4 st[5];
#pragma unroll
      for (int i = 0; i < 5; ++i) { const int idx = tid + 512 * i, rr = idx >> 5, ch = idx & 31, pos = s0 - 15 + rr; st[i] = (u32x4){0u, 0u, 0u, 0u};
          if (idx < 79 * 32 && pos >= 0) st[i] = *(const u32x4*)(P + (size_t)(r0 - 15 + rr) * DIN + ch * 8); }
      const bf16* wt = (const bf16*)(ws + WS_POOLWT) + (size_t)(layer * 4 + g) * 64 * 64; const float* sc = in[4] + layer * DPOOL + g * 64;
      bf16x8 Bf[2][4]; f32x4 sc4[4];
#pragma unroll
      for (int ks = 0; ks < 2; ++ks)
#pragma unroll
          for (int nt = 0; nt < 4; ++nt) Bf[ks][nt] = *(const bf16x8*)(wt + (nt * 16 + fr) * 64 + ks * 32 + 8 * fq);
#pragma unroll
      for (int nt = 0; nt < 4; ++nt) sc4[nt] = *(const f32x4*)(sc + nt * 16 + 4 * fq);
      if (MIX_CVT >= 2 && mrep == 0) { asm volatile("" ::: "memory"); cja = tr_decode(in, ws, cvi); tr_load(cja, cva, lane, 0); cjb = tr_decode(in, ws, cvi + CVS); tr_load(cjb, cvb, lane, 0); asm volatile("" ::: "memory"); }
#pragma unroll
      for (int i = 0; i < 5; ++i) { const int idx = tid + 512 * i; if (idx < 79 * 32) *(LAS u32x4*)(lds + AIN + (idx >> 5) * 512 + (idx & 31) * 16) = st[i]; }
      LDS_BARRIER();
      { const int p = tid & 127, rq = tid >> 7, gp = p >> 5, win = 2 << gp; float S0 = 0.f, S1 = 0.f;
        for (int j = 1; j < win; ++j) { const unsigned a = *(const LAS unsigned*)(lds + AIN + (16 * rq + 15 - j) * 512 + p * 4); S0 += bf_lo(a); S1 += bf_hi(a); }
#pragma unroll 4
        for (int t = 0; t < 16; ++t) { const int lt = 16 * rq + t, rr = lt + 15; const unsigned a = *(const LAS unsigned*)(lds + AIN + rr * 512 + p * 4); const float a0 = bf_lo(a), a1 = bf_hi(a);
            S0 += a0; S1 += a1; const int pos1 = s0 + lt + 1; const float rn = __builtin_amdgcn_rcpf((float)(pos1 < win ? pos1 : win));
            *(LAS unsigned*)(lds + YPL + lt * YST + p * 4) = cvt_pk_bf16(S0 * rn - a0, S1 * rn - a1);
            const unsigned o = *(const LAS unsigned*)(lds + AIN + (rr - win + 1) * 512 + p * 4); S0 -= bf_lo(o); S1 -= bf_hi(o); } }
      LDS_BARRIER();
      for (int prep = 0; prep < 1 + ((CONV_REP >> 3) & 1); ++prep) { f32x4 acc[2][4];
#pragma unroll
        for (int a = 0; a < 2; ++a)
#pragma unroll
            for (int b = 0; b < 4; ++b) acc[a][b] = (f32x4){0.f, 0.f, 0.f, 0.f};
#pragma unroll
        for (int ks = 0; ks < 2; ++ks) { bf16x8 A[2];
#pragma unroll
            for (int mt = 0; mt < 2; ++mt) A[mt] = *(const LAS bf16x8*)(lds + YPL + ((2 * th + mt) * 16 + fr) * YST + (g * 64 + ks * 32 + 8 * fq) * 2);
#pragma unroll
            for (int mt = 0; mt < 2; ++mt)
#pragma unroll
                for (int nt = 0; nt < 4; ++nt) acc[mt][nt] = __builtin_amdgcn_mfma_f32_16x16x32_bf16(Bf[ks][nt], A[mt], acc[mt][nt], 0, 0, 0); }
#pragma unroll
        for (int mt = 0; mt < 2; ++mt)
#pragma unroll
            for (int nt = 0; nt < 4; ++nt) { const int t = r0 + (2 * th + mt) * 16 + fr, d = nt * 16 + 4 * fq; const f32x4 v = acc[mt][nt] * sc4[nt];
                u32x2 o; o.x = cvt_pk_bf16(v[0], v[1]); o.y = cvt_pk_bf16(v[2], v[3]); if (WT_MASK & 1) st8_wt(Y, (unsigned)((t * D + g * 64 + d) * 2), o); else *(u32x2*)(Y + (size_t)t * D + g * 64 + d) = o; } }
      LDS_BARRIER(); }
    asm volatile("" : "+v"(tid)); lane = tid & 63;
    for (int mrep = 0; mrep < 1 + ((MIX_REP >> 1) & 1); ++mrep) if (MIX_MASK & 2) { constexpr int VN = 0, VST = 800; const int nj = half ? 128 : 64, nks = nj >> 5;
      const int h = w & 3, ih = w >> 2, fr = lane & 15, fq = lane >> 4, q4 = (lane & 15) >> 2, p4 = lane & 3;
      const bf16* wsb = (const bf16*)(ws + WS_GMWS) + (size_t)(layer * 4 + h) * 128 * 128;
      const float* gg = in[5] + layer * DGM; const float* bb = in[7] + (size_t)(layer * 4 + h) * 128;
      u32x4 raw[16]; const int nr = nj >> 3;
#pragma unroll
      for (int i = 0; i < 16; ++i) { raw[i] = (u32x4){0u, 0u, 0u, 0u}; if (i < nr && lane < 48) raw[i] = *(const u32x4*)(P + (size_t)(blk0 + i * 8 + w) * DIN + 640 + lane * 8); }
      bf16x8 Aw[4][2]; f32x4 g4[6]; float bi[2];
#pragma unroll
      for (int ks = 0; ks < 4; ++ks)
#pragma unroll
          for (int mt = 0; mt < 2; ++mt) { Aw[ks][mt] = (bf16x8){0, 0, 0, 0, 0, 0, 0, 0}; if (ks < nks) Aw[ks][mt] = *(const bf16x8*)(wsb + (size_t)(half * 64 + (2 * ih + mt) * 16 + fr) * 128 + ks * 32 + 8 * fq); }
#pragma unroll
      for (int ct = 0; ct < 6; ++ct) g4[ct] = *(const f32x4*)(gg + h * 96 + ct * 16 + 4 * fq);
#pragma unroll
      for (int mt = 0; mt < 2; ++mt) bi[mt] = bb[half * 64 + (2 * ih + mt) * 16 + fr];
#pragma unroll
      for (int i = 0; i < 16; ++i) { if (i < nr) { float f[8]; unpack8(raw[i], f); float s = 0.f;
#pragma unroll
              for (int q = 0; q < 8; ++q) s += f[q] * f[q];
              s = wave_sum(s); const float rs = 1.0f / sqrtf(s * (1.0f / DGM) + EPS);
              u32x4 o; o.x = cvt_pk_bf16(f[0] * rs, f[1] * rs); o.y = cvt_pk_bf16(f[2] * rs, f[3] * rs); o.z = cvt_pk_bf16(f[4] * rs, f[5] * rs); o.w = cvt_pk_bf16(f[6] * rs, f[7] * rs);
              if (lane < 48) *(LAS u32x4*)(lds + VN + (i * 8 + w) * VST + lane * 16) = o; } }
      u32x2 uu[2][6];
#pragma unroll
      for (int mt = 0; mt < 2; ++mt)
#pragma unroll
          for (int ct = 0; ct < 6; ++ct) uu[mt][ct] = *(const u32x2*)(P + (size_t)(r0 + (2 * ih + mt) * 16 + fr) * DIN + 256 + h * 96 + ct * 16 + 4 * fq);
      LDS_BARRIER();
      { f32x4 acc[2][6];
#pragma unroll
        for (int a = 0; a < 2; ++a)
#pragma unroll
            for (int b = 0; b < 6; ++b) acc[a][b] = (f32x4){0.f, 0.f, 0.f, 0.f};
#pragma unroll
        for (int ks = 0; ks < 4; ++ks) { if (ks < nks) {
#pragma unroll
            for (int ct = 0; ct < 6; ++ct) { const unsigned ad = VN + (32 * ks + 8 * fq + q4) * VST + (h * 96 + ct * 16 + 4 * p4) * 2;
                const s16x4 t0 = __builtin_amdgcn_ds_read_tr16_b64_v4i16((LAS s16x4*)(lds + ad)), t1 = __builtin_amdgcn_ds_read_tr16_b64_v4i16((LAS s16x4*)(lds + ad + 4 * VST));
                bf16x8 B; B[0] = t0[0]; B[1] = t0[1]; B[2] = t0[2]; B[3] = t0[3]; B[4] = t1[0]; B[5] = t1[1]; B[6] = t1[2]; B[7] = t1[3];
#pragma unroll
                for (int mt = 0; mt < 2; ++mt) acc[mt][ct] = __builtin_amdgcn_mfma_f32_16x16x32_bf16(B, Aw[ks][mt], acc[mt][ct], 0, 0, 0); } } }
#pragma unroll
        for (int mt = 0; mt < 2; ++mt) { const int t = r0 + (2 * ih + mt) * 16 + fr;
#pragma unroll
            for (int ct = 0; ct < 6; ++ct) { const int c4 = h * 96 + ct * 16 + 4 * fq; const f32x4 z = acc[mt][ct] * g4[ct] + bi[mt]; const u32x2 uv = uu[mt][ct];
                u32x2 o; o.x = cvt_pk_bf16(bf_lo(uv.x) * z[0], bf_hi(uv.x) * z[1]); o.y = cvt_pk_bf16(bf_lo(uv.y) * z[2], bf_hi(uv.y) * z[3]); if (WT_MASK & 1) st8_wt(Y, (unsigned)((t * D + 256 + c4) * 2), o); else *(u32x2*)(Y + (size_t)t * D + 256 + c4) = o; } } }
      LDS_BARRIER(); }
    if (MIX_CVT >= 2) { tr_store(cja, cva, nullptr, lane, 0); tr_store(cjb, cvb, nullptr, lane, 0); }
    asm volatile("" : "+v"(tid)); lane = tid & 63;
    for (int mrep = 0; mrep < 1 + ((MIX_REP >> 2) & 1); ++mrep) if (MIX_MASK & 4) { constexpr int HC = 0, TT = 72192, TST = 784;
      { const char* dwsrc = (const char*)(in[8] + (size_t)layer * 31 * DCV);
#pragma unroll
        for (int i = 0; i < 6; ++i) { const int c = i * 8 + w; if (c * 1024 + lane * 16 < 31 * DCV * 4) __builtin_amdgcn_global_load_lds((const unsigned*)(dwsrc + c * 1024 + lane * 16), (LAS unsigned*)(lds + TT + c * 1024), 16, 0, 0); } }
      for (int crep = 0; crep < 1 + (CONV_REP & 1); ++crep) { u32x4 cvr[9], cgr[9];
#pragma unroll
        for (int i = 0; i < 9; ++i) { const int idx = tid + 512 * i, rr = idx / 48, ch = idx % 48, pos = s0 - 30 + rr; cvr[i] = (u32x4){0u, 0u, 0u, 0u}; cgr[i] = (u32x4){0u, 0u, 0u, 0u};
            if (idx < 94 * 48 && pos >= 0) { const bf16* pr = P + (size_t)(r0 - 30 + rr) * DIN; cvr[i] = *(const u32x4*)(pr + 1024 + ch * 8); cgr[i] = *(const u32x4*)(pr + 1408 + ch * 8); } }
        if (MIX_CVT >= 4 && mrep == 0 && crep == 0) { asm volatile("" ::: "memory"); cja = tr_decode(in, ws, cvi + 2 * CVS); tr_load(cja, cva, lane, 0); cjb = tr_decode(in, ws, cvi + 3 * CVS); tr_load(cjb, cvb, lane, 0); asm volatile("" ::: "memory"); }
#pragma unroll
        for (int i = 0; i < 9; ++i) { const int idx = tid + 512 * i, rr = idx / 48, ch = idx % 48; float a[8], b[8]; unpack8(cvr[i], a); unpack8(cgr[i], b);
#pragma unroll
            for (int q = 0; q < 8; ++q) a[q] *= fast_sigmoid(b[q]);
            u32x4 o; o.x = cvt_pk_bf16(a[0], a[1]); o.y = cvt_pk_bf16(a[2], a[3]); o.z = cvt_pk_bf16(a[4], a[5]); o.w = cvt_pk_bf16(a[6], a[7]);
            if (idx < 94 * 48) *(LAS u32x4*)(lds + HC + rr * 768 + ch * 16) = o; } }
      asm volatile("s_waitcnt vmcnt(0)" ::: "memory");
      LDS_BARRIER();
      asm volatile("" : "+v"(tid)); lane = tid & 63;
      const int fr = lane & 15, fq = lane >> 4; const bf16* pw = (const bf16*)(ws + WS_PWT) + (size_t)layer * DCV * DCV;
      bf16x8 Bp[4][3], Bq[8][3];
      for (int crep = 0; crep < 1 + ((CONV_REP >> 1) & 1); ++crep) { const float* dwb = in[9] + layer * DCV; const float* lg = in[10] + layer * DCV; const float* lb = in[11] + layer * DCV;
        f32x2 g2[3], bt2[3];
#pragma unroll
        for (int q = 0; q < 3; ++q) { g2[q] = *(const f32x2*)(lg + 128 * q + 2 * lane); bt2[q] = *(const f32x2*)(lb + 128 * q + 2 * lane); }
        float dd[8][6];
#pragma unroll
        for (int q = 0; q < 3; ++q) { const int c = 128 * q + 2 * lane; f32x2 wj[31];
#pragma unroll
            for (int j = 0; j < 31; ++j) wj[j] = *(const LAS f32x2*)(lds + TT + (j * DCV + c) * 4);
            const f32x2 b2 = *(const f32x2*)(dwb + c); f32x2 a2[8];
#pragma unroll
            for (int r = 0; r < 8; ++r) a2[r] = b2;
#pragma unroll
            for (int s = 0; s < 38; ++s) { const unsigned hv = *(const LAS unsigned*)(lds + HC + (8 * w + s) * 768 + c * 2); const f32x2 h2 = (f32x2){bf_lo(hv), bf_hi(hv)};
#pragma unroll
                for (int r = 0; r < 8; ++r) { const int j = s - r; if (j >= 0 && j <= 30) a2[r] = __builtin_elementwise_fma(h2, wj[j], a2[r]); } }
#pragma unroll
            for (int r = 0; r < 8; ++r) { dd[r][2 * q] = a2[r][0]; dd[r][2 * q + 1] = a2[r][1]; asm volatile("" : "+v"(dd[r][2 * q]), "+v"(dd[r][2 * q + 1])); }
            asm volatile("" ::: "memory"); }
#pragma unroll
        for (int ks = 0; ks < 4; ++ks)
#pragma unroll
            for (int nt = 0; nt < 3; ++nt) Bp[ks][nt] = *(const bf16x8*)(pw + (size_t)((3 * w + nt) * 16 + fr) * DCV + ks * 32 + 8 * fq);
#pragma unroll
        for (int ks = 0; ks < 8; ++ks)
#pragma unroll
            for (int nt = 0; nt < 3; ++nt) Bq[ks][nt] = *(const bf16x8*)(pw + (size_t)((3 * w + nt) * 16 + fr) * DCV + (4 + ks) * 32 + 8 * fq);
        LDS_BARRIER();
#pragma unroll
        for (int r = 0; r < 8; ++r) { float s = 0.f, v = 0.f;
#pragma unroll
            for (int q = 0; q < 6; ++q) { s += dd[r][q]; v += dd[r][q] * dd[r][q]; }
            const float mu = wave_sum(s) * (1.0f / DCV), ex2 = wave_sum(v) * (1.0f / DCV);
#pragma unroll
            for (int q = 0; q < 6; ++q) dd[r][q] -= mu;
            const float rs = 1.0f / sqrtf(fmaxf(ex2 - mu * mu, 0.f) + EPS);
#pragma unroll
            for (int q = 0; q < 3; ++q) { float y0 = dd[r][2 * q] * rs * g2[q][0] + bt2[q][0], y1 = dd[r][2 * q + 1] * rs * g2[q][1] + bt2[q][1]; y0 *= fast_sigmoid(y0); y1 *= fast_sigmoid(y1);
                *(LAS unsigned*)(lds + TT + (8 * w + r) * TST + (128 * q + 2 * lane) * 2) = cvt_pk_bf16(y0, y1); } } }
      LDS_BARRIER();
      for (int crep = 0; crep < 1 + ((CONV_REP >> 2) & 1); ++crep) { f32x4 acc[4][3];
#pragma unroll
        for (int a = 0; a < 4; ++a)
#pragma unroll
            for (int b = 0; b < 3; ++b) acc[a][b] = (f32x4){0.f, 0.f, 0.f, 0.f};
        const f32x4* pb4 = (const f32x4*)(in[13] + layer * DCV); f32x4 pbv[3];
#pragma unroll
        for (int nt = 0; nt < 3; ++nt) pbv[nt] = pb4[(3 * w + nt) * 4 + fq];
#pragma unroll
        for (int ks = 0; ks < 12; ++ks) { bf16x8 A[4];
#pragma unroll
            for (int mt = 0; mt < 4; ++mt) A[mt] = *(const LAS bf16x8*)(lds + TT + (mt * 16 + fr) * TST + (ks * 32 + 8 * fq) * 2);
#pragma unroll
            for (int mt = 0; mt < 4; ++mt)
#pragma unroll
                for (int nt = 0; nt < 3; ++nt) acc[mt][nt] = __builtin_amdgcn_mfma_f32_16x16x32_bf16(ks < 4 ? Bp[ks & 3][nt] : Bq[(ks - 4) & 7][nt], A[mt], acc[mt][nt], 0, 0, 0); }
#pragma unroll
        for (int mt = 0; mt < 4; ++mt)
#pragma unroll
            for (int nt = 0; nt < 3; ++nt) { const int t = r0 + mt * 16 + fr, n4 = (3 * w + nt) * 16 + 4 * fq; const f32x4 v = acc[mt][nt] + pbv[nt];
                u32x2 o; o.x = cvt_pk_bf16(v[0], v[1]); o.y = cvt_pk_bf16(v[2], v[3]); if (WT_MASK & 1) st8_wt(Y, (unsigned)((t * D + 640 + n4) * 2), o); else *(u32x2*)(Y + (size_t)t * D + 640 + n4) = o; } }
      LDS_BARRIER(); }
    if (MIX_CVT >= 4) { tr_store(cja, cva, nullptr, lane, 0); tr_store(cjb, cvb, nullptr, lane, 0); }
}

__device__ __forceinline__ void router_phase(Frame& F) {
    LAS unsigned char* lds = F.lds; int lane = F.lane; asm volatile("" : "+v"(lane)); const int w = F.wave; unsigned char* ws = F.ws;
    const InTab in = in_tab(F); const bf16* XBr = (const bf16*)(ws + WS_XB); const float* g2 = in[15] + D; const float* R = in[19];
    unsigned* rowoff = (unsigned*)(ws + WS_ROWOFF); float* rs_e = (float*)(ws + WS_RS); float* gate_e = (float*)(ws + WS_GATE); int* sel = (int*)(ws + WS_SEL);
    unsigned* cnt = F.ctl + CW_CNT;
    LAS int* se0 = (LAS int*)lds; LAS int* se1 = se0 + 64; LAS float* sw0 = (LAS float*)(se1 + 64); LAS float* sw1 = sw0 + 64; LAS float* srs = sw1 + 64;
    float Rg[4][4][8];
#pragma unroll
    for (int j = 0; j < 4; ++j)
#pragma unroll
        for (int q = 0; q < 4; ++q) { const int k = 8 * lane + 512 * (j >> 1) + 4 * (j & 1) + q; const float gk = g2[k]; const f32x4 a = *(const f32x4*)(R + k * 8), b = *(const f32x4*)(R + k * 8 + 4);
            Rg[j][q][0] = a[0] * gk; Rg[j][q][1] = a[1] * gk; Rg[j][q][2] = a[2] * gk; Rg[j][q][3] = a[3] * gk; Rg[j][q][4] = b[0] * gk; Rg[j][q][5] = b[1] * gk; Rg[j][q][6] = b[2] * gk; Rg[j][q][7] = b[3] * gk; }
    for (int b = F.vcu; b < M / 64; b += F.G) {
        f32x4 cva[8], cvb[8]; TrJob cja, cjb; const int cvi = R9_BEG + b * 8 + w;
        if (R9_CVT >= 2) { cja = tr_decode(in, ws, cvi); tr_load(cja, cva, lane, 0); cjb = tr_decode(in, ws, cvi + (M / 64) * 8); tr_load(cjb, cvb, lane, 0); }
        for (int i = 0; i < 8; ++i) { const int tl = 8 * w + i, t = 64 * b + tl; const u32x4* xr = (const u32x4*)(XBr + (size_t)t * D) + lane; float ss = 0.f, le[8];
#pragma unroll
            for (int e = 0; e < 8; ++e) le[e] = 0.f;
            const u32x4 xa = xr[0], xb2 = xr[64]; u32x2 qa, qb;
#pragma unroll
            for (int j = 0; j < 4; ++j) { const u32x4 xw = (j < 2) ? xa : xb2; const unsigned w0_ = (j & 1) ? xw.z : xw.x, w1_ = (j & 1) ? xw.w : xw.y; const f32x4 v = (f32x4){bf_lo(w0_), bf_hi(w0_), bf_lo(w1_), bf_hi(w1_)};
#pragma unroll
                for (int q = 0; q < 4; ++q) { ss += v[q] * v[q];
#pragma unroll
                    for (int e = 0; e < 8; ++e) le[e] += v[q] * Rg[j][q][e]; }
                const unsigned p8 = cvt4_fp8(v[0], v[1], v[2], v[3]); if (j == 0) qa.x = p8; else if (j == 1) qa.y = p8; else if (j == 2) qb.x = p8; else qb.y = p8; }
            { u32x2* xq = (u32x2*)(ws + WS_XQ + (size_t)t * D) + lane; xq[0] = qa; xq[64] = qb; }
            ss = wave_sum(ss);
#pragma unroll
            for (int e = 0; e < 8; ++e) le[e] = wave_sum(le[e]);
            const float rs = 1.0f / sqrtf(ss * (1.0f / D) + EPS);
            int i0 = 0; float l0 = le[0];
#pragma unroll
            for (int e = 1; e < 8; ++e) if (le[e] > l0) { l0 = le[e]; i0 = e; }
            int i1 = -1; float l1 = -3.0e38f;
#pragma unroll
            for (int e = 0; e < 8; ++e) if (e != i0 && le[e] > l1) { l1 = le[e]; i1 = e; }
            const float ex = expf((l1 - l0) * rs), w0 = 1.0f / (1.0f + ex), w1 = ex / (1.0f + ex);
            if (lane == 0) { se0[tl] = i0; se1[tl] = i1; sw0[tl] = w0; sw1[tl] = w1; srs[tl] = rs; } }
        __syncthreads();
        if (w == 0) { const int e0 = se0[lane], e1 = se1[lane]; int r0 = 0, r1 = 0; const unsigned long long lt = (1ull << lane) - 1ull;
            int l0 = 0, l1 = 0, nmine = 0;
#pragma unroll
            for (int e = 0; e < 8; ++e) { const unsigned long long m0 = __ballot(e0 == e), m1 = __ballot(e1 == e); const int n0 = __popcll(m0), n = n0 + __popcll(m1);
                if (e0 == e) l0 = __popcll(m0 & lt);
                if (e1 == e) l1 = n0 + __popcll(m1 & lt);
                nmine = (lane == e) ? n : nmine; }
            unsigned base = 0u;
            if (lane < 8 && nmine > 0) base = __hip_atomic_fetch_add(cnt + 64 * lane, (unsigned)nmine, RLX_AGENT);
            r0 = (int)__shfl(base, e0) + l0; r1 = (int)__shfl(base, e1) + l1;
            const int t = 64 * b + lane; const float rs = srs[lane];
            rowoff[e0 * ECAP + r0] = (unsigned)t * (unsigned)D; rs_e[e0 * ECAP + r0] = rs; gate_e[e0 * ECAP + r0] = sw0[lane];
            rowoff[e1 * ECAP + r1] = (unsigned)t * (unsigned)D; rs_e[e1 * ECAP + r1] = rs; gate_e[e1 * ECAP + r1] = sw1[lane];
            *(int4*)(sel + 4 * t) = make_int4(e0, r0, e1, r1); }
        if (R9_CVT >= 2) { tr_store(cja, cva, nullptr, lane, 0); tr_store(cjb, cvb, nullptr, lane, 0); }
        __syncthreads();
    }
}
__device__ __forceinline__ void moe_panels(Frame& F, int (&pb)[9]) {
    unsigned* cnt = F.ctl + CW_CNT; pb[0] = 0;
#pragma unroll
    for (int e = 0; e < 8; ++e) { const unsigned c = (unsigned)__builtin_amdgcn_readfirstlane(__hip_atomic_load(cnt + 64 * e, RLX_AGENT)); pb[e + 1] = pb[e] + (int)((c + 255u) >> 8); }
}
__device__ __forceinline__ void final_phase(Frame& F) {
    int pb[9]; moe_panels(F, pb);
    const int total = pb[8] * 4, nfull = (total / F.G) * F.G, NPf = nfull / 4, sp = pg8::moe_split(total - nfull, F.G); const bf16* slabs = (const bf16*)(F.ws + WS_SLAB);
    int lane = F.lane; asm volatile("" : "+v"(lane));
    const int gw = F.vcu * 8 + F.wave, NGW = F.G * 8; unsigned char* ws = F.ws;
    const bf16* YP = (const bf16*)(ws + WS_YP); const int* sel = (const int*)(ws + WS_SEL); const float* fg = in_tab(F)[23]; float* X = F.out; const bf16* XBf = (const bf16*)(ws + WS_XB2);
    f32x4 g4[4];
#pragma unroll
    for (int j = 0; j < 4; ++j) g4[j] = *((const f32x4*)fg + lane + 64 * j);
    for (int t = gw; t < M; t += NGW) { const int4 s = *(const int4*)(sel + 4 * t); int b0 = 0, b1 = 0;
#pragma unroll
        for (int e = 0; e < 8; ++e) { b0 = (s.x == e) ? pb[e] : b0; b1 = (s.z == e) ? pb[e] : b1; }
        const int pr[2] = {256 * b0 + s.y, 256 * b1 + s.w};
        const u32x2* xr = (const u32x2*)(XBf + (size_t)t * D) + lane;
        f32x4 v[4];
#pragma unroll
        for (int j = 0; j < 4; ++j) { const u32x2 a = xr[64 * j]; v[j] = (f32x4){bf_lo(a.x), bf_hi(a.x), bf_lo(a.y), bf_hi(a.y)}; }
#pragma unroll
        for (int k = 0; k < 2; ++k) { const int pm = pr[k] >> 8, lr = pr[k] & 255;
            if (sp > 1 && pm >= NPf) {
#pragma unroll
                for (int j = 0; j < 4; ++j) { const bf16* sb = slabs + (size_t)(((pm - NPf) * 4 + j) * sp) * 65536 + lr * 256 + 4 * lane; u32x2 a[14];
#pragma unroll
                    for (int ks = 0; ks < 14; ++ks) { a[ks] = (u32x2){0u, 0u}; if (ks < sp) a[ks] = *(const u32x2*)(sb + (size_t)ks * 65536); }
#pragma unroll
                    for (int ks = 0; ks < 14; ++ks) { v[j][0] += bf_lo(a[ks].x); v[j][1] += bf_hi(a[ks].x); v[j][2] += bf_lo(a[ks].y); v[j][3] += bf_hi(a[ks].y); } }
            } else { const u32x2* y = (const u32x2*)(YP + (size_t)pr[k] * D) + lane;
#pragma unroll
                for (int j = 0; j < 4; ++j) { const u32x2 a = __builtin_nontemporal_load(y + 64 * j); v[j][0] += bf_lo(a.x); v[j][1] += bf_hi(a.x); v[j][2] += bf_lo(a.y); v[j][3] += bf_hi(a.y); } } }
        float ss = 0.f;
#pragma unroll
        for (int j = 0; j < 4; ++j) ss += (v[j][0] * v[j][0] + v[j][1] * v[j][1]) + (v[j][2] * v[j][2] + v[j][3] * v[j][3]);
        ss = wave_sum(ss); const float rs = 1.0f / sqrtf(ss * (1.0f / D) + EPS);
        f32x4* o = (f32x4*)(X + (size_t)t * D) + lane;
#pragma unroll
        for (int j = 0; j < 4; ++j) __builtin_nontemporal_store(v[j] * rs * g4[j], o + 64 * j); }
}

template <class Sched> __device__ __forceinline__ void stage_rstd(Frame& F, const Sched& S, const float* ssq, LAS float* rtab) {
    pg8::Unit u; int tid = F.tid; asm volatile("" : "+v"(tid)); __syncthreads();
#pragma unroll 1
    for (int i = 0; i < 8 && S.next(i, u); ++i) if (tid < 256) rtab[i * 256 + tid] = pg8::rstd_of(ssq, u.pm * 256 + tid);
    __syncthreads();
}
struct Args { const float* in[24]; float* out; unsigned char* ws; int ph_lo, ph_hi, li, pad; };
__global__ void __launch_bounds__(512, 2) fwd(Args args) {
    extern __shared__ __attribute__((aligned(16))) unsigned char lds_raw[];
    Frame F;
    F.lds = (LAS unsigned char*)lds_raw; F.MISC = (volatile LAS unsigned*)(F.lds + MISC_OFF);
    F.tid = threadIdx.x; F.lane = F.tid & 63; F.wave = __builtin_amdgcn_readfirstlane(F.tid >> 6);
    F.G = gridDim.x; { const int bx = blockIdx.x; F.vcu = (F.G % 8 == 0) ? (bx % 8) * (F.G / 8) + bx / 8 : bx; }
    F.in.t = (const LAS unsigned long long*)(F.lds + INTAB_OFF); F.out = args.out; F.ws = args.ws; F.ctl = (unsigned*)(args.ws + WS_CTL);
    for (int u = F.tid; u < 64; u += 512) ((LAS unsigned*)(F.lds + MISC_OFF))[u] = 0u;
    if (F.tid < 24) ((LAS unsigned long long*)(F.lds + INTAB_OFF))[F.tid] = (unsigned long long)args.in[F.tid];
    __syncthreads();
    jobs_setup(F);
    XcdBarrier bar = xcd_barrier_post(F.ctl + CW_BAR + args.li * XCD_BAR_WORDS, F.MISC + 8);
    const int lo = args.ph_lo, hi = args.ph_hi;
#ifndef PH_MASK
#define PH_MASK 0xFFFF
#endif
#define PH_ON(k) (((PH_MASK) >> (k)) & 1)
#ifndef REP_MASK
#define REP_MASK 0
#endif
#define REPS(k) (1 + (((REP_MASK) >> (k)) & 1))
#ifndef PRO_PROBE
#define PRO_PROBE 0
#endif
#ifndef CVT_BEFORE
#define CVT_BEFORE 0
#endif
#ifndef EPI_PROBE
#define EPI_PROBE 0
#endif
#define IN(k) (lo <= (k) && (k) < hi)
#define SEAM(k) do { if (IN(k) && IN((k) + 1)) xcd_barrier(bar); } while (0)
#define SEAMH(k, first) do { if (IN(k) && IN((k) + 1)) xcd_barrier_host(bar, F, (first)); } while (0)
    unsigned char* ws = args.ws; LAS unsigned* gtab = (LAS unsigned*)(F.lds + GTAB_OFF);
    bf16* XB = (bf16*)(ws + WS_XB); float* ssq = (float*)(ws + WS_SSQ);
    if (F.G != 256) return;

    if (PH_ON(0) && IN(0)) for (int rep = 0; rep < REPS(0); ++rep) { p0_prologue(F, rep == 0 ? 0 : PRO_PROBE); __syncthreads(); }
    SEAMH(0, 0);
#pragma unroll 1
    for (int layer = 0; layer < 2; ++layer) {
        const int pbase = 1 + layer * 5;
        if (PH_ON(1) && IN(pbase)) for (int rep = 0; rep < REPS(1); ++rep) { pg8::Gemm g{XB, (const bf16*)(ws + WS_WIN) + (size_t)layer * DIN * D, D, 0}; pg8::StaticOrder S; S.init(M, DIN, F.G, (int)blockIdx.x);
            stage_rstd(F, S, ssq, (LAS float*)gtab); pg8::EpiP E{(bf16*)(ws + WS_P), DIN, (const LAS float*)gtab}; pg8::gemm_phase<pg8::EpiP, pg8::StaticOrder, true, true>(F.lds, gtab, g, S, E);
            if (rep == 0) tail_convert(F, layer ? H6_BEG : H1_BEG, H1_N, (int)blockIdx.x - 192, 64); }
        SEAMH(pbase, layer == 0 ? 1 : -1);
        if (PH_ON(2) && IN(pbase + 1)) for (int rep = 0; rep < REPS(2); ++rep) { for (int u = F.vcu; u < M / 64; u += F.G) mixer_unit(F, u, layer, layer ? MX1_BEG : MX0_BEG); }
        SEAMH(pbase + 1, layer == 0 ? 2 : -1);
        if (PH_ON(3) && IN(pbase + 2)) for (int rep = 0; rep < (layer == 0 ? REPS(3) : 1); ++rep) { pg8::Gemm g{(const bf16*)(ws + WS_Y), (const bf16*)(ws + WS_WOUT) + (size_t)layer * D * D, D, 0}; pg8::StaticOrder S; S.init(M, D, F.G, (int)blockIdx.x);
            pg8::EpiResid E{(const float*)nullptr, XB, ssq}; pg8::gemm_phase<pg8::EpiResid, pg8::StaticOrder, false, true>(F.lds, gtab, g, S, E); }
        SEAMH(pbase + 2, layer == 0 ? 3 : -1);
        if (layer == 0) {
            if (PH_ON(4) && IN(4)) for (int rep = 0; rep < REPS(4); ++rep) { pg8::Gemm g{XB, (const bf16*)(ws + WS_WGU), D, 0}; pg8::StaticOrder S; S.init(M, NGU, F.G, (int)blockIdx.x);
                stage_rstd(F, S, ssq, (LAS float*)gtab); pg8::EpiSwiglu<false> E{(bf16*)(ws + WS_ACT), DFF, (const LAS float*)gtab, 0, 1.0f}; pg8::gemm_phase<pg8::EpiSwiglu<false>, pg8::StaticOrder, true, true>(F.lds, gtab, g, S, E);
                if (rep == 0) tail_convert(F, H4_BEG, H4_N, (int)blockIdx.x - 128, 128); }
            SEAMH(4, 4);
            if (PH_ON(5) && IN(5)) { pg8::Gemm g{(const bf16*)(ws + WS_ACT), (const bf16*)(ws + WS_WD), DFF, 0}; pg8::StaticOrder S; S.init(M, D, F.G, (int)blockIdx.x);
                pg8::EpiResid E{(const float*)nullptr, XB, ssq}; pg8::gemm_phase<pg8::EpiResid, pg8::StaticOrder, false, true>(F.lds, gtab, g, S, E); }
            SEAMH(5, 5);
        }
    }
    if (PH_ON(9) && IN(9)) router_phase(F);
    SEAM(9);
#ifndef STAGGER_US
#define STAGGER_US 0
#endif
    if (PH_ON(10) && IN(10)) for (int rep = 0; rep < REPS(10); ++rep) {
        if (STAGGER_US > 0 && (blockIdx.x & 1)) { const unsigned long long t0 = __builtin_amdgcn_s_memrealtime(); while (__builtin_amdgcn_s_memrealtime() - t0 < (unsigned long long)(STAGGER_US * 100)) __builtin_amdgcn_s_sleep(8); __syncthreads(); }
        pg8::MoeOrderGather S; moe_panels(F, S.pb); S.nN = NGUE / 256; S.nwg = S.pb[8] * S.nN; S.G = F.G; S.c = (int)blockIdx.x; S.rowoff = (const unsigned*)(ws + WS_ROWOFF); S.rs_e = (const float*)(ws + WS_RS); S.gate_e = (const float*)(ws + WS_GATE);
        pg8::Gemm g{(const bf16*)(ws + WS_XQ), (const bf16*)(ws + WS_MOE_WGU), D / 2, (size_t)NGUE * D / 2};
        pg8::EpiSwiglu<true> E{(bf16*)(ws + WS_ACTM), DFE, (const LAS float*)(gtab + 512), rep == 0 ? 0 : EPI_PROBE, 1.0f / W8_GU};
        pg8::gemm_phase<pg8::EpiSwiglu<true>, pg8::MoeOrderGather, true, true, true>(F.lds, gtab, g, S, E);
        if (rep == 0) { const int rem = S.nwg % F.G, idle = rem ? F.G - rem : 0, nconv = idle < 48 ? F.G : (idle > 192 ? 192 : idle);
            tail_convert(F, H10_BEG, H10_N, ((int)blockIdx.x - rem + F.G) % F.G, nconv); } }
    SEAM(10);
    if (PH_ON(11) && IN(11)) for (int rep = 0; rep < REPS(11); ++rep) { pg8::MoeOrderDown S; moe_panels(F, S.pb); S.init(F.G, (int)blockIdx.x);
        pg8::Gemm g{(const bf16*)(ws + WS_ACTM), (const bf16*)(ws + WS_MOE_WD), DFE / 2, (size_t)D * DFE / 2};
        pg8::EpiBf16 E{(bf16*)(ws + WS_YP), D, (bf16*)(ws + WS_SLAB), 1.0f / W8_D};
        pg8::gemm_phase<pg8::EpiBf16, pg8::MoeOrderDown, true, true, true>(F.lds, gtab, g, S, E); }
    SEAM(11);
    if (PH_ON(12) && IN(12)) final_phase(F);
#undef IN
#undef SEAM
}
#ifndef MK_PER_PHASE
#define MK_PER_PHASE 0
#endif
extern "C" void kernel_launch(void* const* d_in, const int* in_sizes, int n_in, void* d_out, int out_size, void* d_ws, size_t ws_size, hipStream_t stream) {
    static int grid = 0;
    if (grid == 0) {
        if (n_in != 24 || out_size != M * D || ws_size < WS_END) { fprintf(stderr, "kernel_launch: unexpected shapes (n_in %d out %d ws %zu)\n", n_in, out_size, ws_size); grid = -1; return; }
        int dev = 0, cus = 0;
        if (hipGetDevice(&dev) != hipSuccess || hipDeviceGetAttribute(&cus, hipDeviceAttributeMultiprocessorCount, dev) != hipSuccess) { grid = -1; return; }
        if (hipFuncSetAttribute((const void*)fwd, hipFuncAttributeMaxDynamicSharedMemorySize, LDS_BYTES) != hipSuccess) { fprintf(stderr, "kernel_launch: hipFuncSetAttribute failed\n"); grid = -1; return; }
        int per_cu = 0;
        if (hipOccupancyMaxActiveBlocksPerMultiprocessor(&per_cu, (const void*)fwd, 512, LDS_BYTES) != hipSuccess || per_cu < 1) fprintf(stderr, "kernel_launch: occupancy query says %d\n", per_cu);
        (void)hipGetLastError();
        grid = cus;
        if (grid != 256) { fprintf(stderr, "kernel_launch: built for 256 CUs, found %d\n", grid); grid = -1; return; }
    }
    if (grid < 0) return;
    (void)hipMemsetAsync((char*)d_ws + WS_CTL, 0, CTL_ZERO_BYTES, stream);
    Args a{};
    for (int i = 0; i < 24; ++i) a.in[i] = (const float*)d_in[i];
    a.out = (float*)d_out; a.ws = (unsigned char*)d_ws; a.pad = 0;
#if MK_PER_PHASE
    for (int p = 0; p < NPHASE; ++p) { a.ph_lo = p; a.ph_hi = p + 1; a.li = p; hipLaunchKernelGGL(fwd, dim3(grid), dim3(512), LDS_BYTES, stream, a); }
#else
    a.ph_lo = 0; a.ph_hi = NPHASE; a.li = 0; hipLaunchKernelGGL(fwd, dim3(grid), dim3(512), LDS_BYTES, stream, a);
#endif
}
```

```cpp
#define MK_PER_PHASE 0
#define PG_WGM 4
#define NT_ACT 0
#define HID_PW 8
#define H10_SHARE 11264
#define SEAM_RELAX 0
#define NT_ACTM 0
#define SB_CVT 2
#include <hip/hip_runtime.h>
#include <cstdio>
#include <cstdint>
constexpr int M = 16384, D = 1024, SEQ = 8192, DIN = 1792, DFF = 2816, DFE = 3584, NE = 8;
constexpr int DPOOL = 256, DGM = 384, DCV = 384;
constexpr int NGU = 2 * DFF, NGUE = 2 * DFE;
constexpr int ECAP = 16384;
constexpr int PMAX = 2 * M + NE * 256;
constexpr float EPS = 1e-6f;

#define LAS __attribute__((address_space(3)))
#define GAS __attribute__((address_space(1)))
typedef unsigned short bf16;
typedef short bf16x8 __attribute__((ext_vector_type(8)));
typedef short s16x4 __attribute__((ext_vector_type(4)));
typedef float f32x4 __attribute__((ext_vector_type(4)));
typedef float f32x2 __attribute__((ext_vector_type(2)));
typedef unsigned u32x4 __attribute__((ext_vector_type(4)));
typedef unsigned u32x2 __attribute__((ext_vector_type(2)));

__device__ __forceinline__ unsigned cvt_pk_bf16(float lo, float hi) { unsigned r; asm volatile("v_cvt_pk_bf16_f32 %0, %1, %2" : "=v"(r) : "v"(lo), "v"(hi)); return r; }
__device__ __forceinline__ int lane_id_v() { int l; asm volatile("v_mbcnt_lo_u32_b32 %0, -1, 0\n\tv_mbcnt_hi_u32_b32 %0, -1, %0" : "=v"(l)); return l; }
typedef int i32x4 __attribute__((ext_vector_type(4)));
typedef int i32x8 __attribute__((ext_vector_type(8)));
__device__ __forceinline__ unsigned cvt4_fp8(float a, float b, float c, float d) { int r = 0; r = __builtin_amdgcn_cvt_pk_fp8_f32(a, b, r, false); r = __builtin_amdgcn_cvt_pk_fp8_f32(c, d, r, true); return (unsigned)r; }
__device__ __forceinline__ i32x8 cat8(const bf16x8 a, const bf16x8 b) { const i32x4 x = __builtin_bit_cast(i32x4, a), y = __builtin_bit_cast(i32x4, b); return __builtin_shufflevector(x, y, 0, 1, 2, 3, 4, 5, 6, 7); }
#ifndef WT_MASK
#define WT_MASK 0
#endif
__device__ __forceinline__ void st16_wt(const void* base, unsigned off, u32x4 w) { asm volatile("s_nop 4\n\tglobal_store_dwordx4 %0, %1, %2 sc1\n\ts_nop 1" :: "v"(off), "v"(w), "s"(base) : "memory"); }
__device__ __forceinline__ void st16_wt_u(const void* base, unsigned off, u32x4 w) {
    const unsigned long long b = (unsigned long long)base; const unsigned lo = __builtin_amdgcn_readfirstlane((unsigned)b), hi = __builtin_amdgcn_readfirstlane((unsigned)(b >> 32));
    st16_wt((const void*)(((unsigned long long)hi << 32) | lo), off, w); }
__device__ __forceinline__ void st8_wt(const void* base, unsigned off, u32x2 w) { asm volatile("s_nop 4\n\tglobal_store_dwordx2 %0, %1, %2 sc1" :: "v"(off), "v"(w), "s"(base) : "memory"); }
__device__ __forceinline__ float bf_lo(unsigned w) { return __uint_as_float(w << 16); }
__device__ __forceinline__ float bf_hi(unsigned w) { return __uint_as_float(w & 0xffff0000u); }
__device__ __forceinline__ float fast_sigmoid(float x) { return __builtin_amdgcn_rcpf(1.0f + __builtin_amdgcn_exp2f(-1.4426950408889634f * x)); }
template <int CTRL> __device__ __forceinline__ float dpp_f(float v) { return __int_as_float(__builtin_amdgcn_update_dpp(0, __float_as_int(v), CTRL, 0xF, 0xF, true)); }
__device__ __forceinline__ float wave_sum(float v) {
    v += dpp_f<0xB1>(v); v += dpp_f<0x4E>(v); v += dpp_f<0x141>(v); v += dpp_f<0x140>(v);
    const int iv = __float_as_int(v);
    return (__int_as_float(__builtin_amdgcn_readlane(iv, 0)) + __int_as_float(__builtin_amdgcn_readlane(iv, 16))) + (__int_as_float(__builtin_amdgcn_readlane(iv, 32)) + __int_as_float(__builtin_amdgcn_readlane(iv, 48)));
}

#ifndef NT_ACT2
#define NT_ACT2 0
#endif
#ifndef PG_WGM
#define PG_WGM 8
#endif
namespace pg8 {
constexpr int BM = 256, BK = 64, HALF = 128, HTB = HALF * BK * 2, STAGE_BYTES = 8 * HTB, NXCD = 8, WGM = PG_WGM;
__host__ __device__ __forceinline__ int lds_byte(int r, int c) { const int st = (r >> 4) * 2 + (c >> 5), rr = r & 15, cc = c & 31, ob = rr * 64 + cc * 2; return st * 1024 + (ob ^ (((ob >> 9) & 1) << 5)); }
__host__ __device__ __forceinline__ void stage_rc(int b, int& R, int& C) { const int st = b / 1024, sb = b % 1024, swz = sb ^ (((sb >> 9) & 1) << 5); R = (st >> 1) * 16 + swz / 64; C = (st & 1) * 32 + (swz % 64) / 2; }
__host__ __device__ __forceinline__ int perm32(int rho) { const int n = rho >> 4, i = rho & 15; return 8 * (i >> 2) + 4 * n + (i & 3); }

struct Unit { int pm, pn, e, tab, k0b, nt, slab, ui; };
struct Gemm { const bf16* A; const bf16* Bt; int K; size_t bstride_e; };

__device__ __forceinline__ void order_map(int wgid, int nM, int nN, int& pm, int& pn) {
    const int nwg = nM * nN; { const int q = nwg / NXCD, r = nwg % NXCD, xcd = wgid % NXCD, off = wgid / NXCD; wgid = (xcd < r ? xcd * (q + 1) : r * (q + 1) + (xcd - r) * q) + off; }
    const int nig = WGM * nN, gid = wgid / nig, fm = gid * WGM, gsz = (nM - fm) < WGM ? (nM - fm) : WGM;
    pm = fm + ((wgid % nig) % gsz); pn = (wgid % nig) / gsz;
}
struct StaticOrder {
    static constexpr bool GATHER = false;
    int nM, nN, nwg, G, c;
    __device__ void init(int Mrows, int N, int G_, int c_) { nM = Mrows / BM; nN = N / BM; nwg = nM * nN; G = G_; c = c_; }
    __device__ __forceinline__ bool next(int i, Unit& u) const { const long L = (long)i * G + c; if (L >= nwg) return false; order_map((int)L, nM, nN, u.pm, u.pn); u.e = 0; u.tab = i * 256; u.k0b = 0; u.nt = 0; u.slab = -1; return true; }
    __device__ __forceinline__ const unsigned* a_table(const Unit&) const { return nullptr; }
    __device__ __forceinline__ const float* rs_table(const Unit&) const { return nullptr; }
    __device__ __forceinline__ const float* gate_table(const Unit&) const { return nullptr; }
};
struct MoeOrder {
    int pb[9]; int nN, nwg, G, c; const unsigned* rowoff; const float* rs_e; const float* gate_e;
    __device__ __forceinline__ bool next(int i, Unit& u) const {
        const long L = (long)i * G + c; if (L >= nwg) return false; order_map((int)L, pb[8], nN, u.pm, u.pn); u.k0b = 0; u.nt = 0; u.slab = -1;
        int e = 0;
#pragma unroll
        for (int k = 1; k < 8; ++k) e += (int)((unsigned)(pb[k] - u.pm - 1) >> 31);
        int pbe = pb[0];
#pragma unroll
        for (int k = 1; k < 8; ++k) pbe = (e == k) ? pb[k] : pbe;
        u.e = e; u.tab = e * ECAP + 256 * (u.pm - pbe); return true;
    }
    __device__ __forceinline__ const unsigned* a_table(const Unit& u) const { return rowoff + u.tab; }
    __device__ __forceinline__ const float* rs_table(const Unit& u) const { return rs_e + u.tab; }
    __device__ __forceinline__ const float* gate_table(const Unit& u) const { return gate_e + u.tab; }
};
struct MoeOrderGather : MoeOrder { static constexpr bool GATHER = true; };
#ifndef FORCE_SPLIT
#define FORCE_SPLIT 0
#endif
constexpr int MOE_DOWN_KT = DFE / 128;
static_assert(MOE_DOWN_KT == 28, "moe_split assumes 28 K-tiles");
__host__ __device__ __forceinline__ int moe_split(int r, int G) { if (FORCE_SPLIT) return r == 0 ? 1 : FORCE_SPLIT;
    return r == 0 ? 1 : (r * 7 <= G ? 7 : (r * 2 <= G ? 2 : 1)); }
struct MoeOrderDown {
    static constexpr bool GATHER = false;
    int pb[9]; int G, c, NPf, nfull, r, s;
    __device__ __forceinline__ void init(int G_, int c_) { G = G_; c = c_; const int total = pb[8] * 4; nfull = (total / G) * G; NPf = nfull / 4; r = total - nfull; s = moe_split(r, G); }
    __device__ __forceinline__ bool next(int i, Unit& u) const {
        const int L = i * G + c; u.tab = 0;
        if (L < nfull) { order_map(L, NPf, 4, u.pm, u.pn); u.k0b = 0; u.nt = 0; u.slab = -1; }
        else { const int j = L - nfull; if (j >= r * s) return false; const int lu = j / s, ks = j - lu * s; u.pm = NPf + (lu >> 2); u.pn = lu & 3; u.nt = MOE_DOWN_KT / s; u.k0b = ks * u.nt * BK * 2; u.slab = s > 1 ? j : -1; }
        int e = 0;
#pragma unroll
        for (int k = 1; k < 8; ++k) e += (int)((unsigned)(pb[k] - u.pm - 1) >> 31);
        u.e = e; return true;
    }
    __device__ __forceinline__ const unsigned* a_table(const Unit&) const { return nullptr; }
    __device__ __forceinline__ const float* rs_table(const Unit&) const { return nullptr; }
    __device__ __forceinline__ const float* gate_table(const Unit&) const { return nullptr; }
};

__device__ __forceinline__ float rstd_of(const float* ssq, int row) { const float s = (ssq[row] + ssq[M + row]) + (ssq[2 * M + row] + ssq[3 * M + row]); return 1.0f / sqrtf(s * (1.0f / D) + EPS); }

struct EpiP {
    static constexpr bool PERM = true, AFTER_DRAIN = false; static constexpr int NSTORE = 16;
    bf16* O; int ldc; const LAS float* rtab;
    __device__ __forceinline__ void operator()(const f32x4 (&acc)[2][2][4][2], const Unit& u, int wr, int wc, int fr, int fq) const {
        const int row0 = u.pm * BM + wr * 64 + fr, col0 = u.pn * BM + wc * 32 + 8 * fq;
#pragma unroll
        for (int ai = 0; ai < 2; ++ai)
#pragma unroll
            for (int m = 0; m < 4; ++m) { const int row = row0 + ai * HALF + m * 16; const float rs = rtab[u.tab + wr * 64 + fr + ai * HALF + m * 16]; bf16* rowp = O + (size_t)row * ldc + col0;
#pragma unroll
                for (int bj = 0; bj < 2; ++bj) { const f32x4 v0 = acc[ai][bj][m][0] * rs, v1 = acc[ai][bj][m][1] * rs;
                    u32x4 w; w.x = cvt_pk_bf16(v0[0], v0[1]); w.y = cvt_pk_bf16(v0[2], v0[3]); w.z = cvt_pk_bf16(v1[0], v1[1]); w.w = cvt_pk_bf16(v1[2], v1[3]);
                    if (WT_MASK & 4) st16_wt(O, (unsigned)((row * ldc + col0 + bj * HALF) * 2), w); else if (NT_ACT2) __builtin_nontemporal_store(w, (u32x4*)(rowp + bj * HALF)); else *(u32x4*)(rowp + bj * HALF) = w; } }
    }
};
#ifndef NT_ACTM
#define NT_ACTM 1
#endif
#ifndef NT_ACT
#define NT_ACT 0
#endif
#ifndef ACT_AUX
#define ACT_AUX -1
#endif
template <bool MOE, bool OUT8 = MOE> struct EpiSwiglu {
    static constexpr bool PERM = true, AFTER_DRAIN = false; static constexpr int NSTORE = 8;
    bf16* O; int ldc; const LAS float* rtab; int mode; float inv;
    __device__ __forceinline__ void operator()(const f32x4 (&acc)[2][2][4][2], const Unit& u, int wr, int wc, int fr, int fq) const {
        if (mode == 2) { asm volatile("" :: "v"(acc[0][0][0][0][0]), "v"(acc[1][1][3][1][3])); return; }
        const int lr0 = wr * 64 + fr, col0 = u.pn * HALF + wc * 32 + 8 * fq;
#pragma unroll
        for (int ai = 0; ai < 2; ++ai)
#pragma unroll
            for (int m = 0; m < 4; ++m) { const int lr = lr0 + ai * HALF + m * 16, row = u.pm * BM + lr; float rs, gw;
                float o[8], c1, c2;
                if (MOE) { c1 = rtab[(u.ui & 1) * 512 + lr]; c2 = rtab[(u.ui & 1) * 512 + 256 + lr]; } else { rs = rtab[u.tab + lr]; gw = 1.0f; const float rsi = rs * inv; c1 = rsi * -1.4426950408889634f; c2 = rsi * rsi * gw; }
#pragma unroll
                for (int n = 0; n < 2; ++n) { const f32x4 ga = acc[ai][0][m][n], gu = ga * acc[ai][1][m][n] * c2, ex = ga * c1;
                    f32x4 den = (f32x4){__builtin_amdgcn_exp2f(ex[0]), __builtin_amdgcn_exp2f(ex[1]), __builtin_amdgcn_exp2f(ex[2]), __builtin_amdgcn_exp2f(ex[3])} + 1.0f;
                    const f32x4 rc = (f32x4){__builtin_amdgcn_rcpf(den[0]), __builtin_amdgcn_rcpf(den[1]), __builtin_amdgcn_rcpf(den[2]), __builtin_amdgcn_rcpf(den[3])}, ov = gu * rc;
                    o[n * 4 + 0] = ov[0]; o[n * 4 + 1] = ov[1]; o[n * 4 + 2] = ov[2]; o[n * 4 + 3] = ov[3]; }
                if constexpr (OUT8) { u32x2 w8; w8.x = cvt4_fp8(o[0], o[1], o[2], o[3]); w8.y = cvt4_fp8(o[4], o[5], o[6], o[7]);
                    if (mode == 1) { asm volatile("" :: "v"(w8.x), "v"(w8.y)); } else if (NT_ACTM) __builtin_nontemporal_store(w8, (u32x2*)((unsigned char*)O + (size_t)row * ldc + col0)); else *(u32x2*)((unsigned char*)O + (size_t)row * ldc + col0) = w8; }
                else { u32x4 w; w.x = cvt_pk_bf16(o[0], o[1]); w.y = cvt_pk_bf16(o[2], o[3]); w.z = cvt_pk_bf16(o[4], o[5]); w.w = cvt_pk_bf16(o[6], o[7]);
                    if (mode == 1) { asm volatile("" :: "v"(w.x), "v"(w.y), "v"(w.z), "v"(w.w)); } else if (WT_MASK & 8) st16_wt(O, (unsigned)(row * ldc + col0) * 2u, w); else if (NT_ACT) __builtin_nontemporal_store(w, (u32x4*)(O + (size_t)row * ldc + col0)); else *(u32x4*)(O + (size_t)row * ldc + col0) = w; } }
    }
};
struct EpiBf16 {
    static constexpr bool PERM = true, AFTER_DRAIN = false; static constexpr int NSTORE = 16;
    bf16* O; int ldc; bf16* slabs; float inv;
    __device__ __forceinline__ void operator()(const f32x4 (&acc)[2][2][4][2], const Unit& u, int wr, int wc, int fr, int fq) const {
        const bool sl = u.slab >= 0; bf16* base = sl ? slabs + (size_t)u.slab * (BM * BM) : O; const int ld = sl ? BM : ldc;
        const int row0 = (sl ? 0 : u.pm * BM) + wr * 64 + fr, col0 = (sl ? 0 : u.pn * BM) + wc * 32 + 8 * fq;
#pragma unroll
        for (int ai = 0; ai < 2; ++ai)
#pragma unroll
            for (int m = 0; m < 4; ++m) { bf16* rowp = base + (size_t)(row0 + ai * HALF + m * 16) * ld + col0;
#pragma unroll
                for (int bj = 0; bj < 2; ++bj) { const f32x4 v0 = acc[ai][bj][m][0] * inv, v1 = acc[ai][bj][m][1] * inv;
                    u32x4 w; w.x = cvt_pk_bf16(v0[0], v0[1]); w.y = cvt_pk_bf16(v0[2], v0[3]); w.z = cvt_pk_bf16(v1[0], v1[1]); w.w = cvt_pk_bf16(v1[2], v1[3]);
                    if (WT_MASK & 16) st16_wt(base, (unsigned)(((row0 + ai * HALF + m * 16) * ld + col0 + bj * HALF) * 2), w); else if (NT_ACT2) __builtin_nontemporal_store(w, (u32x4*)(rowp + bj * HALF)); else *(u32x4*)(rowp + bj * HALF) = w; } }
    }
};
struct EpiResid {
    static constexpr bool PERM = true, AFTER_DRAIN = true; static constexpr int NSTORE = 0;
    const float* xold32; bf16* XB; float* ssq; float inv;
    __device__ __forceinline__ void fused(f32x4 (&acc)[2][2][4][2], const Unit& u, int wr, int wc, int fr, int fq, LAS unsigned char* lds, int wid, int lane) const {
        LAS float* Pt = (LAS float*)lds;
        const int col0 = u.pn * BM + wc * 32 + 8 * fq;
        u32x4 old[2][4][2];
#pragma unroll
        for (int ai = 0; ai < 2; ++ai)
#pragma unroll
            for (int m = 0; m < 4; ++m) { const int r = ai * HALF + wr * 64 + m * 16 + fr; const size_t off = (size_t)(u.pm * BM + r) * D + col0;
#pragma unroll
                for (int bj = 0; bj < 2; ++bj) old[ai][m][bj] = *(const u32x4*)(XB + off + bj * HALF); }
#pragma unroll
        for (int ai = 0; ai < 2; ++ai)
#pragma unroll
            for (int m = 0; m < 4; ++m) { const int r = ai * HALF + wr * 64 + m * 16 + fr; const size_t off = (size_t)(u.pm * BM + r) * D + col0; float s = 0.f;
#pragma unroll
                for (int bj = 0; bj < 2; ++bj) { const u32x4 w0 = old[ai][m][bj];
                    const f32x4 b0 = (f32x4){bf_lo(w0.x), bf_hi(w0.x), bf_lo(w0.y), bf_hi(w0.y)}, b1 = (f32x4){bf_lo(w0.z), bf_hi(w0.z), bf_lo(w0.w), bf_hi(w0.w)};
                    const f32x4 o0 = b0 + acc[ai][bj][m][0] * inv, o1 = b1 + acc[ai][bj][m][1] * inv;
                    u32x4 w; w.x = cvt_pk_bf16(o0[0], o0[1]); w.y = cvt_pk_bf16(o0[2], o0[3]); w.z = cvt_pk_bf16(o1[0], o1[1]); w.w = cvt_pk_bf16(o1[2], o1[3]); *(u32x4*)(XB + off + bj * HALF) = w;
                    s += ((o0[0] * o0[0] + o0[1] * o0[1]) + (o0[2] * o0[2] + o0[3] * o0[3])) + ((o1[0] * o1[0] + o1[1] * o1[1]) + (o1[2] * o1[2] + o1[3] * o1[3])); }
                s += __int_as_float(__builtin_amdgcn_ds_bpermute((lane ^ 16) << 2, __float_as_int(s))); s += __int_as_float(__builtin_amdgcn_ds_bpermute((lane ^ 32) << 2, __float_as_int(s)));
                if (fq == 0) Pt[r * 4 + wc] = s; }
        __syncthreads();
        const int t = wid * 64 + lane;
        if (t < 256) { const float s = (Pt[t * 4 + 0] + Pt[t * 4 + 1]) + (Pt[t * 4 + 2] + Pt[t * 4 + 3]); ssq[(size_t)u.pn * M + u.pm * BM + t] = s; }
        __syncthreads();
    }
};

struct NoHook { __device__ __forceinline__ void operator()() const {} };
template <class Epi, class Sched, bool ALIGN_EPI = false, bool SP2 = true, bool F8 = false, class Hook = NoHook>
__device__ __forceinline__ void gemm_phase(LAS unsigned char* lds, LAS unsigned* gtab, const Gemm g, const Sched& S, const Epi& E, const int wave, const Hook& hook = Hook()) {
    constexpr bool GATHER = Sched::GATHER;
    static_assert(!GATHER || SP2, "gather needs the SP2 loop (lgkmcnt(0) waits only)");
    int wid_ = wave; asm volatile("" : "+s"(wid_));
    const int lane = lane_id_v(), wid = wid_, tid = wid * 64 + lane, wr = wid >> 2, wc = wid & 3, fr = lane & 15, fq = lane >> 4;
    const int K = g.K; int nt = K / BK;
    unsigned voffA[2], voffB[2];
#pragma unroll
    for (int i = 0; i < 2; ++i) { int R, C; stage_rc(tid * 16 + i * 8192, R, C); const int Rb = Epi::PERM ? ((R & ~31) + perm32(R & 31)) : R;
        voffA[i] = (unsigned)(R * K + C) * 2u; voffB[i] = (unsigned)(Rb * K + C) * 2u; }
    const size_t kstep = (size_t)(BK * 2);
    const size_t hstep = (size_t)HALF * K * 2;
    const size_t tstep = 2 * hstep;
    const unsigned ldsw = (unsigned)wid * 1024u;
    const int aoff = lds_byte(wr * 64 + fr, fq * 8), boff = lds_byte(wc * 32 + fr, fq * 8);
#define PG8_SA(b, h) (((b) * 2 + (h)) * HTB)
#define PG8_SB(b, h) ((4 + (b) * 2 + (h)) * HTB)
#define PG8_STAGE(bufoff, gbase, voff) do { _Pragma("unroll") for (int _i = 0; _i < 2; ++_i) { unsigned _vo = (voff)[_i]; asm volatile("" : "+v"(_vo)); \
        __builtin_amdgcn_global_load_lds((const unsigned*)((const char*)(gbase) + _vo), (LAS unsigned*)(lds + (bufoff) + ldsw + _i * 8192), 16, 0, 0); } } while (0)
#define PG8_STAGE_A(bufoff, ubase, kb, h) do { if constexpr (GATHER) { PG8_STAGE(bufoff, (const char*)g.A + (kb), ga[h]); } else { PG8_STAGE(bufoff, (ubase) + (size_t)(h) * hstep + (kb), voffA); } } while (0)
#define PG8_LDA(dst, b, h) do { _Pragma("unroll") for (int m = 0; m < 4; ++m) _Pragma("unroll") for (int k = 0; k < 2; ++k) dst[m][k] = *(const LAS bf16x8*)(lds + PG8_SA(b, h) + aoff + m * 2048 + k * 1024); } while (0)
#define PG8_LDB(dst, b, h) do { _Pragma("unroll") for (int n = 0; n < 2; ++n) _Pragma("unroll") for (int k = 0; k < 2; ++k) dst[n][k] = *(const LAS bf16x8*)(lds + PG8_SB(b, h) + boff + n * 2048 + k * 1024); } while (0)
#define PG8_MMA(ai, bj, At, Bt) do { __builtin_amdgcn_s_setprio(1); _Pragma("unroll") for (int m = 0; m < 4; ++m) _Pragma("unroll") for (int n = 0; n < 2; ++n) { \
        if constexpr (F8) acc[ai][bj][m][n] = __builtin_amdgcn_mfma_scale_f32_16x16x128_f8f6f4(cat8(Bt[n][0], Bt[n][1]), cat8(At[m][0], At[m][1]), acc[ai][bj][m][n], 0, 0, 0, 0, 0, 0); \
        else { _Pragma("unroll") for (int k = 0; k < 2; ++k) acc[ai][bj][m][n] = __builtin_amdgcn_mfma_f32_16x16x32_bf16(Bt[n][k], At[m][k], acc[ai][bj][m][n], 0, 0, 0); } } __builtin_amdgcn_s_setprio(0); } while (0)
#define PG8_WAIT_V(n) asm volatile("s_waitcnt vmcnt(" #n ")" ::: "memory")
#define PG8_WAIT_L(n) asm volatile("s_waitcnt lgkmcnt(" #n ")" ::: "memory")
#ifndef PK_ZERO
#define PK_ZERO 1
#endif
#ifndef EARLY_WB
#define EARLY_WB 0
#endif
#ifndef SEAM_RELAX
#define SEAM_RELAX 1
#endif
#define PG8_WAIT_VS() do { const int _rl = __builtin_amdgcn_readfirstlane((t == 0 && ui > 0) ? 1 : 0); if constexpr (SEAM_RELAX && Epi::NSTORE == 8) asm volatile("s_waitcnt vmcnt(16)\n\ts_cmp_lg_u32 %0, 0\n\ts_cbranch_scc1 .Lrelax%=\n\ts_waitcnt vmcnt(8)\n.Lrelax%=:" :: "s"(_rl) : "memory", "scc"); \
        else if constexpr (SEAM_RELAX && Epi::NSTORE == 16) asm volatile("s_waitcnt vmcnt(24)\n\ts_cmp_lg_u32 %0, 0\n\ts_cbranch_scc1 .Lrelax%=\n\ts_waitcnt vmcnt(8)\n.Lrelax%=:" :: "s"(_rl) : "memory", "scc"); else PG8_WAIT_V(8); } while (0)
#define PG8_BAR __builtin_amdgcn_s_barrier()
#define PG8_SCHED __builtin_amdgcn_sched_barrier(0)
#define PG8_GTAB_DMA(un, slot) do { if (wid < 4) { __builtin_amdgcn_global_load_lds(S.a_table(un) + wid * 64 + lane, (LAS unsigned*)(gtab + (slot) * 256 + wid * 64), 4, 0, 0); \
            __builtin_amdgcn_global_load_lds((const unsigned*)S.gate_table(un) + wid * 64 + lane, (LAS unsigned*)(gtab + 512 + (slot) * 512 + 256 + wid * 64), 4, 0, 0); } \
        else __builtin_amdgcn_global_load_lds((const unsigned*)S.rs_table(un) + (wid - 4) * 64 + lane, (LAS unsigned*)(gtab + 512 + (slot) * 512 + (wid - 4) * 64), 4, 0, 0); } while (0)
#define PG8_GTAB_READ(dst, slot) do { _Pragma("unroll") for (int _i = 0; _i < 2; ++_i) { int _R, _C; stage_rc(tid * 16 + _i * 8192, _R, _C); _Pragma("unroll") for (int _h = 0; _h < 2; ++_h) dst[_h][_i] = gtab[(slot) * 256 + _h * HALF + _R] + (unsigned)_C * 2u; } } while (0)
    Unit cur, nxt; int ui = 0;
    if (!S.next(0, cur)) return;
    f32x4 acc[2][2][4][2];
#pragma unroll
    for (int a = 0; a < 2; ++a)
#pragma unroll
        for (int b = 0; b < 2; ++b)
#pragma unroll
            for (int m = 0; m < 4; ++m)
#pragma unroll
                for (int n = 0; n < 2; ++n) acc[a][b][m][n] = (f32x4){0.f, 0.f, 0.f, 0.f};
    bf16x8 At[4][2], B0[2][2], B1[2][2];
    unsigned ga[2][2];
    if (cur.nt) nt = cur.nt;
    const char* cA = (const char*)g.A + (GATHER ? (size_t)0 : (size_t)cur.pm * tstep + cur.k0b); const char* cB = (const char*)g.Bt + ((size_t)cur.e * g.bstride_e) * 2 + (size_t)cur.pn * tstep + cur.k0b;
    if constexpr (GATHER && SP2) { PG8_GTAB_DMA(cur, 0); PG8_STAGE(PG8_SB(0, 0), cB, voffB); PG8_STAGE(PG8_SB(0, 1), cB + hstep, voffB); PG8_WAIT_V(4); PG8_BAR; PG8_GTAB_READ(ga, 0);
        PG8_STAGE_A(PG8_SA(0, 0), cA, 0, 0); PG8_STAGE_A(PG8_SA(0, 1), cA, 0, 1); }
    else if constexpr (GATHER) { PG8_GTAB_DMA(cur, 0); PG8_WAIT_V(0); PG8_BAR; PG8_GTAB_READ(ga, 0); }
    if constexpr (SP2) {
        if constexpr (!GATHER) { PG8_STAGE(PG8_SB(0, 0), cB, voffB); PG8_STAGE(PG8_SB(0, 1), cB + hstep, voffB); PG8_STAGE_A(PG8_SA(0, 0), cA, 0, 0); PG8_STAGE_A(PG8_SA(0, 1), cA, 0, 1); hook(); }
        if (wr == 1) PG8_BAR;
        PG8_WAIT_V(2); PG8_BAR;
        PG8_STAGE(PG8_SB(1, 0), cB + kstep, voffB); PG8_STAGE_A(PG8_SA(1, 0), cA, kstep, 0); PG8_STAGE(PG8_SB(1, 1), cB + hstep + kstep, voffB);
        PG8_WAIT_V(6); PG8_BAR;
    } else {
        PG8_STAGE(PG8_SB(0, 0), cB, voffB); PG8_STAGE_A(PG8_SA(0, 0), cA, 0, 0); PG8_STAGE(PG8_SB(0, 1), cB + hstep, voffB); PG8_STAGE_A(PG8_SA(0, 1), cA, 0, 1);
        if (wr == 1) PG8_BAR;
        PG8_WAIT_V(4); PG8_BAR;
        PG8_STAGE(PG8_SB(1, 0), cB + kstep, voffB); PG8_STAGE_A(PG8_SA(1, 0), cA, kstep, 0); PG8_STAGE(PG8_SB(1, 1), cB + hstep + kstep, voffB);
        PG8_WAIT_V(6); PG8_BAR;
    }
    for (;;) {
        const bool has_next = S.next(ui + 1, nxt);
        const char* nA = (has_next && !GATHER) ? (const char*)g.A + (size_t)nxt.pm * tstep + nxt.k0b : cA;
        const char* nB = has_next ? (const char*)g.Bt + ((size_t)nxt.e * g.bstride_e) * 2 + (size_t)nxt.pn * tstep + nxt.k0b : cB;
        for (int t = 0; t < nt; t += 2) {
            const bool last = (t == nt - 2);
            const size_t k1 = (size_t)(t + 1) * kstep;
            const char* a2 = last ? nA : cA; const size_t k2 = last ? 0 : (size_t)(t + 2) * kstep;
            const char* b2 = last ? nB : cB + (size_t)(t + 2) * kstep; const char* b3 = b2 + kstep;
            const size_t k3 = k2 + kstep;
            if constexpr (GATHER) {
                if (t == nt - 4 && has_next) PG8_GTAB_DMA(nxt, (ui + 1) & 1);
            }
            if constexpr (SP2) {
            PG8_LDB(B0, 0, 0); PG8_LDB(B1, 0, 1); PG8_SCHED; PG8_LDA(At, 0, 0); PG8_STAGE_A(PG8_SA(1, 1), cA, k1, 1);
            if constexpr (GATHER) { if (last && has_next) PG8_GTAB_READ(ga, (ui + 1) & 1); }
            PG8_WAIT_VS(); PG8_WAIT_L(0); PG8_BAR; PG8_MMA(0, 0, At, B0); PG8_MMA(0, 1, At, B1); PG8_BAR; PG8_SCHED;
            PG8_LDA(At, 0, 1); PG8_STAGE(PG8_SB(0, 0), b2, voffB); PG8_STAGE(PG8_SB(0, 1), b2 + hstep, voffB); PG8_STAGE_A(PG8_SA(0, 0), a2, k2, 0);
            PG8_WAIT_VS(); PG8_WAIT_L(0); PG8_BAR; PG8_MMA(1, 0, At, B0); PG8_MMA(1, 1, At, B1); PG8_BAR; PG8_SCHED;
            PG8_LDB(B0, 1, 0); PG8_LDB(B1, 1, 1); PG8_SCHED; PG8_LDA(At, 1, 0); PG8_STAGE_A(PG8_SA(0, 1), a2, k2, 1);
            PG8_WAIT_V(8); PG8_WAIT_L(0); PG8_BAR; PG8_MMA(0, 0, At, B0); PG8_MMA(0, 1, At, B1); PG8_BAR; PG8_SCHED;
            PG8_LDA(At, 1, 1); PG8_STAGE(PG8_SB(1, 0), b3, voffB); PG8_STAGE(PG8_SB(1, 1), b3 + hstep, voffB); PG8_STAGE_A(PG8_SA(1, 0), a2, k3, 0);
            PG8_WAIT_V(8); PG8_WAIT_L(0); PG8_BAR; PG8_MMA(1, 0, At, B0); PG8_MMA(1, 1, At, B1); PG8_BAR; PG8_SCHED;
            } else {
            PG8_LDB(B0, 0, 0); PG8_SCHED; PG8_LDA(At, 0, 0); PG8_STAGE_A(PG8_SA(1, 1), cA, k1, 1);
            PG8_WAIT_L(8); PG8_BAR; PG8_WAIT_L(0); PG8_MMA(0, 0, At, B0); PG8_BAR; PG8_SCHED;
            PG8_LDB(B1, 0, 1); PG8_STAGE(PG8_SB(0, 0), b2, voffB);
            PG8_BAR; PG8_WAIT_L(0); PG8_MMA(0, 1, At, B1); PG8_BAR;
            PG8_LDA(At, 0, 1); PG8_STAGE_A(PG8_SA(0, 0), a2, k2, 0);
            PG8_BAR; PG8_WAIT_L(0); PG8_MMA(1, 0, At, B0); PG8_BAR; PG8_SCHED;
            PG8_STAGE(PG8_SB(0, 1), b2 + hstep, voffB);
            PG8_WAIT_V(6); PG8_BAR; PG8_MMA(1, 1, At, B1); PG8_BAR;
            PG8_LDB(B0, 1, 0); PG8_SCHED; PG8_LDA(At, 1, 0); PG8_STAGE_A(PG8_SA(0, 1), a2, k2, 1);
            PG8_WAIT_L(8); PG8_BAR; PG8_WAIT_L(0); PG8_MMA(0, 0, At, B0); PG8_BAR; PG8_SCHED;
            PG8_LDB(B1, 1, 1); PG8_STAGE(PG8_SB(1, 0), b3, voffB);
            PG8_BAR; PG8_WAIT_L(0); PG8_MMA(0, 1, At, B1); PG8_BAR;
            PG8_LDA(At, 1, 1); PG8_STAGE_A(PG8_SA(1, 0), a2, k3, 0);
            PG8_BAR; PG8_WAIT_L(0); PG8_MMA(1, 0, At, B0); PG8_BAR; PG8_SCHED;
            PG8_STAGE(PG8_SB(1, 1), b3 + hstep, voffB);
            PG8_WAIT_V(6); PG8_BAR; PG8_MMA(1, 1, At, B1); PG8_BAR;
            }
        }
        if constexpr (ALIGN_EPI) { if (wr == 0) PG8_BAR; }
        cur.ui = ui;
        if constexpr (!Epi::AFTER_DRAIN) { int le; asm volatile("v_mbcnt_lo_u32_b32 %0, -1, 0\n\tv_mbcnt_hi_u32_b32 %0, -1, %0" : "=v"(le)); E(acc, cur, wr, wc, le & 15, le >> 4); }
        if (!has_next) break;
        if (EARLY_WB && blockIdx.x < 8 && wid == 0) asm volatile("buffer_wbl2 sc1" ::: "memory");
        { f32x2 z2 = (f32x2){0.f, 0.f}; asm volatile("" : "+v"(z2));
#pragma unroll
        for (int a = 0; a < 2; ++a)
#pragma unroll
            for (int b = 0; b < 2; ++b)
#pragma unroll
                for (int m = 0; m < 4; ++m)
#pragma unroll
                    for (int n = 0; n < 2; ++n) { if (PK_ZERO) { f32x2 h0, h1; asm volatile("v_pk_mov_b32 %0, %1, %1 op_sel:[0,1]" : "=v"(h0) : "v"(z2)); asm volatile("v_pk_mov_b32 %0, %1, %1 op_sel:[0,1]" : "=v"(h1) : "v"(z2));
                            acc[a][b][m][n] = (f32x4){h0[0], h0[1], h1[0], h1[1]}; } else acc[a][b][m][n] = (f32x4){0.f, 0.f, 0.f, 0.f}; } }
        cur = nxt; cA = nA; cB = nB; ++ui; nt = cur.nt ? cur.nt : K / BK;
        if constexpr (ALIGN_EPI) { if (wr == 1) PG8_BAR; }
    }
    PG8_WAIT_V(0);
    if constexpr (!ALIGN_EPI) { if (wr == 0) PG8_BAR; }
    PG8_BAR;
    if constexpr (Epi::AFTER_DRAIN) { const int le = lane_id_v(); E.fused(acc, cur, wr, wc, le & 15, le >> 4, lds, wid, le); }
#undef PG8_SA
#undef PG8_SB
#undef PG8_STAGE
#undef PG8_STAGE_A
#undef PG8_LDA
#undef PG8_LDB
#undef PG8_MMA
#undef PG8_WAIT_V
#undef PG8_WAIT_VS
#undef PG8_WAIT_L
#undef PG8_BAR
#undef PG8_SCHED
#undef PG8_GTAB_DMA
#undef PG8_GTAB_READ
}
}
constexpr size_t MiB = 1u << 20;
constexpr size_t WS_CTL = 0, CTL_ZERO_BYTES = 256 * 1024;
constexpr size_t WS_ROWOFF = 1 * MiB;
constexpr size_t WS_RS = WS_ROWOFF + 512 * 1024;
constexpr size_t WS_GATE = WS_RS + 512 * 1024;
constexpr size_t WS_SEL = WS_GATE + 512 * 1024;
constexpr size_t WS_SSQ = WS_SEL + 256 * 1024;
constexpr size_t WS_SMALLW = 4 * MiB;
constexpr size_t WS_PWT = WS_SMALLW;
constexpr size_t WS_POOLWT = WS_PWT + 2 * 384 * 384 * 2;
constexpr size_t WS_GMWS = WS_POOLWT + 2 * 4 * 64 * 64 * 2;
constexpr size_t WS_XB = 6 * MiB;
constexpr size_t WS_SLAB = 162 * MiB;
constexpr size_t WS_XB2 = WS_XB;
constexpr size_t WS_MOE_WD = 38 * MiB;
constexpr size_t WS_MOE_WGU = 94 * MiB;
constexpr size_t WS_XQ = 150 * MiB;
constexpr size_t WS_YP = 94 * MiB;
constexpr size_t WS_ACTM = 206 * MiB;
constexpr size_t WS_P = 206 * MiB;
constexpr size_t WS_Y = 262 * MiB;
constexpr size_t WS_ACT = 206 * MiB;
constexpr size_t WS_WIN = 294 * MiB;
constexpr size_t WS_WOUT = 301 * MiB;
constexpr size_t WS_WGU = 305 * MiB;
constexpr size_t WS_WD = 316 * MiB;
constexpr size_t WS_END = 444 * MiB;
static_assert(WS_SSQ + 4 * (size_t)M * 4 <= WS_SMALLW && WS_GMWS + 2 * 4 * 128 * 128 * 2 <= WS_XB && WS_XB + (size_t)M * D * 2 <= WS_MOE_WD, "ws map 1");
static_assert(WS_MOE_WGU + (size_t)NE * NGUE * D <= WS_XQ && WS_XQ + (size_t)M * D <= WS_ACTM, "fp8 MoE gate|up weights, XQ");
static_assert(WS_SLAB >= WS_YP + (size_t)PMAX * D * 2 && WS_SLAB + 256 * (size_t)65536 * 2 <= WS_ACTM, "slabs");
static_assert(WS_MOE_WD + (size_t)NE * D * DFE * 2 <= WS_MOE_WGU && WS_MOE_WGU + (size_t)NE * NGUE * D * 2 <= WS_ACTM && WS_YP + (size_t)PMAX * D * 2 <= WS_ACTM, "ws map 2");
static_assert(WS_ACTM + (size_t)PMAX * DFE * 2 <= WS_END && WS_P + (size_t)M * DIN * 2 <= WS_Y && WS_Y + (size_t)M * D * 2 <= WS_WIN && WS_ACT + (size_t)M * DFF * 2 <= WS_WIN, "ws map 3");
static_assert(WS_WIN + 2 * (size_t)DIN * D * 2 <= WS_WOUT && WS_WOUT + 2 * (size_t)D * D * 2 <= WS_WGU && WS_WGU + (size_t)NGU * D * 2 <= WS_WD && WS_WD + (size_t)D * DFF * 2 <= WS_END, "ws map 4");
constexpr int CW_BAR = 4096;
constexpr int CW_CNT = 49152;
constexpr int CW_CVT = 140000;
constexpr int NPHASE = 13;
static_assert(CW_BAR + NPHASE * 3456 <= CW_CNT && (size_t)(CW_CNT + 8 * 64) * 4 <= CTL_ZERO_BYTES, "control words inside the per-call memset");
constexpr int RING_BYTES = 131072;
constexpr int GTAB_OFF = RING_BYTES;
constexpr int MISC_OFF = GTAB_OFF + 8192;
constexpr int INTAB_OFF = MISC_OFF + 256;
constexpr int JOBS_OFF = INTAB_OFF + 256;
constexpr int LDS_BYTES = 147456;
static_assert(JOBS_OFF + 7 * 12 * 32 <= LDS_BYTES, "LDS map (jobs)");
static_assert(MISC_OFF + 256 <= LDS_BYTES, "LDS map");

typedef GAS unsigned gu32;
#define RLX_AGENT __ATOMIC_RELAXED, __HIP_MEMORY_SCOPE_AGENT
#define LDS_WAIT() asm volatile("s_waitcnt lgkmcnt(0)" ::: "memory")
#define VM_WAIT() asm volatile("s_waitcnt vmcnt(0)" ::: "memory")

#define XB_TMO      128
#define XB_XCNT(j)  (256  + 64 * (j))
#define XB_XSUB(j)  (1280 + 64 * (j))
#define XB_XGEN(j)  (2304 + 64 * (j))
#define XB_TOP      3328
#define XB_TOPGEN   3392
#define XCD_BAR_WORDS 3456
#define XB_SPIN_CAP (1u << 18)
__device__ __forceinline__ unsigned xb_ld(unsigned* p)              { return __hip_atomic_load(p, __ATOMIC_RELAXED, __HIP_MEMORY_SCOPE_AGENT); }
__device__ __forceinline__ unsigned xb_add(unsigned* p, unsigned v) { return __hip_atomic_fetch_add(p, v, __ATOMIC_RELAXED, __HIP_MEMORY_SCOPE_AGENT); }
__device__ __forceinline__ unsigned xb_xcc_id() { return (unsigned)__builtin_amdgcn_s_getreg((3 << 11) | 20) & 0xFu; }
#define XB_SPIN(cond, bar) do { unsigned _sp = 0; while (cond) { __builtin_amdgcn_s_sleep(1); \
    if ((++_sp & 255u) == 0u) { if (xb_ld(&(bar)[XB_TMO])) break; if (_sp > XB_SPIN_CAP) { atomicAdd(&(bar)[XB_TMO], 1u); break; } } } } while (0)
struct XcdBarrier { unsigned* bar; unsigned x; volatile LAS unsigned* st; int w; };
__device__ __forceinline__ XcdBarrier xcd_barrier_post(unsigned* bar, volatile LAS unsigned* st, int wave) {
    XcdBarrier b; b.bar = bar; b.x = xb_xcc_id(); b.st = st; b.w = wave;
    if (b.w == 0 && lane_id_v() == 0) (void)xb_add(&bar[XB_XCNT(b.x)], 1u);
    return b;
}
__device__ __forceinline__ void xcd_barrier_complete(unsigned* bar, unsigned x, unsigned& nloc, unsigned& nx) {
    const unsigned G = gridDim.x * gridDim.y * gridDim.z;
    unsigned sum, cnt, mine, sp = 0u;
    for (;;) {
        sum = 0u; cnt = 0u; mine = 0u;
#pragma unroll
        for (unsigned j = 0; j < 16; ++j) { const unsigned c = xb_ld(&bar[XB_XCNT(j)]); sum += c; cnt += (c > 0u) ? 1u : 0u; mine = (j == x) ? c : mine; }
        if (sum == G) break;
        __builtin_amdgcn_s_sleep(1);
        if ((++sp & 255u) == 0u) { if (xb_ld(&bar[XB_TMO])) break; if (sp > XB_SPIN_CAP) { atomicAdd(&bar[XB_TMO], 1u); break; } }
    }
    nloc = mine > 0u ? mine : 1u; nx = cnt > 0u ? cnt : 1u;
}
__device__ __forceinline__ void xcd_barrier(const XcdBarrier& b) {
    asm volatile("s_waitcnt vmcnt(0)" ::: "memory");
    __syncthreads();
    if (b.w == 0 && lane_id_v() == 0) {
        unsigned* bar = b.bar;
        __builtin_amdgcn_s_waitcnt(0);
        unsigned nloc = b.st[0], nx = b.st[1];
        if (nloc == 0u) { xcd_barrier_complete(bar, b.x, nloc, nx); b.st[0] = nloc; b.st[1] = nx; }
        const unsigned old = xb_add(&bar[XB_XSUB(b.x)], 1u);
        const unsigned gen = old / nloc;
        if (old + 1u == (gen + 1u) * nloc) {
            __builtin_amdgcn_fence(__ATOMIC_RELEASE, "agent");
            asm volatile("s_waitcnt vmcnt(0)" ::: "memory");
            const unsigned og = xb_add(&bar[XB_TOP], 1u);
            const unsigned tg = og / nx;
            if (og + 1u == (tg + 1u) * nx) xb_add(&bar[XB_TOPGEN], 1u);
            else XB_SPIN(xb_ld(&bar[XB_TOPGEN]) == tg, bar);
            __builtin_amdgcn_fence(__ATOMIC_ACQUIRE, "agent");
            xb_add(&bar[XB_XGEN(b.x)], 1u);
            asm volatile("s_waitcnt vmcnt(0)" ::: "memory");
        } else {
            XB_SPIN(xb_ld(&bar[XB_XGEN(b.x)]) == gen, bar);
            __builtin_amdgcn_fence(__ATOMIC_ACQUIRE, "agent");
            asm volatile("s_waitcnt vmcnt(0)" ::: "memory");
        }
    }
    __syncthreads();
}

extern __shared__ __attribute__((aligned(16))) unsigned char lds_raw[];
struct InTab { const LAS unsigned long long* t;
    __device__ __forceinline__ const float* operator[](int k) const { unsigned off = (unsigned)k * 8u; asm volatile("" : "+v"(off));
        const unsigned long long v = *(const LAS unsigned long long*)((LAS unsigned char*)lds_raw + INTAB_OFF + off); const unsigned lo = __builtin_amdgcn_readfirstlane((unsigned)v), hi = __builtin_amdgcn_readfirstlane((unsigned)(v >> 32));
        return (const float*)(const GAS float*)(((unsigned long long)hi << 32) | lo); } };
struct InTabV {
    __device__ __forceinline__ const float* operator[](int k) const { const unsigned long long v = *(const LAS unsigned long long*)((LAS unsigned char*)lds_raw + INTAB_OFF + (unsigned)k * 8u); return (const float*)(const GAS float*)v; } };
struct Frame {
    LAS unsigned char* lds; volatile LAS unsigned* MISC; unsigned* ctl;
    int wave, vcu, G;
    InTab in; float* out; unsigned char* ws;
};

__device__ __forceinline__ InTab in_tab(Frame& F) { return F.in; }
#ifndef DENSE_F8
#define DENSE_F8 1
#endif
constexpr int DENSE_F8D = DENSE_F8;
constexpr float W8_D = 128.0f;
constexpr float W8_GU = 64.0f;
struct TrJob { const float* src; bf16* dst; const float* gk; int K, N, f8; };
__device__ __forceinline__ TrJob tr_mat(const float* W, int K, int N, bf16* WT, int mode, const float* gk, int r, int f8 = 0) {
    const int nblk = N / 32, kb = r / nblk, nb = r % nblk, n0 = 32 * nb, k0 = 64 * kb;
    const int drow = mode == 0 ? n0 : ((n0 >> 7) * 256 + (n0 & 127) + (mode == 2 ? 128 : 0));
    TrJob j; j.src = W + (size_t)k0 * N + n0; j.dst = f8 ? (bf16*)((unsigned char*)WT + (size_t)drow * K + k0) : WT + (size_t)drow * K + k0; j.gk = gk ? gk + k0 : nullptr; j.K = K; j.N = N; j.f8 = f8; return j;
}
constexpr int TR_I_IN = (D / 64) * (DIN / 32), TR_I_OUT = (D / 64) * (D / 32), TR_I_G = (D / 64) * (DFF / 32), TR_I_D = (DFF / 64) * (D / 32), TR_I_MG = (D / 64) * (DFE / 32), TR_I_MD = (DFE / 64) * (D / 32), TR_I_PW = (DCV / 64) * (DCV / 32), TR_I_PL = 2;
constexpr int TR_E_END = TR_I_IN + 2 * TR_I_PW + 8 * TR_I_PL;
constexpr int TR_A_END = TR_E_END + TR_I_OUT + 2 * TR_I_G + TR_I_D;
constexpr int TR_B_END = TR_A_END + TR_I_IN + TR_I_OUT;
constexpr int TR_C_END = TR_B_END + 2 * NE * TR_I_MG;
constexpr int TR_D_END = TR_C_END + NE * TR_I_MD;
template <class IT> __device__ __forceinline__ TrJob tr_decode(const IT in, unsigned char* ws, int r) {
    if (r < TR_I_IN) return tr_mat(in[2], D, DIN, (bf16*)(ws + WS_WIN), 0, in[1], r); r -= TR_I_IN;
    if (r < 2 * TR_I_PW) { const int l = r / TR_I_PW; return tr_mat(in[12] + (size_t)l * DCV * DCV, DCV, DCV, (bf16*)(ws + WS_PWT) + (size_t)l * DCV * DCV, 0, nullptr, r % TR_I_PW); } r -= 2 * TR_I_PW;
    if (r < 8 * TR_I_PL) { const int gi = r / TR_I_PL; return tr_mat(in[3] + (size_t)gi * 64 * 64, 64, 64, (bf16*)(ws + WS_POOLWT) + (size_t)gi * 64 * 64, 0, nullptr, r % TR_I_PL); } r -= 8 * TR_I_PL;
    if (r < TR_I_OUT) return tr_mat(in[14], D, D, (bf16*)(ws + WS_WOUT), 0, nullptr, r); r -= TR_I_OUT;
    if (r < TR_I_G) return tr_mat(in[16], D, DFF, (bf16*)(ws + WS_WGU), 1, in[15], r); r -= TR_I_G;
    if (r < TR_I_G) return tr_mat(in[17], D, DFF, (bf16*)(ws + WS_WGU), 2, in[15], r); r -= TR_I_G;
    if (r < TR_I_D) return tr_mat(in[18], DFF, D, (bf16*)(ws + WS_WD), 0, nullptr, r, DENSE_F8D ? 2 : 0); r -= TR_I_D;
    if (r < TR_I_IN) return tr_mat(in[2] + (size_t)D * DIN, D, DIN, (bf16*)(ws + WS_WIN) + (size_t)DIN * D, 0, in[1] + D, r); r -= TR_I_IN;
    if (r < TR_I_OUT) return tr_mat(in[14] + (size_t)D * D, D, D, (bf16*)(ws + WS_WOUT) + (size_t)D * D, 0, nullptr, r); r -= TR_I_OUT;
    if (r < 2 * NE * TR_I_MG) { const int e = r / (2 * TR_I_MG), q = r % (2 * TR_I_MG), up = q / TR_I_MG;
        return tr_mat(in[20 + up] + (size_t)e * D * DFE, D, DFE, (bf16*)(ws + WS_MOE_WGU + (size_t)e * NGUE * D), 1 + up, in[15] + D, q % TR_I_MG, 1); } r -= 2 * NE * TR_I_MG;
    { const int e = r / TR_I_MD; return tr_mat(in[22] + (size_t)e * DFE * D, DFE, D, (bf16*)(ws + WS_MOE_WD + (size_t)e * D * DFE), 0, nullptr, r % TR_I_MD, 2); }
}
__device__ __forceinline__ void tr_load(const TrJob& j, f32x4 (&v)[10], int lane, int probe) {
    const int n4 = (lane & 7) * 4, k8 = (lane >> 3) * 8;
    if (probe == 2) {
#pragma unroll
        for (int i = 0; i < 10; ++i) v[i] = (f32x4){1.f, 2.f, 3.f, 4.f};
        return; }
#pragma unroll
    for (int i = 0; i < 8; ++i) v[i] = __builtin_nontemporal_load((const f32x4*)(j.src + (size_t)(k8 + i) * j.N + n4));
    if (j.gk) { v[8] = *(const f32x4*)(j.gk + k8); v[9] = *(const f32x4*)(j.gk + k8 + 4); }
}
__device__ __forceinline__ void tr_store(const TrJob& j, const f32x4 (&vin)[10], LAS float* scr, int lane, int probe) {
    (void)scr; const int n4 = (lane & 7) * 4, k8 = (lane >> 3) * 8; f32x4 v[8];
    if (j.gk || j.f8) { const float sc = j.f8 == 0 ? 1.0f : (j.f8 == 1 ? W8_GU : W8_D); f32x4 g0 = (f32x4){sc, sc, sc, sc}, g1 = g0; if (j.gk) { g0 = vin[8] * sc; g1 = vin[9] * sc; }
        v[0] = vin[0] * g0[0]; v[1] = vin[1] * g0[1]; v[2] = vin[2] * g0[2]; v[3] = vin[3] * g0[3]; v[4] = vin[4] * g1[0]; v[5] = vin[5] * g1[1]; v[6] = vin[6] * g1[2]; v[7] = vin[7] * g1[3]; }
    else {
#pragma unroll
        for (int i = 0; i < 8; ++i) v[i] = vin[i]; }
    if (j.f8) {
#pragma unroll
        for (int q = 0; q < 4; ++q) { u32x2 o; o.x = cvt4_fp8(v[0][q], v[1][q], v[2][q], v[3][q]); o.y = cvt4_fp8(v[4][q], v[5][q], v[6][q], v[7][q]);
            *(GAS u32x2*)((GAS unsigned char*)j.dst + (size_t)(n4 + q) * j.K + k8) = o; }
        return; }
#pragma unroll
    for (int q = 0; q < 4; ++q) { u32x4 o; o.x = cvt_pk_bf16(v[0][q], v[1][q]); o.y = cvt_pk_bf16(v[2][q], v[3][q]); o.z = cvt_pk_bf16(v[4][q], v[5][q]); o.w = cvt_pk_bf16(v[6][q], v[7][q]);
        if (probe == 1 || probe == 2) { asm volatile("" :: "v"(o.x), "v"(o.y), "v"(o.z), "v"(o.w)); } else if (WT_MASK & 1) st16_wt_u(j.dst, (unsigned)(((n4 + q) * j.K + k8) * 2), o); else *(GAS u32x4*)(j.dst + (size_t)(n4 + q) * j.K + k8) = o; }
}
__device__ __forceinline__ void tr_run(Frame& F, int first, int count, int widx, int nw, int probe) {
    LAS float* scr = (LAS float*)(F.lds + F.wave * 16384); int lane = lane_id_v(); asm volatile("" : "+v"(lane)); const InTab in = in_tab(F); unsigned char* ws = F.ws;
    const int end = first + count; f32x4 v[4][10]; TrJob j[4];
#pragma unroll
    for (int k = 0; k < 4; ++k) { const int it = first + widx + k * nw; if (it < end) { j[k] = tr_decode(in, ws, it); tr_load(j[k], v[k], lane, probe); } }
    for (int it = first + widx; it < end; it += 4 * nw) {
#pragma unroll
        for (int k = 0; k < 4; ++k) { const int ik = it + k * nw, nx = ik + 4 * nw;
            if (ik < end) tr_store(j[k], v[k], scr, lane, probe);
            if (nx < end) { j[k] = tr_decode(in, ws, nx); tr_load(j[k], v[k], lane, probe); } } }
}
#ifndef H10_SHARE
#define H10_SHARE 8192
#endif
#ifndef HID_PW
#define HID_PW 2
#endif
static_assert(HID_PW % 4 == 0, "the batched tail conversion takes four tiles at a time");
constexpr int HID_PER_WAVE = HID_PW, H1_N = 64 * 8 * HID_PER_WAVE, H4_N = 128 * 8 * HID_PER_WAVE, H6_N = 64 * 8 * HID_PER_WAVE, H10_N = H10_SHARE;
constexpr int H10_BEG = TR_D_END - H10_N;
#ifndef MIX_CVT
#define MIX_CVT 0
#endif
#ifndef R9_CVT
#define R9_CVT 0
#endif
#ifndef SB_CVT
#define SB_CVT 2
#endif
constexpr int MX_N = (M / 64) * 8 * MIX_CVT, R9_N = (M / 64) * 8 * R9_CVT, SB_N = 7 * 256 * SB_CVT;
constexpr int H1_BEG = TR_E_END, S0_BEG = H1_BEG + H1_N, S1_BEG = S0_BEG + SB_N, S2_BEG = S1_BEG + SB_N, S3_BEG = S2_BEG + SB_N, H4_BEG = S3_BEG + SB_N, S4_BEG = H4_BEG + H4_N, S5_BEG = S4_BEG + SB_N,
              H6_BEG = S5_BEG + SB_N, MX0_BEG = H6_BEG + H6_N, MX1_BEG = MX0_BEG + MX_N, R9_BEG = MX1_BEG + MX_N, PRO_BEG = R9_BEG + R9_N;
static_assert(PRO_BEG <= H10_BEG, "hidden conversion shares exceed the weight tiles");
static_assert(H1_BEG + TR_I_OUT <= S0_BEG, "w_out of layer 0 (phase 3): inside H1");
static_assert(TR_A_END - TR_I_D <= S1_BEG, "dense gate|up weights (phase 4): visible by phase 3 at the latest, i.e. inside H1 | S0");
static_assert(TR_A_END <= S2_BEG, "dense down weights (phase 5): inside H1 | S0 | S1");
static_assert(TR_A_END + TR_I_IN <= S3_BEG && TR_B_END <= S5_BEG, "layer-1 projections (phases 6, 8)");
static_assert(TR_C_END <= H10_BEG && MIX_CVT == 0 && R9_CVT == 0, "MoE gate|up weights before phase 10 (H6 is visible from phase 7); no hosting in mixers / router in this layout");

struct JobRec { unsigned long long src, dst, gk; int K, N; };
__device__ __forceinline__ TrJob job_read(const LAS JobRec* r) {
    const u32x4 a = *(const LAS u32x4*)r, c = *((const LAS u32x4*)r + 1); TrJob j;
    const unsigned s0 = __builtin_amdgcn_readfirstlane(a.x), s1 = __builtin_amdgcn_readfirstlane(a.y), d0 = __builtin_amdgcn_readfirstlane(a.z), d1 = __builtin_amdgcn_readfirstlane(a.w);
    const unsigned g0 = __builtin_amdgcn_readfirstlane(c.x), g1 = __builtin_amdgcn_readfirstlane(c.y);
    j.src = (const float*)(const GAS float*)(((unsigned long long)s1 << 32) | s0); j.dst = (bf16*)(GAS bf16*)(((unsigned long long)d1 << 32) | d0); j.gk = (const float*)(const GAS float*)(((unsigned long long)g1 << 32) | g0);
    j.K = __builtin_amdgcn_readfirstlane(c.z); const int nf = __builtin_amdgcn_readfirstlane(c.w); j.N = nf & 0xFFFFF; j.f8 = (int)((unsigned)nf >> 30); return j;
}
__device__ __forceinline__ void job_write(LAS JobRec* r, const TrJob& j) {
    const unsigned long long s = (unsigned long long)j.src, d = (unsigned long long)j.dst, g = (unsigned long long)j.gk; LAS u32x4* o = (LAS u32x4*)r;
    u32x4 a, c; a.x = (unsigned)s; a.y = (unsigned)(s >> 32); a.z = (unsigned)d; a.w = (unsigned)(d >> 32); c.x = (unsigned)g; c.y = (unsigned)(g >> 32); c.z = (unsigned)j.K; c.w = (unsigned)j.N | ((unsigned)j.f8 << 30); o[0] = a; o[1] = c;
}
#ifndef TAIL_V2
#define TAIL_V2 1
#endif
__device__ __forceinline__ void tail_convert(Frame& F, int first, int count, int rank, int nwg_idle, bool exact = true) {
    if (rank < 0 || rank >= nwg_idle) return;
    const int nw = nwg_idle * 8, widx = rank * 8 + F.wave;
    if (!TAIL_V2 || !exact) { tr_run(F, first, count, widx, nw, 0); return; }
    const int nt = count / nw; int lane = lane_id_v(); asm volatile("" : "+v"(lane));
    const InTab in = in_tab(F); unsigned char* ws = F.ws; LAS JobRec* tab = (LAS JobRec*)(F.lds + F.wave * 2048);
    if (lane < nt) { const TrJob j = tr_decode(InTabV{}, ws, first + widx + lane * nw); job_write(tab + lane, j); }
    asm volatile("s_waitcnt lgkmcnt(0)" ::: "memory");
#pragma unroll 1
    for (int q = 0; q < nt; q += 4) { TrJob j[4]; f32x4 v[4][10];
#pragma unroll
        for (int k = 0; k < 4; ++k) { j[k] = job_read(tab + q + k); const int n4 = (lane & 7) * 4, k8 = (lane >> 3) * 8;
#pragma unroll
            for (int i = 0; i < 8; ++i) v[k][i] = __builtin_nontemporal_load((const f32x4*)(j[k].src + (size_t)(k8 + i) * j[k].N + n4));
            const float* gp = j[k].gk ? j[k].gk + k8 : j[k].src; v[k][8] = *(const f32x4*)gp; v[k][9] = *(const f32x4*)(gp + 4); }
#pragma unroll
        for (int k = 0; k < 4; ++k) tr_store(j[k], v[k], nullptr, lane, 0); }
}
__device__ __forceinline__ void jobs_setup(Frame& F) {
    if (SB_CVT == 0 || F.wave == 0) return;
    const InTab in = in_tab(F); unsigned char* ws = F.ws; LAS JobRec* tab = (LAS JobRec*)(F.lds + JOBS_OFF) + (F.wave - 1) * 12;
    { const int q = lane_id_v(); if (q < 6 * SB_CVT) { const int sI = q / SB_CVT, k = q - sI * SB_CVT; const int beg = sI < 4 ? S0_BEG + sI * SB_N : S4_BEG + (sI - 4) * SB_N;
        const TrJob j = tr_decode(InTabV{}, ws, beg + (int)blockIdx.x * 7 + F.wave - 1 + k * 7 * 256); job_write(tab + sI * 2 + k, j); } }
}
__device__ __forceinline__ void xcd_barrier_host(const XcdBarrier& b, Frame& F, int slot) {
    if (slot < 0 || SB_CVT == 0) { xcd_barrier(b); return; }
    asm volatile("s_waitcnt vmcnt(0)" ::: "memory");
    __syncthreads();
    int lane = lane_id_v(); asm volatile("" : "+v"(lane));
    f32x4 va[10], vb[10]; TrJob ja, jb; const bool host = F.wave > 0; const LAS JobRec* jr = (const LAS JobRec*)(F.lds + JOBS_OFF) + (F.wave - 1) * 12 + slot * 2;
    if (host) { ja = job_read(jr); tr_load(ja, va, lane, 0); if (SB_CVT >= 2) { jb = job_read(jr + 1); tr_load(jb, vb, lane, 0); } }
    if (b.w == 0 && lane_id_v() == 0) {
        unsigned* bar = b.bar;
        __builtin_amdgcn_s_waitcnt(0);
        unsigned nloc = b.st[0], nx = b.st[1];
        if (nloc == 0u) { xcd_barrier_complete(bar, b.x, nloc, nx); b.st[0] = nloc; b.st[1] = nx; }
        const unsigned old = xb_add(&bar[XB_XSUB(b.x)], 1u);
        const unsigned gen = old / nloc;
        if (old + 1u == (gen + 1u) * nloc) {
            __builtin_amdgcn_fence(__ATOMIC_RELEASE, "agent");
            asm volatile("s_waitcnt vmcnt(0)" ::: "memory");
            const unsigned og = xb_add(&bar[XB_TOP], 1u);
            const unsigned tg = og / nx;
            if (og + 1u == (tg + 1u) * nx) xb_add(&bar[XB_TOPGEN], 1u);
            else XB_SPIN(xb_ld(&bar[XB_TOPGEN]) == tg, bar);
            __builtin_amdgcn_fence(__ATOMIC_ACQUIRE, "agent");
            xb_add(&bar[XB_XGEN(b.x)], 1u);
            asm volatile("s_waitcnt vmcnt(0)" ::: "memory");
        } else {
            XB_SPIN(xb_ld(&bar[XB_XGEN(b.x)]) == gen, bar);
            __builtin_amdgcn_fence(__ATOMIC_ACQUIRE, "agent");
            asm volatile("s_waitcnt vmcnt(0)" ::: "memory");
        }
    }
    __syncthreads();
    if (host) { tr_store(ja, va, nullptr, lane, 0); if (SB_CVT >= 2) tr_store(jb, vb, nullptr, lane, 0); }
}
__device__ __forceinline__ void p0_prologue(Frame& F, int probe) {
    LAS float* scr = (LAS float*)(F.lds + F.wave * 16384);
    int lane = lane_id_v(); asm volatile("" : "+v"(lane));
    const int gw = F.vcu * 8 + F.wave, NGW = F.G * 8;
    const InTab in = in_tab(F); unsigned char* ws = F.ws;
    tr_run(F, 0, TR_E_END, gw, NGW, probe);
    tr_run(F, PRO_BEG, H10_BEG - PRO_BEG, gw, NGW, probe);
    { const float* src = in[6]; bf16* dst = (bf16*)(ws + WS_GMWS);
      for (int i = gw * 64 + lane; i < 2 * 4 * 128 * 128 / 8; i += NGW * 64) { const f32x4 a = *(const f32x4*)(src + (size_t)i * 8), b = *(const f32x4*)(src + (size_t)i * 8 + 4);
          u32x4 o; o.x = cvt_pk_bf16(a[0], a[1]); o.y = cvt_pk_bf16(a[2], a[3]); o.z = cvt_pk_bf16(b[0], b[1]); o.w = cvt_pk_bf16(b[2], b[3]); *(u32x4*)(dst + (size_t)i * 8) = o; } }
    { u32x4* t = (u32x4*)(ws + WS_ROWOFF); for (int i = gw * 64 + lane; i < NE * ECAP / 4; i += NGW * 64) { const unsigned r = (unsigned)(4 * i) & (unsigned)(M - 1);
          t[i] = (u32x4){r * (unsigned)D, (r + 1u) * (unsigned)D, (r + 2u) * (unsigned)D, (r + 3u) * (unsigned)D}; } }
    { const float* x = in[0]; bf16* XB = (bf16*)(ws + WS_XB); float* ssq = (float*)(ws + WS_SSQ);
      for (int m0 = gw; m0 < M; m0 += 4 * NGW) { f32x4 v[4][4];
#pragma unroll
          for (int r = 0; r < 4; ++r) { const int m = m0 + r * NGW; const f32x4* xr = (const f32x4*)(x + (size_t)m * D) + lane;
#pragma unroll
              for (int j = 0; j < 4; ++j) v[r][j] = (m < M) ? __builtin_nontemporal_load(xr + 64 * j) : (f32x4){0.f, 0.f, 0.f, 0.f}; }
#pragma unroll
          for (int r = 0; r < 4; ++r) { const int m = m0 + r * NGW; if (m >= M) break; float s = 0.f;
#pragma unroll
              for (int j = 0; j < 4; ++j) s += (v[r][j][0] * v[r][j][0] + v[r][j][1] * v[r][j][1]) + (v[r][j][2] * v[r][j][2] + v[r][j][3] * v[r][j][3]);
              s = wave_sum(s);
              u32x2* o = (u32x2*)(XB + (size_t)m * D) + lane;
#pragma unroll
              for (int j = 0; j < 4; ++j) { u32x2 w; w.x = cvt_pk_bf16(v[r][j][0], v[r][j][1]); w.y = cvt_pk_bf16(v[r][j][2], v[r][j][3]); o[64 * j] = w; }
              if (lane < 4) ssq[(size_t)lane * M + m] = lane == 0 ? s : 0.f; } } }
}

__device__ __forceinline__ void unpack8(const u32x4 w, float (&f)[8]) { f[0] = bf_lo(w.x); f[1] = bf_hi(w.x); f[2] = bf_lo(w.y); f[3] = bf_hi(w.y); f[4] = bf_lo(w.z); f[5] = bf_hi(w.z); f[6] = bf_lo(w.w); f[7] = bf_hi(w.w); }
#define LDS_BARRIER() asm volatile("s_waitcnt lgkmcnt(0)\n\ts_barrier" ::: "memory")
#ifndef TP_ID
#define TP_ID 0
#endif
#ifndef TP_MUL
#define TP_MUL 8
#endif
#define TP_DECL(id) unsigned long long _tp##id = 0
#define TP_BEGIN(id) do { if (TP_ID == id) _tp##id = __builtin_amdgcn_s_memrealtime(); } while (0)
#define TP_END(id) do { if (TP_ID == id) { const unsigned long long _t1 = __builtin_amdgcn_s_memrealtime(), _d = (_t1 - _tp##id) * TP_MUL; while (__builtin_amdgcn_s_memrealtime() - _t1 < _d) __builtin_amdgcn_s_sleep(8); } } while (0)
__device__ __forceinline__ void mixer_unit(Frame& F, int u, int layer, int cvt0) {
    LAS unsigned char* lds = F.lds; int tid = (F.wave * 64 + lane_id_v()); asm volatile("" : "+v"(tid)); int lane = tid & 63; const int w = F.wave;
    const InTab in = in_tab(F); unsigned char* ws = F.ws;
    const bf16* P = (const bf16*)(ws + WS_P); bf16* Y = (bf16*)(ws + WS_Y);
    const int r0 = 64 * u, s0 = r0 & (SEQ - 1), half = u & 1, blk0 = r0 & ~127;
#ifndef CONV_REP
#define CONV_REP 0
#endif
#ifndef MIX_MASK
#define MIX_MASK 7
#endif
#ifndef MIX_REP
#define MIX_REP 0
#endif
    f32x4 cva[10], cvb[10]; TrJob cja, cjb; const int cvi = cvt0 + u * 8 + w; constexpr int CVS = (M / 64) * 8;
    TP_DECL(1); TP_DECL(2); TP_DECL(3); TP_DECL(4); TP_DECL(5); TP_DECL(6); TP_DECL(7); TP_BEGIN(7); TP_BEGIN(1);
#ifndef MIX_PF
#define MIX_PF 1
#endif
    u32x4 raw[16]; bf16x8 Aw[4][2]; f32x4 g4[6]; float bi[2]; u32x2 uu[2][6];
    u32x4 cvr[9], cgr[9];
#define GM_LOADS() do { const int h_ = w & 3, ih_ = w >> 2, fr_ = lane & 15, fq_ = lane >> 4, nks_ = half ? 4 : 2, nr_ = half ? 16 : 8; \
      const bf16* wsb_ = (const bf16*)(ws + WS_GMWS) + (size_t)(layer * 4 + h_) * 128 * 128; const float* gg_ = in[5] + layer * DGM; const float* bb_ = in[7] + (size_t)(layer * 4 + h_) * 128; \
      _Pragma("unroll") for (int i = 0; i < 16; ++i) { raw[i] = (u32x4){0u, 0u, 0u, 0u}; if (i < nr_ && lane < 48) raw[i] = *(const u32x4*)(P + (size_t)(blk0 + i * 8 + w) * DIN + 640 + lane * 8); } \
      _Pragma("unroll") for (int ks = 0; ks < 4; ++ks) _Pragma("unroll") for (int mt = 0; mt < 2; ++mt) { Aw[ks][mt] = (bf16x8){0, 0, 0, 0, 0, 0, 0, 0}; if (ks < nks_) Aw[ks][mt] = *(const bf16x8*)(wsb_ + (size_t)(half * 64 + (2 * ih_ + mt) * 16 + fr_) * 128 + ks * 32 + 8 * fq_); } \
      _Pragma("unroll") for (int ct = 0; ct < 6; ++ct) g4[ct] = *(const f32x4*)(gg_ + h_ * 96 + ct * 16 + 4 * fq_); \
      _Pragma("unroll") for (int mt = 0; mt < 2; ++mt) bi[mt] = bb_[half * 64 + (2 * ih_ + mt) * 16 + fr_]; \
      _Pragma("unroll") for (int mt = 0; mt < 2; ++mt) _Pragma("unroll") for (int ct = 0; ct < 6; ++ct) uu[mt][ct] = *(const u32x2*)(P + (size_t)(r0 + (2 * ih_ + mt) * 16 + fr_) * DIN + 256 + h_ * 96 + ct * 16 + 4 * fq_); } while (0)
#define CV_LOADS() do { _Pragma("unroll") for (int i = 0; i < 9; ++i) { const int idx = tid + 512 * i, rr = idx / 48, ch = idx % 48, pos = s0 - 30 + rr; cvr[i] = (u32x4){0u, 0u, 0u, 0u}; cgr[i] = (u32x4){0u, 0u, 0u, 0u}; \
          if (idx < 94 * 48 && pos >= 0) { const bf16* pr = P + (size_t)(r0 - 30 + rr) * DIN; cvr[i] = *(const u32x4*)(pr + 1024 + ch * 8); cgr[i] = *(const u32x4*)(pr + 1408 + ch * 8); } } } while (0)
    for (int mrep = 0; mrep < 1 + (MIX_REP & 1); ++mrep) if (MIX_MASK & 1) { constexpr int AIN = 0, YPL = 40448, YST = 528;
      const int g = w >> 1, th = w & 1, fr = lane & 15, fq = lane >> 4;
      u32x4 st[5];
#pragma unroll
      for (int i = 0; i < 5; ++i) { const int idx = tid + 512 * i, rr = idx >> 5, ch = idx & 31, pos = s0 - 15 + rr; st[i] = (u32x4){0u, 0u, 0u, 0u};
          if (idx < 79 * 32 && pos >= 0) st[i] = *(const u32x4*)(P + (size_t)(r0 - 15 + rr) * DIN + ch * 8); }
      const bf16* wt = (const bf16*)(ws + WS_POOLWT) + (size_t)(layer * 4 + g) * 64 * 64; const float* sc = in[4] + layer * DPOOL + g * 64;
      bf16x8 Bf[2][4]; f32x4 sc4[4];
#pragma unroll
      for (int ks = 0; ks < 2; ++ks)
#pragma unroll
          for (int nt = 0; nt < 4; ++nt) Bf[ks][nt] = *(const bf16x8*)(wt + (nt * 16 + fr) * 64 + ks * 32 + 8 * fq);
#pragma unroll
      for (int nt = 0; nt < 4; ++nt) sc4[nt] = *(const f32x4*)(sc + nt * 16 + 4 * fq);
      if (MIX_CVT >= 2 && mrep == 0) { asm volatile("" ::: "memory"); cja = tr_decode(in, ws, cvi); tr_load(cja, cva, lane, 0); cjb = tr_decode(in, ws, cvi + CVS); tr_load(cjb, cvb, lane, 0); asm volatile("" ::: "memory"); }
#pragma unroll
      for (int i = 0; i < 5; ++i) { const int idx = tid + 512 * i; if (idx < 79 * 32) *(LAS u32x4*)(lds + AIN + (idx >> 5) * 512 + (idx & 31) * 16) = st[i]; }
      LDS_BARRIER();
      if (MIX_PF) { GM_LOADS(); }
      { const int p = tid & 127, rq = tid >> 7, gp = p >> 5, win = 2 << gp; float S0 = 0.f, S1 = 0.f;
        for (int j = 1; j < win; ++j) { const unsigned a = *(const LAS unsigned*)(lds + AIN + (16 * rq + 15 - j) * 512 + p * 4); S0 += bf_lo(a); S1 += bf_hi(a); }
#pragma unroll 4
        for (int t = 0; t < 16; ++t) { const int lt = 16 * rq + t, rr = lt + 15; const unsigned a = *(const LAS unsigned*)(lds + AIN + rr * 512 + p * 4); const float a0 = bf_lo(a), a1 = bf_hi(a);
            S0 += a0; S1 += a1; const int pos1 = s0 + lt + 1; const float rn = __builtin_amdgcn_rcpf((float)(pos1 < win ? pos1 : win));
            *(LAS unsigned*)(lds + YPL + lt * YST + p * 4) = cvt_pk_bf16(S0 * rn - a0, S1 * rn - a1);
            const unsigned o = *(const LAS unsigned*)(lds + AIN + (rr - win + 1) * 512 + p * 4); S0 -= bf_lo(o); S1 -= bf_hi(o); } }
      LDS_BARRIER();
      for (int prep = 0; prep < 1 + ((CONV_REP >> 3) & 1); ++prep) { f32x4 acc[2][4];
#pragma unroll
        for (int a = 0; a < 2; ++a)
#pragma unroll
            for (int b = 0; b < 4; ++b) acc[a][b] = (f32x4){0.f, 0.f, 0.f, 0.f};
#pragma unroll
        for (int ks = 0; ks < 2; ++ks) { bf16x8 A[2];
#pragma unroll
            for (int mt = 0; mt < 2; ++mt) A[mt] = *(const LAS bf16x8*)(lds + YPL + ((2 * th + mt) * 16 + fr) * YST + (g * 64 + ks * 32 + 8 * fq) * 2);
#pragma unroll
            for (int mt = 0; mt < 2; ++mt)
#pragma unroll
                for (int nt = 0; nt < 4; ++nt) acc[mt][nt] = __builtin_amdgcn_mfma_f32_16x16x32_bf16(Bf[ks][nt], A[mt], acc[mt][nt], 0, 0, 0); }
#pragma unroll
        for (int mt = 0; mt < 2; ++mt)
#pragma unroll
            for (int nt = 0; nt < 4; ++nt) { const int t = r0 + (2 * th + mt) * 16 + fr, d = nt * 16 + 4 * fq; const f32x4 v = acc[mt][nt] * sc4[nt];
                u32x2 o; o.x = cvt_pk_bf16(v[0], v[1]); o.y = cvt_pk_bf16(v[2], v[3]); if (WT_MASK & 1) st8_wt(Y, (unsigned)((t * D + g * 64 + d) * 2), o); else *(u32x2*)(Y + (size_t)t * D + g * 64 + d) = o; } }
      LDS_BARRIER(); }
    TP_END(1); TP_BEGIN(2);
    asm volatile("" : "+v"(tid)); lane = tid & 63;
    for (int mrep = 0; mrep < 1 + ((MIX_REP >> 1) & 1); ++mrep) if (MIX_MASK & 2) { constexpr int VN = 0, VST = 800; const int nj = half ? 128 : 64, nks = nj >> 5;
      const int h = w & 3, ih = w >> 2, fr = lane & 15, fq = lane >> 4, q4 = (lane & 15) >> 2, p4 = lane & 3;
      const bf16* wsb = (const bf16*)(ws + WS_GMWS) + (size_t)(layer * 4 + h) * 128 * 128;
      const float* gg = in[5] + layer * DGM; const float* bb = in[7] + (size_t)(layer * 4 + h) * 128;
      const int nr = nj >> 3;
      if (!MIX_PF) { GM_LOADS(); }
#pragma unroll
      for (int i = 0; i < 16; ++i) { if (i < nr) { float f[8]; unpack8(raw[i], f); float s = 0.f;
#pragma unroll
              for (int q = 0; q < 8; ++q) s += f[q] * f[q];
              s = wave_sum(s); const float rs = 1.0f / sqrtf(s * (1.0f / DGM) + EPS);
              u32x4 o; o.x = cvt_pk_bf16(f[0] * rs, f[1] * rs); o.y = cvt_pk_bf16(f[2] * rs, f[3] * rs); o.z = cvt_pk_bf16(f[4] * rs, f[5] * rs); o.w = cvt_pk_bf16(f[6] * rs, f[7] * rs);
              if (lane < 48) *(LAS u32x4*)(lds + VN + (i * 8 + w) * VST + lane * 16) = o; } }
      LDS_BARRIER();
      if (MIX_PF) { CV_LOADS(); }
      { f32x4 acc[2][6];
#pragma unroll
        for (int a = 0; a < 2; ++a)
#pragma unroll
            for (int b = 0; b < 6; ++b) acc[a][b] = (f32x4){0.f, 0.f, 0.f, 0.f};
#pragma unroll
        for (int ks = 0; ks < 4; ++ks) { if (ks < nks) {
#pragma unroll
            for (int ct = 0; ct < 6; ++ct) { const unsigned ad = VN + (32 * ks + 8 * fq + q4) * VST + (h * 96 + ct * 16 + 4 * p4) * 2;
                const s16x4 t0 = __builtin_amdgcn_ds_read_tr16_b64_v4i16((LAS s16x4*)(lds + ad)), t1 = __builtin_amdgcn_ds_read_tr16_b64_v4i16((LAS s16x4*)(lds + ad + 4 * VST));
                bf16x8 B; B[0] = t0[0]; B[1] = t0[1]; B[2] = t0[2]; B[3] = t0[3]; B[4] = t1[0]; B[5] = t1[1]; B[6] = t1[2]; B[7] = t1[3];
#pragma unroll
                for (int mt = 0; mt < 2; ++mt) acc[mt][ct] = __builtin_amdgcn_mfma_f32_16x16x32_bf16(B, Aw[ks][mt], acc[mt][ct], 0, 0, 0); } } }
#pragma unroll
        for (int mt = 0; mt < 2; ++mt) { const int t = r0 + (2 * ih + mt) * 16 + fr;
#pragma unroll
            for (int ct = 0; ct < 6; ++ct) { const int c4 = h * 96 + ct * 16 + 4 * fq; const f32x4 z = acc[mt][ct] * g4[ct] + bi[mt]; const u32x2 uv = uu[mt][ct];
                u32x2 o; o.x = cvt_pk_bf16(bf_lo(uv.x) * z[0], bf_hi(uv.x) * z[1]); o.y = cvt_pk_bf16(bf_lo(uv.y) * z[2], bf_hi(uv.y) * z[3]); if (WT_MASK & 1) st8_wt(Y, (unsigned)((t * D + 256 + c4) * 2), o); else *(u32x2*)(Y + (size_t)t * D + 256 + c4) = o; } } }
      LDS_BARRIER(); }
    if (MIX_CVT >= 2) { tr_store(cja, cva, nullptr, lane, 0); tr_store(cjb, cvb, nullptr, lane, 0); }
    TP_END(2); TP_BEGIN(3);
    asm volatile("" : "+v"(tid)); lane = tid & 63;
    for (int mrep = 0; mrep < 1 + ((MIX_REP >> 2) & 1); ++mrep) if (MIX_MASK & 4) { constexpr int HC = 0, TT = 72192, TST = 784;
      { const char* dwsrc = (const char*)(in[8] + (size_t)layer * 31 * DCV);
#pragma unroll
        for (int i = 0; i < 6; ++i) { const int c = i * 8 + w; if (c * 1024 + lane * 16 < 31 * DCV * 4) __builtin_amdgcn_global_load_lds((const unsigned*)(dwsrc + c * 1024 + lane * 16), (LAS unsigned*)(lds + TT + c * 1024), 16, 0, 0); } }
      for (int crep = 0; crep < 1 + (CONV_REP & 1); ++crep) {
        if (!MIX_PF || crep > 0) { CV_LOADS(); }
        if (MIX_CVT >= 4 && mrep == 0 && crep == 0) { asm volatile("" ::: "memory"); cja = tr_decode(in, ws, cvi + 2 * CVS); tr_load(cja, cva, lane, 0); cjb = tr_decode(in, ws, cvi + 3 * CVS); tr_load(cjb, cvb, lane, 0); asm volatile("" ::: "memory"); }
#pragma unroll
        for (int i = 0; i < 9; ++i) { const int idx = tid + 512 * i, rr = idx / 48, ch = idx % 48; float a[8], b[8]; unpack8(cvr[i], a); unpack8(cgr[i], b);
#pragma unroll
            for (int q = 0; q < 8; ++q) a[q] *= fast_sigmoid(b[q]);
            u32x4 o; o.x = cvt_pk_bf16(a[0], a[1]); o.y = cvt_pk_bf16(a[2], a[3]); o.z = cvt_pk_bf16(a[4], a[5]); o.w = cvt_pk_bf16(a[6], a[7]);
            if (idx < 94 * 48) *(LAS u32x4*)(lds + HC + rr * 768 + ch * 16) = o; } }
      asm volatile("s_waitcnt vmcnt(0)" ::: "memory");
      LDS_BARRIER();
      TP_END(3); TP_BEGIN(4);
      asm volatile("" : "+v"(tid)); lane = tid & 63;
      const int fr = lane & 15, fq = lane >> 4; const bf16* pw = (const bf16*)(ws + WS_PWT) + (size_t)layer * DCV * DCV;
      bf16x8 Bp[4][3], Bq[8][3];
      for (int crep = 0; crep < 1 + ((CONV_REP >> 1) & 1); ++crep) { const float* dwb = in[9] + layer * DCV; const float* lg = in[10] + layer * DCV; const float* lb = in[11] + layer * DCV;
#pragma unroll
        for (int ks = 0; ks < 2; ++ks)
#pragma unroll
            for (int nt = 0; nt < 3; ++nt) Bp[ks][nt] = *(const bf16x8*)(pw + (size_t)((3 * w + nt) * 16 + fr) * DCV + ks * 32 + 8 * fq);
        float dd[8][6];
#pragma unroll
        for (int q = 0; q < 3; ++q) { const int c = 128 * q + 2 * lane; f32x2 wj[31];
#pragma unroll
            for (int j = 0; j < 31; ++j) wj[j] = *(const LAS f32x2*)(lds + TT + (j * DCV + c) * 4);
            const f32x2 b2 = *(const f32x2*)(dwb + c); f32x2 a2[8];
#pragma unroll
            for (int r = 0; r < 8; ++r) a2[r] = b2;
#pragma unroll
            for (int s = 0; s < 38; ++s) { const unsigned hv = *(const LAS unsigned*)(lds + HC + (8 * w + s) * 768 + c * 2); const f32x2 h2 = (f32x2){bf_lo(hv), bf_hi(hv)};
#pragma unroll
                for (int r = 0; r < 8; ++r) { const int j = s - r; if (j >= 0 && j <= 30) a2[r] = __builtin_elementwise_fma(h2, wj[j], a2[r]); } }
#pragma unroll
            for (int r = 0; r < 8; ++r) { dd[r][2 * q] = a2[r][0]; dd[r][2 * q + 1] = a2[r][1]; asm volatile("" : "+v"(dd[r][2 * q]), "+v"(dd[r][2 * q + 1])); }
            asm volatile("" ::: "memory"); }
#pragma unroll
        for (int ks = 2; ks < 4; ++ks)
#pragma unroll
            for (int nt = 0; nt < 3; ++nt) Bp[ks][nt] = *(const bf16x8*)(pw + (size_t)((3 * w + nt) * 16 + fr) * DCV + ks * 32 + 8 * fq);
        LDS_BARRIER();
        f32x2 g2[3], bt2[3];
#pragma unroll
        for (int q = 0; q < 3; ++q) { g2[q] = *(const f32x2*)(lg + 128 * q + 2 * lane); bt2[q] = *(const f32x2*)(lb + 128 * q + 2 * lane); }
        TP_END(4); TP_BEGIN(5);
#pragma unroll
        for (int r = 0; r < 8; ++r) { float s = 0.f, v = 0.f;
#pragma unroll
            for (int nt = 0; nt < 3; ++nt) Bq[r][nt] = *(const bf16x8*)(pw + (size_t)((3 * w + nt) * 16 + fr) * DCV + (4 + r) * 32 + 8 * fq);
#pragma unroll
            for (int q = 0; q < 6; ++q) { s += dd[r][q]; v += dd[r][q] * dd[r][q]; }
            const float mu = wave_sum(s) * (1.0f / DCV), ex2 = wave_sum(v) * (1.0f / DCV);
#pragma unroll
            for (int q = 0; q < 6; ++q) dd[r][q] -= mu;
            const float rs = 1.0f / sqrtf(fmaxf(ex2 - mu * mu, 0.f) + EPS);
#pragma unroll
            for (int q = 0; q < 3; ++q) { float y0 = dd[r][2 * q] * rs * g2[q][0] + bt2[q][0], y1 = dd[r][2 * q + 1] * rs * g2[q][1] + bt2[q][1]; y0 *= fast_sigmoid(y0); y1 *= fast_sigmoid(y1);
                *(LAS unsigned*)(lds + TT + (8 * w + r) * TST + (128 * q + 2 * lane) * 2) = cvt_pk_bf16(y0, y1); } } }
      LDS_BARRIER();
      TP_END(5); TP_BEGIN(6);
      for (int crep = 0; crep < 1 + ((CONV_REP >> 2) & 1); ++crep) { f32x4 acc[4][3];
#pragma unroll
        for (int a = 0; a < 4; ++a)
#pragma unroll
            for (int b = 0; b < 3; ++b) acc[a][b] = (f32x4){0.f, 0.f, 0.f, 0.f};
        const f32x4* pb4 = (const f32x4*)(in[13] + layer * DCV); f32x4 pbv[3];
#pragma unroll
        for (int nt = 0; nt < 3; ++nt) pbv[nt] = pb4[(3 * w + nt) * 4 + fq];
#pragma unroll
        for (int ks = 0; ks < 12; ++ks) { bf16x8 A[4];
#pragma unroll
            for (int mt = 0; mt < 4; ++mt) A[mt] = *(const LAS bf16x8*)(lds + TT + (mt * 16 + fr) * TST + (ks * 32 + 8 * fq) * 2);
#pragma unroll
            for (int mt = 0; mt < 4; ++mt)
#pragma unroll
                for (int nt = 0; nt < 3; ++nt) acc[mt][nt] = __builtin_amdgcn_mfma_f32_16x16x32_bf16(ks < 4 ? Bp[ks & 3][nt] : Bq[(ks - 4) & 7][nt], A[mt], acc[mt][nt], 0, 0, 0); }
#pragma unroll
        for (int mt = 0; mt < 4; ++mt)
#pragma unroll
            for (int nt = 0; nt < 3; ++nt) { const int t = r0 + mt * 16 + fr, n4 = (3 * w + nt) * 16 + 4 * fq; const f32x4 v = acc[mt][nt] + pbv[nt];
                u32x2 o; o.x = cvt_pk_bf16(v[0], v[1]); o.y = cvt_pk_bf16(v[2], v[3]); if (WT_MASK & 1) st8_wt(Y, (unsigned)((t * D + 640 + n4) * 2), o); else *(u32x2*)(Y + (size_t)t * D + 640 + n4) = o; } }
      LDS_BARRIER(); }
    TP_END(6); TP_END(7);
#undef GM_LOADS
#undef CV_LOADS
    if (MIX_CVT >= 4) { tr_store(cja, cva, nullptr, lane, 0); tr_store(cjb, cvb, nullptr, lane, 0); }
}

__device__ __forceinline__ void router_phase(Frame& F) {
    LAS unsigned char* lds = F.lds; int lane = lane_id_v(); asm volatile("" : "+v"(lane)); const int w = F.wave; unsigned char* ws = F.ws;
    const InTab in = in_tab(F); const bf16* XBr = (const bf16*)(ws + WS_XB); const float* g2 = in[15] + D; const float* R = in[19];
    unsigned* rowoff = (unsigned*)(ws + WS_ROWOFF); float* rs_e = (float*)(ws + WS_RS); float* gate_e = (float*)(ws + WS_GATE); int* sel = (int*)(ws + WS_SEL);
    constexpr float KC1 = -1.4426950408889634f / W8_GU, KC2 = 1.0f / (W8_GU * W8_GU);
    unsigned* cnt = F.ctl + CW_CNT;
    LAS int* se0 = (LAS int*)lds; LAS int* se1 = se0 + 64; LAS float* sw0 = (LAS float*)(se1 + 64); LAS float* sw1 = sw0 + 64; LAS float* srs = sw1 + 64;
    f32x2 Rg[4][4][4];
#pragma unroll
    for (int j = 0; j < 4; ++j)
#pragma unroll
        for (int q = 0; q < 4; ++q) { const int k = 8 * lane + 512 * (j >> 1) + 4 * (j & 1) + q; const float gk = g2[k]; const f32x4 a = *(const f32x4*)(R + k * 8), b = *(const f32x4*)(R + k * 8 + 4);
            Rg[j][q][0] = (f32x2){a[0] * gk, a[1] * gk}; Rg[j][q][1] = (f32x2){a[2] * gk, a[3] * gk}; Rg[j][q][2] = (f32x2){b[0] * gk, b[1] * gk}; Rg[j][q][3] = (f32x2){b[2] * gk, b[3] * gk}; }
    for (int b = F.vcu; b < M / 64; b += F.G) {
        f32x4 cva[10], cvb[10]; TrJob cja, cjb; const int cvi = R9_BEG + b * 8 + w;
        if (R9_CVT >= 2) { cja = tr_decode(in, ws, cvi); tr_load(cja, cva, lane, 0); cjb = tr_decode(in, ws, cvi + (M / 64) * 8); tr_load(cjb, cvb, lane, 0); }
        float mle[8], mss = 1.0f;
#pragma unroll
        for (int e = 0; e < 8; ++e) mle[e] = 0.f;
        for (int i = 0; i < 8; ++i) { const int tl = 8 * w + i, t = 64 * b + tl; const u32x4* xr = (const u32x4*)(XBr + (size_t)t * D) + lane; float ss = 0.f, le[8]; f32x2 le2[4];
#pragma unroll
            for (int e = 0; e < 4; ++e) le2[e] = (f32x2){0.f, 0.f};
            const u32x4 xa = xr[0], xb2 = xr[64]; u32x2 qa, qb;
#pragma unroll
            for (int j = 0; j < 4; ++j) { const u32x4 xw = (j < 2) ? xa : xb2; const unsigned w0_ = (j & 1) ? xw.z : xw.x, w1_ = (j & 1) ? xw.w : xw.y; const f32x4 v = (f32x4){bf_lo(w0_), bf_hi(w0_), bf_lo(w1_), bf_hi(w1_)};
#pragma unroll
                for (int q = 0; q < 4; ++q) { ss += v[q] * v[q]; const f32x2 vv = (f32x2){v[q], v[q]};
#pragma unroll
                    for (int e = 0; e < 4; ++e) le2[e] = __builtin_elementwise_fma(vv, Rg[j][q][e], le2[e]); }
                const unsigned p8 = cvt4_fp8(v[0], v[1], v[2], v[3]); if (j == 0) qa.x = p8; else if (j == 1) qa.y = p8; else if (j == 2) qb.x = p8; else qb.y = p8; }
            { u32x2* xq = (u32x2*)(ws + WS_XQ + (size_t)t * D) + lane; xq[0] = qa; xq[64] = qb; }
            ss = wave_sum(ss);
#pragma unroll
            for (int e = 0; e < 4; ++e) { le[2 * e] = wave_sum(le2[e][0]); le[2 * e + 1] = wave_sum(le2[e][1]); }
            { const bool mine = (lane == i); mss = mine ? ss : mss;
#pragma unroll
              for (int e = 0; e < 8; ++e) mle[e] = mine ? le[e] : mle[e]; } }
        { const float rs = 1.0f / sqrtf(mss * (1.0f / D) + EPS);
          int i0 = 0; float l0 = mle[0];
#pragma unroll
          for (int e = 1; e < 8; ++e) if (mle[e] > l0) { l0 = mle[e]; i0 = e; }
          int i1 = -1; float l1 = -3.0e38f;
#pragma unroll
          for (int e = 0; e < 8; ++e) if (e != i0 && mle[e] > l1) { l1 = mle[e]; i1 = e; }
          const float ex = expf((l1 - l0) * rs), w0 = 1.0f / (1.0f + ex), w1 = ex / (1.0f + ex);
          if (lane < 8) { const int tl = 8 * w + lane; se0[tl] = i0; se1[tl] = i1; sw0[tl] = w0; sw1[tl] = w1; srs[tl] = rs; } }
        __syncthreads();
        if (w == 0) { const int e0 = se0[lane], e1 = se1[lane]; int r0 = 0, r1 = 0; const unsigned long long lt = (1ull << lane) - 1ull;
            int l0 = 0, l1 = 0, nmine = 0;
#pragma unroll
            for (int e = 0; e < 8; ++e) { const unsigned long long m0 = __ballot(e0 == e), m1 = __ballot(e1 == e); const int n0 = __popcll(m0), n = n0 + __popcll(m1);
                if (e0 == e) l0 = __popcll(m0 & lt);
                if (e1 == e) l1 = n0 + __popcll(m1 & lt);
                nmine = (lane == e) ? n : nmine; }
            unsigned base = 0u;
            if (lane < 8 && nmine > 0) base = __hip_atomic_fetch_add(cnt + 64 * lane, (unsigned)nmine, RLX_AGENT);
            r0 = (int)__shfl(base, e0) + l0; r1 = (int)__shfl(base, e1) + l1;
            const int t = 64 * b + lane; const float rs = srs[lane];
            rowoff[e0 * ECAP + r0] = (unsigned)t * (unsigned)D; rs_e[e0 * ECAP + r0] = rs * KC1; gate_e[e0 * ECAP + r0] = rs * rs * KC2 * sw0[lane];
            rowoff[e1 * ECAP + r1] = (unsigned)t * (unsigned)D; rs_e[e1 * ECAP + r1] = rs * KC1; gate_e[e1 * ECAP + r1] = rs * rs * KC2 * sw1[lane];
            *(int4*)(sel + 4 * t) = make_int4(e0, r0, e1, r1); }
        if (R9_CVT >= 2) { tr_store(cja, cva, nullptr, lane, 0); tr_store(cjb, cvb, nullptr, lane, 0); }
        __syncthreads();
    }
}
#ifndef PB_CACHE
#define PB_CACHE 1
#endif
__device__ __forceinline__ void moe_panels(Frame& F, int (&pb)[9], int keep = 1) {
    if (!keep && MK_PER_PHASE == 0 && PB_CACHE) {
#pragma unroll
        for (int e = 0; e < 9; ++e) pb[e] = __builtin_amdgcn_readfirstlane((int)F.MISC[16 + e]);
        return; }
    unsigned* cnt = F.ctl + CW_CNT; pb[0] = 0;
#pragma unroll
    for (int e = 0; e < 8; ++e) { const unsigned c = (unsigned)__builtin_amdgcn_readfirstlane(__hip_atomic_load(cnt + 64 * e, RLX_AGENT)); pb[e + 1] = pb[e] + (int)((c + 255u) >> 8); }
    if (MK_PER_PHASE == 0 && PB_CACHE) { if (F.wave == 0 && lane_id_v() == 0) {
#pragma unroll
            for (int e = 0; e < 9; ++e) F.MISC[16 + e] = (unsigned)pb[e]; }
        __syncthreads(); }
}
__device__ __forceinline__ void final_phase(Frame& F) {
    int pb[9]; moe_panels(F, pb, 0);
    const int total = pb[8] * 4, nfull = (total / F.G) * F.G, NPf = nfull / 4, sp = pg8::moe_split(total - nfull, F.G); const bf16* slabs = (const bf16*)(F.ws + WS_SLAB);
    int lane = lane_id_v(); asm volatile("" : "+v"(lane));
    const int gw = F.vcu * 8 + F.wave, NGW = F.G * 8; unsigned char* ws = F.ws;
    const bf16* YP = (const bf16*)(ws + WS_YP); const int* sel = (const int*)(ws + WS_SEL); const float* fg = in_tab(F)[23]; float* X = F.out; const bf16* XBf = (const bf16*)(ws + WS_XB2);
    f32x4 g4[4];
#pragma unroll
    for (int j = 0; j < 4; ++j) g4[j] = *((const f32x4*)fg + lane + 64 * j);
    for (int t = gw; t < M; t += NGW) { const int4 s = *(const int4*)(sel + 4 * t); int b0 = 0, b1 = 0;
#pragma unroll
        for (int e = 0; e < 8; ++e) { b0 = (s.x == e) ? pb[e] : b0; b1 = (s.z == e) ? pb[e] : b1; }
        const int pr[2] = {256 * b0 + s.y, 256 * b1 + s.w};
        const u32x2* xr = (const u32x2*)(XBf + (size_t)t * D) + lane;
        f32x4 v[4];
#pragma unroll
        for (int j = 0; j < 4; ++j) { const u32x2 a = xr[64 * j]; v[j] = (f32x4){bf_lo(a.x), bf_hi(a.x), bf_lo(a.y), bf_hi(a.y)}; }
#pragma unroll
        for (int k = 0; k < 2; ++k) { const int pm = pr[k] >> 8, lr = pr[k] & 255;
            if (sp > 1 && pm >= NPf) {
#pragma unroll
                for (int j = 0; j < 4; ++j) { const bf16* sb = slabs + (size_t)(((pm - NPf) * 4 + j) * sp) * 65536 + lr * 256 + 4 * lane; u32x2 a[14];
#pragma unroll
                    for (int ks = 0; ks < 14; ++ks) { a[ks] = (u32x2){0u, 0u}; if (ks < sp) a[ks] = *(const u32x2*)(sb + (size_t)ks * 65536); }
#pragma unroll
                    for (int ks = 0; ks < 14; ++ks) { v[j][0] += bf_lo(a[ks].x); v[j][1] += bf_hi(a[ks].x); v[j][2] += bf_lo(a[ks].y); v[j][3] += bf_hi(a[ks].y); } }
            } else { const u32x2* y = (const u32x2*)(YP + (size_t)pr[k] * D) + lane;
#pragma unroll
                for (int j = 0; j < 4; ++j) { const u32x2 a = __builtin_nontemporal_load(y + 64 * j); v[j][0] += bf_lo(a.x); v[j][1] += bf_hi(a.x); v[j][2] += bf_lo(a.y); v[j][3] += bf_hi(a.y); } } }
        float ss = 0.f;
#pragma unroll
        for (int j = 0; j < 4; ++j) ss += (v[j][0] * v[j][0] + v[j][1] * v[j][1]) + (v[j][2] * v[j][2] + v[j][3] * v[j][3]);
        ss = wave_sum(ss); const float rs = 1.0f / sqrtf(ss * (1.0f / D) + EPS);
        f32x4* o = (f32x4*)(X + (size_t)t * D) + lane;
#pragma unroll
        for (int j = 0; j < 4; ++j) __builtin_nontemporal_store(v[j] * rs * g4[j], o + 64 * j); }
}

template <class Sched> __device__ __forceinline__ void stage_rstd(Frame& F, const Sched& S, const float* ssq, LAS float* rtab) {
    pg8::Unit u; int tid = (F.wave * 64 + lane_id_v()); asm volatile("" : "+v"(tid)); __syncthreads();
#pragma unroll 1
    for (int i = 0; i < 8 && S.next(i, u); ++i) if (tid < 256) rtab[i * 256 + tid] = pg8::rstd_of(ssq, u.pm * 256 + tid);
    __syncthreads();
}
#ifndef DENSE_F8
#define DENSE_F8 1
#endif
__device__ __forceinline__ int opq(int x) { asm volatile("" : "+s"(x)); return x; }
struct Args { const float* in[24]; float* out; unsigned char* ws; int ph_lo, ph_hi, li, pad; };
__global__ void __launch_bounds__(512, 2) fwd(Args args) {
    Frame F;
    F.lds = (LAS unsigned char*)lds_raw; F.MISC = (volatile LAS unsigned*)(F.lds + MISC_OFF);
    F.wave = __builtin_amdgcn_readfirstlane((int)threadIdx.x >> 6);
    F.G = gridDim.x; { const int bx = blockIdx.x; F.vcu = (F.G % 8 == 0) ? (bx % 8) * (F.G / 8) + bx / 8 : bx; }
    F.in.t = (const LAS unsigned long long*)(F.lds + INTAB_OFF); F.out = args.out; F.ws = args.ws; F.ctl = (unsigned*)(args.ws + WS_CTL);
    for (int u = (F.wave * 64 + lane_id_v()); u < 64; u += 512) ((LAS unsigned*)(F.lds + MISC_OFF))[u] = 0u;
    if ((F.wave * 64 + lane_id_v()) < 24) ((LAS unsigned long long*)(F.lds + INTAB_OFF))[(F.wave * 64 + lane_id_v())] = (unsigned long long)args.in[(F.wave * 64 + lane_id_v())];
    __syncthreads();
    jobs_setup(F);
    XcdBarrier bar = xcd_barrier_post(F.ctl + CW_BAR + args.li * XCD_BAR_WORDS, F.MISC + 8, F.wave);
    const int lo = MK_PER_PHASE ? args.ph_lo : 0, hi = MK_PER_PHASE ? args.ph_hi : NPHASE;
#ifndef PH_MASK
#define PH_MASK 0xFFFF
#endif
#define PH_ON(k) (((PH_MASK) >> (k)) & 1)
#ifndef REP_MASK
#define REP_MASK 0
#endif
#define REPS(k) (1 + (((REP_MASK) >> (k)) & 1))
#ifndef PRO_PROBE
#define PRO_PROBE 0
#endif
#ifndef CVT_BEFORE
#define CVT_BEFORE 0
#endif
#ifndef EPI_PROBE
#define EPI_PROBE 0
#endif
#define IN(k) (lo <= (k) && (k) < hi)
#define SEAM(k) do { if (IN(k) && IN((k) + 1)) xcd_barrier(bar); } while (0)
#define SEAMH(k, first) do { if (IN(k) && IN((k) + 1)) xcd_barrier_host(bar, F, (first)); } while (0)
    unsigned char* ws = args.ws; LAS unsigned* gtab = (LAS unsigned*)(F.lds + GTAB_OFF);
    bf16* XB = (bf16*)(ws + WS_XB); float* ssq = (float*)(ws + WS_SSQ);
    if (F.G != 256) return;

    if (PH_ON(0) && IN(0)) for (int rep = 0; rep < REPS(0); ++rep) { p0_prologue(F, rep == 0 ? 0 : PRO_PROBE); __syncthreads(); }
    SEAMH(0, 0);
#pragma unroll 1
    for (int layer = 0; layer < 2; ++layer) {
        const int pbase = 1 + layer * 5;
        if (PH_ON(1) && IN(pbase)) for (int rep = 0; rep < REPS(1); ++rep) { pg8::Gemm g{XB, (const bf16*)(ws + WS_WIN) + (size_t)opq(layer) * DIN * D, D, 0}; pg8::StaticOrder S; S.init(M, DIN, F.G, (int)blockIdx.x);
            pg8::EpiP E{(bf16*)(ws + WS_P), DIN, (const LAS float*)gtab}; auto hk = [&]() { stage_rstd(F, S, ssq, (LAS float*)gtab); };
            pg8::gemm_phase<pg8::EpiP, pg8::StaticOrder, true, true, false, decltype(hk)>(F.lds, gtab, g, S, E, F.wave, hk);
            if (rep == 0) tail_convert(F, opq(layer) ? H6_BEG : H1_BEG, H1_N, (int)blockIdx.x - 192, 64); }
        SEAMH(pbase, opq(layer) == 0 ? 1 : -1);
        if (PH_ON(2) && IN(pbase + 1)) for (int rep = 0; rep < REPS(2); ++rep) { for (int u = F.vcu; u < M / 64; u += F.G) mixer_unit(F, u, opq(layer), 0); }
        SEAMH(pbase + 1, opq(layer) == 0 ? 2 : -1);
        if (PH_ON(3) && IN(pbase + 2)) for (int rep = 0; rep < (layer == 0 ? REPS(3) : 1); ++rep) { pg8::Gemm g{(const bf16*)(ws + WS_Y), (const bf16*)(ws + WS_WOUT) + (size_t)opq(layer) * D * D, D, 0}; pg8::StaticOrder S; S.init(M, D, F.G, (int)blockIdx.x);
            pg8::EpiResid E{(const float*)nullptr, XB, ssq, 1.0f}; pg8::gemm_phase<pg8::EpiResid, pg8::StaticOrder, false, true>(F.lds, gtab, g, S, E, F.wave); }
        SEAMH(pbase + 2, opq(layer) == 0 ? 3 : -1);
        if (layer == 0) {
            if (PH_ON(4) && IN(4)) for (int rep = 0; rep < REPS(4); ++rep) { pg8::Gemm g{XB, (const bf16*)(ws + WS_WGU), D, 0}; pg8::StaticOrder S; S.init(M, NGU, F.G, (int)blockIdx.x);
                pg8::EpiSwiglu<false, DENSE_F8 != 0> E{(bf16*)(ws + WS_ACT), DFF, (const LAS float*)gtab, 0, 1.0f}; auto hk = [&]() { stage_rstd(F, S, ssq, (LAS float*)gtab); };
                pg8::gemm_phase<pg8::EpiSwiglu<false, DENSE_F8 != 0>, pg8::StaticOrder, true, true, false, decltype(hk)>(F.lds, gtab, g, S, E, F.wave, hk);
                if (rep == 0) tail_convert(F, H4_BEG, H4_N, (int)blockIdx.x - 128, 128); }
            SEAMH(4, 4);
            if (PH_ON(5) && IN(5)) { pg8::Gemm g{(const bf16*)(ws + WS_ACT), (const bf16*)(ws + WS_WD), DENSE_F8 ? DFF / 2 : DFF, 0}; pg8::StaticOrder S; S.init(M, D, F.G, (int)blockIdx.x);
                pg8::EpiResid E{(const float*)nullptr, XB, ssq, DENSE_F8 ? 1.0f / W8_D : 1.0f}; pg8::gemm_phase<pg8::EpiResid, pg8::StaticOrder, false, true, DENSE_F8 != 0>(F.lds, gtab, g, S, E, F.wave); }
            SEAMH(5, 5);
        }
    }
    if (PH_ON(9) && IN(9)) router_phase(F);
    SEAM(9);
#ifndef STAGGER_US
#define STAGGER_US 0
#endif
    if (PH_ON(10) && IN(10)) for (int rep = 0; rep < REPS(10); ++rep) {
        if (STAGGER_US > 0 && (blockIdx.x & 1)) { const unsigned long long t0 = __builtin_amdgcn_s_memrealtime(); while (__builtin_amdgcn_s_memrealtime() - t0 < (unsigned long long)(STAGGER_US * 100)) __builtin_amdgcn_s_sleep(8); __syncthreads(); }
        pg8::MoeOrderGather S; moe_panels(F, S.pb); S.nN = NGUE / 256; S.nwg = S.pb[8] * S.nN; S.G = F.G; S.c = (int)blockIdx.x; S.rowoff = (const unsigned*)(ws + WS_ROWOFF); S.rs_e = (const float*)(ws + WS_RS); S.gate_e = (const float*)(ws + WS_GATE);
        pg8::Gemm g{(const bf16*)(ws + WS_XQ), (const bf16*)(ws + WS_MOE_WGU), D / 2, (size_t)NGUE * D / 2};
        pg8::EpiSwiglu<true> E{(bf16*)(ws + WS_ACTM), DFE, (const LAS float*)(gtab + 512), rep == 0 ? 0 : EPI_PROBE, 1.0f / W8_GU};
        pg8::gemm_phase<pg8::EpiSwiglu<true>, pg8::MoeOrderGather, true, true, true>(F.lds, gtab, g, S, E, F.wave);
        if (rep == 0) { const int rem = S.nwg % F.G, idle = rem ? F.G - rem : 0, nconv = idle < 48 ? F.G : (idle > 192 ? 192 : idle);
            tail_convert(F, H10_BEG, H10_N, ((int)blockIdx.x - rem + F.G) % F.G, nconv, false); } }
    SEAM(10);
    if (PH_ON(11) && IN(11)) for (int rep = 0; rep < REPS(11); ++rep) { pg8::MoeOrderDown S; moe_panels(F, S.pb, 0); S.init(F.G, (int)blockIdx.x);
        pg8::Gemm g{(const bf16*)(ws + WS_ACTM), (const bf16*)(ws + WS_MOE_WD), DFE / 2, (size_t)D * DFE / 2};
        pg8::EpiBf16 E{(bf16*)(ws + WS_YP), D, (bf16*)(ws + WS_SLAB), 1.0f / W8_D};
        pg8::gemm_phase<pg8::EpiBf16, pg8::MoeOrderDown, true, true, true>(F.lds, gtab, g, S, E, F.wave); }
    SEAM(11);
    if (PH_ON(12) && IN(12)) final_phase(F);
#undef IN
#undef SEAM
}
#ifndef MK_PER_PHASE
#define MK_PER_PHASE 0
#endif
extern "C" void kernel_launch(void* const* d_in, const int* in_sizes, int n_in, void* d_out, int out_size, void* d_ws, size_t ws_size, hipStream_t stream) {
    static int grid = 0;
    if (grid == 0) {
        if (n_in != 24 || out_size != M * D || ws_size < WS_END) { fprintf(stderr, "kernel_launch: unexpected shapes (n_in %d out %d ws %zu)\n", n_in, out_size, ws_size); grid = -1; return; }
        int dev = 0, cus = 0;
        if (hipGetDevice(&dev) != hipSuccess || hipDeviceGetAttribute(&cus, hipDeviceAttributeMultiprocessorCount, dev) != hipSuccess) { grid = -1; return; }
        if (hipFuncSetAttribute((const void*)fwd, hipFuncAttributeMaxDynamicSharedMemorySize, LDS_BYTES) != hipSuccess) { fprintf(stderr, "kernel_launch: hipFuncSetAttribute failed\n"); grid = -1; return; }
        int per_cu = 0;
        if (hipOccupancyMaxActiveBlocksPerMultiprocessor(&per_cu, (const void*)fwd, 512, LDS_BYTES) != hipSuccess || per_cu < 1) fprintf(stderr, "kernel_launch: occupancy query says %d\n", per_cu);
        (void)hipGetLastError();
        grid = cus;
        if (grid != 256) { fprintf(stderr, "kernel_launch: built for 256 CUs, found %d\n", grid); grid = -1; return; }
    }
    if (grid < 0) return;
    (void)hipMemsetAsync((char*)d_ws + WS_CTL, 0, CTL_ZERO_BYTES, stream);
    Args a{};
    for (int i = 0; i < 24; ++i) a.in[i] = (const float*)d_in[i];
    a.out = (float*)d_out; a.ws = (unsigned char*)d_ws; a.pad = 0;
#if MK_PER_PHASE
    for (int p = 0; p < NPHASE; ++p) { a.ph_lo = p; a.ph_hi = p + 1; a.li = p; hipLaunchKernelGGL(fwd, dim3(grid), dim3(512), LDS_BYTES, stream, a); }
#else
    a.ph_lo = 0; a.ph_hi = NPHASE; a.li = 0; hipLaunchKernelGGL(fwd, dim3(grid), dim3(512), LDS_BYTES, stream, a);
#endif
}
```
